# Optimizing an MI355X kernel written in HIP

```python
import jax, jax.numpy as jnp
from jax import lax
import numpy as np

D_MODEL = 2048
BATCH = 2
SEQ = 8192
DEPTH = 1

PLE_DIM = 256
NORM_EPS = 1e-6
ATT_HEADS = 8
ATT_HEAD_DIM = 128
ATT_WIDTH = ATT_HEADS * ATT_HEAD_DIM
MOBA_BLOCK = 256
MOBA_TOPK = 3
MOBA_Q_CHUNK = 64
SGU_GROUPS = 8
SGU_GROUP_DIM = 128
SGU_WIDTH = SGU_GROUPS * SGU_GROUP_DIM
SGU_CHUNK = 128
PEER_HEADS = 8
PEER_N_KEYS = 128
PEER_N_EXPERTS = PEER_N_KEYS * PEER_N_KEYS
PEER_D_KEY = 256
PEER_HALF = PEER_D_KEY // 2
PEER_TOPK = 16
PEER_TOKEN_CHUNK = 128
IN_WIDTHS = (ATT_WIDTH, ATT_WIDTH, ATT_WIDTH, SGU_WIDTH, SGU_WIDTH, D_MODEL, D_MODEL)
IN_SPLITS = tuple(int(s) for s in np.cumsum(IN_WIDTHS)[:-1])
IN_TOTAL = int(sum(IN_WIDTHS))

kernel_name = "hybrid_moba_gmlp_peer_ple"


def rms_norm(x, gain):
    xf = x.astype(jnp.float32)
    y = xf * lax.rsqrt(jnp.mean(xf * xf, axis=-1, keepdims=True) + NORM_EPS)
    return (y * gain.astype(jnp.float32)).astype(x.dtype)


def layer_norm(x, gain, bias):
    xf = x.astype(jnp.float32)
    mu = jnp.mean(xf, axis=-1, keepdims=True)
    xc = xf - mu
    y = xc * lax.rsqrt(jnp.mean(xc * xc, axis=-1, keepdims=True) + NORM_EPS)
    return (y * gain.astype(jnp.float32) + bias.astype(jnp.float32)).astype(x.dtype)


def moba_attention(q, k, v):
    b, s, h, dh = q.shape
    nb = -(-s // MOBA_BLOCK)
    s_pad = nb * MOBA_BLOCK
    pad = ((0, 0), (0, s_pad - s), (0, 0), (0, 0))
    q, k, v = [jnp.pad(t, pad).transpose(0, 2, 1, 3) for t in (q, k, v)]
    kb = k.reshape(b, h, nb, MOBA_BLOCK, dh)
    vb = v.reshape(b, h, nb, MOBA_BLOCK, dh)
    k_mean = jnp.mean(kb.astype(jnp.float32), axis=3)
    n_sel = min(MOBA_TOPK, nb)
    n_chunks = s_pad // MOBA_Q_CHUNK
    scale = dh ** -0.5
    bi = jnp.arange(b)[:, None, None, None]
    hi = jnp.arange(h)[None, :, None, None]
    sel_len = n_sel * MOBA_BLOCK

    def chunk_fn(c):
        q0 = c * MOBA_Q_CHUNK
        j = q0 // MOBA_BLOCK
        qc = lax.dynamic_slice_in_dim(q, q0, MOBA_Q_CHUNK, axis=2)
        gate = jnp.einsum('bhqd,bhnd->bhqn', qc.astype(jnp.float32), k_mean)
        gate = jnp.where(jnp.arange(nb) < j, gate, -jnp.inf)
        _, sel = lax.top_k(gate, n_sel)
        sel_valid = jnp.arange(n_sel) < j
        ks = kb[bi, hi, sel]
        vs = vb[bi, hi, sel]
        s_sel = jnp.einsum('bhqd,bhqnkd->bhqnk', qc, ks).astype(jnp.float32) * scale
        s_sel = jnp.where(sel_valid[:, None], s_sel, -jnp.inf).reshape(b, h, MOBA_Q_CHUNK, sel_len)
        k_own = lax.dynamic_slice_in_dim(kb, j, 1, axis=2)[:, :, 0]
        v_own = lax.dynamic_slice_in_dim(vb, j, 1, axis=2)[:, :, 0]
        s_own = jnp.einsum('bhqd,bhkd->bhqk', qc, k_own).astype(jnp.float32) * scale
        q_pos = q0 + jnp.arange(MOBA_Q_CHUNK)
        k_pos = j * MOBA_BLOCK + jnp.arange(MOBA_BLOCK)
        s_own = jnp.where(k_pos[None, :] <= q_pos[:, None], s_own, -jnp.inf)
        probs = jax.nn.softmax(jnp.concatenate([s_sel, s_own], axis=-1), axis=-1)
        p_sel = probs[..., :sel_len].reshape(b, h, MOBA_Q_CHUNK, n_sel, MOBA_BLOCK).astype(vb.dtype)
        p_own = probs[..., sel_len:].astype(vb.dtype)
        return (jnp.einsum('bhqnk,bhqnkd->bhqd', p_sel, vs)
                + jnp.einsum('bhqk,bhkd->bhqd', p_own, v_own))

    outs = lax.map(chunk_fn, jnp.arange(n_chunks))
    out = outs.transpose(1, 0, 3, 2, 4).reshape(b, s_pad, h, dh)
    return out[:, :s]


def spatial_gating(u, vg, ln_g, ln_b, w_s, b_s):
    b, s, _ = u.shape
    vg = layer_norm(vg, ln_g, ln_b)
    nc = s // SGU_CHUNK
    vr = vg.reshape(b, nc, SGU_CHUNK, SGU_GROUPS, SGU_GROUP_DIM)
    causal = jnp.tril(jnp.ones((SGU_CHUNK, SGU_CHUNK), dtype=bool))
    w = jnp.where(causal[None], w_s, jnp.zeros_like(w_s))
    mixed = jnp.einsum('gts,bnsgc->bntgc', w, vr) + b_s.T[:, :, None]
    return u * mixed.reshape(b, s, SGU_WIDTH)


def peer(x, w_query, sub_keys, expert_down, expert_up):
    b, s, d = x.shape
    t = b * s
    xf = x.reshape(t, d)
    q = (xf @ w_query).reshape(t, PEER_HEADS, 2, PEER_HALF)
    scores = jnp.einsum('thpk,hpnk->thpn', q, sub_keys).astype(jnp.float32)
    top_s, top_i = lax.top_k(scores, PEER_TOPK)
    cand = top_s[:, :, 0, :, None] + top_s[:, :, 1, None, :]
    cand_id = top_i[:, :, 0, :, None] * PEER_N_KEYS + top_i[:, :, 1, None, :]
    n_cand = PEER_TOPK * PEER_TOPK
    best_s, best_pos = lax.top_k(cand.reshape(t, PEER_HEADS, n_cand), PEER_TOPK)
    expert_id = jnp.take_along_axis(cand_id.reshape(t, PEER_HEADS, n_cand), best_pos, axis=-1)
    gates = jax.nn.softmax(best_s, axis=-1).astype(x.dtype)
    n_e = PEER_HEADS * PEER_TOPK
    nch = t // PEER_TOKEN_CHUNK

    def chunk_fn(args):
        xc, idc, gc = args
        u = expert_down[idc]
        v = expert_up[idc]
        hid = jax.nn.gelu(jnp.einsum('cd,ced->ce', xc, u), approximate=False)
        return jnp.einsum('ce,ced->cd', gc * hid, v)

    y = lax.map(chunk_fn, (xf.reshape(nch, PEER_TOKEN_CHUNK, d),
                           expert_id.reshape(nch, PEER_TOKEN_CHUNK, n_e),
                           gates.reshape(nch, PEER_TOKEN_CHUNK, n_e)))
    return y.reshape(b, s, d)


def setup_inputs(seed: int = 0) -> dict:
    key = jax.random.key(seed)
    ks = jax.random.split(key, 24)
    f32 = jnp.float32
    L, D = DEPTH, D_MODEL

    def nrm(k, shape, scale):
        return jax.random.normal(k, shape, f32) * scale

    def gain(k, shape):
        return 1.0 + 0.02 * jax.random.normal(k, shape, f32)

    return {
        "x": jax.random.normal(ks[0], (BATCH, SEQ, D), f32),
        "p": jax.random.normal(ks[1], (DEPTH, BATCH, SEQ, PLE_DIM), f32),
        "norm_mix_g": gain(ks[2], (L, D)),
        "w_in": nrm(ks[3], (L, D, IN_TOTAL), D ** -0.5),
        "sgu_ln_g": gain(ks[4], (L, SGU_WIDTH)),
        "sgu_ln_b": nrm(ks[5], (L, SGU_WIDTH), 0.02),
        "sgu_w": nrm(ks[6], (L, SGU_GROUPS, SGU_CHUNK, SGU_CHUNK), SGU_CHUNK ** -0.5),
        "sgu_b": gain(ks[7], (L, SGU_GROUPS, SGU_CHUNK)),
        "w_branch_attn": nrm(ks[8], (L, ATT_WIDTH, D), ATT_WIDTH ** -0.5),
        "w_branch_sgu": nrm(ks[9], (L, SGU_WIDTH, D), SGU_WIDTH ** -0.5),
        "w_out": nrm(ks[10], (L, D, D), D ** -0.5),
        "norm_ffn_g": gain(ks[11], (L, D)),
        "peer_w_query": nrm(ks[12], (L, D, PEER_HEADS * PEER_D_KEY), D ** -0.5),
        "peer_sub_keys": nrm(ks[13], (L, PEER_HEADS, 2, PEER_N_KEYS, PEER_HALF), PEER_HALF ** -0.5),
        "peer_down": nrm(ks[14], (L, PEER_N_EXPERTS, D), D ** -0.5),
        "peer_up": nrm(ks[15], (L, PEER_N_EXPERTS, D), PEER_HEADS ** -0.5),
        "norm_ple_g": gain(ks[16], (L, D)),
        "ple_w_proj": nrm(ks[17], (L, PLE_DIM, D), PLE_DIM ** -0.5),
        "ple_w_gate": nrm(ks[18], (L, D, D), D ** -0.5),
        "final_norm_g": gain(ks[19], (D,)),
    }


def reference(x, p, norm_mix_g, w_in, sgu_ln_g, sgu_ln_b, sgu_w, sgu_b, w_branch_attn, w_branch_sgu,
              w_out, norm_ffn_g, peer_w_query, peer_sub_keys, peer_down, peer_up, norm_ple_g,
              ple_w_proj, ple_w_gate, final_norm_g):
    b, s, _ = x.shape
    h = x
    for i in range(DEPTH):
        xn = rms_norm(h, norm_mix_g[i])
        proj = xn @ w_in[i]
        q, k, v, u, vg, g_a, g_b = jnp.split(proj, IN_SPLITS, axis=-1)
        q = q.reshape(b, s, ATT_HEADS, ATT_HEAD_DIM)
        k = k.reshape(b, s, ATT_HEADS, ATT_HEAD_DIM)
        v = v.reshape(b, s, ATT_HEADS, ATT_HEAD_DIM)
        y_att = moba_attention(q, k, v).reshape(b, s, ATT_WIDTH)
        y_sgu = spatial_gating(jax.nn.gelu(u, approximate=False), jax.nn.gelu(vg, approximate=False),
                               sgu_ln_g[i], sgu_ln_b[i], sgu_w[i], sgu_b[i])
        merged = (jax.nn.sigmoid(g_a) * (y_att @ w_branch_attn[i])
                  + jax.nn.sigmoid(g_b) * (y_sgu @ w_branch_sgu[i]))
        h = h + merged @ w_out[i]
        h = h + peer(rms_norm(h, norm_ffn_g[i]), peer_w_query[i], peer_sub_keys[i], peer_down[i], peer_up[i])
        ple_gate = jax.nn.sigmoid(rms_norm(h, norm_ple_g[i]) @ ple_w_gate[i])
        h = h + ple_gate * (p[i] @ ple_w_proj[i])
    return rms_norm(h, final_norm_g)
```

```cpp
#define MK_SINGLE 1
#define EXP_NT 2
#define ALL_XCD 1
#include <hip/hip_runtime.h>
#include <hip/hip_cooperative_groups.h>
#include <cstdio>
#include <cstdint>
namespace cg = cooperative_groups;

#ifndef MK_SINGLE
#define MK_SINGLE 1
#endif
#ifndef NAIVE_MASK
#define NAIVE_MASK 0u
#endif

#ifndef GI8_ALIGN
#define GI8_ALIGN true
#endif
#ifndef ATT_PROBE_SKIPC
#define ATT_PROBE_SKIPC 0
#define ATT_PROBE_SKIPQ 0
#endif
#ifndef ATT_FINE
#define ATT_FINE 0
#endif
#ifndef ATT_MIX
#define ATT_MIX 1
#endif
#ifndef QUANT_FIRST
#define QUANT_FIRST 0
#endif
#ifndef ALL_XCD
#define ALL_XCD 0
#endif
#ifndef USE_XCDBAR
#define USE_XCDBAR 1
#endif
#ifndef DEBUG_CHECK
#define DEBUG_CHECK 0
#endif
#ifndef DBG_GA
#define DBG_GA 200.0f
#define DBG_GS 2.0f
#define DBG_GT 1.0f
#endif
#define DEV __device__ __forceinline__
#define LAS __attribute__((address_space(3)))
typedef unsigned short bf16;
typedef float f32x2 __attribute__((ext_vector_type(2)));
typedef float f32x4 __attribute__((ext_vector_type(4)));
typedef float f32x16 __attribute__((ext_vector_type(16)));
typedef short bf16x8 __attribute__((ext_vector_type(8)));
typedef unsigned v4u __attribute__((ext_vector_type(4)));
typedef unsigned v2u __attribute__((ext_vector_type(2)));
typedef __bf16 bfx2 __attribute__((ext_vector_type(2)));

constexpr int T = 16384, SEQ = 8192, D = 2048, INW = 9216, NH = 8, HD = 128, NBLK = 32, BLK = 256;
constexpr int C_Q = 0, C_K = 1024, C_V = 2048, C_U = 3072, C_VG = 4096, C_GA = 5120, C_GB = 7168;
constexpr int NEXP = 16384, PLE = 256;
constexpr int PST = INW;
constexpr float EPS = 1e-6f;

constexpr size_t MiB = 1u << 20;
constexpr size_t WS_CTL = 0;
constexpr size_t WS_WIN = 1 * MiB, WS_WBA = 37 * MiB, WS_WBS = 41 * MiB, WS_WOUT = 45 * MiB, WS_WQ = 53 * MiB, WS_WG = 61 * MiB, WS_WPROJ = 69 * MiB;
constexpr size_t WS_PB = 70 * MiB, WS_SKB = 78 * MiB, WS_KMEAN = 79 * MiB;
constexpr size_t WS_XN = 80 * MiB, WS_YATT = 1 * MiB, WS_YSGU = 112 * MiB, WS_H2N = 112 * MiB;
constexpr size_t WS_PROJ = 144 * MiB, WS_DN8 = 80 * MiB, WS_UP8 = 498 * MiB, WS_SDN = 79 * MiB + 256 * 1024, WS_RSS = 528 * MiB, WS_H1N = 272 * MiB, WS_QP = 336 * MiB, WS_EID = 400 * MiB, WS_EGATE = 408 * MiB;
constexpr size_t WS_SC = 79 * MiB + 640 * 1024;
constexpr size_t WS_MQ8 = 336 * MiB;
constexpr size_t WS_SEL = 464 * MiB, WS_LSE = 466 * MiB;
constexpr size_t WS_VT = 434 * MiB, WS_MERGED = 434 * MiB, WS_GTMP = 434 * MiB;
constexpr size_t WS_H2B = 144 * MiB;
constexpr size_t WS_END = 530 * MiB;

constexpr int LDS_BYTES = 147456;
constexpr int NTHREADS = 512;

DEV unsigned pkbf(float a, float b) { bfx2 v = __builtin_convertvector((f32x2){a, b}, bfx2); return __builtin_bit_cast(unsigned, v); }
DEV float bflo(unsigned w) { return __uint_as_float(w << 16); }
DEV float bfhi(unsigned w) { return __uint_as_float(w & 0xffff0000u); }
DEV float bf2f(bf16 b) { return __uint_as_float(((unsigned)b) << 16); }
DEV float wave_sum(float v) {
#pragma unroll
    for (int o = 1; o < 64; o <<= 1) v += __shfl_xor(v, o);
    return v;
}
template <int CTRL> DEV float dppq(float v) { return __int_as_float(__builtin_amdgcn_update_dpp(0, __float_as_int(v), CTRL, 0xF, 0xF, false)); }
DEV float wsum_q(float v) {
    v += dppq<0xB1>(v); v += dppq<0x4E>(v); v += dppq<0x1B>(dppq<0x141>(v)); v += dppq<0x128>(v);
    { const auto r = __builtin_amdgcn_permlane16_swap(__float_as_uint(v), __float_as_uint(v), false, false); v = __uint_as_float(r[0]) + __uint_as_float(r[1]); }
    { const auto r = __builtin_amdgcn_permlane32_swap(__float_as_uint(v), __float_as_uint(v), false, false); v = __uint_as_float(r[0]) + __uint_as_float(r[1]); }
    return v;
}
DEV float wmax_q(float v) {
    v = fmaxf(v, dppq<0xB1>(v)); v = fmaxf(v, dppq<0x4E>(v)); v = fmaxf(v, dppq<0x1B>(dppq<0x141>(v))); v = fmaxf(v, dppq<0x128>(v));
    { const auto r = __builtin_amdgcn_permlane16_swap(__float_as_uint(v), __float_as_uint(v), false, false); v = fmaxf(__uint_as_float(r[0]), __uint_as_float(r[1])); }
    { const auto r = __builtin_amdgcn_permlane32_swap(__float_as_uint(v), __float_as_uint(v), false, false); v = fmaxf(__uint_as_float(r[0]), __uint_as_float(r[1])); }
    return v;
}
DEV float sigmoidf_(float x) { return __builtin_amdgcn_rcpf(1.0f + __expf(-x)); }
DEV float gelu_erf(float v) { return 0.5f * v * (1.0f + erff(v * 0.70710678118f)); }
#define MFMA32(a, b, c) __builtin_amdgcn_mfma_f32_32x32x16_bf16((a), (b), (c), 0, 0, 0)
DEV int crow(int reg, int h) { return (reg & 3) + 8 * (reg >> 2) + 4 * h; }
namespace pg8 {
#define PG8_LAS __attribute__((address_space(3)))
typedef unsigned short bf16_t;
typedef short bf16x8 __attribute__((ext_vector_type(8)));
typedef float f32x4 __attribute__((ext_vector_type(4)));
typedef unsigned u32x4 __attribute__((ext_vector_type(4)));
constexpr int BM = 256, BK = 64, HALF = 128, HTB = HALF * BK * 2  , STAGE_BYTES = 8 * HTB, NXCD = 8, WGM = 8;

__host__ __device__ __forceinline__ int lds_byte(int r, int c) { const int st = (r >> 4) * 2 + (c >> 5), rr = r & 15, cc = c & 31, ob = rr * 64 + cc * 2; return st * 1024 + (ob ^ (((ob >> 9) & 1) << 5)); }
__host__ __device__ __forceinline__ void stage_rc(int b, int& R, int& C) { const int st = b / 1024, sb = b % 1024, swz = sb ^ (((sb >> 9) & 1) << 5); R = (st >> 1) * 16 + swz / 64; C = (st & 1) * 32 + (swz % 64) / 2; }
__host__ __device__ __forceinline__ int perm32(int rho) { const int n = rho >> 4, i = rho & 15; return 8 * (i >> 2) + 4 * n + (i & 3); }

struct Unit { int pm, pn; };
struct Gemm { const bf16_t* A; const bf16_t* Bt; int M, N, K; const bf16_t* A2; int lda; };

struct StaticOrder {
    int nM, nN, nwg, G, c;
    __host__ __device__ __forceinline__ void init(int M, int N, int G_, int c_) { nM = M / BM; nN = N / BM; nwg = nM * nN; G = G_; c = c_; }
    __host__ __device__ __forceinline__ bool next(int i, Unit& u) const {
        const long L = (long)i * G + c; if (L >= nwg) return false;
        int wgid = (int)L; { const int q = nwg / NXCD, r = nwg % NXCD, xcd = wgid % NXCD, off = wgid / NXCD; wgid = (xcd < r ? xcd * (q + 1) : r * (q + 1) + (xcd - r) * q) + off; }
        const int nig = WGM * nN, gid = wgid / nig, fm = gid * WGM, gsz = (nM - fm) < WGM ? (nM - fm) : WGM;
        u.pm = fm + ((wgid % nig) % gsz); u.pn = (wgid % nig) / gsz; return true;
    }
    __device__ __forceinline__ void a_ready(const Unit&) const {}
    __device__ __forceinline__ void done(const Unit&) const {}
};


typedef float f32x2 __attribute__((ext_vector_type(2)));
__device__ __forceinline__ f32x2 gelu_pk(f32x2 v) {
    const f32x2 av = __builtin_elementwise_abs(v), d = av * 0.2316418882f + 1.0f;
    f32x2 t; t.x = __builtin_amdgcn_rcpf(d.x); t.y = __builtin_amdgcn_rcpf(d.y);
    f32x2 q = t * 0.5307027145f + (-0.7265760135f); q = q * t + 0.7107068705f; q = q * t + (-0.142248368f); q = q * t + 0.127414796f; q = q * t;
    const f32x2 s = (v * v) * (-0.72134752044f);
    f32x2 e; e.x = __builtin_amdgcn_exp2f(s.x); e.y = __builtin_amdgcn_exp2f(s.y);
    const f32x2 m = v * (q * e), r = v - m;
    f32x2 o; o.x = v.x < 0.f ? m.x : r.x; o.y = v.y < 0.f ? m.y : r.y; return o;
}
template <class F> struct EpiW {
    static constexpr bool PERM = false, AFTER_DRAIN = false, HAS_MID = false;
    F f;
    __device__ __forceinline__ void operator()(const f32x4 (&acc)[2][2][4][2], const Unit& u, int wr, int wc, int fr, int fq) const {
        const int row0 = u.pm * BM + wr * 64 + fr, col0 = u.pn * BM + wc * 32 + 4 * fq;
#pragma unroll
        for (int ai = 0; ai < 2; ++ai)
#pragma unroll
            for (int m = 0; m < 4; ++m) {
#pragma unroll
                for (int bj = 0; bj < 2; ++bj)
#pragma unroll
                    for (int n = 0; n < 2; ++n) f.elem4(row0 + ai * HALF + m * 16, col0 + bj * HALF + n * 16, acc[ai][bj][m][n]);
                asm volatile("" ::: "memory");
            }
    }
};

typedef int i32x4 __attribute__((ext_vector_type(4)));
template <class F> struct EpiW8 {
    static constexpr bool PERM = false, AFTER_DRAIN = false, HAS_MID = false;
    F f; const float* rs; const float* cs;
    __device__ __forceinline__ void operator()(const i32x4 (&acc)[2][2][4][2], const Unit& u, int wr, int wc, int fr, int fq) const {
        const int row0 = u.pm * BM + wr * 64 + fr, col0 = u.pn * BM + wc * 32 + 4 * fq;
        f32x4 cv[2][2];
#pragma unroll
        for (int bj = 0; bj < 2; ++bj)
#pragma unroll
            for (int n = 0; n < 2; ++n) cv[bj][n] = *(const f32x4*)(cs + col0 + bj * HALF + n * 16);
        float rsv[8];
#pragma unroll
        for (int g = 0; g < 8; ++g) rsv[g] = rs[row0 + (g >> 2) * HALF + (g & 3) * 16];
#pragma unroll
        for (int ai = 0; ai < 2; ++ai)
#pragma unroll
            for (int m = 0; m < 4; ++m) { const int row = row0 + ai * HALF + m * 16; const float r = rsv[ai * 4 + m];
#pragma unroll
                for (int bj = 0; bj < 2; ++bj)
#pragma unroll
                    for (int n = 0; n < 2; ++n) { const i32x4 a = acc[ai][bj][m][n]; const f32x4 c4 = cv[bj][n];
                        f.elem4(row, col0 + bj * HALF + n * 16, (f32x4){(float)a.x * (r * c4.x), (float)a.y * (r * c4.y), (float)a.z * (r * c4.z), (float)a.w * (r * c4.w)}); }
                asm volatile("" ::: "memory");
            }
    }
};
template <class Epi, class Sched, bool ALIGN_EPI = false, bool SP2 = false>
__device__ __forceinline__ void gemm_phase(PG8_LAS unsigned char* lds, const Gemm g, const Sched& S, const Epi& E) {
    const int tid = threadIdx.x, wid = __builtin_amdgcn_readfirstlane(tid >> 6), lane = tid & 63, wr = wid >> 2, wc = wid & 3, fr = lane & 15, fq = lane >> 4;
    const int K = g.K, nt = K / BK;
    unsigned voffA[2], voffB[2];
#pragma unroll
    for (int i = 0; i < 2; ++i) { int R, C; stage_rc(tid * 16 + i * 8192, R, C); const int Rb = Epi::PERM ? ((R & ~31) + perm32(R & 31)) : R;
        voffA[i] = (unsigned)(R * g.lda + C) * 2u; voffB[i] = (unsigned)(Rb * K + C) * 2u; }
    const size_t kstep = (size_t)(BK * 2);
    const size_t hstep = (size_t)HALF * K * 2;
    const size_t tstep = 2 * hstep;
    const size_t hstepA = (size_t)HALF * g.lda * 2, tstepA = 2 * hstepA;
    const int nth = nt / 2; const ptrdiff_t a2off = (const char*)g.A2 - (const char*)g.A - (ptrdiff_t)nth * (BK * 2);
    const unsigned ldsw = (unsigned)wid * 1024u;
    const int aoff = lds_byte(wr * 64 + fr, fq * 8), boff = lds_byte(wc * 32 + fr, fq * 8);
#define PG8_SA(b, h) (((b) * 2 + (h)) * HTB)
#define PG8_SB(b, h) ((4 + (b) * 2 + (h)) * HTB)
#define PG8_STAGE(bufoff, gbase, voff) do { _Pragma("unroll") for (int _i = 0; _i < 2; ++_i) \
        __builtin_amdgcn_global_load_lds((const unsigned*)((const char*)(gbase) + (voff)[_i]), (PG8_LAS unsigned*)(lds + (bufoff) + ldsw + _i * 8192), 16, 0, 0); } while (0)
#define PG8_LDA(dst, b, h) do { _Pragma("unroll") for (int m = 0; m < 4; ++m) _Pragma("unroll") for (int k = 0; k < 2; ++k) dst[m][k] = *(const PG8_LAS bf16x8*)(lds + PG8_SA(b, h) + aoff + m * 2048 + k * 1024); } while (0)
#define PG8_LDB(dst, b, h) do { _Pragma("unroll") for (int n = 0; n < 2; ++n) _Pragma("unroll") for (int k = 0; k < 2; ++k) dst[n][k] = *(const PG8_LAS bf16x8*)(lds + PG8_SB(b, h) + boff + n * 2048 + k * 1024); } while (0)
#define PG8_MMA(ai, bj, At, Bt) do { __builtin_amdgcn_s_setprio(1); _Pragma("unroll") for (int m = 0; m < 4; ++m) _Pragma("unroll") for (int n = 0; n < 2; ++n) _Pragma("unroll") for (int k = 0; k < 2; ++k) \
        acc[ai][bj][m][n] = __builtin_amdgcn_mfma_f32_16x16x32_bf16(Bt[n][k], At[m][k], acc[ai][bj][m][n], 0, 0, 0); __builtin_amdgcn_s_setprio(0); } while (0)
#define PG8_WAIT_V(n) asm volatile("s_waitcnt vmcnt(" #n ")" ::: "memory")
#define PG8_WAIT_L(n) asm volatile("s_waitcnt lgkmcnt(" #n ")" ::: "memory")
#define PG8_BAR __builtin_amdgcn_s_barrier()
#define PG8_SCHED __builtin_amdgcn_sched_barrier(0)
    Unit cur, nxt; int ui = 0;
    if (!S.next(0, cur)) return;
    f32x4 acc[2][2][4][2];
#pragma unroll
    for (int a = 0; a < 2; ++a)
#pragma unroll
        for (int b = 0; b < 2; ++b)
#pragma unroll
            for (int m = 0; m < 4; ++m)
#pragma unroll
                for (int n = 0; n < 2; ++n) acc[a][b][m][n] = (f32x4){0.f, 0.f, 0.f, 0.f};
    bf16x8 At[4][2], B0[2][2], B1[2][2];
    const char* cA = (const char*)g.A + (size_t)cur.pm * tstepA; const char* cB = (const char*)g.Bt + (size_t)cur.pn * tstep;
    S.a_ready(cur);
    if constexpr (SP2) {
        PG8_STAGE(PG8_SB(0, 0), cB, voffB); PG8_STAGE(PG8_SB(0, 1), cB + hstep, voffB); PG8_STAGE(PG8_SA(0, 0), cA, voffA); PG8_STAGE(PG8_SA(0, 1), cA + hstepA, voffA);
        if (wr == 1) PG8_BAR;
        PG8_WAIT_V(2); PG8_BAR;
        PG8_STAGE(PG8_SB(1, 0), cB + kstep, voffB); PG8_STAGE(PG8_SA(1, 0), cA + kstep, voffA); PG8_STAGE(PG8_SB(1, 1), cB + hstep + kstep, voffB);
        PG8_WAIT_V(6); PG8_BAR;
    } else {
        PG8_STAGE(PG8_SB(0, 0), cB, voffB); PG8_STAGE(PG8_SA(0, 0), cA, voffA); PG8_STAGE(PG8_SB(0, 1), cB + hstep, voffB); PG8_STAGE(PG8_SA(0, 1), cA + hstepA, voffA);
        if (wr == 1) PG8_BAR;
        PG8_WAIT_V(4); PG8_BAR;
        PG8_STAGE(PG8_SB(1, 0), cB + kstep, voffB); PG8_STAGE(PG8_SA(1, 0), cA + kstep, voffA); PG8_STAGE(PG8_SB(1, 1), cB + hstep + kstep, voffB);
        PG8_WAIT_V(6); PG8_BAR;
    }
    for (;;) {
        const bool has_next = S.next(ui + 1, nxt);
        const char* nA = has_next ? (const char*)g.A + (size_t)nxt.pm * tstepA : cA; const char* nB = has_next ? (const char*)g.Bt + (size_t)nxt.pn * tstep : cB;
        if constexpr (Epi::HAS_MID) {
        for (int t = 0; t < nth; t += 2) {
            const bool last = (t == nt - 2);
            const char* a1 = cA + (t + 1 >= nth ? a2off : 0) + (size_t)(t + 1) * kstep;
            const char* a2 = last ? nA : cA + (t + 2 >= nth ? a2off : 0) + (size_t)(t + 2) * kstep; const char* b2 = last ? nB : cB + (size_t)(t + 2) * kstep;
            const char* a3 = a2 + kstep; const char* b3 = b2 + kstep;
            if (last && has_next) S.a_ready(nxt);
            if constexpr (SP2) {
            PG8_LDB(B0, 0, 0); PG8_LDB(B1, 0, 1); PG8_SCHED; PG8_LDA(At, 0, 0); PG8_STAGE(PG8_SA(1, 1), a1 + hstepA, voffA);
            PG8_WAIT_V(8); PG8_WAIT_L(0); PG8_BAR; PG8_MMA(0, 0, At, B0); PG8_MMA(0, 1, At, B1); PG8_BAR; PG8_SCHED;
            PG8_LDA(At, 0, 1); PG8_STAGE(PG8_SB(0, 0), b2, voffB); PG8_STAGE(PG8_SB(0, 1), b2 + hstep, voffB); PG8_STAGE(PG8_SA(0, 0), a2, voffA);
            PG8_WAIT_V(8); PG8_WAIT_L(0); PG8_BAR; PG8_MMA(1, 0, At, B0); PG8_MMA(1, 1, At, B1); PG8_BAR; PG8_SCHED;
            PG8_LDB(B0, 1, 0); PG8_LDB(B1, 1, 1); PG8_SCHED; PG8_LDA(At, 1, 0); PG8_STAGE(PG8_SA(0, 1), a2 + hstepA, voffA);
            PG8_WAIT_V(8); PG8_WAIT_L(0); PG8_BAR; PG8_MMA(0, 0, At, B0); PG8_MMA(0, 1, At, B1); PG8_BAR; PG8_SCHED;
            PG8_LDA(At, 1, 1); PG8_STAGE(PG8_SB(1, 0), b3, voffB); PG8_STAGE(PG8_SB(1, 1), b3 + hstep, voffB); PG8_STAGE(PG8_SA(1, 0), a3, voffA);
            PG8_WAIT_V(8); PG8_WAIT_L(0); PG8_BAR; PG8_MMA(1, 0, At, B0); PG8_MMA(1, 1, At, B1); PG8_BAR; PG8_SCHED;
            } else {
            PG8_LDB(B0, 0, 0); PG8_SCHED; PG8_LDA(At, 0, 0); PG8_STAGE(PG8_SA(1, 1), a1 + hstepA, voffA);
            PG8_WAIT_L(8); PG8_BAR; PG8_WAIT_L(0); PG8_MMA(0, 0, At, B0); PG8_BAR; PG8_SCHED;
            PG8_LDB(B1, 0, 1); PG8_STAGE(PG8_SB(0, 0), b2, voffB);
            PG8_BAR; PG8_WAIT_L(0); PG8_MMA(0, 1, At, B1); PG8_BAR;
            PG8_LDA(At, 0, 1); PG8_STAGE(PG8_SA(0, 0), a2, voffA);
            PG8_BAR; PG8_WAIT_L(0); PG8_MMA(1, 0, At, B0); PG8_BAR; PG8_SCHED;
            PG8_STAGE(PG8_SB(0, 1), b2 + hstep, voffB);
            PG8_WAIT_V(6); PG8_BAR; PG8_MMA(1, 1, At, B1); PG8_BAR;
            PG8_LDB(B0, 1, 0); PG8_SCHED; PG8_LDA(At, 1, 0); PG8_STAGE(PG8_SA(0, 1), a2 + hstepA, voffA);
            PG8_WAIT_L(8); PG8_BAR; PG8_WAIT_L(0); PG8_MMA(0, 0, At, B0); PG8_BAR; PG8_SCHED;
            PG8_LDB(B1, 1, 1); PG8_STAGE(PG8_SB(1, 0), b3, voffB);
            PG8_BAR; PG8_WAIT_L(0); PG8_MMA(0, 1, At, B1); PG8_BAR;
            PG8_LDA(At, 1, 1); PG8_STAGE(PG8_SA(1, 0), a3, voffA);
            PG8_BAR; PG8_WAIT_L(0); PG8_MMA(1, 0, At, B0); PG8_BAR; PG8_SCHED;
            PG8_STAGE(PG8_SB(1, 1), b3 + hstep, voffB);
            PG8_WAIT_V(6); PG8_BAR; PG8_MMA(1, 1, At, B1); PG8_BAR;
            }
        }
        E.mid(acc, cur, wr, wc, fr, fq);
        for (int t = nth; t < nt; t += 2) {
            const bool last = (t == nt - 2);
            const char* a1 = cA + (t + 1 >= nth ? a2off : 0) + (size_t)(t + 1) * kstep;
            const char* a2 = last ? nA : cA + (t + 2 >= nth ? a2off : 0) + (size_t)(t + 2) * kstep; const char* b2 = last ? nB : cB + (size_t)(t + 2) * kstep;
            const char* a3 = a2 + kstep; const char* b3 = b2 + kstep;
            if (last && has_next) S.a_ready(nxt);
            if constexpr (SP2) {
            PG8_LDB(B0, 0, 0); PG8_LDB(B1, 0, 1); PG8_SCHED; PG8_LDA(At, 0, 0); PG8_STAGE(PG8_SA(1, 1), a1 + hstepA, voffA);
            PG8_WAIT_V(8); PG8_WAIT_L(0); PG8_BAR; PG8_MMA(0, 0, At, B0); PG8_MMA(0, 1, At, B1); PG8_BAR; PG8_SCHED;
            PG8_LDA(At, 0, 1); PG8_STAGE(PG8_SB(0, 0), b2, voffB); PG8_STAGE(PG8_SB(0, 1), b2 + hstep, voffB); PG8_STAGE(PG8_SA(0, 0), a2, voffA);
            PG8_WAIT_V(8); PG8_WAIT_L(0); PG8_BAR; PG8_MMA(1, 0, At, B0); PG8_MMA(1, 1, At, B1); PG8_BAR; PG8_SCHED;
            PG8_LDB(B0, 1, 0); PG8_LDB(B1, 1, 1); PG8_SCHED; PG8_LDA(At, 1, 0); PG8_STAGE(PG8_SA(0, 1), a2 + hstepA, voffA);
            PG8_WAIT_V(8); PG8_WAIT_L(0); PG8_BAR; PG8_MMA(0, 0, At, B0); PG8_MMA(0, 1, At, B1); PG8_BAR; PG8_SCHED;
            PG8_LDA(At, 1, 1); PG8_STAGE(PG8_SB(1, 0), b3, voffB); PG8_STAGE(PG8_SB(1, 1), b3 + hstep, voffB); PG8_STAGE(PG8_SA(1, 0), a3, voffA);
            PG8_WAIT_V(8); PG8_WAIT_L(0); PG8_BAR; PG8_MMA(1, 0, At, B0); PG8_MMA(1, 1, At, B1); PG8_BAR; PG8_SCHED;
            } else {
            PG8_LDB(B0, 0, 0); PG8_SCHED; PG8_LDA(At, 0, 0); PG8_STAGE(PG8_SA(1, 1), a1 + hstepA, voffA);
            PG8_WAIT_L(8); PG8_BAR; PG8_WAIT_L(0); PG8_MMA(0, 0, At, B0); PG8_BAR; PG8_SCHED;
            PG8_LDB(B1, 0, 1); PG8_STAGE(PG8_SB(0, 0), b2, voffB);
            PG8_BAR; PG8_WAIT_L(0); PG8_MMA(0, 1, At, B1); PG8_BAR;
            PG8_LDA(At, 0, 1); PG8_STAGE(PG8_SA(0, 0), a2, voffA);
            PG8_BAR; PG8_WAIT_L(0); PG8_MMA(1, 0, At, B0); PG8_BAR; PG8_SCHED;
            PG8_STAGE(PG8_SB(0, 1), b2 + hstep, voffB);
            PG8_WAIT_V(6); PG8_BAR; PG8_MMA(1, 1, At, B1); PG8_BAR;
            PG8_LDB(B0, 1, 0); PG8_SCHED; PG8_LDA(At, 1, 0); PG8_STAGE(PG8_SA(0, 1), a2 + hstepA, voffA);
            PG8_WAIT_L(8); PG8_BAR; PG8_WAIT_L(0); PG8_MMA(0, 0, At, B0); PG8_BAR; PG8_SCHED;
            PG8_LDB(B1, 1, 1); PG8_STAGE(PG8_SB(1, 0), b3, voffB);
            PG8_BAR; PG8_WAIT_L(0); PG8_MMA(0, 1, At, B1); PG8_BAR;
            PG8_LDA(At, 1, 1); PG8_STAGE(PG8_SA(1, 0), a3, voffA);
            PG8_BAR; PG8_WAIT_L(0); PG8_MMA(1, 0, At, B0); PG8_BAR; PG8_SCHED;
            PG8_STAGE(PG8_SB(1, 1), b3 + hstep, voffB);
            PG8_WAIT_V(6); PG8_BAR; PG8_MMA(1, 1, At, B1); PG8_BAR;
            }
        }
        } else {
        for (int t = 0; t < nt; t += 2) {
            const bool last = (t == nt - 2);
            const char* a1 = cA + (t + 1 >= nth ? a2off : 0) + (size_t)(t + 1) * kstep;
            const char* a2 = last ? nA : cA + (t + 2 >= nth ? a2off : 0) + (size_t)(t + 2) * kstep; const char* b2 = last ? nB : cB + (size_t)(t + 2) * kstep;
            const char* a3 = a2 + kstep; const char* b3 = b2 + kstep;
            if (last && has_next) S.a_ready(nxt);
            if constexpr (SP2) {
            PG8_LDB(B0, 0, 0); PG8_LDB(B1, 0, 1); PG8_SCHED; PG8_LDA(At, 0, 0); PG8_STAGE(PG8_SA(1, 1), a1 + hstepA, voffA);
            PG8_WAIT_V(8); PG8_WAIT_L(0); PG8_BAR; PG8_MMA(0, 0, At, B0); PG8_MMA(0, 1, At, B1); PG8_BAR; PG8_SCHED;
            PG8_LDA(At, 0, 1); PG8_STAGE(PG8_SB(0, 0), b2, voffB); PG8_STAGE(PG8_SB(0, 1), b2 + hstep, voffB); PG8_STAGE(PG8_SA(0, 0), a2, voffA);
            PG8_WAIT_V(8); PG8_WAIT_L(0); PG8_BAR; PG8_MMA(1, 0, At, B0); PG8_MMA(1, 1, At, B1); PG8_BAR; PG8_SCHED;
            PG8_LDB(B0, 1, 0); PG8_LDB(B1, 1, 1); PG8_SCHED; PG8_LDA(At, 1, 0); PG8_STAGE(PG8_SA(0, 1), a2 + hstepA, voffA);
            PG8_WAIT_V(8); PG8_WAIT_L(0); PG8_BAR; PG8_MMA(0, 0, At, B0); PG8_MMA(0, 1, At, B1); PG8_BAR; PG8_SCHED;
            PG8_LDA(At, 1, 1); PG8_STAGE(PG8_SB(1, 0), b3, voffB); PG8_STAGE(PG8_SB(1, 1), b3 + hstep, voffB); PG8_STAGE(PG8_SA(1, 0), a3, voffA);
            PG8_WAIT_V(8); PG8_WAIT_L(0); PG8_BAR; PG8_MMA(1, 0, At, B0); PG8_MMA(1, 1, At, B1); PG8_BAR; PG8_SCHED;
            } else {
            PG8_LDB(B0, 0, 0); PG8_SCHED; PG8_LDA(At, 0, 0); PG8_STAGE(PG8_SA(1, 1), a1 + hstepA, voffA);
            PG8_WAIT_L(8); PG8_BAR; PG8_WAIT_L(0); PG8_MMA(0, 0, At, B0); PG8_BAR; PG8_SCHED;
            PG8_LDB(B1, 0, 1); PG8_STAGE(PG8_SB(0, 0), b2, voffB);
            PG8_BAR; PG8_WAIT_L(0); PG8_MMA(0, 1, At, B1); PG8_BAR;
            PG8_LDA(At, 0, 1); PG8_STAGE(PG8_SA(0, 0), a2, voffA);
            PG8_BAR; PG8_WAIT_L(0); PG8_MMA(1, 0, At, B0); PG8_BAR; PG8_SCHED;
            PG8_STAGE(PG8_SB(0, 1), b2 + hstep, voffB);
            PG8_WAIT_V(6); PG8_BAR; PG8_MMA(1, 1, At, B1); PG8_BAR;
            PG8_LDB(B0, 1, 0); PG8_SCHED; PG8_LDA(At, 1, 0); PG8_STAGE(PG8_SA(0, 1), a2 + hstepA, voffA);
            PG8_WAIT_L(8); PG8_BAR; PG8_WAIT_L(0); PG8_MMA(0, 0, At, B0); PG8_BAR; PG8_SCHED;
            PG8_LDB(B1, 1, 1); PG8_STAGE(PG8_SB(1, 0), b3, voffB);
            PG8_BAR; PG8_WAIT_L(0); PG8_MMA(0, 1, At, B1); PG8_BAR;
            PG8_LDA(At, 1, 1); PG8_STAGE(PG8_SA(1, 0), a3, voffA);
            PG8_BAR; PG8_WAIT_L(0); PG8_MMA(1, 0, At, B0); PG8_BAR; PG8_SCHED;
            PG8_STAGE(PG8_SB(1, 1), b3 + hstep, voffB);
            PG8_WAIT_V(6); PG8_BAR; PG8_MMA(1, 1, At, B1); PG8_BAR;
            }
        }
        }
        if constexpr (ALIGN_EPI) { if (wr == 0) PG8_BAR; }
        if constexpr (!Epi::AFTER_DRAIN) { E(acc, cur, wr, wc, fr, fq); S.done(cur); }
        if (!has_next) break;
#pragma unroll
        for (int a = 0; a < 2; ++a)
#pragma unroll
            for (int b = 0; b < 2; ++b)
#pragma unroll
                for (int m = 0; m < 4; ++m)
#pragma unroll
                    for (int n = 0; n < 2; ++n) acc[a][b][m][n] = (f32x4){0.f, 0.f, 0.f, 0.f};
        cur = nxt; cA = nA; cB = nB; ++ui;
        if constexpr (ALIGN_EPI) { if (wr == 1) PG8_BAR; }
    }
    PG8_WAIT_V(0);
    if constexpr (!ALIGN_EPI) { if (wr == 0) PG8_BAR; }
    PG8_BAR;
    if constexpr (Epi::AFTER_DRAIN) { E.fused(acc, cur, wr, wc, fr, fq, lds, wid, lane); S.done(cur); }
#undef PG8_SA
#undef PG8_SB
#undef PG8_STAGE
#undef PG8_LDA
#undef PG8_LDB
#undef PG8_MMA
#undef PG8_WAIT_V
#undef PG8_WAIT_L
#undef PG8_BAR
#undef PG8_SCHED
}

typedef int i32x4 __attribute__((ext_vector_type(4)));
template <class Epi, class Sched, bool ALIGN_EPI = false, bool SP2 = false>
__device__ __forceinline__ void gemm_phase_i8(PG8_LAS unsigned char* lds, const Gemm g, const Sched& S, const Epi& E) {
    const int tid = threadIdx.x, wid = __builtin_amdgcn_readfirstlane(tid >> 6), lane = tid & 63, wr = wid >> 2, wc = wid & 3, fr = lane & 15, fq = lane >> 4;
    const int K = g.K, nt = K / 128;
    unsigned voffA[2], voffB[2];
#pragma unroll
    for (int i = 0; i < 2; ++i) { int R, C; stage_rc(tid * 16 + i * 8192, R, C); const int Rb = Epi::PERM ? ((R & ~31) + perm32(R & 31)) : R;
        voffA[i] = (unsigned)(R * K + C * 2); voffB[i] = (unsigned)(Rb * K + C * 2); }
    const size_t kstep = (size_t)(BK * 2);
    const size_t hstep = (size_t)HALF * K;
    const size_t tstep = 2 * hstep;
    const unsigned ldsw = (unsigned)wid * 1024u;
    const int aoff = lds_byte(wr * 64 + fr, fq * 8), boff = lds_byte(wc * 32 + fr, fq * 8);
#define PG8_SA(b, h) (((b) * 2 + (h)) * HTB)
#define PG8_SB(b, h) ((4 + (b) * 2 + (h)) * HTB)
#define PG8_STAGE(bufoff, gbase, voff) do { _Pragma("unroll") for (int _i = 0; _i < 2; ++_i) \
        __builtin_amdgcn_global_load_lds((const unsigned*)((const char*)(gbase) + (voff)[_i]), (PG8_LAS unsigned*)(lds + (bufoff) + ldsw + _i * 8192), 16, 0, 0); } while (0)
#define PG8_LDA(dst, b, h) do { _Pragma("unroll") for (int m = 0; m < 4; ++m) _Pragma("unroll") for (int k = 0; k < 2; ++k) dst[m][k] = *(const PG8_LAS i32x4*)(lds + PG8_SA(b, h) + aoff + m * 2048 + k * 1024); } while (0)
#define PG8_LDB(dst, b, h) do { _Pragma("unroll") for (int n = 0; n < 2; ++n) _Pragma("unroll") for (int k = 0; k < 2; ++k) dst[n][k] = *(const PG8_LAS i32x4*)(lds + PG8_SB(b, h) + boff + n * 2048 + k * 1024); } while (0)
#define PG8_MMA(ai, bj, At, Bt) do { __builtin_amdgcn_s_setprio(1); _Pragma("unroll") for (int m = 0; m < 4; ++m) _Pragma("unroll") for (int n = 0; n < 2; ++n) _Pragma("unroll") for (int k = 0; k < 2; ++k) \
        acc[ai][bj][m][n] = __builtin_amdgcn_mfma_i32_16x16x64_i8(Bt[n][k], At[m][k], acc[ai][bj][m][n], 0, 0, 0); __builtin_amdgcn_s_setprio(0); } while (0)
#define PG8_WAIT_V(n) asm volatile("s_waitcnt vmcnt(" #n ")" ::: "memory")
#define PG8_WAIT_L(n) asm volatile("s_waitcnt lgkmcnt(" #n ")" ::: "memory")
#define PG8_BAR __builtin_amdgcn_s_barrier()
#define PG8_SCHED __builtin_amdgcn_sched_barrier(0)
    Unit cur, nxt; int ui = 0;
    if (!S.next(0, cur)) return;
    i32x4 acc[2][2][4][2];
#pragma unroll
    for (int a = 0; a < 2; ++a)
#pragma unroll
        for (int b = 0; b < 2; ++b)
#pragma unroll
            for (int m = 0; m < 4; ++m)
#pragma unroll
                for (int n = 0; n < 2; ++n) acc[a][b][m][n] = (i32x4){0, 0, 0, 0};
    i32x4 At[4][2], B0[2][2], B1[2][2];
    const char* cA = (const char*)g.A + (size_t)cur.pm * tstep; const char* cB = (const char*)g.Bt + (size_t)cur.pn * tstep;
    S.a_ready(cur);
    if constexpr (SP2) {
        PG8_STAGE(PG8_SB(0, 0), cB, voffB); PG8_STAGE(PG8_SB(0, 1), cB + hstep, voffB); PG8_STAGE(PG8_SA(0, 0), cA, voffA); PG8_STAGE(PG8_SA(0, 1), cA + hstep, voffA);
        if (wr == 1) PG8_BAR;
        PG8_WAIT_V(2); PG8_BAR;
        PG8_STAGE(PG8_SB(1, 0), cB + kstep, voffB); PG8_STAGE(PG8_SA(1, 0), cA + kstep, voffA); PG8_STAGE(PG8_SB(1, 1), cB + hstep + kstep, voffB);
        PG8_WAIT_V(6); PG8_BAR;
    } else {
        PG8_STAGE(PG8_SB(0, 0), cB, voffB); PG8_STAGE(PG8_SA(0, 0), cA, voffA); PG8_STAGE(PG8_SB(0, 1), cB + hstep, voffB); PG8_STAGE(PG8_SA(0, 1), cA + hstep, voffA);
        if (wr == 1) PG8_BAR;
        PG8_WAIT_V(4); PG8_BAR;
        PG8_STAGE(PG8_SB(1, 0), cB + kstep, voffB); PG8_STAGE(PG8_SA(1, 0), cA + kstep, voffA); PG8_STAGE(PG8_SB(1, 1), cB + hstep + kstep, voffB);
        PG8_WAIT_V(6); PG8_BAR;
    }
    for (;;) {
        const bool has_next = S.next(ui + 1, nxt);
        const char* nA = has_next ? (const char*)g.A + (size_t)nxt.pm * tstep : cA; const char* nB = has_next ? (const char*)g.Bt + (size_t)nxt.pn * tstep : cB;
        for (int t = 0; t < nt; t += 2) {
            const bool last = (t == nt - 2);
            const char* a1 = cA + (size_t)(t + 1) * kstep;
            const char* a2 = last ? nA : cA + (size_t)(t + 2) * kstep; const char* b2 = last ? nB : cB + (size_t)(t + 2) * kstep;
            const char* a3 = a2 + kstep; const char* b3 = b2 + kstep;
            if (last && has_next) S.a_ready(nxt);
            if constexpr (SP2) {
            PG8_LDB(B0, 0, 0); PG8_LDB(B1, 0, 1); PG8_SCHED; PG8_LDA(At, 0, 0); PG8_STAGE(PG8_SA(1, 1), a1 + hstep, voffA);
            PG8_WAIT_V(8); PG8_WAIT_L(0); PG8_BAR; PG8_MMA(0, 0, At, B0); PG8_MMA(0, 1, At, B1); PG8_BAR; PG8_SCHED;
            PG8_LDA(At, 0, 1); PG8_STAGE(PG8_SB(0, 0), b2, voffB); PG8_STAGE(PG8_SB(0, 1), b2 + hstep, voffB); PG8_STAGE(PG8_SA(0, 0), a2, voffA);
            PG8_WAIT_V(8); PG8_WAIT_L(0); PG8_BAR; PG8_MMA(1, 0, At, B0); PG8_MMA(1, 1, At, B1); PG8_BAR; PG8_SCHED;
            PG8_LDB(B0, 1, 0); PG8_LDB(B1, 1, 1); PG8_SCHED; PG8_LDA(At, 1, 0); PG8_STAGE(PG8_SA(0, 1), a2 + hstep, voffA);
            PG8_WAIT_V(8); PG8_WAIT_L(0); PG8_BAR; PG8_MMA(0, 0, At, B0); PG8_MMA(0, 1, At, B1); PG8_BAR; PG8_SCHED;
            PG8_LDA(At, 1, 1); PG8_STAGE(PG8_SB(1, 0), b3, voffB); PG8_STAGE(PG8_SB(1, 1), b3 + hstep, voffB); PG8_STAGE(PG8_SA(1, 0), a3, voffA);
            PG8_WAIT_V(8); PG8_WAIT_L(0); PG8_BAR; PG8_MMA(1, 0, At, B0); PG8_MMA(1, 1, At, B1); PG8_BAR; PG8_SCHED;
            } else {
            PG8_LDB(B0, 0, 0); PG8_SCHED; PG8_LDA(At, 0, 0); PG8_STAGE(PG8_SA(1, 1), a1 + hstep, voffA);
            PG8_WAIT_L(8); PG8_BAR; PG8_WAIT_L(0); PG8_MMA(0, 0, At, B0); PG8_BAR; PG8_SCHED;
            PG8_LDB(B1, 0, 1); PG8_STAGE(PG8_SB(0, 0), b2, voffB);
            PG8_BAR; PG8_WAIT_L(0); PG8_MMA(0, 1, At, B1); PG8_BAR;
            PG8_LDA(At, 0, 1); PG8_STAGE(PG8_SA(0, 0), a2, voffA);
            PG8_BAR; PG8_WAIT_L(0); PG8_MMA(1, 0, At, B0); PG8_BAR; PG8_SCHED;
            PG8_STAGE(PG8_SB(0, 1), b2 + hstep, voffB);
            PG8_WAIT_V(6); PG8_BAR; PG8_MMA(1, 1, At, B1); PG8_BAR;
            PG8_LDB(B0, 1, 0); PG8_SCHED; PG8_LDA(At, 1, 0); PG8_STAGE(PG8_SA(0, 1), a2 + hstep, voffA);
            PG8_WAIT_L(8); PG8_BAR; PG8_WAIT_L(0); PG8_MMA(0, 0, At, B0); PG8_BAR; PG8_SCHED;
            PG8_LDB(B1, 1, 1); PG8_STAGE(PG8_SB(1, 0), b3, voffB);
            PG8_BAR; PG8_WAIT_L(0); PG8_MMA(0, 1, At, B1); PG8_BAR;
            PG8_LDA(At, 1, 1); PG8_STAGE(PG8_SA(1, 0), a3, voffA);
            PG8_BAR; PG8_WAIT_L(0); PG8_MMA(1, 0, At, B0); PG8_BAR; PG8_SCHED;
            PG8_STAGE(PG8_SB(1, 1), b3 + hstep, voffB);
            PG8_WAIT_V(6); PG8_BAR; PG8_MMA(1, 1, At, B1); PG8_BAR;
            }
        }
        if constexpr (ALIGN_EPI) { if (wr == 0) PG8_BAR; }
        if constexpr (!Epi::AFTER_DRAIN) { E(acc, cur, wr, wc, fr, fq); S.done(cur); }
        if (!has_next) break;
#pragma unroll
        for (int a = 0; a < 2; ++a)
#pragma unroll
            for (int b = 0; b < 2; ++b)
#pragma unroll
                for (int m = 0; m < 4; ++m)
#pragma unroll
                    for (int n = 0; n < 2; ++n) acc[a][b][m][n] = (i32x4){0, 0, 0, 0};
        cur = nxt; cA = nA; cB = nB; ++ui;
        if constexpr (ALIGN_EPI) { if (wr == 1) PG8_BAR; }
    }
    PG8_WAIT_V(0);
    if constexpr (!ALIGN_EPI) { if (wr == 0) PG8_BAR; }
    PG8_BAR;
    if constexpr (Epi::AFTER_DRAIN) { E.fused(acc, cur, wr, wc, fr, fq, lds, wid, lane); S.done(cur); }
#undef PG8_SA
#undef PG8_SB
#undef PG8_STAGE
#undef PG8_LDA
#undef PG8_LDB
#undef PG8_MMA
#undef PG8_WAIT_V
#undef PG8_WAIT_L
#undef PG8_BAR
#undef PG8_SCHED
}
}

struct Ctx {
    const float *x, *p, *g_mix, *w_in, *ln_g, *ln_b, *sgu_w, *sgu_b, *w_ba, *w_bs, *w_out, *g_ffn, *w_pq, *subk, *dn, *up, *g_ple, *w_pp, *w_pg, *g_fin;
    float* out;
    bf16 *WinT, *WbaT, *WbsT, *WoutT, *WqT, *WgT, *WprojT, *pb, *skb, *xn, *proj, *vT, *yatt, *ysgu, *merged, *h1n, *qp, *h2n, *gtmp, *h2b, *swb;
    float *kmean, *kmp, *sst, *egate, *sdn, *sup, *lse, *xs, *h2s, *wcs, *gcs, *qcs, *h1s, *rss, *ocs, *ms; int *eid, *sel; unsigned char *xq8, *WinT8, *WgT8, *WqT8, *h2q8, *h1q8, *WoutT8, *mq8; unsigned char *dn8, *up8;
    int G, bid, tid, lane, wave;
};

DEV void transpose_item(const float* W, int K, int N, bf16* WT, const float* gain, LAS float* scr, int item, int lane, int ldt = 0) {
    if (ldt == 0) ldt = K;
    const int nblk = N / 32, kb = item / nblk, nb = item % nblk, k0 = 64 * kb, n0 = 32 * nb;
#pragma unroll
    for (int i = 0; i < 8; ++i) { const int kk = 8 * i + (lane >> 3), cc = (lane & 7) * 4; const float gsc = gain ? gain[k0 + kk] : 1.0f;
        const f32x4 w = *(const f32x4*)(W + (size_t)(k0 + kk) * N + n0 + cc); LAS float* sp = scr + kk * 33 + cc; sp[0] = w.x * gsc; sp[1] = w.y * gsc; sp[2] = w.z * gsc; sp[3] = w.w * gsc; }
    asm volatile("s_waitcnt lgkmcnt(0)" ::: "memory");
    const int c = lane & 7;
#pragma unroll
    for (int j = 0; j < 4; ++j) { const int n = (lane >> 3) + 8 * j; const LAS float* s = scr + (8 * c) * 33 + n;
        v4u o; o.x = pkbf(s[0 * 33], s[1 * 33]); o.y = pkbf(s[2 * 33], s[3 * 33]); o.z = pkbf(s[4 * 33], s[5 * 33]); o.w = pkbf(s[6 * 33], s[7 * 33]);
        *(v4u*)(WT + (size_t)(n0 + n) * ldt + k0 + 8 * c) = o; }
    asm volatile("s_waitcnt lgkmcnt(0)" ::: "memory");
}
DEV void row_rms_bf16(const float* xrow, bf16* orow, int lane) {
    const f32x4* xr = (const f32x4*)xrow + lane;
    f32x4 v[8]; float s = 0.f;
#pragma unroll
    for (int j = 0; j < 8; ++j) { v[j] = xr[64 * j]; s += (v[j].x * v[j].x + v[j].y * v[j].y) + (v[j].z * v[j].z + v[j].w * v[j].w); }
    const float r = 1.0f / sqrtf(wave_sum(s) * (1.0f / D) + EPS);
    v2u* o8 = (v2u*)orow + lane;
#pragma unroll
    for (int j = 0; j < 8; ++j) { v2u w; w.x = pkbf(v[j].x * r, v[j].y * r); w.y = pkbf(v[j].z * r, v[j].w * r); o8[64 * j] = w; }
}
DEV void cvt_items(const float* src, bf16* dst, size_t n8, const float* gain, size_t gtid, size_t gthreads) {
    for (size_t i = gtid; i < n8; i += gthreads) {
        const f32x4 a = ((const f32x4*)src)[2 * i], b = ((const f32x4*)src)[2 * i + 1];
        f32x4 ga = {1.f, 1.f, 1.f, 1.f}, gb = ga;
        if (gain) { const size_t c = (i * 8) % D; ga = *(const f32x4*)(gain + c); gb = *(const f32x4*)(gain + c + 4); }
        v4u o; o.x = pkbf(a.x * ga.x, a.y * ga.y); o.y = pkbf(a.z * ga.z, a.w * ga.w); o.z = pkbf(b.x * gb.x, b.y * gb.y); o.w = pkbf(b.z * gb.z, b.w * gb.w);
        ((v4u*)dst)[i] = o;
    }
}
DEV float wave_max(float v);
DEV unsigned q4(float a, float b, float c_, float d, float inv, int off);
DEV void colmax_item(const float* W, int N, const float* gain, unsigned* cam, int item, int lane) {
    const int nblk = N / 256, kb = item / nblk, nb = item % nblk, k0 = 64 * kb, n0 = 256 * nb + 4 * lane;
    f32x4 am = {0.f, 0.f, 0.f, 0.f};
#pragma unroll 8
    for (int kk = 0; kk < 64; ++kk) { const f32x4 w = *(const f32x4*)(W + (size_t)(k0 + kk) * N + n0); const float g = gain ? gain[k0 + kk] : 1.0f;
        am.x = fmaxf(am.x, fabsf(w.x * g)); am.y = fmaxf(am.y, fabsf(w.y * g)); am.z = fmaxf(am.z, fabsf(w.z * g)); am.w = fmaxf(am.w, fabsf(w.w * g)); }
    atomicMax(cam + n0, __float_as_uint(am.x)); atomicMax(cam + n0 + 1, __float_as_uint(am.y)); atomicMax(cam + n0 + 2, __float_as_uint(am.z)); atomicMax(cam + n0 + 3, __float_as_uint(am.w));
}
DEV void transpose_item_i8(const float* W, int K, int N, unsigned char* WT8, const float* gain, const unsigned* cam, LAS float* scr, int item, int lane) {
    const int nblk = N / 32, kb = item / nblk, nb = item % nblk, k0 = 64 * kb, n0 = 32 * nb;
#pragma unroll
    for (int i = 0; i < 8; ++i) { const int kk = 8 * i + (lane >> 3), cc = (lane & 7) * 4; const float gsc = gain ? gain[k0 + kk] : 1.0f;
        const f32x4 w = *(const f32x4*)(W + (size_t)(k0 + kk) * N + n0 + cc); LAS float* sp = scr + kk * 33 + cc; sp[0] = w.x * gsc; sp[1] = w.y * gsc; sp[2] = w.z * gsc; sp[3] = w.w * gsc; }
    asm volatile("s_waitcnt lgkmcnt(0)" ::: "memory");
    const int cq = lane & 3;
#pragma unroll
    for (int j = 0; j < 2; ++j) { const int n = (lane >> 2) + 16 * j; const LAS float* s = scr + (16 * cq) * 33 + n;
        const float am = __uint_as_float(cam[n0 + n]); const float inv = am > 0.f ? 127.0f / am : 0.f;
        v4u o; o.x = q4(s[0 * 33], s[1 * 33], s[2 * 33], s[3 * 33], inv, 0); o.y = q4(s[4 * 33], s[5 * 33], s[6 * 33], s[7 * 33], inv, 0);
        o.z = q4(s[8 * 33], s[9 * 33], s[10 * 33], s[11 * 33], inv, 0); o.w = q4(s[12 * 33], s[13 * 33], s[14 * 33], s[15 * 33], inv, 0);
        *(v4u*)(WT8 + (size_t)(n0 + n) * K + k0 + 16 * cq) = o; }
    asm volatile("s_waitcnt lgkmcnt(0)" ::: "memory");
}
DEV void row_rms_i8(const float* xrow, unsigned char* orow, float* sc, int lane) {
    const f32x4* xr = (const f32x4*)xrow + lane;
    f32x4 v[8]; float s = 0.f, am = 0.f;
#pragma unroll
    for (int j = 0; j < 8; ++j) { v[j] = xr[64 * j]; s += (v[j].x * v[j].x + v[j].y * v[j].y) + (v[j].z * v[j].z + v[j].w * v[j].w);
        am = fmaxf(am, fmaxf(fmaxf(fabsf(v[j].x), fabsf(v[j].y)), fmaxf(fabsf(v[j].z), fabsf(v[j].w)))); }
    const float r = 1.0f / sqrtf(wave_sum(s) * (1.0f / D) + EPS);
    am = wave_max(am);
    const float inv = am > 0.f ? 127.0f / am : 0.f;
    unsigned* o4 = (unsigned*)orow + lane;
#pragma unroll
    for (int j = 0; j < 8; ++j) o4[64 * j] = q4(v[j].x, v[j].y, v[j].z, v[j].w, inv, 0);
    if (lane == 0) *sc = am * (1.0f / 127.0f) * r;
}
DEV void phase_prologue2(const Ctx& c, LAS unsigned char* lds, const unsigned* cam) {
    LAS float* scr = (LAS float*)(lds + c.wave * 16384);
    const int gw = c.bid * 8 + c.wave, NGW = c.G * 8;
    constexpr int I_IN = (D / 64) * (INW / 32), I_SQ = (D / 64) * (D / 32);
    for (int it = gw; it < I_IN + I_SQ; it += NGW) {
        if (it < I_IN) transpose_item_i8(c.w_in, D, INW, c.WinT8, c.g_mix, cam, scr, it, c.lane);
        else transpose_item_i8(c.w_pg, D, D, c.WgT8, c.g_ple, cam + INW, scr, it - I_IN, c.lane);
    }
    for (int i = c.bid * NTHREADS + c.tid; i < INW + D; i += c.G * NTHREADS) { const float s = __uint_as_float(cam[i]) * (1.0f / 127.0f); if (i < INW) c.wcs[i] = s; else c.gcs[i - INW] = s; }
}
DEV void phase_prologue(const Ctx& c, LAS unsigned char* lds, unsigned* cam, unsigned* kcnt) {
    LAS float* scr = (LAS float*)(lds + c.wave * 16384);
    const int gw = c.bid * 8 + c.wave, NGW = c.G * 8;
    constexpr int I_IN = (D / 64) * (INW / 32), I_BA = (1024 / 64) * (D / 32), I_SQ = (D / 64) * (D / 32), I_PP = (PLE / 64) * (D / 32);
    constexpr int C_IN = (D / 64) * (INW / 256), C_SQ = (D / 64) * (D / 256);
    for (int it = gw; it < C_IN + C_SQ; it += NGW) {
        if (it < C_IN) colmax_item(c.w_in, INW, c.g_mix, cam, it, c.lane); else colmax_item(c.w_pg, D, c.g_ple, cam + INW, it - C_IN, c.lane);
    }
    asm volatile("s_waitcnt vmcnt(0)" ::: "memory");
    if (c.lane == 0) { __builtin_amdgcn_fence(__ATOMIC_RELEASE, "agent"); asm volatile("s_waitcnt vmcnt(0)" ::: "memory"); __hip_atomic_fetch_add(kcnt, 1u, __ATOMIC_RELAXED, __HIP_MEMORY_SCOPE_AGENT); }
    constexpr int NITEMS = 2 * I_BA + 2 * I_SQ + I_PP;
    for (int it = gw; it < NITEMS; it += NGW) {
        int r = it;
        if (r < I_BA) { transpose_item(c.w_ba, 1024, D, c.WbaT, nullptr, scr, r, c.lane, 2048); continue; } r -= I_BA;
        if (r < I_BA) { transpose_item(c.w_bs, 1024, D, c.WbaT + 1024, nullptr, scr, r, c.lane, 2048); continue; } r -= I_BA;
        if (r < I_SQ) { transpose_item(c.w_out, D, D, c.WoutT, nullptr, scr, r, c.lane); continue; } r -= I_SQ;
        if (r < I_SQ) { transpose_item(c.w_pq, D, D, c.WqT, c.g_ffn, scr, r, c.lane); continue; } r -= I_SQ;
        transpose_item(c.w_pp, PLE, D, c.WprojT, nullptr, scr, r, c.lane);
    }
    {
        f32x4 vn[8]; int m = gw;
        if (m < T) { const f32x4* xr = (const f32x4*)(c.x + (size_t)m * D) + c.lane;
#pragma unroll
            for (int j = 0; j < 8; ++j) vn[j] = xr[64 * j]; }
        for (; m < T; m += NGW) {
            f32x4 v[8];
#pragma unroll
            for (int j = 0; j < 8; ++j) v[j] = vn[j];
            { const int mn = m + NGW < T ? m + NGW : m; const f32x4* xr = (const f32x4*)(c.x + (size_t)mn * D) + c.lane;
#pragma unroll
              for (int j = 0; j < 8; ++j) vn[j] = xr[64 * j]; }
            float s = 0.f, am = 0.f;
#pragma unroll
            for (int j = 0; j < 8; ++j) { s += (v[j].x * v[j].x + v[j].y * v[j].y) + (v[j].z * v[j].z + v[j].w * v[j].w);
                am = fmaxf(am, fmaxf(fmaxf(fabsf(v[j].x), fabsf(v[j].y)), fmaxf(fabsf(v[j].z), fabsf(v[j].w)))); }
            const float r = 1.0f / sqrtf(wsum_q(s) * (1.0f / D) + EPS);
            am = wmax_q(am);
            const float inv = am > 0.f ? 127.0f / am : 0.f;
            unsigned* o4 = (unsigned*)(c.xq8 + (size_t)m * D) + c.lane;
#pragma unroll
            for (int j = 0; j < 8; ++j) o4[64 * j] = q4(v[j].x, v[j].y, v[j].z, v[j].w, inv, 0);
            if (c.lane == 0) c.xs[m] = am * (1.0f / 127.0f) * r;
        }
    }
    const size_t gtid = (size_t)c.bid * NTHREADS + c.tid, gthreads = (size_t)c.G * NTHREADS;
    cvt_items(c.p, c.pb, (size_t)T * PLE / 8, nullptr, gtid, gthreads);
    cvt_items(c.subk, c.skb, (size_t)NH * 2 * 128 * 128 / 8, nullptr, gtid, gthreads);
    for (size_t i = gtid; i < (size_t)8 * 128 * 128 / 8; i += gthreads) {
        const int t = (int)(i >> 4) & 127, s0 = (int)(i & 15) * 8; const f32x4 a = *(const f32x4*)(c.sgu_w + i * 8), b = *(const f32x4*)(c.sgu_w + i * 8 + 4);
        v4u o; o.x = pkbf(s0 + 0 <= t ? a.x : 0.f, s0 + 1 <= t ? a.y : 0.f); o.y = pkbf(s0 + 2 <= t ? a.z : 0.f, s0 + 3 <= t ? a.w : 0.f);
        o.z = pkbf(s0 + 4 <= t ? b.x : 0.f, s0 + 5 <= t ? b.y : 0.f); o.w = pkbf(s0 + 6 <= t ? b.z : 0.f, s0 + 7 <= t ? b.w : 0.f);
        *(v4u*)(c.swb + i * 8) = o; }
    if (c.lane == 0) { unsigned sp = 0; while (__hip_atomic_load(kcnt, __ATOMIC_RELAXED, __HIP_MEMORY_SCOPE_AGENT) < (unsigned)NGW) { __builtin_amdgcn_s_sleep(2); if (++sp > (1u << 22)) break; } }
    __builtin_amdgcn_fence(__ATOMIC_ACQUIRE, "agent");
    asm volatile("s_waitcnt vmcnt(0)" ::: "memory");
    phase_prologue2(c, lds, cam);
}

DEV float rsum16(float v) { v += dppq<0xB1>(v); v += dppq<0x4E>(v); v += dppq<0x1B>(dppq<0x141>(v)); v += dppq<0x128>(v); return v; }
struct F1 { bf16* proj;
    DEV void elem4(int row, int col, f32x4 v) const {
        if (col >= C_GA) { v.x = sigmoidf_(v.x); v.y = sigmoidf_(v.y); v.z = sigmoidf_(v.z); v.w = sigmoidf_(v.w); }
        else if (col >= C_U) { const f32x2 a = pg8::gelu_pk((f32x2){v.x, v.y}), b = pg8::gelu_pk((f32x2){v.z, v.w}); v = (f32x4){a.x, a.y, b.x, b.y}; }
        v2u w; w.x = pkbf(v.x, v.y); w.y = pkbf(v.z, v.w); *(v2u*)(proj + (size_t)row * PST + col) = w; } };
constexpr float GQ = 255.99f;
DEV unsigned gate_q(float x) { return (unsigned)__builtin_amdgcn_rcpf((1.0f / GQ) + __builtin_amdgcn_exp2f(fmaf(x, -1.4426950408889634f, -7.999943641f))); }
DEV f32x4 gate_dq(unsigned w) { return (f32x4){((float)(w & 0xffu) + 0.5f) * (1.0f / GQ), ((float)((w >> 8) & 0xffu) + 0.5f) * (1.0f / GQ), ((float)((w >> 16) & 0xffu) + 0.5f) * (1.0f / GQ), ((float)(w >> 24) + 0.5f) * (1.0f / GQ)}; }
struct EpiIn { static constexpr bool PERM = false, AFTER_DRAIN = false, HAS_MID = false; bf16* proj; const float* rs; const float* cs; float* kmp; float* sst;
    DEV void operator()(const pg8::i32x4 (&acc)[2][2][4][2], const pg8::Unit& u, int wr, int wc, int fr, int fq) const {
        const int row0 = u.pm * 256 + wr * 64 + fr, col0 = u.pn * 256 + wc * 32 + 4 * fq;
        const bool isK = u.pn >= C_K / 256 && u.pn < C_V / 256, isVG = u.pn >= C_VG / 256 && u.pn < C_GA / 256;
        f32x4 cv[2][2];
#pragma unroll
        for (int bj = 0; bj < 2; ++bj)
#pragma unroll
            for (int n = 0; n < 2; ++n) cv[bj][n] = *(const f32x4*)(cs + col0 + bj * 128 + n * 16);
        float rsv[8];
#pragma unroll
        for (int g = 0; g < 8; ++g) rsv[g] = rs[row0 + (g >> 2) * 128 + (g & 3) * 16];
        f32x4 ksum[2][2];
#pragma unroll
        for (int bj = 0; bj < 2; ++bj)
#pragma unroll
            for (int n = 0; n < 2; ++n) ksum[bj][n] = (f32x4){0.f, 0.f, 0.f, 0.f};
#pragma unroll
        for (int ai = 0; ai < 2; ++ai)
#pragma unroll
            for (int m = 0; m < 4; ++m) { const int row = row0 + ai * 128 + m * 16; const float r = rsv[ai * 4 + m]; float ss = 0.f, sq = 0.f;
#pragma unroll
                for (int bj = 0; bj < 2; ++bj)
#pragma unroll
                    for (int n = 0; n < 2; ++n) { const pg8::i32x4 a = acc[ai][bj][m][n]; const f32x4 c4 = cv[bj][n]; const int col = col0 + bj * 128 + n * 16;
                        f32x4 v = (f32x4){(float)a.x * (r * c4.x), (float)a.y * (r * c4.y), (float)a.z * (r * c4.z), (float)a.w * (r * c4.w)};
                        if (col >= C_GA) {
                            const unsigned q0 = gate_q(v.x), q1 = gate_q(v.y), q2 = gate_q(v.z), q3 = gate_q(v.w);
                            *(unsigned*)((unsigned char*)(proj + (size_t)row * PST + C_GA) + (col - C_GA)) = q0 | (q1 << 8) | (q2 << 16) | (q3 << 24); continue; }
                        if (col >= C_U) { const f32x2 ga = pg8::gelu_pk((f32x2){v.x, v.y}), gb = pg8::gelu_pk((f32x2){v.z, v.w}); v = (f32x4){ga.x, ga.y, gb.x, gb.y}; }
                        v2u w; w.x = pkbf(v.x, v.y); w.y = pkbf(v.z, v.w); *(v2u*)(proj + (size_t)row * PST + col) = w;
                        if (isK) ksum[bj][n] += v;
                        if (isVG) { const float e0 = bflo(w.x), e1 = bfhi(w.x), e2 = bflo(w.y), e3 = bfhi(w.y); ss += (e0 + e1) + (e2 + e3); sq += (e0 * e0 + e1 * e1) + (e2 * e2 + e3 * e3); } }
                if (isVG) { ss += __shfl_xor(ss, 16); sq += __shfl_xor(sq, 16); ss += __shfl_xor(ss, 32); sq += __shfl_xor(sq, 32);
                    if (fq == 0) *(f32x2*)(sst + ((size_t)row * 16 + (u.pn - C_VG / 256) * 4 + wc) * 2) = (f32x2){ss, sq}; }
                asm volatile("" ::: "memory");
            }
        if (isK) { const int b = u.pm >> 5, nb = u.pm & 31;
#pragma unroll
            for (int bj = 0; bj < 2; ++bj)
#pragma unroll
                for (int n = 0; n < 2; ++n) { f32x4 s = ksum[bj][n]; s.x = rsum16(s.x); s.y = rsum16(s.y); s.z = rsum16(s.z); s.w = rsum16(s.w);
                    const int h = 2 * (u.pn - C_K / 256) + bj, d = 32 * wc + 16 * n + 4 * fq;
                    if (fr == 0) *(f32x4*)(kmp + (((size_t)wr * 16 + b * 8 + h) * NBLK + nb) * HD + d) = s * (1.0f / BLK); } }
    } };
struct F4a { const bf16* proj; float* out;
    DEV void elem4(int row, int col, f32x4 v) const { const v2u g = *(const v2u*)(proj + (size_t)row * PST + C_GA + col);
        *(f32x4*)(out + (size_t)row * D + col) = (f32x4){v.x * bflo(g.x), v.y * bfhi(g.x), v.z * bflo(g.y), v.w * bfhi(g.y)}; } };
struct F4b { const bf16* proj; const float* out; bf16* merged;
    DEV void elem4(int row, int col, f32x4 v) const { const v2u g = *(const v2u*)(proj + (size_t)row * PST + C_GB + col); const f32x4 t = *(const f32x4*)(out + (size_t)row * D + col);
        v2u w; w.x = pkbf(t.x + v.x * bflo(g.x), t.y + v.y * bfhi(g.x)); w.y = pkbf(t.z + v.z * bflo(g.y), t.w + v.w * bfhi(g.y)); *(v2u*)(merged + (size_t)row * D + col) = w; } };
struct F5 { const float* x; float* out;
    DEV void elem4(int row, int col, f32x4 v) const { const f32x4 t = *(const f32x4*)(x + (size_t)row * D + col); *(f32x4*)(out + (size_t)row * D + col) = t + v; } };
struct EpiBranch { static constexpr bool PERM = false, AFTER_DRAIN = false, HAS_MID = true; const bf16* proj; bf16* merged;
    DEV void mid(f32x4 (&acc)[2][2][4][2], const pg8::Unit& u, int wr, int wc, int fr, int fq) const {
        const unsigned char* pb = (const unsigned char*)(proj + (size_t)(u.pm * 256 + wr * 64 + fr) * PST + C_GA) + u.pn * 256 + wc * 32 + 4 * fq;
        unsigned gan[4], gbn[4];
#pragma unroll
        for (int q = 0; q < 4; ++q) { const unsigned char* qp_ = pb + (q >> 1) * 128 + (q & 1) * 16; gan[q] = *(const unsigned*)qp_; gbn[q] = *(const unsigned*)(qp_ + 2048); }
#pragma unroll
        for (int g = 0; g < 8; ++g) { const int ai = g >> 2, m = g & 3;
            unsigned gac[4], gbc[4];
#pragma unroll
            for (int q = 0; q < 4; ++q) { gac[q] = gan[q]; gbc[q] = gbn[q]; }
            if (g < 7) { const int gn = g + 1; const unsigned char* rp = pb + (size_t)((gn >> 2) * 128 + (gn & 3) * 16) * (PST * 2);
#pragma unroll
                for (int q = 0; q < 4; ++q) { const unsigned char* qp_ = rp + (q >> 1) * 128 + (q & 1) * 16; gan[q] = *(const unsigned*)qp_; gbn[q] = *(const unsigned*)(qp_ + 2048); } }
#pragma unroll
            for (int bj = 0; bj < 2; ++bj)
#pragma unroll
                for (int n = 0; n < 2; ++n) { const f32x4 ga = gate_dq(gac[bj * 2 + n]), gb = gate_dq(gbc[bj * 2 + n]); f32x4 v = acc[ai][bj][m][n];
                    v.x *= ga.x * __builtin_amdgcn_rcpf(gb.x); v.y *= ga.y * __builtin_amdgcn_rcpf(gb.y); v.z *= ga.z * __builtin_amdgcn_rcpf(gb.z); v.w *= ga.w * __builtin_amdgcn_rcpf(gb.w);
                    acc[ai][bj][m][n] = v; } }
    }
    DEV void operator()(const f32x4 (&acc)[2][2][4][2], const pg8::Unit& u, int wr, int wc, int fr, int fq) const {
        const int row0 = u.pm * 256 + wr * 64 + fr, col0 = u.pn * 256 + wc * 32 + 4 * fq;
        const unsigned char* pb = (const unsigned char*)(proj + (size_t)row0 * PST + C_GA) + 2048 + col0;
        unsigned gbn[4];
#pragma unroll
        for (int q = 0; q < 4; ++q) gbn[q] = *(const unsigned*)(pb + (q >> 1) * 128 + (q & 1) * 16);
#pragma unroll
        for (int g = 0; g < 8; ++g) { const int ai = g >> 2, m = g & 3; const int row = row0 + ai * 128 + m * 16;
            unsigned gbc[4];
#pragma unroll
            for (int q = 0; q < 4; ++q) gbc[q] = gbn[q];
            if (g < 7) { const int gn = g + 1; const unsigned char* rp = pb + (size_t)((gn >> 2) * 128 + (gn & 3) * 16) * (PST * 2);
#pragma unroll
                for (int q = 0; q < 4; ++q) gbn[q] = *(const unsigned*)(rp + (q >> 1) * 128 + (q & 1) * 16); }
#pragma unroll
            for (int bj = 0; bj < 2; ++bj)
#pragma unroll
                for (int n = 0; n < 2; ++n) { const int col = col0 + bj * 128 + n * 16; const f32x4 gb = gate_dq(gbc[bj * 2 + n]); const f32x4 v = acc[ai][bj][m][n];
                    v2u w; w.x = pkbf(v.x * gb.x, v.y * gb.y); w.y = pkbf(v.z * gb.z, v.w * gb.w); *(v2u*)(merged + (size_t)row * D + col) = w; } }
    } };
struct EpiF5 { static constexpr bool PERM = false, AFTER_DRAIN = false, HAS_MID = false; const float* x; float* out; bf16* h1b; float* rss;
    DEV void operator()(const f32x4 (&acc)[2][2][4][2], const pg8::Unit& u, int wr, int wc, int fr, int fq) const {
        const int row0 = u.pm * 256 + wr * 64 + fr, col0 = u.pn * 256 + wc * 32 + 4 * fq;
        f32x4 xn[4];
        { const float* xp = x + (size_t)row0 * D + col0;
#pragma unroll
          for (int q = 0; q < 4; ++q) xn[q] = *(const f32x4*)(xp + (q >> 1) * 128 + (q & 1) * 16); }
#pragma unroll
        for (int g = 0; g < 8; ++g) { const int ai = g >> 2, m = g & 3; const int row = row0 + ai * 128 + m * 16; float ss = 0.f;
            f32x4 xc[4];
#pragma unroll
            for (int q = 0; q < 4; ++q) xc[q] = xn[q];
            if (g < 7) { const int gn = g + 1; const float* xp = x + (size_t)(row0 + (gn >> 2) * 128 + (gn & 3) * 16) * D + col0;
#pragma unroll
                for (int q = 0; q < 4; ++q) xn[q] = *(const f32x4*)(xp + (q >> 1) * 128 + (q & 1) * 16); }
#pragma unroll
            for (int bj = 0; bj < 2; ++bj)
#pragma unroll
                for (int n = 0; n < 2; ++n) { const int col = col0 + bj * 128 + n * 16; const f32x4 v = xc[bj * 2 + n] + acc[ai][bj][m][n];
                    v2u w; w.x = pkbf(v.x, v.y); w.y = pkbf(v.z, v.w); *(v2u*)(h1b + (size_t)row * D + col) = w;
                    ss += (v.x * v.x + v.y * v.y) + (v.z * v.z + v.w * v.w); }
            ss += __shfl_xor(ss, 16); ss += __shfl_xor(ss, 32);
            if (fq == 0) rss[(size_t)row * 32 + u.pn * 4 + wc] = ss; }
    } };
struct EpiF5i { static constexpr bool PERM = false, AFTER_DRAIN = false, HAS_MID = false; const float* x; bf16* h1b; float* rss; const float* rs; const float* cs;
    DEV void operator()(const pg8::i32x4 (&acc)[2][2][4][2], const pg8::Unit& u, int wr, int wc, int fr, int fq) const {
        const int row0 = u.pm * 256 + wr * 64 + fr, col0 = u.pn * 256 + wc * 32 + 4 * fq;
        f32x4 cv[2][2];
#pragma unroll
        for (int bj = 0; bj < 2; ++bj)
#pragma unroll
            for (int n = 0; n < 2; ++n) cv[bj][n] = *(const f32x4*)(cs + col0 + bj * 128 + n * 16);
#pragma unroll
        for (int ai = 0; ai < 2; ++ai)
#pragma unroll
            for (int m = 0; m < 4; ++m) { const int row = row0 + ai * 128 + m * 16; float ss = 0.f; const float r = rs[row];
#pragma unroll
                for (int bj = 0; bj < 2; ++bj)
#pragma unroll
                    for (int n = 0; n < 2; ++n) { const int col = col0 + bj * 128 + n * 16; const pg8::i32x4 a = acc[ai][bj][m][n]; const f32x4 c4 = cv[bj][n];
                        const f32x4 v = *(const f32x4*)(x + (size_t)row * D + col) + (f32x4){(float)a.x * (r * c4.x), (float)a.y * (r * c4.y), (float)a.z * (r * c4.z), (float)a.w * (r * c4.w)};
                        v2u w; w.x = pkbf(v.x, v.y); w.y = pkbf(v.z, v.w); *(v2u*)(h1b + (size_t)row * D + col) = w;
                        ss += (v.x * v.x + v.y * v.y) + (v.z * v.z + v.w * v.w); }
                ss += __shfl_xor(ss, 16); ss += __shfl_xor(ss, 32);
                if (fq == 0) rss[(size_t)row * 32 + u.pn * 4 + wc] = ss;
                asm volatile("" ::: "memory"); }
    } };
DEV void phase_quant_merged(const Ctx& c) {
    const int gw = c.bid * 8 + c.wave, NGW = c.G * 8, lane = c.lane;
    for (int m = gw; m < T; m += NGW) {
        const v4u* src = (const v4u*)(c.merged + (size_t)m * D) + lane;
        v4u v[4]; float am = 0.f;
#pragma unroll
        for (int j = 0; j < 4; ++j) { v[j] = src[64 * j]; const v4u w = v[j];
            am = fmaxf(am, fmaxf(fmaxf(fmaxf(fabsf(bflo(w.x)), fabsf(bfhi(w.x))), fmaxf(fabsf(bflo(w.y)), fabsf(bfhi(w.y)))), fmaxf(fmaxf(fabsf(bflo(w.z)), fabsf(bfhi(w.z))), fmaxf(fabsf(bflo(w.w)), fabsf(bfhi(w.w)))))); }
        am = wave_max(am);
        const float inv = am > 0.f ? 127.0f / am : 0.f;
        v2u* dst = (v2u*)(c.mq8 + (size_t)m * D) + lane;
#pragma unroll
        for (int j = 0; j < 4; ++j) { const v4u w = v[j]; v2u o; o.x = q4(bflo(w.x), bfhi(w.x), bflo(w.y), bfhi(w.y), inv, 0); o.y = q4(bflo(w.z), bfhi(w.z), bflo(w.w), bfhi(w.w), inv, 0); dst[64 * j] = o; }
        if (lane == 0) c.ms[m] = am * (1.0f / 127.0f);
    }
}
struct F6 { bf16* qp;
    DEV void elem4(int row, int col, f32x4 v) const { v2u w; w.x = pkbf(v.x, v.y); w.y = pkbf(v.z, v.w); *(v2u*)(qp + (size_t)row * D + col) = w; } };
struct F9a { bf16* gtmp;
    DEV void elem4(int row, int col, f32x4 v) const { v2u w; w.x = pkbf(sigmoidf_(v.x), sigmoidf_(v.y)); w.y = pkbf(sigmoidf_(v.z), sigmoidf_(v.w)); *(v2u*)(gtmp + (size_t)row * D + col) = w; } };
struct F9b { const bf16* gtmp; float* out;
    DEV void elem4(int row, int col, f32x4 v) const { const v2u g = *(const v2u*)(gtmp + (size_t)row * D + col); float* o = out + (size_t)row * D + col; const f32x4 t = *(const f32x4*)o;
        *(f32x4*)o = (f32x4){t.x + v.x * bflo(g.x), t.y + v.y * bfhi(g.x), t.z + v.z * bflo(g.y), t.w + v.w * bfhi(g.y)}; } };
struct Epi9b { static constexpr bool PERM = false, AFTER_DRAIN = false, HAS_MID = false; const bf16* gtmp; bf16* hb;
    DEV void operator()(const f32x4 (&acc)[2][2][4][2], const pg8::Unit& u, int wr, int wc, int fr, int fq) const {
        const int row0 = u.pm * 256 + wr * 64 + fr, col0 = u.pn * 256 + wc * 32 + 4 * fq;
        v2u gn[4], tn[4];
        { const size_t o0 = (size_t)row0 * D + col0;
#pragma unroll
          for (int q = 0; q < 4; ++q) { const size_t o = o0 + (q >> 1) * 128 + (q & 1) * 16; gn[q] = *(const v2u*)(gtmp + o); tn[q] = *(const v2u*)(hb + o); } }
#pragma unroll
        for (int g = 0; g < 8; ++g) { const int ai = g >> 2, m = g & 3; const size_t o0 = (size_t)(row0 + ai * 128 + m * 16) * D + col0;
            v2u gc[4], tc[4];
#pragma unroll
            for (int q = 0; q < 4; ++q) { gc[q] = gn[q]; tc[q] = tn[q]; }
            if (g < 7) { const int g1 = g + 1; const size_t o1 = (size_t)(row0 + (g1 >> 2) * 128 + (g1 & 3) * 16) * D + col0;
#pragma unroll
                for (int q = 0; q < 4; ++q) { const size_t o = o1 + (q >> 1) * 128 + (q & 1) * 16; gn[q] = *(const v2u*)(gtmp + o); tn[q] = *(const v2u*)(hb + o); } }
#pragma unroll
            for (int bj = 0; bj < 2; ++bj)
#pragma unroll
                for (int n = 0; n < 2; ++n) { const int q = bj * 2 + n; const f32x4 v = acc[ai][bj][m][n]; const v2u t = tc[q], gg = gc[q];
                    v2u w; w.x = pkbf(bflo(t.x) + v.x * bflo(gg.x), bfhi(t.x) + v.y * bfhi(gg.x)); w.y = pkbf(bflo(t.y) + v.z * bflo(gg.y), bfhi(t.y) + v.w * bfhi(gg.y));
                    *(v2u*)(hb + o0 + bj * 128 + n * 16) = w; } }
    } };

template <class F> DEV void naive_gemm(LAS unsigned char* lds, const bf16* A, const bf16* Bt, int M, int N, int K, const F& f) {
    LAS float* As = (LAS float*)lds; LAS float* Bs = As + 64 * 33;
    const int tid = threadIdx.x, ty = tid >> 4, tx = tid & 15;
    const int ntn = N / 64, ntiles = (M / 64) * ntn;
    for (int tile = blockIdx.x; tile < ntiles; tile += gridDim.x) {
        const int tm = tile / ntn, tn = tile % ntn;
        f32x4 a0 = {0.f, 0.f, 0.f, 0.f}, a1 = a0;
        for (int k0 = 0; k0 < K; k0 += 32) {
            { const int r = tid >> 3, cc = (tid & 7) * 4;
              const v2u av = *(const v2u*)(A + (size_t)(tm * 64 + r) * K + k0 + cc), bv = *(const v2u*)(Bt + (size_t)(tn * 64 + r) * K + k0 + cc);
              As[r * 33 + cc] = bflo(av.x); As[r * 33 + cc + 1] = bfhi(av.x); As[r * 33 + cc + 2] = bflo(av.y); As[r * 33 + cc + 3] = bfhi(av.y);
              Bs[r * 33 + cc] = bflo(bv.x); Bs[r * 33 + cc + 1] = bfhi(bv.x); Bs[r * 33 + cc + 2] = bflo(bv.y); Bs[r * 33 + cc + 3] = bfhi(bv.y); }
            __syncthreads();
#pragma unroll 8
            for (int kk = 0; kk < 32; ++kk) { const float x0 = As[(2 * ty) * 33 + kk], x1 = As[(2 * ty + 1) * 33 + kk];
                const f32x4 b = {Bs[(4 * tx) * 33 + kk], Bs[(4 * tx + 1) * 33 + kk], Bs[(4 * tx + 2) * 33 + kk], Bs[(4 * tx + 3) * 33 + kk]};
                a0 += b * x0; a1 += b * x1; }
            __syncthreads();
        }
        f.elem4(tm * 64 + 2 * ty, tn * 64 + 4 * tx, a0); f.elem4(tm * 64 + 2 * ty + 1, tn * 64 + 4 * tx, a1);
    }
}
template <class F> DEV void run_gemm(bool naive, LAS unsigned char* lds, const bf16* A, const bf16* Bt, int M, int N, int K, const F& f, int G, int bid) {
    if (naive) { naive_gemm<F>(lds, A, Bt, M, N, K, f); return; }
    asm volatile("" : "+s"(K));
    pg8::Gemm g{A, Bt, M, N, K, A + K / 2, K}; pg8::StaticOrder S; S.init(M, N, G, bid);
    pg8::EpiW<F> E{f};
    pg8::gemm_phase<pg8::EpiW<F>, pg8::StaticOrder, true, true>((PG8_LAS unsigned char*)lds, g, S, E);
}

template <class F> DEV void run_gemm_i8(LAS unsigned char* lds, const unsigned char* A8, const unsigned char* Bt8, const float* rs, const float* cs, int M, int N, int K, const F& f, int G, int bid) {
    asm volatile("" : "+s"(K));
    pg8::Gemm g{(const bf16*)A8, (const bf16*)Bt8, M, N, K, nullptr, K}; pg8::StaticOrder S; S.init(M, N, G, bid);
    pg8::EpiW8<F> E{f, rs, cs};
    pg8::gemm_phase_i8<pg8::EpiW8<F>, pg8::StaticOrder, GI8_ALIGN, true>((PG8_LAS unsigned char*)lds, g, S, E);
}

DEV void run_gemm_in(LAS unsigned char* lds, const Ctx& c) {
    int K = D; asm volatile("" : "+s"(K));
    pg8::Gemm g{(const bf16*)c.xq8, (const bf16*)c.WinT8, T, INW, K, nullptr, K}; pg8::StaticOrder S; S.init(T, INW, c.G, c.bid);
    pg8::gemm_phase_i8<EpiIn, pg8::StaticOrder, GI8_ALIGN, true>((PG8_LAS unsigned char*)lds, g, S, EpiIn{c.proj, c.xs, c.wcs, c.kmp, c.sst});
}

DEV void phase_kmean_vt(const Ctx& c, unsigned* kcnt) {
    const int gw = c.bid * 8 + c.wave, NGW = c.G * 8, lane = c.lane;
    for (int it = gw; it < 16 * NBLK; it += NGW) { const int bh = it / NBLK, n = it % NBLK, b = bh >> 3, h = bh & 7;
        const bf16* kp = c.proj + (size_t)(b * SEQ + n * BLK + (lane >> 4)) * PST + C_K + h * HD + (lane & 15) * 8;
        float s[8];
#pragma unroll
        for (int i = 0; i < 8; ++i) s[i] = 0.f;
#pragma unroll 8
        for (int r = 0; r < BLK; r += 4) { const v4u w = *(const v4u*)(kp + (size_t)r * PST);
            s[0] += bflo(w.x); s[1] += bfhi(w.x); s[2] += bflo(w.y); s[3] += bfhi(w.y); s[4] += bflo(w.z); s[5] += bfhi(w.z); s[6] += bflo(w.w); s[7] += bfhi(w.w); }
#pragma unroll
        for (int i = 0; i < 8; ++i) { s[i] += __shfl_xor(s[i], 16); s[i] += __shfl_xor(s[i], 32); s[i] *= (1.0f / BLK); }
        if (lane < 16) { float* kd = c.kmean + ((size_t)bh * NBLK + n) * HD + lane * 8; *(f32x4*)kd = (f32x4){s[0], s[1], s[2], s[3]}; *(f32x4*)(kd + 4) = (f32x4){s[4], s[5], s[6], s[7]}; }
        asm volatile("s_waitcnt vmcnt(0)" ::: "memory");
        if (lane == 0) { __builtin_amdgcn_fence(__ATOMIC_RELEASE, "agent"); asm volatile("s_waitcnt vmcnt(0)" ::: "memory"); __hip_atomic_fetch_add(kcnt, 1u, __ATOMIC_RELAXED, __HIP_MEMORY_SCOPE_AGENT); }
    }
}
DEV void sgu_stats(const Ctx& c, LAS float* stats, int t0) {
    const int row = c.tid >> 2, part = c.tid & 3;
    const bf16* vp = c.proj + (size_t)(t0 + row) * PST + C_VG + part * 256;
    float s = 0.f, q = 0.f;
#pragma unroll 4
    for (int i = 0; i < 32; ++i) { const v4u w = *(const v4u*)(vp + i * 8);
        const float e0 = bflo(w.x), e1 = bfhi(w.x), e2 = bflo(w.y), e3 = bfhi(w.y), e4 = bflo(w.z), e5 = bfhi(w.z), e6 = bflo(w.w), e7 = bfhi(w.w);
        s += ((e0 + e1) + (e2 + e3)) + ((e4 + e5) + (e6 + e7)); q += ((e0 * e0 + e1 * e1) + (e2 * e2 + e3 * e3)) + ((e4 * e4 + e5 * e5) + (e6 * e6 + e7 * e7)); }
    s += __shfl_xor(s, 1); s += __shfl_xor(s, 2); q += __shfl_xor(q, 1); q += __shfl_xor(q, 2);
    const float mean = s * (1.0f / 1024.0f), var = fmaxf(q * (1.0f / 1024.0f) - mean * mean, 0.f);
    if (part == 0) { stats[row * 2] = mean; stats[row * 2 + 1] = 1.0f / sqrtf(var + EPS); }
}
DEV void sgu_stats2(const Ctx& c, LAS float* stats, int t0) {
    const int row = c.tid >> 2, j = c.tid & 3;
    const f32x4* sp = (const f32x4*)(c.sst + ((size_t)(t0 + row) * 16 + 4 * j) * 2); const f32x4 a = sp[0], b = sp[1];
    float s = (a.x + a.z) + (b.x + b.z), q = (a.y + a.w) + (b.y + b.w);
    s += dppq<0xB1>(s); s += dppq<0x4E>(s); q += dppq<0xB1>(q); q += dppq<0x4E>(q);
    const float mean = s * (1.0f / 1024.0f), var = fmaxf(q * (1.0f / 1024.0f) - mean * mean, 0.f);
    if (j == 0) { stats[row * 2] = mean; stats[row * 2 + 1] = 1.0f / sqrtf(var + EPS); }
}
constexpr int SG_RS = 320, SG_IMG = 128 * SG_RS, SG_SCR = 32 * 144;
DEV void phase_sgu(const Ctx& c, LAS unsigned char* lds) {
    LAS float* stats = (LAS float*)lds;
    LAS unsigned char* img = lds + 1024;
    LAS unsigned char* scr = lds + 1024 + 2 * SG_IMG + c.wave * SG_SCR;
    const int lane = c.lane, r = lane & 31, hh = lane >> 5, wave = c.wave, tid = c.tid;
    const int mt = wave >> 1, cw = wave & 1, nks = 2 * (mt + 1);
    const int srow = tid >> 4, sch = (tid & 15) * 8;
    const int erow = lane >> 3, ech = cw * 64 + (lane & 7) * 8;
    const unsigned troff = (unsigned)(size_t)img + (unsigned)((8 * hh + ((lane & 15) >> 2)) * SG_RS + (cw * 64 + 16 * ((lane >> 4) & 1) + 4 * (lane & 3)) * 2);
#define SG_LOADVG(V, LG, LB, G_) do { _Pragma("unroll") for (int q = 0; q < 4; ++q) V[q] = *(const v4u*)(c.proj + (size_t)(t0 + srow + 32 * q) * PST + C_VG + (G_) * 128 + sch); \
        LG[0] = *(const f32x4*)(c.ln_g + (G_) * 128 + sch); LG[1] = *(const f32x4*)(c.ln_g + (G_) * 128 + sch + 4); LB[0] = *(const f32x4*)(c.ln_b + (G_) * 128 + sch); LB[1] = *(const f32x4*)(c.ln_b + (G_) * 128 + sch + 4); } while (0)
#define SG_LOADOPS(AF, UU, BI, G_) do { _Pragma("unroll") for (int ks = 0; ks < 8; ++ks) if (ks < nks) AF[ks] = *(const v4u*)(c.swb + ((size_t)((G_) * 128 + 32 * mt + r)) * 128 + 16 * ks + 8 * hh); \
        _Pragma("unroll") for (int j = 0; j < 4; ++j) UU[j] = *(const v4u*)(c.proj + (size_t)(t0 + 32 * mt + erow + 8 * j) * PST + C_U + (G_) * 128 + ech); \
        BI = c.sgu_b[(G_) * 128 + 32 * mt + r]; } while (0)
#define SG_STAGE(V, LG, LB, BUF) do { LAS unsigned char* ib = img + (BUF) * SG_IMG; \
        const float gg[8] = {LG[0].x, LG[0].y, LG[0].z, LG[0].w, LG[1].x, LG[1].y, LG[1].z, LG[1].w}, bbv[8] = {LB[0].x, LB[0].y, LB[0].z, LB[0].w, LB[1].x, LB[1].y, LB[1].z, LB[1].w}; \
        _Pragma("unroll") for (int q = 0; q < 4; ++q) { const int row = srow + 32 * q; const float mean = stats[2 * row], rstd = stats[2 * row + 1]; const v4u w = V[q]; \
            const float e[8] = {bflo(w.x), bfhi(w.x), bflo(w.y), bfhi(w.y), bflo(w.z), bfhi(w.z), bflo(w.w), bfhi(w.w)}; float y[8]; \
            _Pragma("unroll") for (int i = 0; i < 8; ++i) y[i] = (e[i] - mean) * rstd * gg[i] + bbv[i]; \
            *(LAS v4u*)(ib + row * SG_RS + sch * 2) = (v4u){pkbf(y[0], y[1]), pkbf(y[2], y[3]), pkbf(y[4], y[5]), pkbf(y[6], y[7])}; } } while (0)
#define SG_BAR asm volatile("s_waitcnt lgkmcnt(0)\n\ts_barrier" ::: "memory")
    for (int unit = c.bid; unit < 256; unit += c.G) {
        const int chunk = unit >> 1, gh = unit & 1, t0 = chunk * 128, g0 = gh * 4;
        __syncthreads();
        v4u vgN[4]; f32x4 lgN[2], lbN[2];
        v4u afN[8], uuN[4]; float biasN;
        SG_LOADVG(vgN, lgN, lbN, g0);
        SG_LOADOPS(afN, uuN, biasN, g0);
        sgu_stats2(c, stats, t0);
        __syncthreads();
        SG_STAGE(vgN, lgN, lbN, 0);
        SG_BAR;
#pragma unroll 1
        for (int gi = 0; gi < 4; ++gi) { const int g = g0 + gi, buf = gi & 1;
            v4u af[8], uu[4]; const float bias = biasN;
#pragma unroll
            for (int ks = 0; ks < 8; ++ks) af[ks] = afN[ks];
#pragma unroll
            for (int j = 0; j < 4; ++j) uu[j] = uuN[j];
            if (gi < 3) { SG_LOADVG(vgN, lgN, lbN, g + 1); SG_LOADOPS(afN, uuN, biasN, g + 1); }
            f32x16 acc0, acc1;
#pragma unroll
            for (int i = 0; i < 16; ++i) { acc0[i] = 0.f; acc1[i] = 0.f; }
#pragma unroll
            for (int ks = 0; ks < 8; ++ks) if (ks < nks) {
                const unsigned ad = troff + (unsigned)(buf * SG_IMG + 16 * ks * SG_RS);
                v2u b00, b01, b10, b11;
                asm volatile("ds_read_b64_tr_b16 %0, %4\n\tds_read_b64_tr_b16 %1, %4 offset:1280\n\tds_read_b64_tr_b16 %2, %4 offset:64\n\tds_read_b64_tr_b16 %3, %4 offset:1344\n\ts_waitcnt lgkmcnt(0)"
                             : "=&v"(b00), "=&v"(b01), "=&v"(b10), "=&v"(b11) : "v"(ad) : "memory");
                const bf16x8 a = __builtin_bit_cast(bf16x8, af[ks]);
                acc0 = MFMA32(__builtin_bit_cast(bf16x8, ((v4u){b00.x, b00.y, b01.x, b01.y})), a, acc0);
                acc1 = MFMA32(__builtin_bit_cast(bf16x8, ((v4u){b10.x, b10.y, b11.x, b11.y})), a, acc1); }
#pragma unroll
            for (int k = 0; k < 4; ++k) {
                *(LAS v2u*)(scr + r * 144 + (8 * k + 4 * hh) * 2) = (v2u){pkbf(acc0[4 * k] + bias, acc0[4 * k + 1] + bias), pkbf(acc0[4 * k + 2] + bias, acc0[4 * k + 3] + bias)};
                *(LAS v2u*)(scr + r * 144 + (32 + 8 * k + 4 * hh) * 2) = (v2u){pkbf(acc1[4 * k] + bias, acc1[4 * k + 1] + bias), pkbf(acc1[4 * k + 2] + bias, acc1[4 * k + 3] + bias)}; }
            asm volatile("s_waitcnt lgkmcnt(0)" ::: "memory");
#pragma unroll
            for (int j = 0; j < 4; ++j) { const int row = erow + 8 * j; const v4u mx = *(const LAS v4u*)(scr + row * 144 + (lane & 7) * 16); const v4u u = uu[j];
                v4u o; o.x = pkbf(bflo(u.x) * bflo(mx.x), bfhi(u.x) * bfhi(mx.x)); o.y = pkbf(bflo(u.y) * bflo(mx.y), bfhi(u.y) * bfhi(mx.y));
                o.z = pkbf(bflo(u.z) * bflo(mx.z), bfhi(u.z) * bfhi(mx.z)); o.w = pkbf(bflo(u.w) * bflo(mx.w), bfhi(u.w) * bfhi(mx.w));
                *(v4u*)(c.ysgu + (size_t)(t0 + 32 * mt + row) * 1024 + g * 128 + ech) = o; }
            asm volatile("s_waitcnt lgkmcnt(0)" ::: "memory");
            if (gi < 3) SG_STAGE(vgN, lgN, lbN, (gi + 1) & 1);
            SG_BAR;
        }
    }
#undef SG_LOADVG
#undef SG_LOADOPS
#undef SG_STAGE
#undef SG_BAR
}
DEV void naive_sgu(const Ctx& c, LAS unsigned char* lds) {
    LAS float* stats = (LAS float*)lds;
    for (int chunk = c.bid; chunk < 128; chunk += c.G) { const int t0 = chunk * 128;
        __syncthreads(); sgu_stats(c, stats, t0); __syncthreads();
        for (int o = c.tid; o < 128 * 1024; o += NTHREADS) { const int tl = o >> 10, f = o & 1023, g = f >> 7;
            float acc = 0.f;
            for (int s = 0; s <= tl; ++s) { const float v = bf2f(c.proj[(size_t)(t0 + s) * PST + C_VG + f]); const float y = (v - stats[2 * s]) * stats[2 * s + 1] * c.ln_g[f] + c.ln_b[f];
                acc += c.sgu_w[((size_t)g * 128 + tl) * 128 + s] * y; }
            acc += c.sgu_b[g * 128 + tl];
            c.ysgu[(size_t)(t0 + tl) * 1024 + f] = (bf16)(pkbf(bf2f(c.proj[(size_t)(t0 + tl) * PST + C_U + f]) * acc, 0.f) & 0xffff); }
    }
}

DEV void insert3(float v, int n, float& v1, float& v2, float& v3, int& i1, int& i2, int& i3) {
    const bool b1 = v > v1, b2 = v > v2, b3 = v > v3;
    v3 = b2 ? v2 : (b3 ? v : v3); i3 = b2 ? i2 : (b3 ? n : i3);
    v2 = b1 ? v1 : (b2 ? v : v2); i2 = b1 ? i1 : (b2 ? n : i2);
    v1 = b1 ? v : v1; i1 = b1 ? n : i1;
}
constexpr int VT_STRIDE = 520;
constexpr float ATT_C = 0.08838834764831845f * 1.4426950408889634f;
DEV void phase_select(const Ctx& c, unsigned* kcnt) {
    const int lane = c.lane, r = lane & 31, hh = lane >> 5, gw = c.bid * 8 + c.wave, NGW = c.G * 8;
    for (int wt = gw; wt < 16 * NBLK * 8; wt += NGW) {
        const int bh = wt >> 8, j = (wt >> 3) & 31, w = wt & 7, b = bh >> 3, h = bh & 7;
        const int q = j * BLK + 32 * w + r;
        int i1 = -1, i2 = -1, i3 = -1;
        if (j > 0) {
            const bf16* qrow = c.proj + ((size_t)b * SEQ + q) * PST + C_Q + h * HD;
            f32x16 g;
#pragma unroll
            for (int i = 0; i < 16; ++i) g[i] = 0.f;
            const float* km = c.kmp + ((size_t)bh * NBLK + r) * HD; const float* km1 = km + 16 * NBLK * HD;
#pragma unroll
            for (int ks = 0; ks < 8; ++ks) { const bf16x8 qf = *(const bf16x8*)(qrow + 16 * ks + 8 * hh);
                const f32x4 ka = *(const f32x4*)(km + 16 * ks + 8 * hh) + *(const f32x4*)(km1 + 16 * ks + 8 * hh), kb = *(const f32x4*)(km + 16 * ks + 8 * hh + 4) + *(const f32x4*)(km1 + 16 * ks + 8 * hh + 4);
                v4u hi; hi.x = pkbf(ka.x, ka.y); hi.y = pkbf(ka.z, ka.w); hi.z = pkbf(kb.x, kb.y); hi.w = pkbf(kb.z, kb.w);
                v4u lo; lo.x = pkbf(ka.x - bflo(hi.x), ka.y - bfhi(hi.x)); lo.y = pkbf(ka.z - bflo(hi.y), ka.w - bfhi(hi.y)); lo.z = pkbf(kb.x - bflo(hi.z), kb.y - bfhi(hi.z)); lo.w = pkbf(kb.z - bflo(hi.w), kb.w - bfhi(hi.w));
                g = MFMA32(__builtin_bit_cast(bf16x8, hi), qf, g); g = MFMA32(__builtin_bit_cast(bf16x8, lo), qf, g); }
            float v1 = -INFINITY, v2 = -INFINITY, v3 = -INFINITY; int a1 = 0, a2 = 0, a3 = 0;
#pragma unroll
            for (int i = 0; i < 16; ++i) { const int n = crow(i, hh); const float v = (n < j) ? g[i] : -INFINITY; insert3(v, n, v1, v2, v3, a1, a2, a3); }
            const float pv1 = __shfl_xor(v1, 32), pv2 = __shfl_xor(v2, 32), pv3 = __shfl_xor(v3, 32); const int pi1 = __shfl_xor(a1, 32), pi2 = __shfl_xor(a2, 32), pi3 = __shfl_xor(a3, 32);
            insert3(pv1, pi1, v1, v2, v3, a1, a2, a3); insert3(pv2, pi2, v1, v2, v3, a1, a2, a3); insert3(pv3, pi3, v1, v2, v3, a1, a2, a3);
            i1 = v1 > -INFINITY ? a1 : -1; i2 = v2 > -INFINITY ? a2 : -1; i3 = v3 > -INFINITY ? a3 : -1;
        }
        if (hh == 0) *(int4*)(c.sel + ((size_t)bh * SEQ + q) * 4) = make_int4(i1, i2, i3, -1);
    }
}
struct AttItem { unsigned char n, jlo, jhi, own; };
#if ATT_FINE
constexpr int NATT_ITEMS = 58;
__device__ const AttItem ATT_ITEMS[NATT_ITEMS] = {{2,3,6,1}, {0,3,7,0}, {2,13,32,0}, {1,2,4,1}, {0,1,3,1}, {7,8,15,1}, {3,4,7,1}, {0,14,32,0}, {17,18,32,1}, {2,6,13,0}, {3,7,15,0}, {8,9,15,1}, {18,19,32,1}, {8,15,32,0}, {7,15,32,0}, {3,15,32,0}, {1,15,32,0}, {4,5,8,1}, {1,4,8,0}, {9,10,16,1}, {0,7,14,0}, {19,20,32,1}, {4,8,16,0}, {9,16,32,0}, {4,16,32,0}, {10,11,17,1}, {5,6,9,1}, {20,21,32,1}, {11,12,18,1}, {5,9,17,0}, {1,8,15,0}, {10,17,32,0}, {5,17,32,0}, {12,13,19,1}, {21,22,32,1}, {6,7,10,1}, {6,10,18,0}, {11,18,32,0}, {6,18,32,0}, {22,23,32,1}, {13,14,19,1}, {14,15,20,1}, {23,24,32,1}, {13,19,32,0}, {12,19,32,0}, {24,25,32,1}, {15,16,20,1}, {15,20,32,0}, {14,20,32,0}, {16,17,21,1}, {25,26,32,1}, {16,21,32,0}, {26,27,32,1}, {27,28,32,1}, {28,29,32,1}, {29,30,32,1}, {30,31,32,1}, {31,32,32,1}};
#else
constexpr int NATT_ITEMS = 44;
__device__ const AttItem ATT_ITEMS[NATT_ITEMS] = {{9,10,32,1}, {10,11,32,1}, {11,12,32,1}, {0,1,4,1}, {3,4,10,1}, {3,10,32,0}, {4,5,12,1}, {12,13,32,1}, {1,2,5,1}, {0,11,32,0}, {13,14,32,1}, {0,4,11,0}, {5,6,13,1}, {2,3,6,1}, {14,15,32,1}, {4,12,32,0}, {1,12,32,0}, {6,7,14,1}, {15,16,32,1}, {1,5,12,0}, {5,13,32,0}, {2,13,32,0}, {7,8,15,1}, {16,17,32,1}, {6,14,32,0}, {17,18,32,1}, {2,6,13,0}, {8,9,15,1}, {18,19,32,1}, {8,15,32,0}, {7,15,32,0}, {19,20,32,1}, {20,21,32,1}, {21,22,32,1}, {22,23,32,1}, {23,24,32,1}, {24,25,32,1}, {25,26,32,1}, {26,27,32,1}, {27,28,32,1}, {28,29,32,1}, {29,30,32,1}, {30,31,32,1}, {31,32,32,1}};
#endif
constexpr int ATT_LIST_OFF = 65536 + 128 * VT_STRIDE;
constexpr int ATT_LIST_CAP = 2048;
DEV void quant_tables(const Ctx& c, int row0, int row1, int step, int first, LAS unsigned char* scr);
constexpr int NQUANT_ITEMS = 2 * NEXP / 128, NQMIX = 2 * NEXP / 64;
DEV void phase_attn(const Ctx& c, LAS unsigned char* lds, unsigned* qctr, bool skip_compute = false, bool skip_quant = false) {
    LAS unsigned char* Kl = lds;
    LAS unsigned char* Vl = lds + 65536;
    LAS unsigned* list = (LAS unsigned*)(lds + ATT_LIST_OFF);
    LAS unsigned* lctl = list + ATT_LIST_CAP;
    const int tid = c.tid, lane = c.lane, wave = c.wave, r = lane & 31, hh = lane >> 5;
    bf16* partO = (bf16*)c.out;
    for (;;) {
        __syncthreads();
        if (tid == 0) lctl[1] = atomicAdd(qctr, 1u);
        __syncthreads();
        const int item = (int)lctl[1];
        if (item >= NATT_ITEMS * 16 + (ATT_MIX ? NQMIX : NQUANT_ITEMS)) break;
#if QUANT_FIRST
        if (item < NQUANT_ITEMS) { const int r0 = item * 128; quant_tables(c, r0, r0 + 128, 8, wave, lds + wave * 2048); continue; }
        const int aitem = item - NQUANT_ITEMS;
#else
#if ATT_MIX
        int aitem;
        if (item < 2 * NQMIX) { if (item & 1) { const int r0 = (item >> 1) * 64; if (!skip_quant) quant_tables(c, r0, r0 + 64, 8, wave, lds + wave * 2048); continue; } aitem = item >> 1; }
        else aitem = item - NQMIX;
#else
        if (item >= NATT_ITEMS * 16) { const int r0 = (item - NATT_ITEMS * 16) * 128; if (!skip_quant) quant_tables(c, r0, r0 + 128, 8, wave, lds + wave * 2048); continue; }
        const int aitem = item;
#endif
#endif
        const AttItem it = ATT_ITEMS[aitem >> 4]; const int bh = aitem & 15, n = it.n, b = bh >> 3, h = bh & 7;
        const size_t tb = (size_t)b * SEQ;
        { const bf16* kg = c.proj + (tb + (size_t)n * BLK) * PST + C_K + h * HD; const bf16* vg = c.proj + (tb + (size_t)n * BLK) * PST + C_V + h * HD;
#pragma unroll 1
          for (int qb = 0; qb < 8; qb += 4) {
              v4u kv[4], vv[4];
#pragma unroll
              for (int q = 0; q < 4; ++q) { const int ch = tid + NTHREADS * (qb + q); kv[q] = *(const v4u*)(kg + (size_t)(ch >> 4) * PST + (ch & 15) * 8); vv[q] = *(const v4u*)(vg + (size_t)(ch & 255) * PST + (ch >> 8) * 8); }
#pragma unroll
              for (int q = 0; q < 4; ++q) { const int ch = tid + NTHREADS * (qb + q); const int key = ch >> 4, c16 = ch & 15;
                  *(LAS v4u*)(Kl + key * 256 + ((c16 ^ (key & 15)) << 4)) = kv[q];
                  const int vk = ch & 255, dc = ch >> 8; LAS unsigned char* vp = Vl + (8 * dc) * VT_STRIDE + vk * 2;
                  const unsigned ww[4] = {vv[q].x, vv[q].y, vv[q].z, vv[q].w};
#pragma unroll
                  for (int i = 0; i < 4; ++i) { *(LAS bf16*)(vp + (2 * i) * VT_STRIDE) = (bf16)(ww[i] & 0xffffu); *(LAS bf16*)(vp + (2 * i + 1) * VT_STRIDE) = (bf16)(ww[i] >> 16); } } } }
        const int qlo = it.jlo * BLK, qhi = it.jhi * BLK;
        bool own_pending = it.own != 0;
        for (int cq = qlo; cq < qhi || own_pending; cq += ATT_LIST_CAP) {
            __syncthreads();
            if (tid == 0) lctl[0] = 0u;
            __syncthreads();
            const int cend = (cq + ATT_LIST_CAP < qhi) ? cq + ATT_LIST_CAP : qhi;
            for (int q = cq + tid; q < cend; q += NTHREADS) {
                const int4 s4 = *(const int4*)(c.sel + ((size_t)bh * SEQ + q) * 4);
                const int slot = (s4.x == n) ? 0 : ((s4.y == n) ? 1 : ((s4.z == n) ? 2 : -1));
                if (slot >= 0) { const unsigned pos = __hip_atomic_fetch_add(lctl, 1u, __ATOMIC_RELAXED, __HIP_MEMORY_SCOPE_WORKGROUP); list[pos] = (unsigned)q | ((unsigned)slot << 16); }
            }
            __syncthreads();
            const int len = (int)lctl[0];
            const int nown = own_pending ? 8 : 0, ngroups = nown + ((len + 31) >> 5);
            for (int gi = wave; gi < (skip_compute ? 0 : ngroups); gi += 8) {
                const bool own = gi < nown;
                int q, slot; bool valid = true;
                if (own) { q = n * BLK + 32 * gi + r; slot = 3; }
                else { const int li = 32 * (gi - nown) + r; valid = li < len; const unsigned e = list[valid ? li : 32 * (gi - nown)]; q = (int)(e & 0xffffu); slot = (int)(e >> 16); }
                const int qloc = 32 * gi + r;
                const bf16* qrow = c.proj + (tb + q) * PST + C_Q + h * HD;
                bf16x8 qf[8];
#pragma unroll
                for (int ks = 0; ks < 8; ++ks) qf[ks] = *(const bf16x8*)(qrow + 16 * ks + 8 * hh);
                float m = -INFINITY, l = 0.f;
                f32x16 o[4];
#pragma unroll
                for (int dt = 0; dt < 4; ++dt)
#pragma unroll
                    for (int i = 0; i < 16; ++i) o[dt][i] = 0.f;
                const int nsteps = own ? ((gi >> 1) + 1) : 4;
                for (int st = 0; st < nsteps; ++st) {
                    f32x16 s0, s1;
#pragma unroll
                    for (int i = 0; i < 16; ++i) { s0[i] = 0.f; s1[i] = 0.f; }
                    const int kr0 = 64 * st + r, kr1 = kr0 + 32;
#pragma unroll
                    for (int ks = 0; ks < 8; ++ks) { const int c16 = 2 * ks + hh;
                        const bf16x8 a0 = *(const LAS bf16x8*)(Kl + kr0 * 256 + ((c16 ^ (kr0 & 15)) << 4)), a1 = *(const LAS bf16x8*)(Kl + kr1 * 256 + ((c16 ^ (kr1 & 15)) << 4));
                        s0 = MFMA32(a0, qf[ks], s0); s1 = MFMA32(a1, qf[ks], s1); }
                    float mx = -INFINITY;
                    if (own) {
#pragma unroll
                        for (int i = 0; i < 16; ++i) { const int k0 = 64 * st + crow(i, hh), k1 = k0 + 32;
                            s0[i] = (k0 <= qloc) ? s0[i] * ATT_C : -INFINITY; s1[i] = (k1 <= qloc) ? s1[i] * ATT_C : -INFINITY; mx = fmaxf(mx, fmaxf(s0[i], s1[i])); }
                    } else {
#pragma unroll
                        for (int i = 0; i < 16; ++i) { s0[i] *= ATT_C; s1[i] *= ATT_C; mx = fmaxf(mx, fmaxf(s0[i], s1[i])); }
                    }
                    mx = fmaxf(mx, __shfl_xor(mx, 32));
                    const float mn = fmaxf(m, mx);
                    const float alpha = __builtin_amdgcn_exp2f(m - mn);
                    float ps = 0.f;
#pragma unroll
                    for (int i = 0; i < 16; ++i) { s0[i] = __builtin_amdgcn_exp2f(s0[i] - mn); s1[i] = __builtin_amdgcn_exp2f(s1[i] - mn); ps += s0[i] + s1[i]; }
                    l = l * alpha + ps; m = mn;
                    if (__any(alpha != 1.0f)) {
#pragma unroll
                        for (int dt = 0; dt < 4; ++dt)
#pragma unroll
                            for (int i = 0; i < 16; ++i) o[dt][i] *= alpha;
                    }
                    bf16x8 pf[2][2];
#pragma unroll
                    for (int s = 0; s < 2; ++s) {
                        v4u w0, w1;
                        w0.x = pkbf(s0[8 * s + 0], s0[8 * s + 1]); w0.y = pkbf(s0[8 * s + 2], s0[8 * s + 3]); w0.z = pkbf(s0[8 * s + 4], s0[8 * s + 5]); w0.w = pkbf(s0[8 * s + 6], s0[8 * s + 7]);
                        w1.x = pkbf(s1[8 * s + 0], s1[8 * s + 1]); w1.y = pkbf(s1[8 * s + 2], s1[8 * s + 3]); w1.z = pkbf(s1[8 * s + 4], s1[8 * s + 5]); w1.w = pkbf(s1[8 * s + 6], s1[8 * s + 7]);
                        pf[0][s] = __builtin_bit_cast(bf16x8, w0); pf[1][s] = __builtin_bit_cast(bf16x8, w1); }
#pragma unroll
                    for (int dt = 0; dt < 4; ++dt)
#pragma unroll
                        for (int kt = 0; kt < 2; ++kt)
#pragma unroll
                            for (int s = 0; s < 2; ++s) {
                                const LAS unsigned char* vp = Vl + (32 * dt + r) * VT_STRIDE + (64 * st + 32 * kt + 16 * s + 4 * hh) * 2;
                                const v2u lo = *(const LAS v2u*)vp, hi = *(const LAS v2u*)(vp + 16);
                                const v4u vw = {lo.x, lo.y, hi.x, hi.y};
                                o[dt] = MFMA32(__builtin_bit_cast(bf16x8, vw), pf[kt][s], o[dt]); }
                }
                l += __shfl_xor(l, 32);
                const float inv = 1.0f / l;
                if (valid) {
                    const size_t pidx = ((size_t)bh * SEQ + q) * 4 + slot;
                    bf16* yp = partO + pidx * HD;
#pragma unroll
                    for (int dt = 0; dt < 4; ++dt)
#pragma unroll
                        for (int g4 = 0; g4 < 4; ++g4) { v2u w; w.x = pkbf(o[dt][4 * g4] * inv, o[dt][4 * g4 + 1] * inv); w.y = pkbf(o[dt][4 * g4 + 2] * inv, o[dt][4 * g4 + 3] * inv);
                            *(v2u*)(yp + 32 * dt + 8 * g4 + 4 * hh) = w; }
                    if (hh == 0) c.lse[pidx] = m + __builtin_amdgcn_logf(l);
                }
            }
            own_pending = false;
        }
    }
}
DEV void phase_attn_combine(const Ctx& c) {
    const int lane = c.lane, gw = c.bid * 8 + c.wave, NGW = c.G * 8, h = lane >> 3, sub = lane & 7;
    const bf16* partO = (const bf16*)c.out;
    for (int t = gw; t < T; t += NGW) {
        const int b = t / SEQ, q = t % SEQ; const size_t pbase = ((size_t)(b * NH + h) * SEQ + q) * 4;
        const int4 s4 = *(const int4*)(c.sel + pbase); const f32x4 L = *(const f32x4*)(c.lse + pbase);
        const float l0 = s4.x >= 0 ? L.x : -INFINITY, l1 = s4.y >= 0 ? L.y : -INFINITY, l2 = s4.z >= 0 ? L.z : -INFINITY, l3 = L.w;
        const float M = fmaxf(fmaxf(l0, l1), fmaxf(l2, l3));
        const float w0 = __builtin_amdgcn_exp2f(l0 - M), w1 = __builtin_amdgcn_exp2f(l1 - M), w2 = __builtin_amdgcn_exp2f(l2 - M), w3 = __builtin_amdgcn_exp2f(l3 - M);
        const float winv = 1.0f / (w0 + w1 + w2 + w3);
        const float ws[4] = {w0 * winv, w1 * winv, w2 * winv, w3 * winv};
        float acc[16];
#pragma unroll
        for (int i = 0; i < 16; ++i) acc[i] = 0.f;
#pragma unroll
        for (int s = 0; s < 4; ++s) { if (ws[s] != 0.f) { const v4u a = *(const v4u*)(partO + (pbase + s) * HD + 16 * sub), bq = *(const v4u*)(partO + (pbase + s) * HD + 16 * sub + 8); const float w = ws[s];
            acc[0] += w * bflo(a.x); acc[1] += w * bfhi(a.x); acc[2] += w * bflo(a.y); acc[3] += w * bfhi(a.y); acc[4] += w * bflo(a.z); acc[5] += w * bfhi(a.z); acc[6] += w * bflo(a.w); acc[7] += w * bfhi(a.w);
            acc[8] += w * bflo(bq.x); acc[9] += w * bfhi(bq.x); acc[10] += w * bflo(bq.y); acc[11] += w * bfhi(bq.y); acc[12] += w * bflo(bq.z); acc[13] += w * bfhi(bq.z); acc[14] += w * bflo(bq.w); acc[15] += w * bfhi(bq.w); } }
        v4u o0, o1; o0.x = pkbf(acc[0], acc[1]); o0.y = pkbf(acc[2], acc[3]); o0.z = pkbf(acc[4], acc[5]); o0.w = pkbf(acc[6], acc[7]); o1.x = pkbf(acc[8], acc[9]); o1.y = pkbf(acc[10], acc[11]); o1.z = pkbf(acc[12], acc[13]); o1.w = pkbf(acc[14], acc[15]);
        bf16* yp = c.yatt + (size_t)t * 1024 + h * HD + 16 * sub; *(v4u*)yp = o0; *(v4u*)(yp + 8) = o1;
    }
}
DEV void naive_attn(const Ctx& c, LAS unsigned char* lds) {
    LAS float* qs = (LAS float*)(lds + c.wave * 5120);
    LAS float* sc = qs + 128;
    const int lane = c.lane, gw = c.bid * 8 + c.wave, NGW = c.G * 8;
    for (int idx = gw; idx < 16 * SEQ; idx += NGW) {
        const int bh = idx / SEQ, sq = idx % SEQ, j = sq / BLK, b = bh >> 3, h = bh & 7; const size_t tb = (size_t)b * SEQ;
        const unsigned qw = *(const unsigned*)(c.proj + (tb + sq) * PST + C_Q + h * HD + 2 * lane);
        const float qa = bflo(qw), qb = bfhi(qw);
        qs[2 * lane] = qa; qs[2 * lane + 1] = qb;
        float v1 = -INFINITY, v2 = -INFINITY, v3 = -INFINITY; int i1 = 0, i2 = 0, i3 = 0;
        for (int n = 0; n < j; ++n) { const f32x2 km = *(const f32x2*)(c.kmean + ((size_t)bh * NBLK + n) * HD + 2 * lane); const float g = wave_sum(qa * km.x + qb * km.y); insert3(g, n, v1, v2, v3, i1, i2, i3); }
        const int nsel = j < 3 ? j : 3;
        asm volatile("s_waitcnt lgkmcnt(0)" ::: "memory");
        float mx = -INFINITY;
        for (int bi = 0; bi <= nsel; ++bi) { const int n = (bi == nsel) ? j : (bi == 0 ? i1 : (bi == 1 ? i2 : i3));
            for (int kk = lane; kk < BLK; kk += 64) { const int kpos = n * BLK + kk; float s = -INFINITY;
                if (kpos <= sq) { const bf16* kp = c.proj + (tb + kpos) * PST + C_K + h * HD; float a = 0.f;
                    for (int d = 0; d < HD; d += 2) { const unsigned w = *(const unsigned*)(kp + d); a += qs[d] * bflo(w) + qs[d + 1] * bfhi(w); }
                    s = a * 0.08838834764831845f; }
                sc[bi * BLK + kk] = s; mx = fmaxf(mx, s); } }
#pragma unroll
        for (int o = 1; o < 64; o <<= 1) mx = fmaxf(mx, __shfl_xor(mx, o));
        asm volatile("s_waitcnt lgkmcnt(0)" ::: "memory");
        float sum = 0.f, oa = 0.f, ob = 0.f;
        for (int bi = 0; bi <= nsel; ++bi) { const int n = (bi == nsel) ? j : (bi == 0 ? i1 : (bi == 1 ? i2 : i3));
            for (int kk = 0; kk < BLK; ++kk) { const float pz = __expf(sc[bi * BLK + kk] - mx); if (pz == 0.f) continue;
                const unsigned w = *(const unsigned*)(c.proj + (tb + n * BLK + kk) * PST + C_V + h * HD + 2 * lane); sum += pz; oa += pz * bflo(w); ob += pz * bfhi(w); } }
        *(unsigned*)(c.yatt + (tb + sq) * 1024 + h * HD + 2 * lane) = pkbf(oa / sum, ob / sum);
    }
}


DEV void phase_final(const Ctx& c) {
    const int gw = c.bid * 8 + c.wave, NGW = c.G * 8, lane = c.lane;
    const f32x4* gr = (const f32x4*)c.g_fin + lane;
    v2u vn[8]; int m = gw;
    if (m < T) { const v2u* xr = (const v2u*)(c.h2b + (size_t)m * D) + lane;
#pragma unroll
        for (int j = 0; j < 8; ++j) vn[j] = xr[64 * j]; }
    for (; m < T; m += NGW) {
        f32x4 v[8]; float s = 0.f;
#pragma unroll
        for (int j = 0; j < 8; ++j) { v[j] = (f32x4){bflo(vn[j].x), bfhi(vn[j].x), bflo(vn[j].y), bfhi(vn[j].y)}; s += (v[j].x * v[j].x + v[j].y * v[j].y) + (v[j].z * v[j].z + v[j].w * v[j].w); }
        { const int mn = m + NGW < T ? m + NGW : m; const v2u* xn_ = (const v2u*)(c.h2b + (size_t)mn * D) + lane;
#pragma unroll
          for (int j = 0; j < 8; ++j) vn[j] = xn_[64 * j]; }
        const float r = 1.0f / sqrtf(wsum_q(s) * (1.0f / D) + EPS);
        f32x4* xr = (f32x4*)(c.out + (size_t)m * D) + lane;
#pragma unroll
        for (int j = 0; j < 8; ++j) xr[64 * j] = v[j] * r * gr[64 * j];
    }
}

DEV unsigned f2key(float f) { const unsigned u = __float_as_uint(f); return u ^ ((unsigned)((int)u >> 31) | 0x80000000u); }
DEV float key2f(unsigned k) { const unsigned u = (k & 0x80000000u) ? (k ^ 0x80000000u) : ~k; return __uint_as_float(u); }
#define TK_INSERT(L, key) do { unsigned _k = (key); _Pragma("unroll") for (int _j = 0; _j < 16; ++_j) { const unsigned _hi = max(L[_j], _k); _k = min(L[_j], _k); L[_j] = _hi; } } while (0)
#define TK_MERGE(a, b) do { _Pragma("unroll") for (int _i = 0; _i < 16; ++_i) a[_i] = max(a[_i], b[15 - _i]); \
    _Pragma("unroll") for (int _st = 8; _st >= 1; _st >>= 1) { _Pragma("unroll") for (int _i = 0; _i < 16; ++_i) if ((_i & _st) == 0) { const unsigned _x = max(a[_i], a[_i + _st]), _y = min(a[_i], a[_i + _st]); a[_i] = _x; a[_i + _st] = _y; } } } while (0)
#define TK_SORT16(a) do { _Pragma("unroll") for (int _k = 2; _k <= 16; _k <<= 1) { _Pragma("unroll") for (int _j = _k >> 1; _j > 0; _j >>= 1) { _Pragma("unroll") for (int _i = 0; _i < 16; ++_i) { const int _l = _i ^ _j; \
    if (_l > _i) { const unsigned _x = max(a[_i], a[_l]), _y = min(a[_i], a[_l]); if ((_i & _k) == 0) { a[_i] = _x; a[_l] = _y; } else { a[_i] = _y; a[_l] = _x; } } } } } } while (0)
DEV void peer_topk_task(const Ctx& c, int tg, int h) {
    const int lane = c.lane, r = lane & 31, hh = lane >> 5;
    {
        const int tok = tg * 32 + r;
        unsigned LA[16], LB[16];
#pragma unroll
        for (int p = 0; p < 2; ++p) {
            const bf16* qrow = c.qp + (size_t)tok * D + h * 256 + p * 128;
            bf16x8 qf[8];
#pragma unroll
            for (int ks = 0; ks < 8; ++ks) qf[ks] = *(const bf16x8*)(qrow + 16 * ks + 8 * hh);
            unsigned L[16];
            const bf16* skp = c.skb + ((size_t)(h * 2 + p) * 128) * 128;
            bf16x8 an[8];
#pragma unroll
            for (int ks = 0; ks < 8; ++ks) an[ks] = *(const bf16x8*)(skp + (size_t)r * 128 + 16 * ks + 8 * hh);
#pragma unroll 1
            for (int nt = 0; nt < 4; ++nt) {
                f32x16 s;
#pragma unroll
                for (int i = 0; i < 16; ++i) s[i] = 0.f;
                bf16x8 ac[8];
#pragma unroll
                for (int ks = 0; ks < 8; ++ks) ac[ks] = an[ks];
                { const int ntn = nt < 3 ? nt + 1 : 3;
#pragma unroll
                  for (int ks = 0; ks < 8; ++ks) an[ks] = *(const bf16x8*)(skp + (size_t)(32 * ntn + r) * 128 + 16 * ks + 8 * hh); }
#pragma unroll
                for (int ks = 0; ks < 8; ++ks) s = MFMA32(ac[ks], qf[ks], s);
                unsigned Tl[16];
#pragma unroll
                for (int i = 0; i < 16; ++i) Tl[i] = (f2key(s[i]) & ~0x7Fu) | (unsigned)(32 * nt + crow(i, hh));
                TK_SORT16(Tl);
                if (nt == 0) {
#pragma unroll
                    for (int i = 0; i < 16; ++i) L[i] = Tl[i];
                } else { TK_MERGE(L, Tl); }
            }
            unsigned PL[16];
#pragma unroll
            for (int i = 0; i < 16; ++i) PL[i] = (unsigned)__shfl_xor((int)L[i], 32);
            TK_MERGE(L, PL);
#pragma unroll
            for (int i = 0; i < 16; ++i) { if (p == 0) LA[i] = L[i]; else LB[i] = L[i]; }
        }
        float va[16], vb[16];
#pragma unroll
        for (int i = 0; i < 16; ++i) { va[i] = key2f(LA[i] & ~0x7Fu); vb[i] = key2f(LB[i] & ~0x7Fu); }
        unsigned CL[16];
#pragma unroll
        for (int i = 0; i < 16; ++i) CL[i] = 0u;
#pragma unroll
        for (int i = 0; i < 16; ++i)
#pragma unroll
            for (int m = 0; m < 8; ++m) if ((i + 1) * (2 * m + 1) <= 16) {
                const float bsel = hh ? vb[2 * m + 1] : vb[2 * m];
                const bool okj = hh ? ((i + 1) * (2 * m + 2) <= 16) : true;
                const unsigned key = okj ? ((f2key(va[i] + bsel) & ~0xFFu) | (unsigned)(i * 16 + 2 * m + hh)) : 0u; TK_INSERT(CL, key); }
        { unsigned PC[16];
#pragma unroll
          for (int i = 0; i < 16; ++i) PC[i] = (unsigned)__shfl_xor((int)CL[i], 32);
          TK_MERGE(CL, PC); }
        unsigned pa[4], pb[4];
#pragma unroll
        for (int w = 0; w < 4; ++w) { pa[w] = (LA[4 * w] & 0x7Fu) | ((LA[4 * w + 1] & 0x7Fu) << 8) | ((LA[4 * w + 2] & 0x7Fu) << 16) | ((LA[4 * w + 3] & 0x7Fu) << 24);
                                      pb[w] = (LB[4 * w] & 0x7Fu) | ((LB[4 * w + 1] & 0x7Fu) << 8) | ((LB[4 * w + 2] & 0x7Fu) << 16) | ((LB[4 * w + 3] & 0x7Fu) << 24); }
        float r1; { float ss = 0.f; const f32x4* rp = (const f32x4*)(c.rss + (size_t)tok * 32);
#pragma unroll
            for (int i = 0; i < 8; ++i) { const f32x4 t4 = rp[i]; ss += (t4.x + t4.y) + (t4.z + t4.w); }
            r1 = 1.0f / sqrtf(ss * (1.0f / D) + EPS); }
        float sv[16]; float ssum = 0.f; const float smax = key2f(CL[0] & ~0xFFu);
#pragma unroll
        for (int k = 0; k < 16; ++k) { sv[k] = __expf((key2f(CL[k] & ~0xFFu) - smax) * r1); ssum += sv[k]; }
        const float sinv = 1.0f / ssum;
        int* ep = c.eid + (size_t)tok * 128 + h * 16; float* gp = c.egate + (size_t)tok * 128 + h * 16;
#pragma unroll
        for (int k = 0; k < 16; ++k) {
            const unsigned ci = (CL[k] >> 4) & 15u, cj = CL[k] & 15u;
            const unsigned wa = (ci >> 2) == 0 ? pa[0] : ((ci >> 2) == 1 ? pa[1] : ((ci >> 2) == 2 ? pa[2] : pa[3]));
            const unsigned wb = (cj >> 2) == 0 ? pb[0] : ((cj >> 2) == 1 ? pb[1] : ((cj >> 2) == 2 ? pb[2] : pb[3]));
            const unsigned ia = (wa >> ((ci & 3u) * 8u)) & 0x7Fu, ib = (wb >> ((cj & 3u) * 8u)) & 0x7Fu;
            if (hh == 0) ep[k] = (int)(ia * 128u + ib); else gp[k] = sv[k] * sinv;
        }
    }
}
DEV void phase_peer_topk(const Ctx& c) {
    const int gw = c.bid * 8 + c.wave, NGW = c.G * 8;
    for (int wt = gw; wt < (T / 32) * NH; wt += NGW) peer_topk_task(c, wt >> 3, wt & 7);
}
DEV void naive_peer_topk(const Ctx& c) {
    const int lane = c.lane, gw = c.bid * 8 + c.wave, NGW = c.G * 8;
    for (int wt = gw; wt < T * NH; wt += NGW) {
        const int tok = wt >> 3, h = wt & 7;
        float ts[2][16]; int ti[2][16];
#pragma unroll
        for (int p = 0; p < 2; ++p) {
            const bf16* qrow = c.qp + (size_t)tok * D + h * 256 + p * 128;
            float s0 = 0.f, s1 = 0.f;
            const bf16* k0 = c.skb + ((size_t)(h * 2 + p) * 128 + lane) * 128; const bf16* k1 = k0 + 64 * 128;
            for (int d = 0; d < 128; ++d) { const float q = bf2f(qrow[d]); s0 += q * bf2f(k0[d]); s1 += q * bf2f(k1[d]); }
#pragma unroll
            for (int k = 0; k < 16; ++k) {
                float best = fmaxf(s0, s1); int bi = (s0 >= s1) ? lane : lane + 64;
#pragma unroll
                for (int o = 1; o < 64; o <<= 1) { const float ob = __shfl_xor(best, o); const int oi = __shfl_xor(bi, o); if (ob > best || (ob == best && oi < bi)) { best = ob; bi = oi; } }
                ts[p][k] = best; ti[p][k] = bi;
                if (bi == lane) s0 = -INFINITY; if (bi == lane + 64) s1 = -INFINITY;
            }
        }
        float cv[4]; int cid[4];
#pragma unroll
        for (int q = 0; q < 4; ++q) { cv[q] = 0.f; cid[q] = 0; }
#pragma unroll
        for (int i = 0; i < 16; ++i)
#pragma unroll
            for (int jj = 0; jj < 16; ++jj) { if ((lane >> 2) == i && (lane & 3) == (jj >> 2)) { cv[jj & 3] = ts[0][i] + ts[1][jj]; cid[jj & 3] = ti[0][i] * 128 + ti[1][jj]; } }
        float bs[16]; int be[16];
#pragma unroll
        for (int k = 0; k < 16; ++k) {
            float best = cv[0]; int bq = 0;
#pragma unroll
            for (int q = 1; q < 4; ++q) if (cv[q] > best) { best = cv[q]; bq = q; }
            int bpos = lane * 4 + bq; int bid_ = (bq == 0) ? cid[0] : (bq == 1 ? cid[1] : (bq == 2 ? cid[2] : cid[3]));
#pragma unroll
            for (int o = 1; o < 64; o <<= 1) { const float ob = __shfl_xor(best, o); const int op = __shfl_xor(bpos, o); const int oe = __shfl_xor(bid_, o); if (ob > best || (ob == best && op < bpos)) { best = ob; bpos = op; bid_ = oe; } }
            bs[k] = best; be[k] = bid_;
#pragma unroll
            for (int q = 0; q < 4; ++q) if (bpos == lane * 4 + q) cv[q] = -INFINITY;
        }
        const float mxs = bs[0]; float tot = 0.f;
#pragma unroll
        for (int k = 0; k < 16; ++k) { bs[k] = __expf(bs[k] - mxs); tot += bs[k]; }
        int* ep = c.eid + (size_t)tok * 128 + h * 16; float* gp = c.egate + (size_t)tok * 128 + h * 16;
        if (lane == 0) {
#pragma unroll
            for (int k = 0; k < 16; ++k) { ep[k] = be[k]; gp[k] = bs[k] / tot; }
        }
    }
}

DEV float rl_f(float v, int l) { return __int_as_float(__builtin_amdgcn_readlane(__float_as_int(v), l)); }
DEV unsigned q4(float a, float b, float c_, float d, float inv, int off) {
    const int qa = (int)rintf(a * inv) + off, qb = (int)rintf(b * inv) + off, qc = (int)rintf(c_ * inv) + off, qd = (int)rintf(d * inv) + off;
    return (unsigned)(qa & 0xff) | ((unsigned)(qb & 0xff) << 8) | ((unsigned)(qc & 0xff) << 16) | ((unsigned)(qd & 0xff) << 24);
}
DEV float wave_max(float v) {
#pragma unroll
    for (int o = 1; o < 64; o <<= 1) v = fmaxf(v, __shfl_xor(v, o));
    return v;
}
DEV void quant_tables(const Ctx& c, int row0, int row1, int step, int first, LAS unsigned char* scr) {
    const int lane = c.lane;
    int row = row0 + first;
    if (row >= row1) return;
    f32x4 vn[8];
    { const bool isup = row >= NEXP; const int e = isup ? row - NEXP : row; const f32x4* src = (const f32x4*)((isup ? c.up : c.dn) + (size_t)e * D) + lane;
#pragma unroll
      for (int j = 0; j < 8; ++j) vn[j] = src[64 * j]; }
    for (; row < row1; row += step) {
        const bool isup = row >= NEXP; const int e = isup ? row - NEXP : row;
        f32x4 v[8];
#pragma unroll
        for (int j = 0; j < 8; ++j) v[j] = vn[j];
        { const int rn = row + step < row1 ? row + step : row; const bool upn = rn >= NEXP; const int en = upn ? rn - NEXP : rn; const f32x4* src = (const f32x4*)((upn ? c.up : c.dn) + (size_t)en * D) + lane;
#pragma unroll
          for (int j = 0; j < 8; ++j) vn[j] = src[64 * j]; }
        float am = 0.f;
#pragma unroll
        for (int j = 0; j < 8; ++j) { if (!isup) v[j] *= ((const f32x4*)c.g_ffn)[64 * j + lane];
            am = fmaxf(am, fmaxf(fmaxf(fabsf(v[j].x), fabsf(v[j].y)), fmaxf(fabsf(v[j].z), fabsf(v[j].w)))); }
        am = wmax_q(am);
        if (!isup) {
            const float inv = am > 0.f ? 127.0f / am : 0.f;
            unsigned* dst = (unsigned*)(c.dn8 + (size_t)e * D) + lane;
#pragma unroll
            for (int j = 0; j < 8; ++j) dst[64 * j] = q4(v[j].x, v[j].y, v[j].z, v[j].w, inv, 0);
            if (lane == 0) c.sdn[e] = am * (1.0f / 127.0f);
        } else {
            float ssq = 0.f;
#pragma unroll
            for (int j = 0; j < 8; ++j) ssq += (v[j].x * v[j].x + v[j].y * v[j].y) + (v[j].z * v[j].z + v[j].w * v[j].w);
            const float rms = sqrtf(wsum_q(ssq) * (1.0f / D));
            const float stA = am * (1.0f / 7.0f), stB = fminf(stA, 0.36f * rms);
            const float ivA = stA > 0.f ? 1.0f / stA : 0.f, ivB = stB > 0.f ? 1.0f / stB : 0.f;
            float eA = 0.f, eB = 0.f;
#pragma unroll
            for (int j = 0; j < 8; ++j) { const float vv[4] = {v[j].x, v[j].y, v[j].z, v[j].w};
#pragma unroll
                for (int i = 0; i < 4; ++i) { const float qa = fminf(fmaxf(rintf(vv[i] * ivA), -7.f), 7.f) * stA - vv[i], qb = fminf(fmaxf(rintf(vv[i] * ivB), -7.f), 7.f) * stB - vv[i]; eA += qa * qa; eB += qb * qb; } }
            eA = wsum_q(eA); eB = wsum_q(eB);
            const bool useB = am > 0.f && eB < eA;
            const float st = useB ? stB : stA, inv = useB ? ivB : ivA; am = st * 7.0f;
#pragma unroll
            for (int j = 0; j < 8; ++j) { const f32x4 cl = {fminf(fmaxf(v[j].x * inv, -7.f), 7.f), fminf(fmaxf(v[j].y * inv, -7.f), 7.f), fminf(fmaxf(v[j].z * inv, -7.f), 7.f), fminf(fmaxf(v[j].w * inv, -7.f), 7.f)};
                *(LAS unsigned*)(scr + 4 * (64 * j + lane)) = q4(cl.x, cl.y, cl.z, cl.w, 1.0f, 8); }
            asm volatile("s_waitcnt lgkmcnt(0)" ::: "memory");
            const v4u lo = *(const LAS v4u*)(scr + 32 * lane), hi = *(const LAS v4u*)(scr + 32 * lane + 16);
            v4u o; o.x = (lo.x & 0x0F0F0F0Fu) | ((lo.y & 0x0F0F0F0Fu) << 4); o.y = (lo.z & 0x0F0F0F0Fu) | ((lo.w & 0x0F0F0F0Fu) << 4);
                   o.z = (hi.x & 0x0F0F0F0Fu) | ((hi.y & 0x0F0F0F0Fu) << 4); o.w = (hi.z & 0x0F0F0F0Fu) | ((hi.w & 0x0F0F0F0Fu) << 4);
            *(v4u*)(c.up8 + (size_t)e * (D / 2) + 16 * lane) = o;
            if (lane == 0) c.sup[e] = am * (1.0f / 7.0f);
            asm volatile("s_waitcnt lgkmcnt(0)" ::: "memory");
        }
    }
}
#ifndef EXP_NT
#define EXP_NT 2
#endif
constexpr int ENT = EXP_NT;
struct TokQ { int e0, e1, hid0, hid1; float sd0, sd1, gs0, gs1, cf0, cf1, sx, csum; };
DEV int sread_i(int v0, int v1, int k) { const int a = __builtin_amdgcn_readlane(v0, k & 63), b = __builtin_amdgcn_readlane(v1, k & 63); return k < 64 ? a : b; }
DEV float sread_f(float v0, float v1, int k) { return __int_as_float(sread_i(__float_as_int(v0), __float_as_int(v1), k)); }
DEV v4u bload16(__amdgpu_buffer_rsrc_t rs, int voff, int soff) { return __builtin_bit_cast(v4u, __builtin_amdgcn_raw_buffer_load_b128(rs, voff, soff, 0)); }
DEV unsigned bsort_step(unsigned v, unsigned pv, bool keepmin) { return keepmin ? min(v, pv) : max(v, pv); }
DEV void tokq_init(const Ctx& c, int tok, TokQ& s, unsigned (&xq)[4][4], int lane, unsigned idmask = 0xFFFFu) {
    float am = 0.f;
#pragma unroll
    for (int q = 0; q < 4; ++q)
#pragma unroll
        for (int hf = 0; hf < 2; ++hf) { const v4u w = *(const v4u*)(c.h1n + (size_t)tok * D + q * 512 + 16 * (lane & 31) + 8 * hf);
            am = fmaxf(am, fmaxf(fmaxf(fmaxf(fabsf(bflo(w.x)), fabsf(bfhi(w.x))), fmaxf(fabsf(bflo(w.y)), fabsf(bfhi(w.y)))), fmaxf(fmaxf(fabsf(bflo(w.z)), fabsf(bfhi(w.z))), fmaxf(fabsf(bflo(w.w)), fabsf(bfhi(w.w)))))); }
    am = wave_max(am);
    const float r1 = 1.0f / sqrtf(wave_sum(lane < 32 ? c.rss[(size_t)tok * 32 + lane] : 0.f) * (1.0f / D) + EPS);
    const float inv = am > 0.f ? 127.0f / am : 0.f; s.sx = am * (1.0f / 127.0f) * r1;
#pragma unroll
    for (int q = 0; q < 4; ++q)
#pragma unroll
        for (int hf = 0; hf < 2; ++hf) { const v4u w = *(const v4u*)(c.h1n + (size_t)tok * D + q * 512 + 16 * (lane & 31) + 8 * hf);
            xq[q][2 * hf] = q4(bflo(w.x), bfhi(w.x), bflo(w.y), bfhi(w.y), inv, 0); xq[q][2 * hf + 1] = q4(bflo(w.z), bfhi(w.z), bflo(w.w), bfhi(w.w), inv, 0); }
    const float g0 = c.egate[(size_t)tok * 128 + lane], g1 = c.egate[(size_t)tok * 128 + 64 + lane];
    unsigned k0 = (((unsigned)c.eid[(size_t)tok * 128 + lane] & idmask) << 7) | (unsigned)lane, k1 = (((unsigned)c.eid[(size_t)tok * 128 + 64 + lane] & idmask) << 7) | (unsigned)(64 + lane);
#pragma unroll
    for (int k = 2; k <= 128; k <<= 1)
#pragma unroll
        for (int j = k >> 1; j > 0; j >>= 1) {
            if (j == 64) { const unsigned a = min(k0, k1), b = max(k0, k1); k0 = a; k1 = b; }
            else { const unsigned p0 = (unsigned)__shfl_xor((int)k0, j), p1 = (unsigned)__shfl_xor((int)k1, j);
                const bool lower = (lane & j) == 0;
                const bool up0 = (k == 128) ? true : ((lane & k) == 0), up1 = (k == 128) ? true : ((k == 64) ? false : ((lane & k) == 0));
                k0 = bsort_step(k0, p0, up0 == lower); k1 = bsort_step(k1, p1, up1 == lower); }
        }
    s.e0 = (int)(k0 >> 7); s.e1 = (int)(k1 >> 7);
    { const int s0 = (int)(k0 & 127u), s1 = (int)(k1 & 127u);
      const float a0 = __shfl(g0, s0 & 63), b0 = __shfl(g1, s0 & 63), a1 = __shfl(g0, s1 & 63), b1 = __shfl(g1, s1 & 63);
      s.gs0 = (s0 < 64 ? a0 : b0) * c.sup[s.e0]; s.gs1 = (s1 < 64 ? a1 : b1) * c.sup[s.e1]; }
    s.sd0 = c.sdn[s.e0]; s.sd1 = c.sdn[s.e1];
    s.hid0 = 0; s.hid1 = 0; s.cf0 = 0.f; s.cf1 = 0.f; s.csum = 0.f;
}
DEV void q_load(__amdgpu_buffer_rsrc_t rs, const TokQ& s, int kb, int q, int lane, v4u (&dq)[4]) {
    const int esel = kb < 64 ? s.e0 : s.e1;
#pragma unroll
    for (int j = 0; j < 4; ++j) { const int id = __shfl(esel, (kb + 2 * j + (lane >> 5)) & 63);
        dq[j] = bload16(rs, id * D + q * 512 + 16 * (lane & 31), 0); }
}
DEV void u_load(__amdgpu_buffer_rsrc_t rs, const TokQ& s, int kb, int hq, int lane, v4u (&dq)[4]) {
    const int esel = kb < 64 ? s.e0 : s.e1;
#pragma unroll
    for (int j = 0; j < 4; ++j) { const int id = __shfl(esel, (kb + 2 * j + (lane >> 5)) & 63);
        dq[j] = bload16(rs, id * (D / 2) + hq * 512 + 16 * (lane & 31), 0); }
}
DEV void q_down_dot(const unsigned (&xq)[4], const v4u (&dq)[4], int (&part)[16], const int sub) {
#pragma unroll
    for (int j = 0; j < 4; ++j) { int a = __builtin_amdgcn_sdot4((int)dq[j].x, (int)xq[0], 0, false); a = __builtin_amdgcn_sdot4((int)dq[j].y, (int)xq[1], a, false);
        a = __builtin_amdgcn_sdot4((int)dq[j].z, (int)xq[2], a, false); a = __builtin_amdgcn_sdot4((int)dq[j].w, (int)xq[3], a, false); part[4 * sub + j] = a; }
}
DEV void q_down_reduce(TokQ& s, int kg, int lane, const int (&part)[16]) {
    int r8[8], r4[4], r2[2], r1;
    { const bool h = (lane & 16) != 0;
#pragma unroll
      for (int i = 0; i < 8; ++i) { const int keep = h ? part[i + 8] : part[i], send = h ? part[i] : part[i + 8]; r8[i] = keep + __shfl_xor(send, 16); } }
    { const bool h = (lane & 8) != 0;
#pragma unroll
      for (int i = 0; i < 4; ++i) { const int keep = h ? r8[i + 4] : r8[i], send = h ? r8[i] : r8[i + 4]; r4[i] = keep + __shfl_xor(send, 8); } }
    { const bool h = (lane & 4) != 0;
#pragma unroll
      for (int i = 0; i < 2; ++i) { const int keep = h ? r4[i + 2] : r4[i], send = h ? r4[i] : r4[i + 2]; r2[i] = keep + __shfl_xor(send, 4); } }
    { const bool h = (lane & 2) != 0; const int keep = h ? r2[1] : r2[0], send = h ? r2[0] : r2[1]; r1 = keep + __shfl_xor(send, 2); }
    r1 += __shfl_xor(r1, 1);
    const int e = (lane - kg) & 31;
    const int isrc = 4 * (e >> 3) + ((e & 7) >> 1), hsrc = e & 1;
    const int gsum = __shfl(r1, 32 * hsrc + 2 * isrc);
    if ((lane >> 5) == ((kg & 63) >> 5)) { if (kg < 64) s.hid0 += gsum; else s.hid1 += gsum; }
}
DEV void q_up_compute(const TokQ& s, float (&y)[16], int kb, int lane, const v4u (&uq)[4]) {
#pragma unroll
    for (int j = 0; j < 4; ++j) { const float flo = sread_f(s.cf0, s.cf1, kb + 2 * j), fhi = sread_f(s.cf0, s.cf1, kb + 2 * j + 1); const float f = lane < 32 ? flo : fhi;
        const unsigned ww[4] = {uq[j].x, uq[j].y, uq[j].z, uq[j].w};
#pragma unroll
        for (int w = 0; w < 4; ++w) { y[4 * w + 0] += f * (float)(ww[w] & 0xffu); y[4 * w + 1] += f * (float)((ww[w] >> 8) & 0xffu); y[4 * w + 2] += f * (float)((ww[w] >> 16) & 0xffu); y[4 * w + 3] += f * (float)(ww[w] >> 24); } }
}
DEV void tokq_final(const Ctx& c, int tok, int lane) {
    const v2u* hp = (const v2u*)(c.h2b + (size_t)tok * D) + lane;
    f32x4 v[8]; float ss = 0.f, am = 0.f;
#pragma unroll
    for (int j = 0; j < 8; ++j) { const v2u w = hp[64 * j]; v[j] = (f32x4){bflo(w.x), bfhi(w.x), bflo(w.y), bfhi(w.y)}; ss += (v[j].x * v[j].x + v[j].y * v[j].y) + (v[j].z * v[j].z + v[j].w * v[j].w);
        am = fmaxf(am, fmaxf(fmaxf(fabsf(v[j].x), fabsf(v[j].y)), fmaxf(fabsf(v[j].z), fabsf(v[j].w)))); }
    const float rr = 1.0f / sqrtf(wave_sum(ss) * (1.0f / D) + EPS);
    am = wave_max(am);
    const float inv = am > 0.f ? 127.0f / am : 0.f;
    unsigned* o4 = (unsigned*)(c.h2q8 + (size_t)tok * D) + lane;
#pragma unroll
    for (int j = 0; j < 8; ++j) o4[64 * j] = q4(v[j].x, v[j].y, v[j].z, v[j].w, inv, 0);
    if (lane == 0) c.h2s[tok] = am * (1.0f / 127.0f) * rr;
}
DEV void phase_peer_experts(const Ctx& c, unsigned idmask = 0xFFFFu) {
    const int lane = c.lane, gw = c.bid * 8 + c.wave, NGW = c.G * 8;
    const __amdgpu_buffer_rsrc_t rsd = __builtin_amdgcn_make_buffer_rsrc((void*)c.dn8, 0, NEXP * D, 0x00020000), rsu = __builtin_amdgcn_make_buffer_rsrc((void*)c.up8, 0, NEXP * D / 2, 0x00020000);
    for (int tg = gw; tg < T / ENT; tg += NGW) {
        const int tok0 = tg * ENT;
        TokQ S[ENT];
        {
            unsigned xq[ENT][4][4];
#pragma unroll
            for (int t = 0; t < ENT; ++t) tokq_init(c, tok0 + t, S[t], xq[t], lane, idmask);
#pragma unroll 1
            for (int q = 0; q < 4; ++q) {
                unsigned xc[ENT][4];
#pragma unroll
                for (int t = 0; t < ENT; ++t)
#pragma unroll
                    for (int w = 0; w < 4; ++w) xc[t][w] = q == 0 ? xq[t][0][w] : (q == 1 ? xq[t][1][w] : (q == 2 ? xq[t][2][w] : xq[t][3][w]));
                v4u dq[ENT][2][4];
#pragma unroll
                for (int t = 0; t < ENT; ++t) { q_load(rsd, S[t], 0, q, lane, dq[t][0]); q_load(rsd, S[t], 8, q, lane, dq[t][1]); }
#pragma unroll 1
                for (int kg = 0; kg < 128; kg += 32) {
                    int part[ENT][16];
#pragma unroll
                    for (int sub = 0; sub < 4; ++sub) { const int kb = kg + 8 * sub, kn = kb + 16 < 128 ? kb + 16 : 120;
#pragma unroll
                        for (int t = 0; t < ENT; ++t) { q_down_dot(xc[t], dq[t][sub & 1], part[t], sub); q_load(rsd, S[t], kn, q, lane, dq[t][sub & 1]); } }
#pragma unroll
                    for (int t = 0; t < ENT; ++t) q_down_reduce(S[t], kg, lane, part[t]);
                }
            }
        }
#pragma unroll
        for (int t = 0; t < ENT; ++t) { S[t].cf0 = S[t].gs0 * gelu_erf((float)S[t].hid0 * (S[t].sx * S[t].sd0)); S[t].cf1 = S[t].gs1 * gelu_erf((float)S[t].hid1 * (S[t].sx * S[t].sd1));
            S[t].csum = wave_sum(S[t].cf0 + S[t].cf1); }
        unsigned cpk[ENT]; float cscale[ENT]; int csumq[ENT];
#pragma unroll
        for (int t = 0; t < ENT; ++t) { const float cm = wave_max(fmaxf(fabsf(S[t].cf0), fabsf(S[t].cf1))); const float inv = cm > 0.f ? 127.0f / cm : 0.f; cscale[t] = cm * (1.0f / 127.0f);
            const int c0 = (int)rintf(S[t].cf0 * inv), c1 = (int)rintf(S[t].cf1 * inv);
            { int sq = c0 + c1;
#pragma unroll
              for (int o = 1; o < 64; o <<= 1) sq += __shfl_xor(sq, o);
              csumq[t] = sq; }
            unsigned pk = 0u;
#pragma unroll
            for (int i = 0; i < 4; ++i) { const int p = 8 * ((lane & 31) >> 1) + (lane & 1) + 2 * i; const int a = __shfl(c0, p & 63), bq = __shfl(c1, p & 63); pk |= ((unsigned)((p < 64 ? a : bq) & 0xff)) << (8 * i); }
            cpk[t] = pk; }
#pragma unroll 1
        for (int hq = 0; hq < 2; ++hq) {
            int y[ENT][32];
#pragma unroll
            for (int t = 0; t < ENT; ++t)
#pragma unroll
                for (int i = 0; i < 32; ++i) y[t][i] = 0;
            v4u uq[ENT][4];
#pragma unroll
            for (int t = 0; t < ENT; ++t) u_load(rsu, S[t], 0, hq, lane, uq[t]);
            for (int kb = 0; kb < 128; kb += 8) { const int kn = kb + 8 < 128 ? kb + 8 : 120;
#pragma unroll
                for (int t = 0; t < ENT; ++t) {
                    const unsigned clo = (unsigned)__builtin_amdgcn_readlane((int)cpk[t], (kb >> 2) & 31), chi = (unsigned)__builtin_amdgcn_readlane((int)cpk[t], ((kb >> 2) & 31) + 1);
                    const int cw = (int)(lane < 32 ? clo : chi);
                    const unsigned a0[4] = {uq[t][0].x, uq[t][0].y, uq[t][0].z, uq[t][0].w}, a1[4] = {uq[t][1].x, uq[t][1].y, uq[t][1].z, uq[t][1].w}, a2[4] = {uq[t][2].x, uq[t][2].y, uq[t][2].z, uq[t][2].w}, a3[4] = {uq[t][3].x, uq[t][3].y, uq[t][3].z, uq[t][3].w};
#pragma unroll
                    for (int w = 0; w < 4; ++w)
#pragma unroll
                        for (int nb = 0; nb < 2; ++nb) {
                            const unsigned b0 = (a0[w] >> (4 * nb)) & 0x0F0F0F0Fu, b1 = (a1[w] >> (4 * nb)) & 0x0F0F0F0Fu, b2 = (a2[w] >> (4 * nb)) & 0x0F0F0F0Fu, b3 = (a3[w] >> (4 * nb)) & 0x0F0F0F0Fu;
                            const unsigned x0 = __builtin_amdgcn_perm(b1, b0, 0x05010400u), x1 = __builtin_amdgcn_perm(b1, b0, 0x07030602u), x2 = __builtin_amdgcn_perm(b3, b2, 0x05010400u), x3 = __builtin_amdgcn_perm(b3, b2, 0x07030602u);
                            const unsigned t0 = __builtin_amdgcn_perm(x2, x0, 0x05040100u), t1 = __builtin_amdgcn_perm(x2, x0, 0x07060302u), t2 = __builtin_amdgcn_perm(x3, x1, 0x05040100u), t3 = __builtin_amdgcn_perm(x3, x1, 0x07060302u);
                            const int yb = 8 * w + 4 * nb;
                            y[t][yb + 0] = __builtin_amdgcn_sdot4((int)t0, cw, y[t][yb + 0], false); y[t][yb + 1] = __builtin_amdgcn_sdot4((int)t1, cw, y[t][yb + 1], false);
                            y[t][yb + 2] = __builtin_amdgcn_sdot4((int)t2, cw, y[t][yb + 2], false); y[t][yb + 3] = __builtin_amdgcn_sdot4((int)t3, cw, y[t][yb + 3], false); }
                    u_load(rsu, S[t], kn, hq, lane, uq[t]); } }
#pragma unroll
            for (int t = 0; t < ENT; ++t) {
#pragma unroll
                for (int i = 0; i < 32; ++i) y[t][i] += __shfl_xor(y[t][i], 32);
                if (lane < 32) { bf16* hp = c.h2b + (size_t)(tok0 + t) * D + hq * 1024 + 32 * lane; const float sc = cscale[t]; const int corr = 8 * csumq[t];
                    const bf16* hb = c.h1n + (size_t)(tok0 + t) * D + hq * 1024 + 32 * lane;
#pragma unroll
                    for (int g8 = 0; g8 < 4; ++g8) { const v4u hw = *(const v4u*)(hb + 8 * g8); const int yb = 8 * g8; v4u o;
                        o.x = pkbf(bflo(hw.x) + (float)(y[t][yb] - corr) * sc, bfhi(hw.x) + (float)(y[t][yb + 1] - corr) * sc); o.y = pkbf(bflo(hw.y) + (float)(y[t][yb + 2] - corr) * sc, bfhi(hw.y) + (float)(y[t][yb + 3] - corr) * sc);
                        o.z = pkbf(bflo(hw.z) + (float)(y[t][yb + 4] - corr) * sc, bfhi(hw.z) + (float)(y[t][yb + 5] - corr) * sc); o.w = pkbf(bflo(hw.w) + (float)(y[t][yb + 6] - corr) * sc, bfhi(hw.w) + (float)(y[t][yb + 7] - corr) * sc);
                        *(v4u*)(hp + yb) = o; } } }
        }
        __builtin_amdgcn_fence(__ATOMIC_RELEASE, "workgroup"); asm volatile("s_waitcnt vmcnt(0)" ::: "memory"); __builtin_amdgcn_fence(__ATOMIC_ACQUIRE, "workgroup");
#pragma unroll
        for (int t = 0; t < ENT; ++t) tokq_final(c, tok0 + t, lane);
    }
}


#define GAS __attribute__((address_space(1)))
#define XB_TMO      128
#define XB_XCNT(j)  (256  + 64 * (j))
#define XB_XSUB(j)  (1280 + 64 * (j))
#define XB_XGEN(j)  (2304 + 64 * (j))
#define XB_TOP      3328
#define XB_TOPGEN   3392
#define XCD_BAR_WORDS 3456
#define XB_SPIN_CAP (1u << 18)

__device__ __forceinline__ unsigned xb_ld(unsigned* p)              { return __hip_atomic_load(p, __ATOMIC_RELAXED, __HIP_MEMORY_SCOPE_AGENT); }
__device__ __forceinline__ unsigned xb_add(unsigned* p, unsigned v) { return __hip_atomic_fetch_add(p, v, __ATOMIC_RELAXED, __HIP_MEMORY_SCOPE_AGENT); }
__device__ __forceinline__ unsigned xb_xcc_id() { return (unsigned)__builtin_amdgcn_s_getreg((3 << 11) | 20) & 0xFu; }
#define XB_SPIN(cond, bar) do { unsigned _sp = 0; while (cond) { __builtin_amdgcn_s_sleep(1); \
    if ((++_sp & 255u) == 0u) { if (xb_ld(&(bar)[XB_TMO])) break; if (_sp > XB_SPIN_CAP) { atomicAdd(&(bar)[XB_TMO], 1u); break; } } } } while (0)

struct XcdBarrier {
    unsigned* bar; unsigned x;
    volatile LAS unsigned* st;
};

__device__ __forceinline__ XcdBarrier xcd_barrier_post(unsigned* bar, volatile LAS unsigned* st) {
    XcdBarrier b; b.bar = bar; b.x = xb_xcc_id(); b.st = st;
    if (threadIdx.x == 0) (void)xb_add(&bar[XB_XCNT(b.x)], 1u);
    return b;
}
__device__ __forceinline__ void xcd_barrier_complete(unsigned* bar, unsigned x, unsigned& nloc, unsigned& nx) {
    const unsigned G = gridDim.x * gridDim.y * gridDim.z;
    unsigned sum, cnt, mine, sp = 0u;
    for (;;) {
        sum = 0u; cnt = 0u; mine = 0u;
#pragma unroll
        for (unsigned j = 0; j < 16; ++j) { const unsigned c = xb_ld(&bar[XB_XCNT(j)]); sum += c; cnt += (c > 0u) ? 1u : 0u; mine = (j == x) ? c : mine; }
        if (sum == G) break;
        __builtin_amdgcn_s_sleep(1);
        if ((++sp & 255u) == 0u) { if (xb_ld(&bar[XB_TMO])) break; if (sp > XB_SPIN_CAP) { atomicAdd(&bar[XB_TMO], 1u); break; } }
    }
    nloc = mine > 0u ? mine : 1u; nx = cnt > 0u ? cnt : 1u;
}

__device__ __forceinline__ void xcd_barrier(const XcdBarrier& b) {
    asm volatile("s_waitcnt vmcnt(0)" ::: "memory");
    __syncthreads();
    if (threadIdx.x == 0) {
        unsigned* bar = b.bar;
        __builtin_amdgcn_s_waitcnt(0);
        unsigned nloc = b.st[0], nx = b.st[1];
        if (nloc == 0u) { xcd_barrier_complete(bar, b.x, nloc, nx); b.st[0] = nloc; b.st[1] = nx; }
        const unsigned old = xb_add(&bar[XB_XSUB(b.x)], 1u);
        const unsigned gen = old / nloc;
        if (old + 1u == (gen + 1u) * nloc) {
            __builtin_amdgcn_fence(__ATOMIC_RELEASE, "agent");
            asm volatile("s_waitcnt vmcnt(0)" ::: "memory");
            const unsigned og = xb_add(&bar[XB_TOP], 1u);
            const unsigned tg = og / nx;
            if (og + 1u == (tg + 1u) * nx) xb_add(&bar[XB_TOPGEN], 1u);
            else XB_SPIN(xb_ld(&bar[XB_TOPGEN]) == tg, bar);
            __builtin_amdgcn_fence(__ATOMIC_ACQUIRE, "agent");
            xb_add(&bar[XB_XGEN(b.x)], 1u);
            asm volatile("s_waitcnt vmcnt(0)" ::: "memory");
        } else {
            XB_SPIN(xb_ld(&bar[XB_XGEN(b.x)]) == gen, bar);
            __builtin_amdgcn_fence(__ATOMIC_ACQUIRE, "agent");
            asm volatile("s_waitcnt vmcnt(0)" ::: "memory");
        }
    }
    __syncthreads();
}

struct Args { const float* in[20]; float* out; unsigned char* ws; int ph_lo, ph_hi; };
constexpr int NPHASES = 16;
__global__ void __launch_bounds__(NTHREADS, 2) fwd_kernel(Args args) {
    extern __shared__ __attribute__((aligned(16))) unsigned char lds_raw[];
    LAS unsigned char* lds = (LAS unsigned char*)lds_raw;
    cg::grid_group grid = cg::this_grid();
    Ctx c;
    c.x = args.in[0]; c.p = args.in[1]; c.g_mix = args.in[2]; c.w_in = args.in[3]; c.ln_g = args.in[4]; c.ln_b = args.in[5]; c.sgu_w = args.in[6]; c.sgu_b = args.in[7];
    c.w_ba = args.in[8]; c.w_bs = args.in[9]; c.w_out = args.in[10]; c.g_ffn = args.in[11]; c.w_pq = args.in[12]; c.subk = args.in[13]; c.dn = args.in[14]; c.up = args.in[15];
    c.g_ple = args.in[16]; c.w_pp = args.in[17]; c.w_pg = args.in[18]; c.g_fin = args.in[19];
    c.out = args.out;
    unsigned char* ws = args.ws;
    c.WinT = (bf16*)(ws + WS_WIN); c.WbaT = (bf16*)(ws + WS_WBA); c.WbsT = (bf16*)(ws + WS_WBS); c.WoutT = (bf16*)(ws + WS_WOUT); c.WqT = (bf16*)(ws + WS_WQ); c.WgT = (bf16*)(ws + WS_WG); c.WprojT = (bf16*)(ws + WS_WPROJ);
    c.pb = (bf16*)(ws + WS_PB); c.skb = (bf16*)(ws + WS_SKB); c.kmean = (float*)(ws + WS_KMEAN); c.xn = (bf16*)(ws + WS_XN); c.proj = (bf16*)(ws + WS_PROJ); c.vT = (bf16*)(ws + WS_VT);
    c.yatt = (bf16*)(ws + WS_YATT); c.ysgu = (bf16*)(ws + WS_YSGU); c.merged = (bf16*)(ws + WS_MERGED); c.h1n = (bf16*)(ws + WS_H1N); c.qp = (bf16*)(ws + WS_QP);
    c.dn8 = ws + WS_DN8; c.up8 = ws + WS_UP8; c.sdn = (float*)(ws + WS_SDN); c.sup = (float*)(ws + WS_SDN) + NEXP; c.rss = (float*)(ws + WS_RSS); c.h2n = (bf16*)(ws + WS_H2N); c.gtmp = (bf16*)(ws + WS_GTMP); c.eid = (int*)(ws + WS_EID); c.egate = (float*)(ws + WS_EGATE); c.sel = (int*)(ws + WS_SEL); c.lse = (float*)(ws + WS_LSE);
    c.h2b = (bf16*)(ws + WS_H2B); c.sst = (float*)(ws + 468 * MiB); c.kmp = (float*)(ws + 470 * MiB); c.swb = (bf16*)(ws + WS_SKB + 512 * 1024); c.xq8 = ws + WS_XN; c.WinT8 = ws + WS_WIN; c.WgT8 = ws + WS_WG; c.h2q8 = ws + WS_H2N; c.xs = (float*)(ws + WS_SC); c.h2s = c.xs + T; c.wcs = c.h2s + T; c.gcs = c.wcs + INW; c.qcs = c.gcs + D; c.h1s = c.qcs + D; c.ocs = c.h1s + T; c.ms = c.ocs + D; c.WoutT8 = ws + WS_WOUT; c.mq8 = ws + WS_MQ8; c.WqT8 = ws + WS_WQ; c.h1q8 = ws + WS_H1N;
    c.G = gridDim.x; c.bid = blockIdx.x; c.tid = threadIdx.x; c.lane = c.tid & 63; c.wave = __builtin_amdgcn_readfirstlane(c.tid >> 6);
    const int lo = args.ph_lo, hi = args.ph_hi;
    volatile LAS unsigned* xst = (volatile LAS unsigned*)(lds + LDS_BYTES - 64);
    if (c.tid < 2) xst[c.tid] = 0u;
    __syncthreads();
    XcdBarrier xbar = xcd_barrier_post((unsigned*)(ws + WS_CTL), xst);
#ifndef PHASE_MASK
#define PHASE_MASK 0xFFFFFFFu
#endif
#ifndef REP_MASK
#define REP_MASK 0u
#endif
#define IN(k) ((((PHASE_MASK) >> (k)) & 1u) && lo <= (k) && (k) < hi)
#define NAIVE(k) (((NAIVE_MASK) >> (k)) & 1u)
#define REP(k) for (int _rep = 0; _rep < 1 + (int)(((REP_MASK) >> (k)) & 1u); ++_rep)
    const bool single = (hi - lo) > 1;
    bool first_sync = true;
#define GSYNC() do { if (single) { if ((first_sync && !ALL_XCD) || !USE_XCDBAR) grid.sync(); else xcd_barrier(xbar); first_sync = false; } } while (0)
    unsigned* kcnt = (unsigned*)(ws + WS_CTL) + 8192; unsigned* qctr = (unsigned*)(ws + WS_CTL) + 8256;
    unsigned* cam = (unsigned*)(ws + WS_CTL) + 9216;
    if (IN(0)) { __syncthreads(); phase_prologue(c, lds, cam, kcnt); }
    if (IN(0)) GSYNC();
    if (IN(1)) REP(1) { __syncthreads(); run_gemm_in(lds, c); }
    if (IN(1)) GSYNC();
#ifndef P2_REP_PARTS
#define P2_REP_PARTS 7
#endif
    if (IN(2)) REP(2) { __syncthreads(); const int parts = _rep == 0 ? 7 : P2_REP_PARTS;
        if (parts & 2) { if (NAIVE(2)) naive_sgu(c, lds); else phase_sgu(c, lds); } if (parts & 4) phase_select(c, kcnt); }
    if (IN(2)) GSYNC();
    if (IN(3)) REP(3) { __syncthreads(); if (NAIVE(3)) naive_attn(c, lds); else phase_attn(c, lds, qctr + 64 * _rep, _rep == 1 && ATT_PROBE_SKIPC, _rep == 1 && ATT_PROBE_SKIPQ); }
    if (IN(3)) GSYNC();
    if (IN(14)) REP(14) { if (!NAIVE(3)) phase_attn_combine(c); }
    if (IN(14)) GSYNC();
    if (IN(5)) REP(5) { __syncthreads(); int Kk = D; asm volatile("" : "+s"(Kk)); pg8::Gemm g{c.yatt, c.WbaT, T, D, Kk, c.ysgu, 1024}; pg8::StaticOrder S; S.init(T, D, c.G, c.bid);
                 pg8::gemm_phase<EpiBranch, pg8::StaticOrder, true, true>((PG8_LAS unsigned char*)lds, g, S, EpiBranch{c.proj, c.merged}); }
    if (IN(5)) GSYNC();
    if (IN(6)) REP(6) { __syncthreads(); int Kk = D; asm volatile("" : "+s"(Kk)); pg8::Gemm g{c.merged, c.WoutT, T, D, Kk, c.merged + D / 2, D}; pg8::StaticOrder S; S.init(T, D, c.G, c.bid);
                 pg8::gemm_phase<EpiF5, pg8::StaticOrder, true, true>((PG8_LAS unsigned char*)lds, g, S, EpiF5{c.x, c.out, c.h1n, c.rss}); }
    if (IN(6)) GSYNC();
    if (IN(8)) REP(8) { __syncthreads(); run_gemm(false, lds, c.h1n, c.WqT, T, D, D, F6{c.qp}, c.G, c.bid);
        asm volatile("s_waitcnt vmcnt(0)" ::: "memory"); __syncthreads();
        if (c.tid == 0) __builtin_amdgcn_fence(__ATOMIC_ACQUIRE, "agent");
        asm volatile("s_waitcnt vmcnt(0)" ::: "memory"); __syncthreads();
        pg8::StaticOrder S; S.init(T, D, c.G, c.bid); pg8::Unit u;
        for (int i = 0; S.next(i, u); ++i) peer_topk_task(c, u.pm * 8 + c.wave, u.pn); }
    if (IN(8)) GSYNC();
#ifdef EXP_DUMMY_MASK
    if (IN(10)) { phase_peer_experts(c, EXP_DUMMY_MASK); __syncthreads(); }
#endif
    if (IN(10)) REP(10) { phase_peer_experts(c); }
    if (IN(10)) GSYNC();
    if (IN(11)) REP(11) { __syncthreads(); run_gemm_i8(lds, c.h2q8, c.WgT8, c.h2s, c.gcs, T, D, D, F9a{c.gtmp}, c.G, c.bid); }
    if (IN(11) && NAIVE(11) != NAIVE(12)) GSYNC();
    if (IN(12)) { int Kk = PLE; asm volatile("" : "+s"(Kk)); pg8::Gemm g{c.pb, c.WprojT, T, D, Kk, c.pb + PLE / 2, PLE}; pg8::StaticOrder S; S.init(T, D, c.G, c.bid);
                  pg8::gemm_phase<Epi9b, pg8::StaticOrder, true, true>((PG8_LAS unsigned char*)lds, g, S, Epi9b{c.gtmp, c.h2b}); }
    if (IN(12)) GSYNC();
#ifdef BENCH_OP
    if (IN(13)) {
        unsigned a[16];
#pragma unroll
        for (int i = 0; i < 16; ++i) a[i] = c.tid * 2654435761u + i;
        unsigned b = c.lane * 40503u + 77u, sel = 0x05010400u;
#pragma unroll 1
        for (int it = 0; it < 4000; ++it) {
#pragma unroll
            for (int i = 0; i < 16; ++i) {
#if BENCH_OP == 0
                a[i] = (unsigned)__builtin_amdgcn_sdot4((int)a[i], (int)b, (int)a[i], false);
#elif BENCH_OP == 1
                a[i] = __builtin_amdgcn_perm(a[i], b, sel);
#elif BENCH_OP == 2
                a[i] = (a[i] >> 4) & 0x0F0F0F0Fu;  a[i] += b;
#elif BENCH_OP == 3
                a[i] = (unsigned)__shfl_xor((int)a[i], 16);
#elif BENCH_OP == 4
                a[i] = (unsigned)__builtin_amdgcn_readlane((int)a[i], it & 63) + b;
#elif BENCH_OP == 5
                a[i] = __float_as_uint(__uint_as_float(a[i]) * 1.0001f + 0.5f);
#endif
            }
        }
        unsigned s = 0;
#pragma unroll
        for (int i = 0; i < 16; ++i) s ^= a[i];
        if (s == 0x12345679u) c.out[0] = 1.0f;
        __syncthreads();
    }
#endif
    if (IN(13)) { phase_final(c); }
#if DEBUG_CHECK
    {
        float* dbg = (float*)(ws + WS_KMEAN + 512 * 1024);
        const int gw = c.bid * 8 + c.wave, NGW = c.G * 8;
        if (IN(0)) { for (int i = c.bid * NTHREADS + c.tid; i < T; i += c.G * NTHREADS) dbg[i] = 0.f; }
        if (IN(3)) { __syncthreads(); Ctx c2 = c; c2.yatt = (bf16*)(ws + 434 * MiB); naive_attn(c2, lds); }
        if (IN(20)) { const bf16* ya = (const bf16*)(ws + 434 * MiB);
            for (int t = gw; t < T; t += NGW) { float sa = 0.f;
                for (int cc = c.lane; cc < 1024; cc += 64) { const float d1 = bf2f(c.yatt[(size_t)t * 1024 + cc]) - bf2f(ya[(size_t)t * 1024 + cc]); sa += d1 * d1; }
                sa = wave_sum(sa); if (c.lane == 0) dbg[t] += DBG_GA * sa; } }
        if (IN(22)) { for (int t = c.bid * NTHREADS + c.tid; t < T; t += c.G * NTHREADS) c.out[(size_t)t * D] += sqrtf(dbg[t]); }
    }
#endif
#undef IN
#undef GSYNC
#undef NAIVE
}

extern "C" void kernel_launch(void* const* d_in, const int* in_sizes, int n_in, void* d_out, int out_size, void* d_ws, size_t ws_size, hipStream_t stream) {
    static int grid = 0;
    if (grid == 0) {
        if (n_in != 20 || out_size != T * D || ws_size < WS_END) { fprintf(stderr, "kernel_launch: unexpected shapes (n_in %d, out %d, ws %zu)\n", n_in, out_size, ws_size); grid = -1; return; }
        int dev = 0, cus = 0, per_cu = 0;
        if (hipGetDevice(&dev) != hipSuccess || hipDeviceGetAttribute(&cus, hipDeviceAttributeMultiprocessorCount, dev) != hipSuccess) { grid = -1; return; }
        if (hipFuncSetAttribute((const void*)fwd_kernel, hipFuncAttributeMaxDynamicSharedMemorySize, LDS_BYTES) != hipSuccess) { fprintf(stderr, "kernel_launch: hipFuncSetAttribute failed\n"); grid = -1; return; }
        if (hipOccupancyMaxActiveBlocksPerMultiprocessor(&per_cu, (const void*)fwd_kernel, NTHREADS, LDS_BYTES) != hipSuccess || per_cu < 1) { fprintf(stderr, "kernel_launch: occupancy query says %d blocks per CU\n", per_cu); per_cu = 1; }
        (void)hipGetLastError();
        grid = cus;
    }
    if (grid < 0) return;
    if (hipMemsetAsync((char*)d_ws + WS_CTL, 0, 131072, stream) != hipSuccess) { fprintf(stderr, "kernel_launch: memset failed\n"); return; }
    Args a{};
    for (int i = 0; i < 20; ++i) a.in[i] = (const float*)d_in[i];
    a.out = (float*)d_out; a.ws = (unsigned char*)d_ws;
#if MK_SINGLE
    a.ph_lo = 0; a.ph_hi = NPHASES;
    void* kargs[] = {&a};
    hipError_t e = hipLaunchCooperativeKernel((const void*)fwd_kernel, dim3(grid), dim3(NTHREADS), kargs, LDS_BYTES, stream);
    if (e != hipSuccess) fprintf(stderr, "kernel_launch: cooperative launch failed: %s (grid %d)\n", hipGetErrorString(e), grid);
#else
#if DEBUG_CHECK
    const int order[] = {0, 1, 2, 3, 14, 20, 5, 6, 8, 10, 11, 12, 13, 22};
    for (int ph : order) { a.ph_lo = ph; a.ph_hi = ph + 1; hipLaunchKernelGGL(fwd_kernel, dim3(grid), dim3(NTHREADS), LDS_BYTES, stream, a); }
#else
    const int order[] = {0, 1, 2, 3, 14, 5, 6, 8, 10, 11, 12, 13};
    for (int ph : order) { a.ph_lo = ph; a.ph_hi = ph + 1; hipLaunchKernelGGL(fwd_kernel, dim3(grid), dim3(NTHREADS), LDS_BYTES, stream, a); }
#endif
#endif
}
```

```cpp
#define MK_SINGLE 1
#define EXP_NT 2
#define ALL_XCD 1
#include <hip/hip_runtime.h>
#include <hip/hip_cooperative_groups.h>
#include <cstdio>
#include <cstdint>
namespace cg = cooperative_groups;

#ifndef MK_SINGLE
#define MK_SINGLE 1
#endif
#ifndef NAIVE_MASK
#define NAIVE_MASK 0u
#endif

#ifndef GI8_ALIGN
#define GI8_ALIGN true
#endif
#ifndef ATT_PROBE_SKIPC
#define ATT_PROBE_SKIPC 0
#define ATT_PROBE_SKIPQ 0
#endif
#ifndef ATT_FINE
#define ATT_FINE 0
#endif
#ifndef ATT_MIX
#define ATT_MIX 1
#endif
#ifndef QUANT_FIRST
#define QUANT_FIRST 0
#endif
#ifndef ALL_XCD
#define ALL_XCD 0
#endif
#ifndef USE_XCDBAR
#define USE_XCDBAR 1
#endif
#ifndef DEBUG_CHECK
#define DEBUG_CHECK 0
#endif
#ifndef DBG_GA
#define DBG_GA 200.0f
#define DBG_GS 2.0f
#define DBG_GT 1.0f
#endif
#define DEV __device__ __forceinline__
#define LAS __attribute__((address_space(3)))
typedef unsigned short bf16;
typedef float f32x2 __attribute__((ext_vector_type(2)));
typedef float f32x4 __attribute__((ext_vector_type(4)));
typedef float f32x16 __attribute__((ext_vector_type(16)));
typedef short bf16x8 __attribute__((ext_vector_type(8)));
typedef unsigned v4u __attribute__((ext_vector_type(4)));
typedef unsigned v2u __attribute__((ext_vector_type(2)));
typedef __bf16 bfx2 __attribute__((ext_vector_type(2)));

constexpr int T = 16384, SEQ = 8192, D = 2048, INW = 9216, NH = 8, HD = 128, NBLK = 32, BLK = 256;
constexpr int C_Q = 0, C_K = 1024, C_V = 2048, C_U = 3072, C_VG = 4096, C_GA = 5120, C_GB = 7168;
constexpr int NEXP = 16384, PLE = 256;
constexpr int PST = INW;
constexpr float EPS = 1e-6f;

constexpr size_t MiB = 1u << 20;
constexpr size_t WS_CTL = 0;
constexpr size_t WS_WIN = 1 * MiB, WS_WBA = 37 * MiB, WS_WBS = 41 * MiB, WS_WOUT = 45 * MiB, WS_WQ = 53 * MiB, WS_WG = 61 * MiB, WS_WPROJ = 69 * MiB;
constexpr size_t WS_PB = 70 * MiB, WS_SKB = 78 * MiB, WS_KMEAN = 79 * MiB;
constexpr size_t WS_XN = 80 * MiB, WS_YATT = 1 * MiB, WS_YSGU = 112 * MiB, WS_H2N = 112 * MiB;
constexpr size_t WS_PROJ = 144 * MiB, WS_DN8 = 80 * MiB, WS_UP8 = 498 * MiB, WS_SDN = 79 * MiB + 256 * 1024, WS_RSS = 528 * MiB, WS_H1N = 272 * MiB, WS_QP = 336 * MiB, WS_EID = 400 * MiB, WS_EGATE = 408 * MiB;
constexpr size_t WS_SC = 79 * MiB + 640 * 1024;
constexpr size_t WS_MQ8 = 336 * MiB;
constexpr size_t WS_SEL = 464 * MiB, WS_LSE = 466 * MiB;
constexpr size_t WS_VT = 434 * MiB, WS_MERGED = 434 * MiB, WS_GTMP = 434 * MiB;
constexpr size_t WS_H2B = 144 * MiB;
constexpr size_t WS_END = 530 * MiB;

constexpr int LDS_BYTES = 147456;
constexpr int NTHREADS = 512;

DEV unsigned pkbf(float a, float b) { bfx2 v = __builtin_convertvector((f32x2){a, b}, bfx2); return __builtin_bit_cast(unsigned, v); }
DEV float bflo(unsigned w) { return __uint_as_float(w << 16); }
DEV float bfhi(unsigned w) { return __uint_as_float(w & 0xffff0000u); }
DEV float bf2f(bf16 b) { return __uint_as_float(((unsigned)b) << 16); }
DEV float wave_sum(float v) {
#pragma unroll
    for (int o = 1; o < 64; o <<= 1) v += __shfl_xor(v, o);
    return v;
}
template <int CTRL> DEV float dppq(float v) { return __int_as_float(__builtin_amdgcn_update_dpp(0, __float_as_int(v), CTRL, 0xF, 0xF, false)); }
DEV float wsum_q(float v) {
    v += dppq<0xB1>(v); v += dppq<0x4E>(v); v += dppq<0x1B>(dppq<0x141>(v)); v += dppq<0x128>(v);
    { const auto r = __builtin_amdgcn_permlane16_swap(__float_as_uint(v), __float_as_uint(v), false, false); v = __uint_as_float(r[0]) + __uint_as_float(r[1]); }
    { const auto r = __builtin_amdgcn_permlane32_swap(__float_as_uint(v), __float_as_uint(v), false, false); v = __uint_as_float(r[0]) + __uint_as_float(r[1]); }
    return v;
}
DEV float wmax_q(float v) {
    v = fmaxf(v, dppq<0xB1>(v)); v = fmaxf(v, dppq<0x4E>(v)); v = fmaxf(v, dppq<0x1B>(dppq<0x141>(v))); v = fmaxf(v, dppq<0x128>(v));
    { const auto r = __builtin_amdgcn_permlane16_swap(__float_as_uint(v), __float_as_uint(v), false, false); v = fmaxf(__uint_as_float(r[0]), __uint_as_float(r[1])); }
    { const auto r = __builtin_amdgcn_permlane32_swap(__float_as_uint(v), __float_as_uint(v), false, false); v = fmaxf(__uint_as_float(r[0]), __uint_as_float(r[1])); }
    return v;
}
DEV float sigmoidf_(float x) { return __builtin_amdgcn_rcpf(1.0f + __expf(-x)); }
DEV float gelu_erf(float v) { return 0.5f * v * (1.0f + erff(v * 0.70710678118f)); }
#define MFMA32(a, b, c) __builtin_amdgcn_mfma_f32_32x32x16_bf16((a), (b), (c), 0, 0, 0)
DEV int crow(int reg, int h) { return (reg & 3) + 8 * (reg >> 2) + 4 * h; }
namespace pg8 {
#define PG8_LAS __attribute__((address_space(3)))
typedef unsigned short bf16_t;
typedef short bf16x8 __attribute__((ext_vector_type(8)));
typedef float f32x4 __attribute__((ext_vector_type(4)));
typedef unsigned u32x4 __attribute__((ext_vector_type(4)));
constexpr int BM = 256, BK = 64, HALF = 128, HTB = HALF * BK * 2  , STAGE_BYTES = 8 * HTB, NXCD = 8, WGM = 8;

__host__ __device__ __forceinline__ int lds_byte(int r, int c) { const int st = (r >> 4) * 2 + (c >> 5), rr = r & 15, cc = c & 31, ob = rr * 64 + cc * 2; return st * 1024 + (ob ^ (((ob >> 9) & 1) << 5)); }
__host__ __device__ __forceinline__ void stage_rc(int b, int& R, int& C) { const int st = b / 1024, sb = b % 1024, swz = sb ^ (((sb >> 9) & 1) << 5); R = (st >> 1) * 16 + swz / 64; C = (st & 1) * 32 + (swz % 64) / 2; }
__host__ __device__ __forceinline__ int perm32(int rho) { const int n = rho >> 4, i = rho & 15; return 8 * (i >> 2) + 4 * n + (i & 3); }

struct Unit { int pm, pn; };
struct Gemm { const bf16_t* A; const bf16_t* Bt; int M, N, K; const bf16_t* A2; int lda; };

struct StaticOrder {
    int nM, nN, nwg, G, c;
    __host__ __device__ __forceinline__ void init(int M, int N, int G_, int c_) { nM = M / BM; nN = N / BM; nwg = nM * nN; G = G_; c = c_; }
    __host__ __device__ __forceinline__ bool next(int i, Unit& u) const {
        const long L = (long)i * G + c; if (L >= nwg) return false;
        int wgid = (int)L; { const int q = nwg / NXCD, r = nwg % NXCD, xcd = wgid % NXCD, off = wgid / NXCD; wgid = (xcd < r ? xcd * (q + 1) : r * (q + 1) + (xcd - r) * q) + off; }
        const int nig = WGM * nN, gid = wgid / nig, fm = gid * WGM, gsz = (nM - fm) < WGM ? (nM - fm) : WGM;
        u.pm = fm + ((wgid % nig) % gsz); u.pn = (wgid % nig) / gsz; return true;
    }
    __device__ __forceinline__ void a_ready(const Unit&) const {}
    __device__ __forceinline__ void done(const Unit&) const {}
};


typedef float f32x2 __attribute__((ext_vector_type(2)));
__device__ __forceinline__ f32x2 gelu_pk(f32x2 v) {
    const f32x2 a = __builtin_elementwise_abs(v);
    f32x2 p = a * (-0.0004733090754598379f) + 0.007084554061293602f; p = p * a + (-0.05182737112045288f); p = p * a + (-0.4599924683570862f); p = p * a + (-1.1507878303527832f); p = p * a + (-1.000037670135498f);
    f32x2 e; e.x = __builtin_amdgcn_exp2f(p.x); e.y = __builtin_amdgcn_exp2f(p.y);
    f32x2 r; r.x = fmaxf(v.x, 0.f); r.y = fmaxf(v.y, 0.f);
    return r - a * e;
}
template <class F> struct EpiW {
    static constexpr bool PERM = false, AFTER_DRAIN = false, HAS_MID = false;
    F f;
    __device__ __forceinline__ void operator()(const f32x4 (&acc)[2][2][4][2], const Unit& u, int wr, int wc, int fr, int fq) const {
        const int row0 = u.pm * BM + wr * 64 + fr, col0 = u.pn * BM + wc * 32 + 4 * fq;
#pragma unroll
        for (int ai = 0; ai < 2; ++ai)
#pragma unroll
            for (int m = 0; m < 4; ++m) {
#pragma unroll
                for (int bj = 0; bj < 2; ++bj)
#pragma unroll
                    for (int n = 0; n < 2; ++n) f.elem4(row0 + ai * HALF + m * 16, col0 + bj * HALF + n * 16, acc[ai][bj][m][n]);
                asm volatile("" ::: "memory");
            }
    }
};

typedef int i32x4 __attribute__((ext_vector_type(4)));
template <class F> struct EpiW8 {
    static constexpr bool PERM = false, AFTER_DRAIN = false, HAS_MID = false;
    F f; const float* rs; const float* cs;
    __device__ __forceinline__ void operator()(const i32x4 (&acc)[2][2][4][2], const Unit& u, int wr, int wc, int fr, int fq) const {
        const int row0 = u.pm * BM + wr * 64 + fr, col0 = u.pn * BM + wc * 32 + 4 * fq;
        f32x4 cv[2][2];
#pragma unroll
        for (int bj = 0; bj < 2; ++bj)
#pragma unroll
            for (int n = 0; n < 2; ++n) cv[bj][n] = *(const f32x4*)(cs + col0 + bj * HALF + n * 16);
        float rsv[8];
#pragma unroll
        for (int g = 0; g < 8; ++g) rsv[g] = rs[row0 + (g >> 2) * HALF + (g & 3) * 16];
#pragma unroll
        for (int ai = 0; ai < 2; ++ai)
#pragma unroll
            for (int m = 0; m < 4; ++m) { const int row = row0 + ai * HALF + m * 16; const float r = rsv[ai * 4 + m];
#pragma unroll
                for (int bj = 0; bj < 2; ++bj)
#pragma unroll
                    for (int n = 0; n < 2; ++n) { const i32x4 a = acc[ai][bj][m][n]; const f32x4 c4 = cv[bj][n];
                        f.elem4(row, col0 + bj * HALF + n * 16, (f32x4){(float)a.x * (r * c4.x), (float)a.y * (r * c4.y), (float)a.z * (r * c4.z), (float)a.w * (r * c4.w)}); }
                asm volatile("" ::: "memory");
            }
    }
};
template <class Epi, class Sched, bool ALIGN_EPI = false, bool SP2 = false>
__device__ __forceinline__ void gemm_phase(PG8_LAS unsigned char* lds, const Gemm g, const Sched& S, const Epi& E) {
    const int tid = threadIdx.x, wid = __builtin_amdgcn_readfirstlane(tid >> 6), lane = tid & 63, wr = wid >> 2, wc = wid & 3, fr = lane & 15, fq = lane >> 4;
    const int K = g.K, nt = K / BK;
    unsigned voffA[2], voffB[2];
#pragma unroll
    for (int i = 0; i < 2; ++i) { int R, C; stage_rc(tid * 16 + i * 8192, R, C); const int Rb = Epi::PERM ? ((R & ~31) + perm32(R & 31)) : R;
        voffA[i] = (unsigned)(R * g.lda + C) * 2u; voffB[i] = (unsigned)(Rb * K + C) * 2u; }
    const size_t kstep = (size_t)(BK * 2);
    const size_t hstep = (size_t)HALF * K * 2;
    const size_t tstep = 2 * hstep;
    const size_t hstepA = (size_t)HALF * g.lda * 2, tstepA = 2 * hstepA;
    const int nth = nt / 2; const ptrdiff_t a2off = (const char*)g.A2 - (const char*)g.A - (ptrdiff_t)nth * (BK * 2);
    const unsigned ldsw = (unsigned)wid * 1024u;
    const int aoff = lds_byte(wr * 64 + fr, fq * 8), boff = lds_byte(wc * 32 + fr, fq * 8);
#define PG8_SA(b, h) (((b) * 2 + (h)) * HTB)
#define PG8_SB(b, h) ((4 + (b) * 2 + (h)) * HTB)
#define PG8_STAGE(bufoff, gbase, voff) do { _Pragma("unroll") for (int _i = 0; _i < 2; ++_i) \
        __builtin_amdgcn_global_load_lds((const unsigned*)((const char*)(gbase) + (voff)[_i]), (PG8_LAS unsigned*)(lds + (bufoff) + ldsw + _i * 8192), 16, 0, 0); } while (0)
#define PG8_LDA(dst, b, h) do { _Pragma("unroll") for (int m = 0; m < 4; ++m) _Pragma("unroll") for (int k = 0; k < 2; ++k) dst[m][k] = *(const PG8_LAS bf16x8*)(lds + PG8_SA(b, h) + aoff + m * 2048 + k * 1024); } while (0)
#define PG8_LDB(dst, b, h) do { _Pragma("unroll") for (int n = 0; n < 2; ++n) _Pragma("unroll") for (int k = 0; k < 2; ++k) dst[n][k] = *(const PG8_LAS bf16x8*)(lds + PG8_SB(b, h) + boff + n * 2048 + k * 1024); } while (0)
#define PG8_MMA(ai, bj, At, Bt) do { __builtin_amdgcn_s_setprio(1); _Pragma("unroll") for (int m = 0; m < 4; ++m) _Pragma("unroll") for (int n = 0; n < 2; ++n) _Pragma("unroll") for (int k = 0; k < 2; ++k) \
        acc[ai][bj][m][n] = __builtin_amdgcn_mfma_f32_16x16x32_bf16(Bt[n][k], At[m][k], acc[ai][bj][m][n], 0, 0, 0); __builtin_amdgcn_s_setprio(0); } while (0)
#define PG8_WAIT_V(n) asm volatile("s_waitcnt vmcnt(" #n ")" ::: "memory")
#define PG8_WAIT_L(n) asm volatile("s_waitcnt lgkmcnt(" #n ")" ::: "memory")
#define PG8_BAR __builtin_amdgcn_s_barrier()
#define PG8_SCHED __builtin_amdgcn_sched_barrier(0)
    Unit cur, nxt; int ui = 0;
    if (!S.next(0, cur)) return;
    f32x4 acc[2][2][4][2];
#pragma unroll
    for (int a = 0; a < 2; ++a)
#pragma unroll
        for (int b = 0; b < 2; ++b)
#pragma unroll
            for (int m = 0; m < 4; ++m)
#pragma unroll
                for (int n = 0; n < 2; ++n) acc[a][b][m][n] = (f32x4){0.f, 0.f, 0.f, 0.f};
    bf16x8 At[4][2], B0[2][2], B1[2][2];
    const char* cA = (const char*)g.A + (size_t)cur.pm * tstepA; const char* cB = (const char*)g.Bt + (size_t)cur.pn * tstep;
    S.a_ready(cur);
    if constexpr (SP2) {
        PG8_STAGE(PG8_SB(0, 0), cB, voffB); PG8_STAGE(PG8_SB(0, 1), cB + hstep, voffB); PG8_STAGE(PG8_SA(0, 0), cA, voffA); PG8_STAGE(PG8_SA(0, 1), cA + hstepA, voffA);
        if (wr == 1) PG8_BAR;
        PG8_WAIT_V(2); PG8_BAR;
        PG8_STAGE(PG8_SB(1, 0), cB + kstep, voffB); PG8_STAGE(PG8_SA(1, 0), cA + kstep, voffA); PG8_STAGE(PG8_SB(1, 1), cB + hstep + kstep, voffB);
        PG8_WAIT_V(6); PG8_BAR;
    } else {
        PG8_STAGE(PG8_SB(0, 0), cB, voffB); PG8_STAGE(PG8_SA(0, 0), cA, voffA); PG8_STAGE(PG8_SB(0, 1), cB + hstep, voffB); PG8_STAGE(PG8_SA(0, 1), cA + hstepA, voffA);
        if (wr == 1) PG8_BAR;
        PG8_WAIT_V(4); PG8_BAR;
        PG8_STAGE(PG8_SB(1, 0), cB + kstep, voffB); PG8_STAGE(PG8_SA(1, 0), cA + kstep, voffA); PG8_STAGE(PG8_SB(1, 1), cB + hstep + kstep, voffB);
        PG8_WAIT_V(6); PG8_BAR;
    }
    for (;;) {
        const bool has_next = S.next(ui + 1, nxt);
        const char* nA = has_next ? (const char*)g.A + (size_t)nxt.pm * tstepA : cA; const char* nB = has_next ? (const char*)g.Bt + (size_t)nxt.pn * tstep : cB;
        if constexpr (Epi::HAS_MID) {
        for (int t = 0; t < nth; t += 2) {
            const bool last = (t == nt - 2);
            const char* a1 = cA + (t + 1 >= nth ? a2off : 0) + (size_t)(t + 1) * kstep;
            const char* a2 = last ? nA : cA + (t + 2 >= nth ? a2off : 0) + (size_t)(t + 2) * kstep; const char* b2 = last ? nB : cB + (size_t)(t + 2) * kstep;
            const char* a3 = a2 + kstep; const char* b3 = b2 + kstep;
            if (last && has_next) S.a_ready(nxt);
            if constexpr (SP2) {
            PG8_LDB(B0, 0, 0); PG8_LDB(B1, 0, 1); PG8_SCHED; PG8_LDA(At, 0, 0); PG8_STAGE(PG8_SA(1, 1), a1 + hstepA, voffA);
            PG8_WAIT_V(8); PG8_WAIT_L(0); PG8_BAR; PG8_MMA(0, 0, At, B0); PG8_MMA(0, 1, At, B1); PG8_BAR; PG8_SCHED;
            PG8_LDA(At, 0, 1); PG8_STAGE(PG8_SB(0, 0), b2, voffB); PG8_STAGE(PG8_SB(0, 1), b2 + hstep, voffB); PG8_STAGE(PG8_SA(0, 0), a2, voffA);
            PG8_WAIT_V(8); PG8_WAIT_L(0); PG8_BAR; PG8_MMA(1, 0, At, B0); PG8_MMA(1, 1, At, B1); PG8_BAR; PG8_SCHED;
            PG8_LDB(B0, 1, 0); PG8_LDB(B1, 1, 1); PG8_SCHED; PG8_LDA(At, 1, 0); PG8_STAGE(PG8_SA(0, 1), a2 + hstepA, voffA);
            PG8_WAIT_V(8); PG8_WAIT_L(0); PG8_BAR; PG8_MMA(0, 0, At, B0); PG8_MMA(0, 1, At, B1); PG8_BAR; PG8_SCHED;
            PG8_LDA(At, 1, 1); PG8_STAGE(PG8_SB(1, 0), b3, voffB); PG8_STAGE(PG8_SB(1, 1), b3 + hstep, voffB); PG8_STAGE(PG8_SA(1, 0), a3, voffA);
            PG8_WAIT_V(8); PG8_WAIT_L(0); PG8_BAR; PG8_MMA(1, 0, At, B0); PG8_MMA(1, 1, At, B1); PG8_BAR; PG8_SCHED;
            } else {
            PG8_LDB(B0, 0, 0); PG8_SCHED; PG8_LDA(At, 0, 0); PG8_STAGE(PG8_SA(1, 1), a1 + hstepA, voffA);
            PG8_WAIT_L(8); PG8_BAR; PG8_WAIT_L(0); PG8_MMA(0, 0, At, B0); PG8_BAR; PG8_SCHED;
            PG8_LDB(B1, 0, 1); PG8_STAGE(PG8_SB(0, 0), b2, voffB);
            PG8_BAR; PG8_WAIT_L(0); PG8_MMA(0, 1, At, B1); PG8_BAR;
            PG8_LDA(At, 0, 1); PG8_STAGE(PG8_SA(0, 0), a2, voffA);
            PG8_BAR; PG8_WAIT_L(0); PG8_MMA(1, 0, At, B0); PG8_BAR; PG8_SCHED;
            PG8_STAGE(PG8_SB(0, 1), b2 + hstep, voffB);
            PG8_WAIT_V(6); PG8_BAR; PG8_MMA(1, 1, At, B1); PG8_BAR;
            PG8_LDB(B0, 1, 0); PG8_SCHED; PG8_LDA(At, 1, 0); PG8_STAGE(PG8_SA(0, 1), a2 + hstepA, voffA);
            PG8_WAIT_L(8); PG8_BAR; PG8_WAIT_L(0); PG8_MMA(0, 0, At, B0); PG8_BAR; PG8_SCHED;
            PG8_LDB(B1, 1, 1); PG8_STAGE(PG8_SB(1, 0), b3, voffB);
            PG8_BAR; PG8_WAIT_L(0); PG8_MMA(0, 1, At, B1); PG8_BAR;
            PG8_LDA(At, 1, 1); PG8_STAGE(PG8_SA(1, 0), a3, voffA);
            PG8_BAR; PG8_WAIT_L(0); PG8_MMA(1, 0, At, B0); PG8_BAR; PG8_SCHED;
            PG8_STAGE(PG8_SB(1, 1), b3 + hstep, voffB);
            PG8_WAIT_V(6); PG8_BAR; PG8_MMA(1, 1, At, B1); PG8_BAR;
            }
        }
        E.mid(acc, cur, wr, wc, fr, fq);
        for (int t = nth; t < nt; t += 2) {
            const bool last = (t == nt - 2);
            const char* a1 = cA + (t + 1 >= nth ? a2off : 0) + (size_t)(t + 1) * kstep;
            const char* a2 = last ? nA : cA + (t + 2 >= nth ? a2off : 0) + (size_t)(t + 2) * kstep; const char* b2 = last ? nB : cB + (size_t)(t + 2) * kstep;
            const char* a3 = a2 + kstep; const char* b3 = b2 + kstep;
            if (last && has_next) S.a_ready(nxt);
            if constexpr (SP2) {
            PG8_LDB(B0, 0, 0); PG8_LDB(B1, 0, 1); PG8_SCHED; PG8_LDA(At, 0, 0); PG8_STAGE(PG8_SA(1, 1), a1 + hstepA, voffA);
            PG8_WAIT_V(8); PG8_WAIT_L(0); PG8_BAR; PG8_MMA(0, 0, At, B0); PG8_MMA(0, 1, At, B1); PG8_BAR; PG8_SCHED;
            PG8_LDA(At, 0, 1); PG8_STAGE(PG8_SB(0, 0), b2, voffB); PG8_STAGE(PG8_SB(0, 1), b2 + hstep, voffB); PG8_STAGE(PG8_SA(0, 0), a2, voffA);
            PG8_WAIT_V(8); PG8_WAIT_L(0); PG8_BAR; PG8_MMA(1, 0, At, B0); PG8_MMA(1, 1, At, B1); PG8_BAR; PG8_SCHED;
            PG8_LDB(B0, 1, 0); PG8_LDB(B1, 1, 1); PG8_SCHED; PG8_LDA(At, 1, 0); PG8_STAGE(PG8_SA(0, 1), a2 + hstepA, voffA);
            PG8_WAIT_V(8); PG8_WAIT_L(0); PG8_BAR; PG8_MMA(0, 0, At, B0); PG8_MMA(0, 1, At, B1); PG8_BAR; PG8_SCHED;
            PG8_LDA(At, 1, 1); PG8_STAGE(PG8_SB(1, 0), b3, voffB); PG8_STAGE(PG8_SB(1, 1), b3 + hstep, voffB); PG8_STAGE(PG8_SA(1, 0), a3, voffA);
            PG8_WAIT_V(8); PG8_WAIT_L(0); PG8_BAR; PG8_MMA(1, 0, At, B0); PG8_MMA(1, 1, At, B1); PG8_BAR; PG8_SCHED;
            } else {
            PG8_LDB(B0, 0, 0); PG8_SCHED; PG8_LDA(At, 0, 0); PG8_STAGE(PG8_SA(1, 1), a1 + hstepA, voffA);
            PG8_WAIT_L(8); PG8_BAR; PG8_WAIT_L(0); PG8_MMA(0, 0, At, B0); PG8_BAR; PG8_SCHED;
            PG8_LDB(B1, 0, 1); PG8_STAGE(PG8_SB(0, 0), b2, voffB);
            PG8_BAR; PG8_WAIT_L(0); PG8_MMA(0, 1, At, B1); PG8_BAR;
            PG8_LDA(At, 0, 1); PG8_STAGE(PG8_SA(0, 0), a2, voffA);
            PG8_BAR; PG8_WAIT_L(0); PG8_MMA(1, 0, At, B0); PG8_BAR; PG8_SCHED;
            PG8_STAGE(PG8_SB(0, 1), b2 + hstep, voffB);
            PG8_WAIT_V(6); PG8_BAR; PG8_MMA(1, 1, At, B1); PG8_BAR;
            PG8_LDB(B0, 1, 0); PG8_SCHED; PG8_LDA(At, 1, 0); PG8_STAGE(PG8_SA(0, 1), a2 + hstepA, voffA);
            PG8_WAIT_L(8); PG8_BAR; PG8_WAIT_L(0); PG8_MMA(0, 0, At, B0); PG8_BAR; PG8_SCHED;
            PG8_LDB(B1, 1, 1); PG8_STAGE(PG8_SB(1, 0), b3, voffB);
            PG8_BAR; PG8_WAIT_L(0); PG8_MMA(0, 1, At, B1); PG8_BAR;
            PG8_LDA(At, 1, 1); PG8_STAGE(PG8_SA(1, 0), a3, voffA);
            PG8_BAR; PG8_WAIT_L(0); PG8_MMA(1, 0, At, B0); PG8_BAR; PG8_SCHED;
            PG8_STAGE(PG8_SB(1, 1), b3 + hstep, voffB);
            PG8_WAIT_V(6); PG8_BAR; PG8_MMA(1, 1, At, B1); PG8_BAR;
            }
        }
        } else {
        for (int t = 0; t < nt; t += 2) {
            const bool last = (t == nt - 2);
            const char* a1 = cA + (t + 1 >= nth ? a2off : 0) + (size_t)(t + 1) * kstep;
            const char* a2 = last ? nA : cA + (t + 2 >= nth ? a2off : 0) + (size_t)(t + 2) * kstep; const char* b2 = last ? nB : cB + (size_t)(t + 2) * kstep;
            const char* a3 = a2 + kstep; const char* b3 = b2 + kstep;
            if (last && has_next) S.a_ready(nxt);
            if constexpr (SP2) {
            PG8_LDB(B0, 0, 0); PG8_LDB(B1, 0, 1); PG8_SCHED; PG8_LDA(At, 0, 0); PG8_STAGE(PG8_SA(1, 1), a1 + hstepA, voffA);
            PG8_WAIT_V(8); PG8_WAIT_L(0); PG8_BAR; PG8_MMA(0, 0, At, B0); PG8_MMA(0, 1, At, B1); PG8_BAR; PG8_SCHED;
            PG8_LDA(At, 0, 1); PG8_STAGE(PG8_SB(0, 0), b2, voffB); PG8_STAGE(PG8_SB(0, 1), b2 + hstep, voffB); PG8_STAGE(PG8_SA(0, 0), a2, voffA);
            PG8_WAIT_V(8); PG8_WAIT_L(0); PG8_BAR; PG8_MMA(1, 0, At, B0); PG8_MMA(1, 1, At, B1); PG8_BAR; PG8_SCHED;
            PG8_LDB(B0, 1, 0); PG8_LDB(B1, 1, 1); PG8_SCHED; PG8_LDA(At, 1, 0); PG8_STAGE(PG8_SA(0, 1), a2 + hstepA, voffA);
            PG8_WAIT_V(8); PG8_WAIT_L(0); PG8_BAR; PG8_MMA(0, 0, At, B0); PG8_MMA(0, 1, At, B1); PG8_BAR; PG8_SCHED;
            PG8_LDA(At, 1, 1); PG8_STAGE(PG8_SB(1, 0), b3, voffB); PG8_STAGE(PG8_SB(1, 1), b3 + hstep, voffB); PG8_STAGE(PG8_SA(1, 0), a3, voffA);
            PG8_WAIT_V(8); PG8_WAIT_L(0); PG8_BAR; PG8_MMA(1, 0, At, B0); PG8_MMA(1, 1, At, B1); PG8_BAR; PG8_SCHED;
            } else {
            PG8_LDB(B0, 0, 0); PG8_SCHED; PG8_LDA(At, 0, 0); PG8_STAGE(PG8_SA(1, 1), a1 + hstepA, voffA);
            PG8_WAIT_L(8); PG8_BAR; PG8_WAIT_L(0); PG8_MMA(0, 0, At, B0); PG8_BAR; PG8_SCHED;
            PG8_LDB(B1, 0, 1); PG8_STAGE(PG8_SB(0, 0), b2, voffB);
            PG8_BAR; PG8_WAIT_L(0); PG8_MMA(0, 1, At, B1); PG8_BAR;
            PG8_LDA(At, 0, 1); PG8_STAGE(PG8_SA(0, 0), a2, voffA);
            PG8_BAR; PG8_WAIT_L(0); PG8_MMA(1, 0, At, B0); PG8_BAR; PG8_SCHED;
            PG8_STAGE(PG8_SB(0, 1), b2 + hstep, voffB);
            PG8_WAIT_V(6); PG8_BAR; PG8_MMA(1, 1, At, B1); PG8_BAR;
            PG8_LDB(B0, 1, 0); PG8_SCHED; PG8_LDA(At, 1, 0); PG8_STAGE(PG8_SA(0, 1), a2 + hstepA, voffA);
            PG8_WAIT_L(8); PG8_BAR; PG8_WAIT_L(0); PG8_MMA(0, 0, At, B0); PG8_BAR; PG8_SCHED;
            PG8_LDB(B1, 1, 1); PG8_STAGE(PG8_SB(1, 0), b3, voffB);
            PG8_BAR; PG8_WAIT_L(0); PG8_MMA(0, 1, At, B1); PG8_BAR;
            PG8_LDA(At, 1, 1); PG8_STAGE(PG8_SA(1, 0), a3, voffA);
            PG8_BAR; PG8_WAIT_L(0); PG8_MMA(1, 0, At, B0); PG8_BAR; PG8_SCHED;
            PG8_STAGE(PG8_SB(1, 1), b3 + hstep, voffB);
            PG8_WAIT_V(6); PG8_BAR; PG8_MMA(1, 1, At, B1); PG8_BAR;
            }
        }
        }
        if constexpr (ALIGN_EPI) { if (wr == 0) PG8_BAR; }
        if constexpr (!Epi::AFTER_DRAIN) { E(acc, cur, wr, wc, fr, fq); S.done(cur); }
        if (!has_next) break;
#pragma unroll
        for (int a = 0; a < 2; ++a)
#pragma unroll
            for (int b = 0; b < 2; ++b)
#pragma unroll
                for (int m = 0; m < 4; ++m)
#pragma unroll
                    for (int n = 0; n < 2; ++n) acc[a][b][m][n] = (f32x4){0.f, 0.f, 0.f, 0.f};
        cur = nxt; cA = nA; cB = nB; ++ui;
        if constexpr (ALIGN_EPI) { if (wr == 1) PG8_BAR; }
    }
    PG8_WAIT_V(0);
    if constexpr (!ALIGN_EPI) { if (wr == 0) PG8_BAR; }
    PG8_BAR;
    if constexpr (Epi::AFTER_DRAIN) { E.fused(acc, cur, wr, wc, fr, fq, lds, wid, lane); S.done(cur); }
#undef PG8_SA
#undef PG8_SB
#undef PG8_STAGE
#undef PG8_LDA
#undef PG8_LDB
#undef PG8_MMA
#undef PG8_WAIT_V
#undef PG8_WAIT_L
#undef PG8_BAR
#undef PG8_SCHED
}

typedef int i32x4 __attribute__((ext_vector_type(4)));
template <class Epi, class Sched, bool ALIGN_EPI = false, bool SP2 = false>
__device__ __forceinline__ void gemm_phase_i8(PG8_LAS unsigned char* lds, const Gemm g, const Sched& S, const Epi& E) {
    const int tid = threadIdx.x, wid = __builtin_amdgcn_readfirstlane(tid >> 6), lane = tid & 63, wr = wid >> 2, wc = wid & 3, fr = lane & 15, fq = lane >> 4;
    const int K = g.K, nt = K / 128;
    unsigned voffA[2], voffB[2];
#pragma unroll
    for (int i = 0; i < 2; ++i) { int R, C; stage_rc(tid * 16 + i * 8192, R, C); const int Rb = Epi::PERM ? ((R & ~31) + perm32(R & 31)) : R;
        voffA[i] = (unsigned)(R * K + C * 2); voffB[i] = (unsigned)(Rb * K + C * 2); }
    const size_t kstep = (size_t)(BK * 2);
    const size_t hstep = (size_t)HALF * K;
    const size_t tstep = 2 * hstep;
    const unsigned ldsw = (unsigned)wid * 1024u;
    const int aoff = lds_byte(wr * 64 + fr, fq * 8), boff = lds_byte(wc * 32 + fr, fq * 8);
#define PG8_SA(b, h) (((b) * 2 + (h)) * HTB)
#define PG8_SB(b, h) ((4 + (b) * 2 + (h)) * HTB)
#define PG8_STAGE(bufoff, gbase, voff) do { _Pragma("unroll") for (int _i = 0; _i < 2; ++_i) \
        __builtin_amdgcn_global_load_lds((const unsigned*)((const char*)(gbase) + (voff)[_i]), (PG8_LAS unsigned*)(lds + (bufoff) + ldsw + _i * 8192), 16, 0, 0); } while (0)
#define PG8_LDA(dst, b, h) do { _Pragma("unroll") for (int m = 0; m < 4; ++m) _Pragma("unroll") for (int k = 0; k < 2; ++k) dst[m][k] = *(const PG8_LAS i32x4*)(lds + PG8_SA(b, h) + aoff + m * 2048 + k * 1024); } while (0)
#define PG8_LDB(dst, b, h) do { _Pragma("unroll") for (int n = 0; n < 2; ++n) _Pragma("unroll") for (int k = 0; k < 2; ++k) dst[n][k] = *(const PG8_LAS i32x4*)(lds + PG8_SB(b, h) + boff + n * 2048 + k * 1024); } while (0)
#define PG8_MMA(ai, bj, At, Bt) do { __builtin_amdgcn_s_setprio(1); _Pragma("unroll") for (int m = 0; m < 4; ++m) _Pragma("unroll") for (int n = 0; n < 2; ++n) _Pragma("unroll") for (int k = 0; k < 2; ++k) \
        acc[ai][bj][m][n] = __builtin_amdgcn_mfma_i32_16x16x64_i8(Bt[n][k], At[m][k], acc[ai][bj][m][n], 0, 0, 0); __builtin_amdgcn_s_setprio(0); } while (0)
#define PG8_WAIT_V(n) asm volatile("s_waitcnt vmcnt(" #n ")" ::: "memory")
#define PG8_WAIT_L(n) asm volatile("s_waitcnt lgkmcnt(" #n ")" ::: "memory")
#define PG8_BAR __builtin_amdgcn_s_barrier()
#define PG8_SCHED __builtin_amdgcn_sched_barrier(0)
    Unit cur, nxt; int ui = 0;
    if (!S.next(0, cur)) return;
    i32x4 acc[2][2][4][2];
#pragma unroll
    for (int a = 0; a < 2; ++a)
#pragma unroll
        for (int b = 0; b < 2; ++b)
#pragma unroll
            for (int m = 0; m < 4; ++m)
#pragma unroll
                for (int n = 0; n < 2; ++n) acc[a][b][m][n] = (i32x4){0, 0, 0, 0};
    i32x4 At[4][2], B0[2][2], B1[2][2];
    const char* cA = (const char*)g.A + (size_t)cur.pm * tstep; const char* cB = (const char*)g.Bt + (size_t)cur.pn * tstep;
    S.a_ready(cur);
    if constexpr (SP2) {
        PG8_STAGE(PG8_SB(0, 0), cB, voffB); PG8_STAGE(PG8_SB(0, 1), cB + hstep, voffB); PG8_STAGE(PG8_SA(0, 0), cA, voffA); PG8_STAGE(PG8_SA(0, 1), cA + hstep, voffA);
        if (wr == 1) PG8_BAR;
        PG8_WAIT_V(2); PG8_BAR;
        PG8_STAGE(PG8_SB(1, 0), cB + kstep, voffB); PG8_STAGE(PG8_SA(1, 0), cA + kstep, voffA); PG8_STAGE(PG8_SB(1, 1), cB + hstep + kstep, voffB);
        PG8_WAIT_V(6); PG8_BAR;
    } else {
        PG8_STAGE(PG8_SB(0, 0), cB, voffB); PG8_STAGE(PG8_SA(0, 0), cA, voffA); PG8_STAGE(PG8_SB(0, 1), cB + hstep, voffB); PG8_STAGE(PG8_SA(0, 1), cA + hstep, voffA);
        if (wr == 1) PG8_BAR;
        PG8_WAIT_V(4); PG8_BAR;
        PG8_STAGE(PG8_SB(1, 0), cB + kstep, voffB); PG8_STAGE(PG8_SA(1, 0), cA + kstep, voffA); PG8_STAGE(PG8_SB(1, 1), cB + hstep + kstep, voffB);
        PG8_WAIT_V(6); PG8_BAR;
    }
    for (;;) {
        const bool has_next = S.next(ui + 1, nxt);
        const char* nA = has_next ? (const char*)g.A + (size_t)nxt.pm * tstep : cA; const char* nB = has_next ? (const char*)g.Bt + (size_t)nxt.pn * tstep : cB;
        for (int t = 0; t < nt; t += 2) {
            const bool last = (t == nt - 2);
            const char* a1 = cA + (size_t)(t + 1) * kstep;
            const char* a2 = last ? nA : cA + (size_t)(t + 2) * kstep; const char* b2 = last ? nB : cB + (size_t)(t + 2) * kstep;
            const char* a3 = a2 + kstep; const char* b3 = b2 + kstep;
            if (last && has_next) S.a_ready(nxt);
            if constexpr (SP2) {
            PG8_LDB(B0, 0, 0); PG8_LDB(B1, 0, 1); PG8_SCHED; PG8_LDA(At, 0, 0); PG8_STAGE(PG8_SA(1, 1), a1 + hstep, voffA);
            PG8_WAIT_V(8); PG8_WAIT_L(0); PG8_BAR; PG8_MMA(0, 0, At, B0); PG8_MMA(0, 1, At, B1); PG8_BAR; PG8_SCHED;
            PG8_LDA(At, 0, 1); PG8_STAGE(PG8_SB(0, 0), b2, voffB); PG8_STAGE(PG8_SB(0, 1), b2 + hstep, voffB); PG8_STAGE(PG8_SA(0, 0), a2, voffA);
            PG8_WAIT_V(8); PG8_WAIT_L(0); PG8_BAR; PG8_MMA(1, 0, At, B0); PG8_MMA(1, 1, At, B1); PG8_BAR; PG8_SCHED;
            PG8_LDB(B0, 1, 0); PG8_LDB(B1, 1, 1); PG8_SCHED; PG8_LDA(At, 1, 0); PG8_STAGE(PG8_SA(0, 1), a2 + hstep, voffA);
            PG8_WAIT_V(8); PG8_WAIT_L(0); PG8_BAR; PG8_MMA(0, 0, At, B0); PG8_MMA(0, 1, At, B1); PG8_BAR; PG8_SCHED;
            PG8_LDA(At, 1, 1); PG8_STAGE(PG8_SB(1, 0), b3, voffB); PG8_STAGE(PG8_SB(1, 1), b3 + hstep, voffB); PG8_STAGE(PG8_SA(1, 0), a3, voffA);
            PG8_WAIT_V(8); PG8_WAIT_L(0); PG8_BAR; PG8_MMA(1, 0, At, B0); PG8_MMA(1, 1, At, B1); PG8_BAR; PG8_SCHED;
            } else {
            PG8_LDB(B0, 0, 0); PG8_SCHED; PG8_LDA(At, 0, 0); PG8_STAGE(PG8_SA(1, 1), a1 + hstep, voffA);
            PG8_WAIT_L(8); PG8_BAR; PG8_WAIT_L(0); PG8_MMA(0, 0, At, B0); PG8_BAR; PG8_SCHED;
            PG8_LDB(B1, 0, 1); PG8_STAGE(PG8_SB(0, 0), b2, voffB);
            PG8_BAR; PG8_WAIT_L(0); PG8_MMA(0, 1, At, B1); PG8_BAR;
            PG8_LDA(At, 0, 1); PG8_STAGE(PG8_SA(0, 0), a2, voffA);
            PG8_BAR; PG8_WAIT_L(0); PG8_MMA(1, 0, At, B0); PG8_BAR; PG8_SCHED;
            PG8_STAGE(PG8_SB(0, 1), b2 + hstep, voffB);
            PG8_WAIT_V(6); PG8_BAR; PG8_MMA(1, 1, At, B1); PG8_BAR;
            PG8_LDB(B0, 1, 0); PG8_SCHED; PG8_LDA(At, 1, 0); PG8_STAGE(PG8_SA(0, 1), a2 + hstep, voffA);
            PG8_WAIT_L(8); PG8_BAR; PG8_WAIT_L(0); PG8_MMA(0, 0, At, B0); PG8_BAR; PG8_SCHED;
            PG8_LDB(B1, 1, 1); PG8_STAGE(PG8_SB(1, 0), b3, voffB);
            PG8_BAR; PG8_WAIT_L(0); PG8_MMA(0, 1, At, B1); PG8_BAR;
            PG8_LDA(At, 1, 1); PG8_STAGE(PG8_SA(1, 0), a3, voffA);
            PG8_BAR; PG8_WAIT_L(0); PG8_MMA(1, 0, At, B0); PG8_BAR; PG8_SCHED;
            PG8_STAGE(PG8_SB(1, 1), b3 + hstep, voffB);
            PG8_WAIT_V(6); PG8_BAR; PG8_MMA(1, 1, At, B1); PG8_BAR;
            }
        }
        if constexpr (ALIGN_EPI) { if (wr == 0) PG8_BAR; }
        if constexpr (!Epi::AFTER_DRAIN) { E(acc, cur, wr, wc, fr, fq); S.done(cur); }
        if (!has_next) break;
#pragma unroll
        for (int a = 0; a < 2; ++a)
#pragma unroll
            for (int b = 0; b < 2; ++b)
#pragma unroll
                for (int m = 0; m < 4; ++m)
#pragma unroll
                    for (int n = 0; n < 2; ++n) acc[a][b][m][n] = (i32x4){0, 0, 0, 0};
        cur = nxt; cA = nA; cB = nB; ++ui;
        if constexpr (ALIGN_EPI) { if (wr == 1) PG8_BAR; }
    }
    PG8_WAIT_V(0);
    if constexpr (!ALIGN_EPI) { if (wr == 0) PG8_BAR; }
    PG8_BAR;
    if constexpr (Epi::AFTER_DRAIN) { E.fused(acc, cur, wr, wc, fr, fq, lds, wid, lane); S.done(cur); }
#undef PG8_SA
#undef PG8_SB
#undef PG8_STAGE
#undef PG8_LDA
#undef PG8_LDB
#undef PG8_MMA
#undef PG8_WAIT_V
#undef PG8_WAIT_L
#undef PG8_BAR
#undef PG8_SCHED
}
}

struct Ctx {
    const float *x, *p, *g_mix, *w_in, *ln_g, *ln_b, *sgu_w, *sgu_b, *w_ba, *w_bs, *w_out, *g_ffn, *w_pq, *subk, *dn, *up, *g_ple, *w_pp, *w_pg, *g_fin;
    float* out;
    bf16 *WinT, *WbaT, *WbsT, *WoutT, *WqT, *WgT, *WprojT, *pb, *skb, *xn, *proj, *vT, *yatt, *ysgu, *merged, *h1n, *qp, *h2n, *gtmp, *h2b, *swb;
    float *kmean, *kmp, *sst, *egate, *sdn, *sup, *lse, *xs, *h2s, *wcs, *gcs, *qcs, *h1s, *rss, *ocs, *ms; int *eid, *sel; unsigned char *xq8, *WinT8, *WgT8, *WqT8, *h2q8, *h1q8, *WoutT8, *mq8; unsigned char *dn8, *up8;
    int G, bid, tid, lane, wave;
};

DEV void transpose_item(const float* W, int K, int N, bf16* WT, const float* gain, LAS float* scr, int item, int lane, int ldt = 0) {
    if (ldt == 0) ldt = K;
    const int nblk = N / 32, kb = item / nblk, nb = item % nblk, k0 = 64 * kb, n0 = 32 * nb;
#pragma unroll
    for (int i = 0; i < 8; ++i) { const int kk = 8 * i + (lane >> 3), cc = (lane & 7) * 4; const float gsc = gain ? gain[k0 + kk] : 1.0f;
        const f32x4 w = *(const f32x4*)(W + (size_t)(k0 + kk) * N + n0 + cc); LAS float* sp = scr + kk * 33 + cc; sp[0] = w.x * gsc; sp[1] = w.y * gsc; sp[2] = w.z * gsc; sp[3] = w.w * gsc; }
    asm volatile("s_waitcnt lgkmcnt(0)" ::: "memory");
    const int c = lane & 7;
#pragma unroll
    for (int j = 0; j < 4; ++j) { const int n = (lane >> 3) + 8 * j; const LAS float* s = scr + (8 * c) * 33 + n;
        v4u o; o.x = pkbf(s[0 * 33], s[1 * 33]); o.y = pkbf(s[2 * 33], s[3 * 33]); o.z = pkbf(s[4 * 33], s[5 * 33]); o.w = pkbf(s[6 * 33], s[7 * 33]);
        *(v4u*)(WT + (size_t)(n0 + n) * ldt + k0 + 8 * c) = o; }
    asm volatile("s_waitcnt lgkmcnt(0)" ::: "memory");
}
DEV void row_rms_bf16(const float* xrow, bf16* orow, int lane) {
    const f32x4* xr = (const f32x4*)xrow + lane;
    f32x4 v[8]; float s = 0.f;
#pragma unroll
    for (int j = 0; j < 8; ++j) { v[j] = xr[64 * j]; s += (v[j].x * v[j].x + v[j].y * v[j].y) + (v[j].z * v[j].z + v[j].w * v[j].w); }
    const float r = 1.0f / sqrtf(wave_sum(s) * (1.0f / D) + EPS);
    v2u* o8 = (v2u*)orow + lane;
#pragma unroll
    for (int j = 0; j < 8; ++j) { v2u w; w.x = pkbf(v[j].x * r, v[j].y * r); w.y = pkbf(v[j].z * r, v[j].w * r); o8[64 * j] = w; }
}
DEV void cvt_items(const float* src, bf16* dst, size_t n8, const float* gain, size_t gtid, size_t gthreads) {
    for (size_t i = gtid; i < n8; i += gthreads) {
        const f32x4 a = ((const f32x4*)src)[2 * i], b = ((const f32x4*)src)[2 * i + 1];
        f32x4 ga = {1.f, 1.f, 1.f, 1.f}, gb = ga;
        if (gain) { const size_t c = (i * 8) % D; ga = *(const f32x4*)(gain + c); gb = *(const f32x4*)(gain + c + 4); }
        v4u o; o.x = pkbf(a.x * ga.x, a.y * ga.y); o.y = pkbf(a.z * ga.z, a.w * ga.w); o.z = pkbf(b.x * gb.x, b.y * gb.y); o.w = pkbf(b.z * gb.z, b.w * gb.w);
        ((v4u*)dst)[i] = o;
    }
}
DEV float wave_max(float v);
DEV unsigned q4(float a, float b, float c_, float d, float inv, int off);
DEV void colmax_item(const float* W, int N, const float* gain, unsigned* cam, int item, int lane) {
    const int nblk = N / 256, kb = item / nblk, nb = item % nblk, k0 = 64 * kb, n0 = 256 * nb + 4 * lane;
    f32x4 am = {0.f, 0.f, 0.f, 0.f};
#pragma unroll 8
    for (int kk = 0; kk < 64; ++kk) { const f32x4 w = *(const f32x4*)(W + (size_t)(k0 + kk) * N + n0); const float g = gain ? gain[k0 + kk] : 1.0f;
        am.x = fmaxf(am.x, fabsf(w.x * g)); am.y = fmaxf(am.y, fabsf(w.y * g)); am.z = fmaxf(am.z, fabsf(w.z * g)); am.w = fmaxf(am.w, fabsf(w.w * g)); }
    atomicMax(cam + n0, __float_as_uint(am.x)); atomicMax(cam + n0 + 1, __float_as_uint(am.y)); atomicMax(cam + n0 + 2, __float_as_uint(am.z)); atomicMax(cam + n0 + 3, __float_as_uint(am.w));
}
DEV void transpose_item_i8(const float* W, int K, int N, unsigned char* WT8, const float* gain, const unsigned* cam, LAS float* scr, int item, int lane) {
    const int nblk = N / 32, kb = item / nblk, nb = item % nblk, k0 = 64 * kb, n0 = 32 * nb;
#pragma unroll
    for (int i = 0; i < 8; ++i) { const int kk = 8 * i + (lane >> 3), cc = (lane & 7) * 4; const float gsc = gain ? gain[k0 + kk] : 1.0f;
        const f32x4 w = *(const f32x4*)(W + (size_t)(k0 + kk) * N + n0 + cc); LAS float* sp = scr + kk * 33 + cc; sp[0] = w.x * gsc; sp[1] = w.y * gsc; sp[2] = w.z * gsc; sp[3] = w.w * gsc; }
    asm volatile("s_waitcnt lgkmcnt(0)" ::: "memory");
    const int cq = lane & 3;
#pragma unroll
    for (int j = 0; j < 2; ++j) { const int n = (lane >> 2) + 16 * j; const LAS float* s = scr + (16 * cq) * 33 + n;
        const float am = __uint_as_float(cam[n0 + n]); const float inv = am > 0.f ? 127.0f / am : 0.f;
        v4u o; o.x = q4(s[0 * 33], s[1 * 33], s[2 * 33], s[3 * 33], inv, 0); o.y = q4(s[4 * 33], s[5 * 33], s[6 * 33], s[7 * 33], inv, 0);
        o.z = q4(s[8 * 33], s[9 * 33], s[10 * 33], s[11 * 33], inv, 0); o.w = q4(s[12 * 33], s[13 * 33], s[14 * 33], s[15 * 33], inv, 0);
        *(v4u*)(WT8 + (size_t)(n0 + n) * K + k0 + 16 * cq) = o; }
    asm volatile("s_waitcnt lgkmcnt(0)" ::: "memory");
}
DEV void row_rms_i8(const float* xrow, unsigned char* orow, float* sc, int lane) {
    const f32x4* xr = (const f32x4*)xrow + lane;
    f32x4 v[8]; float s = 0.f, am = 0.f;
#pragma unroll
    for (int j = 0; j < 8; ++j) { v[j] = xr[64 * j]; s += (v[j].x * v[j].x + v[j].y * v[j].y) + (v[j].z * v[j].z + v[j].w * v[j].w);
        am = fmaxf(am, fmaxf(fmaxf(fabsf(v[j].x), fabsf(v[j].y)), fmaxf(fabsf(v[j].z), fabsf(v[j].w)))); }
    const float r = 1.0f / sqrtf(wave_sum(s) * (1.0f / D) + EPS);
    am = wave_max(am);
    const float inv = am > 0.f ? 127.0f / am : 0.f;
    unsigned* o4 = (unsigned*)orow + lane;
#pragma unroll
    for (int j = 0; j < 8; ++j) o4[64 * j] = q4(v[j].x, v[j].y, v[j].z, v[j].w, inv, 0);
    if (lane == 0) *sc = am * (1.0f / 127.0f) * r;
}
DEV void phase_prologue2(const Ctx& c, LAS unsigned char* lds, const unsigned* cam) {
    LAS float* scr = (LAS float*)(lds + c.wave * 16384);
    const int gw = c.bid * 8 + c.wave, NGW = c.G * 8;
    constexpr int I_IN = (D / 64) * (INW / 32), I_SQ = (D / 64) * (D / 32);
    for (int it = gw; it < I_IN + I_SQ; it += NGW) {
        if (it < I_IN) transpose_item_i8(c.w_in, D, INW, c.WinT8, c.g_mix, cam, scr, it, c.lane);
        else transpose_item_i8(c.w_pg, D, D, c.WgT8, c.g_ple, cam + INW, scr, it - I_IN, c.lane);
    }
    for (int i = c.bid * NTHREADS + c.tid; i < INW + D; i += c.G * NTHREADS) { const float s = __uint_as_float(cam[i]) * (1.0f / 127.0f); if (i < INW) c.wcs[i] = s; else c.gcs[i - INW] = s; }
}
DEV void phase_prologue(const Ctx& c, LAS unsigned char* lds, unsigned* cam) {
    LAS float* scr = (LAS float*)(lds + c.wave * 16384);
    const int gw = c.bid * 8 + c.wave, NGW = c.G * 8;
    constexpr int I_IN = (D / 64) * (INW / 32), I_BA = (1024 / 64) * (D / 32), I_SQ = (D / 64) * (D / 32), I_PP = (PLE / 64) * (D / 32);
    constexpr int C_IN = (D / 64) * (INW / 256), C_SQ = (D / 64) * (D / 256);
    for (int it = gw; it < C_IN + C_SQ; it += NGW) {
        if (it < C_IN) colmax_item(c.w_in, INW, c.g_mix, cam, it, c.lane); else colmax_item(c.w_pg, D, c.g_ple, cam + INW, it - C_IN, c.lane);
    }
    constexpr int NITEMS = 2 * I_BA + 2 * I_SQ + I_PP;
    for (int it = gw; it < NITEMS; it += NGW) {
        int r = it;
        if (r < I_BA) { transpose_item(c.w_ba, 1024, D, c.WbaT, nullptr, scr, r, c.lane, 2048); continue; } r -= I_BA;
        if (r < I_BA) { transpose_item(c.w_bs, 1024, D, c.WbaT + 1024, nullptr, scr, r, c.lane, 2048); continue; } r -= I_BA;
        if (r < I_SQ) { transpose_item(c.w_out, D, D, c.WoutT, nullptr, scr, r, c.lane); continue; } r -= I_SQ;
        if (r < I_SQ) { transpose_item(c.w_pq, D, D, c.WqT, c.g_ffn, scr, r, c.lane); continue; } r -= I_SQ;
        transpose_item(c.w_pp, PLE, D, c.WprojT, nullptr, scr, r, c.lane);
    }
    {
        f32x4 vn[8]; int m = gw;
        if (m < T) { const f32x4* xr = (const f32x4*)(c.x + (size_t)m * D) + c.lane;
#pragma unroll
            for (int j = 0; j < 8; ++j) vn[j] = xr[64 * j]; }
        for (; m < T; m += NGW) {
            f32x4 v[8];
#pragma unroll
            for (int j = 0; j < 8; ++j) v[j] = vn[j];
            { const int mn = m + NGW < T ? m + NGW : m; const f32x4* xr = (const f32x4*)(c.x + (size_t)mn * D) + c.lane;
#pragma unroll
              for (int j = 0; j < 8; ++j) vn[j] = xr[64 * j]; }
            float s = 0.f, am = 0.f;
#pragma unroll
            for (int j = 0; j < 8; ++j) { s += (v[j].x * v[j].x + v[j].y * v[j].y) + (v[j].z * v[j].z + v[j].w * v[j].w);
                am = fmaxf(am, fmaxf(fmaxf(fabsf(v[j].x), fabsf(v[j].y)), fmaxf(fabsf(v[j].z), fabsf(v[j].w)))); }
            const float r = 1.0f / sqrtf(wsum_q(s) * (1.0f / D) + EPS);
            am = wmax_q(am);
            const float inv = am > 0.f ? 127.0f / am : 0.f;
            unsigned* o4 = (unsigned*)(c.xq8 + (size_t)m * D) + c.lane;
#pragma unroll
            for (int j = 0; j < 8; ++j) o4[64 * j] = q4(v[j].x, v[j].y, v[j].z, v[j].w, inv, 0);
            if (c.lane == 0) c.xs[m] = am * (1.0f / 127.0f) * r;
        }
    }
    const size_t gtid = (size_t)c.bid * NTHREADS + c.tid, gthreads = (size_t)c.G * NTHREADS;
    cvt_items(c.p, c.pb, (size_t)T * PLE / 8, nullptr, gtid, gthreads);
    cvt_items(c.subk, c.skb, (size_t)NH * 2 * 128 * 128 / 8, nullptr, gtid, gthreads);
    for (size_t i = gtid; i < (size_t)8 * 128 * 128 / 8; i += gthreads) {
        const int t = (int)(i >> 4) & 127, s0 = (int)(i & 15) * 8; const f32x4 a = *(const f32x4*)(c.sgu_w + i * 8), b = *(const f32x4*)(c.sgu_w + i * 8 + 4);
        v4u o; o.x = pkbf(s0 + 0 <= t ? a.x : 0.f, s0 + 1 <= t ? a.y : 0.f); o.y = pkbf(s0 + 2 <= t ? a.z : 0.f, s0 + 3 <= t ? a.w : 0.f);
        o.z = pkbf(s0 + 4 <= t ? b.x : 0.f, s0 + 5 <= t ? b.y : 0.f); o.w = pkbf(s0 + 6 <= t ? b.z : 0.f, s0 + 7 <= t ? b.w : 0.f);
        *(v4u*)(c.swb + i * 8) = o; }
}

DEV float rsum16(float v) { v += dppq<0xB1>(v); v += dppq<0x4E>(v); v += dppq<0x1B>(dppq<0x141>(v)); v += dppq<0x128>(v); return v; }
struct F1 { bf16* proj;
    DEV void elem4(int row, int col, f32x4 v) const {
        if (col >= C_GA) { v.x = sigmoidf_(v.x); v.y = sigmoidf_(v.y); v.z = sigmoidf_(v.z); v.w = sigmoidf_(v.w); }
        else if (col >= C_U) { const f32x2 a = pg8::gelu_pk((f32x2){v.x, v.y}), b = pg8::gelu_pk((f32x2){v.z, v.w}); v = (f32x4){a.x, a.y, b.x, b.y}; }
        v2u w; w.x = pkbf(v.x, v.y); w.y = pkbf(v.z, v.w); *(v2u*)(proj + (size_t)row * PST + col) = w; } };
constexpr float GQ = 255.99f;
DEV unsigned gate_q(float x) { return (unsigned)__builtin_amdgcn_rcpf((1.0f / GQ) + __builtin_amdgcn_exp2f(fmaf(x, -1.4426950408889634f, -7.999943641f))); }
DEV f32x4 gate_dq(unsigned w) { return (f32x4){((float)(w & 0xffu) + 0.5f) * (1.0f / GQ), ((float)((w >> 8) & 0xffu) + 0.5f) * (1.0f / GQ), ((float)((w >> 16) & 0xffu) + 0.5f) * (1.0f / GQ), ((float)(w >> 24) + 0.5f) * (1.0f / GQ)}; }
struct EpiIn { static constexpr bool PERM = false, AFTER_DRAIN = false, HAS_MID = false; bf16* proj; const float* rs; const float* cs; float* kmp; float* sst;
    DEV void operator()(const pg8::i32x4 (&acc)[2][2][4][2], const pg8::Unit& u, int wr, int wc, int fr, int fq) const {
        const int row0 = u.pm * 256 + wr * 64 + fr, col0 = u.pn * 256 + wc * 32 + 4 * fq;
        const bool isK = u.pn >= C_K / 256 && u.pn < C_V / 256, isVG = u.pn >= C_VG / 256 && u.pn < C_GA / 256;
        f32x4 cv[2][2];
#pragma unroll
        for (int bj = 0; bj < 2; ++bj)
#pragma unroll
            for (int n = 0; n < 2; ++n) cv[bj][n] = *(const f32x4*)(cs + col0 + bj * 128 + n * 16);
        float rsv[8];
#pragma unroll
        for (int g = 0; g < 8; ++g) rsv[g] = rs[row0 + (g >> 2) * 128 + (g & 3) * 16];
        f32x4 ksum[2][2];
#pragma unroll
        for (int bj = 0; bj < 2; ++bj)
#pragma unroll
            for (int n = 0; n < 2; ++n) ksum[bj][n] = (f32x4){0.f, 0.f, 0.f, 0.f};
#pragma unroll
        for (int ai = 0; ai < 2; ++ai)
#pragma unroll
            for (int m = 0; m < 4; ++m) { const int row = row0 + ai * 128 + m * 16; const float r = rsv[ai * 4 + m]; float ss = 0.f, sq = 0.f;
#pragma unroll
                for (int bj = 0; bj < 2; ++bj)
#pragma unroll
                    for (int n = 0; n < 2; ++n) { const pg8::i32x4 a = acc[ai][bj][m][n]; const f32x4 c4 = cv[bj][n]; const int col = col0 + bj * 128 + n * 16;
                        f32x4 v = (f32x4){(float)a.x * (r * c4.x), (float)a.y * (r * c4.y), (float)a.z * (r * c4.z), (float)a.w * (r * c4.w)};
                        if (col >= C_GA) {
                            const unsigned q0 = gate_q(v.x), q1 = gate_q(v.y), q2 = gate_q(v.z), q3 = gate_q(v.w);
                            *(unsigned*)((unsigned char*)(proj + (size_t)row * PST + C_GA) + (col - C_GA)) = q0 | (q1 << 8) | (q2 << 16) | (q3 << 24); continue; }
                        if (col >= C_U) { const f32x2 ga = pg8::gelu_pk((f32x2){v.x, v.y}), gb = pg8::gelu_pk((f32x2){v.z, v.w}); v = (f32x4){ga.x, ga.y, gb.x, gb.y}; }
                        v2u w; w.x = pkbf(v.x, v.y); w.y = pkbf(v.z, v.w); *(v2u*)(proj + (size_t)row * PST + col) = w;
                        if (isK) ksum[bj][n] += v;
                        if (isVG) { const float e0 = bflo(w.x), e1 = bfhi(w.x), e2 = bflo(w.y), e3 = bfhi(w.y); ss += (e0 + e1) + (e2 + e3); sq += (e0 * e0 + e1 * e1) + (e2 * e2 + e3 * e3); } }
                if (isVG) { ss += __shfl_xor(ss, 16); sq += __shfl_xor(sq, 16); ss += __shfl_xor(ss, 32); sq += __shfl_xor(sq, 32);
                    if (fq == 0) *(f32x2*)(sst + ((size_t)row * 16 + (u.pn - C_VG / 256) * 4 + wc) * 2) = (f32x2){ss, sq}; }
                asm volatile("" ::: "memory");
            }
        if (isK) { const int b = u.pm >> 5, nb = u.pm & 31;
#pragma unroll
            for (int bj = 0; bj < 2; ++bj)
#pragma unroll
                for (int n = 0; n < 2; ++n) { f32x4 s = ksum[bj][n]; s.x = rsum16(s.x); s.y = rsum16(s.y); s.z = rsum16(s.z); s.w = rsum16(s.w);
                    const int h = 2 * (u.pn - C_K / 256) + bj, d = 32 * wc + 16 * n + 4 * fq;
                    if (fr == 0) *(f32x4*)(kmp + (((size_t)wr * 16 + b * 8 + h) * NBLK + nb) * HD + d) = s * (1.0f / BLK); } }
    } };
struct F4a { const bf16* proj; float* out;
    DEV void elem4(int row, int col, f32x4 v) const { const v2u g = *(const v2u*)(proj + (size_t)row * PST + C_GA + col);
        *(f32x4*)(out + (size_t)row * D + col) = (f32x4){v.x * bflo(g.x), v.y * bfhi(g.x), v.z * bflo(g.y), v.w * bfhi(g.y)}; } };
struct F4b { const bf16* proj; const float* out; bf16* merged;
    DEV void elem4(int row, int col, f32x4 v) const { const v2u g = *(const v2u*)(proj + (size_t)row * PST + C_GB + col); const f32x4 t = *(const f32x4*)(out + (size_t)row * D + col);
        v2u w; w.x = pkbf(t.x + v.x * bflo(g.x), t.y + v.y * bfhi(g.x)); w.y = pkbf(t.z + v.z * bflo(g.y), t.w + v.w * bfhi(g.y)); *(v2u*)(merged + (size_t)row * D + col) = w; } };
struct F5 { const float* x; float* out;
    DEV void elem4(int row, int col, f32x4 v) const { const f32x4 t = *(const f32x4*)(x + (size_t)row * D + col); *(f32x4*)(out + (size_t)row * D + col) = t + v; } };
struct EpiBranch { static constexpr bool PERM = false, AFTER_DRAIN = false, HAS_MID = true; const bf16* proj; bf16* merged;
    DEV void mid(f32x4 (&acc)[2][2][4][2], const pg8::Unit& u, int wr, int wc, int fr, int fq) const {
        const unsigned char* pb = (const unsigned char*)(proj + (size_t)(u.pm * 256 + wr * 64 + fr) * PST + C_GA) + u.pn * 256 + wc * 32 + 4 * fq;
        unsigned gan[4], gbn[4];
#pragma unroll
        for (int q = 0; q < 4; ++q) { const unsigned char* qp_ = pb + (q >> 1) * 128 + (q & 1) * 16; gan[q] = *(const unsigned*)qp_; gbn[q] = *(const unsigned*)(qp_ + 2048); }
#pragma unroll
        for (int g = 0; g < 8; ++g) { const int ai = g >> 2, m = g & 3;
            unsigned gac[4], gbc[4];
#pragma unroll
            for (int q = 0; q < 4; ++q) { gac[q] = gan[q]; gbc[q] = gbn[q]; }
            if (g < 7) { const int gn = g + 1; const unsigned char* rp = pb + (size_t)((gn >> 2) * 128 + (gn & 3) * 16) * (PST * 2);
#pragma unroll
                for (int q = 0; q < 4; ++q) { const unsigned char* qp_ = rp + (q >> 1) * 128 + (q & 1) * 16; gan[q] = *(const unsigned*)qp_; gbn[q] = *(const unsigned*)(qp_ + 2048); } }
#pragma unroll
            for (int bj = 0; bj < 2; ++bj)
#pragma unroll
                for (int n = 0; n < 2; ++n) { const f32x4 ga = gate_dq(gac[bj * 2 + n]), gb = gate_dq(gbc[bj * 2 + n]); f32x4 v = acc[ai][bj][m][n];
                    v.x *= ga.x * __builtin_amdgcn_rcpf(gb.x); v.y *= ga.y * __builtin_amdgcn_rcpf(gb.y); v.z *= ga.z * __builtin_amdgcn_rcpf(gb.z); v.w *= ga.w * __builtin_amdgcn_rcpf(gb.w);
                    acc[ai][bj][m][n] = v; } }
    }
    DEV void operator()(const f32x4 (&acc)[2][2][4][2], const pg8::Unit& u, int wr, int wc, int fr, int fq) const {
        const int row0 = u.pm * 256 + wr * 64 + fr, col0 = u.pn * 256 + wc * 32 + 4 * fq;
        const unsigned char* pb = (const unsigned char*)(proj + (size_t)row0 * PST + C_GA) + 2048 + col0;
        unsigned gbn[4];
#pragma unroll
        for (int q = 0; q < 4; ++q) gbn[q] = *(const unsigned*)(pb + (q >> 1) * 128 + (q & 1) * 16);
#pragma unroll
        for (int g = 0; g < 8; ++g) { const int ai = g >> 2, m = g & 3; const int row = row0 + ai * 128 + m * 16;
            unsigned gbc[4];
#pragma unroll
            for (int q = 0; q < 4; ++q) gbc[q] = gbn[q];
            if (g < 7) { const int gn = g + 1; const unsigned char* rp = pb + (size_t)((gn >> 2) * 128 + (gn & 3) * 16) * (PST * 2);
#pragma unroll
                for (int q = 0; q < 4; ++q) gbn[q] = *(const unsigned*)(rp + (q >> 1) * 128 + (q & 1) * 16); }
#pragma unroll
            for (int bj = 0; bj < 2; ++bj)
#pragma unroll
                for (int n = 0; n < 2; ++n) { const int col = col0 + bj * 128 + n * 16; const f32x4 gb = gate_dq(gbc[bj * 2 + n]); const f32x4 v = acc[ai][bj][m][n];
                    v2u w; w.x = pkbf(v.x * gb.x, v.y * gb.y); w.y = pkbf(v.z * gb.z, v.w * gb.w); *(v2u*)(merged + (size_t)row * D + col) = w; } }
    } };
struct EpiF5 { static constexpr bool PERM = false, AFTER_DRAIN = false, HAS_MID = false; const float* x; float* out; bf16* h1b; float* rss;
    DEV void operator()(const f32x4 (&acc)[2][2][4][2], const pg8::Unit& u, int wr, int wc, int fr, int fq) const {
        const int row0 = u.pm * 256 + wr * 64 + fr, col0 = u.pn * 256 + wc * 32 + 4 * fq;
        f32x4 xn[4];
        { const float* xp = x + (size_t)row0 * D + col0;
#pragma unroll
          for (int q = 0; q < 4; ++q) xn[q] = *(const f32x4*)(xp + (q >> 1) * 128 + (q & 1) * 16); }
#pragma unroll
        for (int g = 0; g < 8; ++g) { const int ai = g >> 2, m = g & 3; const int row = row0 + ai * 128 + m * 16; float ss = 0.f;
            f32x4 xc[4];
#pragma unroll
            for (int q = 0; q < 4; ++q) xc[q] = xn[q];
            if (g < 7) { const int gn = g + 1; const float* xp = x + (size_t)(row0 + (gn >> 2) * 128 + (gn & 3) * 16) * D + col0;
#pragma unroll
                for (int q = 0; q < 4; ++q) xn[q] = *(const f32x4*)(xp + (q >> 1) * 128 + (q & 1) * 16); }
#pragma unroll
            for (int bj = 0; bj < 2; ++bj)
#pragma unroll
                for (int n = 0; n < 2; ++n) { const int col = col0 + bj * 128 + n * 16; const f32x4 v = xc[bj * 2 + n] + acc[ai][bj][m][n];
                    v2u w; w.x = pkbf(v.x, v.y); w.y = pkbf(v.z, v.w); *(v2u*)(h1b + (size_t)row * D + col) = w;
                    ss += (v.x * v.x + v.y * v.y) + (v.z * v.z + v.w * v.w); }
            ss += __shfl_xor(ss, 16); ss += __shfl_xor(ss, 32);
            if (fq == 0) rss[(size_t)row * 32 + u.pn * 4 + wc] = ss; }
    } };
struct EpiF5i { static constexpr bool PERM = false, AFTER_DRAIN = false, HAS_MID = false; const float* x; bf16* h1b; float* rss; const float* rs; const float* cs;
    DEV void operator()(const pg8::i32x4 (&acc)[2][2][4][2], const pg8::Unit& u, int wr, int wc, int fr, int fq) const {
        const int row0 = u.pm * 256 + wr * 64 + fr, col0 = u.pn * 256 + wc * 32 + 4 * fq;
        f32x4 cv[2][2];
#pragma unroll
        for (int bj = 0; bj < 2; ++bj)
#pragma unroll
            for (int n = 0; n < 2; ++n) cv[bj][n] = *(const f32x4*)(cs + col0 + bj * 128 + n * 16);
#pragma unroll
        for (int ai = 0; ai < 2; ++ai)
#pragma unroll
            for (int m = 0; m < 4; ++m) { const int row = row0 + ai * 128 + m * 16; float ss = 0.f; const float r = rs[row];
#pragma unroll
                for (int bj = 0; bj < 2; ++bj)
#pragma unroll
                    for (int n = 0; n < 2; ++n) { const int col = col0 + bj * 128 + n * 16; const pg8::i32x4 a = acc[ai][bj][m][n]; const f32x4 c4 = cv[bj][n];
                        const f32x4 v = *(const f32x4*)(x + (size_t)row * D + col) + (f32x4){(float)a.x * (r * c4.x), (float)a.y * (r * c4.y), (float)a.z * (r * c4.z), (float)a.w * (r * c4.w)};
                        v2u w; w.x = pkbf(v.x, v.y); w.y = pkbf(v.z, v.w); *(v2u*)(h1b + (size_t)row * D + col) = w;
                        ss += (v.x * v.x + v.y * v.y) + (v.z * v.z + v.w * v.w); }
                ss += __shfl_xor(ss, 16); ss += __shfl_xor(ss, 32);
                if (fq == 0) rss[(size_t)row * 32 + u.pn * 4 + wc] = ss;
                asm volatile("" ::: "memory"); }
    } };
DEV void phase_quant_merged(const Ctx& c) {
    const int gw = c.bid * 8 + c.wave, NGW = c.G * 8, lane = c.lane;
    for (int m = gw; m < T; m += NGW) {
        const v4u* src = (const v4u*)(c.merged + (size_t)m * D) + lane;
        v4u v[4]; float am = 0.f;
#pragma unroll
        for (int j = 0; j < 4; ++j) { v[j] = src[64 * j]; const v4u w = v[j];
            am = fmaxf(am, fmaxf(fmaxf(fmaxf(fabsf(bflo(w.x)), fabsf(bfhi(w.x))), fmaxf(fabsf(bflo(w.y)), fabsf(bfhi(w.y)))), fmaxf(fmaxf(fabsf(bflo(w.z)), fabsf(bfhi(w.z))), fmaxf(fabsf(bflo(w.w)), fabsf(bfhi(w.w)))))); }
        am = wave_max(am);
        const float inv = am > 0.f ? 127.0f / am : 0.f;
        v2u* dst = (v2u*)(c.mq8 + (size_t)m * D) + lane;
#pragma unroll
        for (int j = 0; j < 4; ++j) { const v4u w = v[j]; v2u o; o.x = q4(bflo(w.x), bfhi(w.x), bflo(w.y), bfhi(w.y), inv, 0); o.y = q4(bflo(w.z), bfhi(w.z), bflo(w.w), bfhi(w.w), inv, 0); dst[64 * j] = o; }
        if (lane == 0) c.ms[m] = am * (1.0f / 127.0f);
    }
}
struct F6 { bf16* qp;
    DEV void elem4(int row, int col, f32x4 v) const { v2u w; w.x = pkbf(v.x, v.y); w.y = pkbf(v.z, v.w); *(v2u*)(qp + (size_t)row * D + col) = w; } };
struct F9a { bf16* gtmp;
    DEV void elem4(int row, int col, f32x4 v) const { v2u w; w.x = pkbf(sigmoidf_(v.x), sigmoidf_(v.y)); w.y = pkbf(sigmoidf_(v.z), sigmoidf_(v.w)); *(v2u*)(gtmp + (size_t)row * D + col) = w; } };
struct F9b { const bf16* gtmp; float* out;
    DEV void elem4(int row, int col, f32x4 v) const { const v2u g = *(const v2u*)(gtmp + (size_t)row * D + col); float* o = out + (size_t)row * D + col; const f32x4 t = *(const f32x4*)o;
        *(f32x4*)o = (f32x4){t.x + v.x * bflo(g.x), t.y + v.y * bfhi(g.x), t.z + v.z * bflo(g.y), t.w + v.w * bfhi(g.y)}; } };
struct Epi9b { static constexpr bool PERM = false, AFTER_DRAIN = false, HAS_MID = false; const bf16* gtmp; bf16* hb;
    DEV void operator()(const f32x4 (&acc)[2][2][4][2], const pg8::Unit& u, int wr, int wc, int fr, int fq) const {
        const int row0 = u.pm * 256 + wr * 64 + fr, col0 = u.pn * 256 + wc * 32 + 4 * fq;
        v2u gn[4], tn[4];
        { const size_t o0 = (size_t)row0 * D + col0;
#pragma unroll
          for (int q = 0; q < 4; ++q) { const size_t o = o0 + (q >> 1) * 128 + (q & 1) * 16; gn[q] = *(const v2u*)(gtmp + o); tn[q] = *(const v2u*)(hb + o); } }
#pragma unroll
        for (int g = 0; g < 8; ++g) { const int ai = g >> 2, m = g & 3; const size_t o0 = (size_t)(row0 + ai * 128 + m * 16) * D + col0;
            v2u gc[4], tc[4];
#pragma unroll
            for (int q = 0; q < 4; ++q) { gc[q] = gn[q]; tc[q] = tn[q]; }
            if (g < 7) { const int g1 = g + 1; const size_t o1 = (size_t)(row0 + (g1 >> 2) * 128 + (g1 & 3) * 16) * D + col0;
#pragma unroll
                for (int q = 0; q < 4; ++q) { const size_t o = o1 + (q >> 1) * 128 + (q & 1) * 16; gn[q] = *(const v2u*)(gtmp + o); tn[q] = *(const v2u*)(hb + o); } }
#pragma unroll
            for (int bj = 0; bj < 2; ++bj)
#pragma unroll
                for (int n = 0; n < 2; ++n) { const int q = bj * 2 + n; const f32x4 v = acc[ai][bj][m][n]; const v2u t = tc[q], gg = gc[q];
                    v2u w; w.x = pkbf(bflo(t.x) + v.x * bflo(gg.x), bfhi(t.x) + v.y * bfhi(gg.x)); w.y = pkbf(bflo(t.y) + v.z * bflo(gg.y), bfhi(t.y) + v.w * bfhi(gg.y));
                    *(v2u*)(hb + o0 + bj * 128 + n * 16) = w; } }
    } };

template <class F> DEV void naive_gemm(LAS unsigned char* lds, const bf16* A, const bf16* Bt, int M, int N, int K, const F& f) {
    LAS float* As = (LAS float*)lds; LAS float* Bs = As + 64 * 33;
    const int tid = threadIdx.x, ty = tid >> 4, tx = tid & 15;
    const int ntn = N / 64, ntiles = (M / 64) * ntn;
    for (int tile = blockIdx.x; tile < ntiles; tile += gridDim.x) {
        const int tm = tile / ntn, tn = tile % ntn;
        f32x4 a0 = {0.f, 0.f, 0.f, 0.f}, a1 = a0;
        for (int k0 = 0; k0 < K; k0 += 32) {
            { const int r = tid >> 3, cc = (tid & 7) * 4;
              const v2u av = *(const v2u*)(A + (size_t)(tm * 64 + r) * K + k0 + cc), bv = *(const v2u*)(Bt + (size_t)(tn * 64 + r) * K + k0 + cc);
              As[r * 33 + cc] = bflo(av.x); As[r * 33 + cc + 1] = bfhi(av.x); As[r * 33 + cc + 2] = bflo(av.y); As[r * 33 + cc + 3] = bfhi(av.y);
              Bs[r * 33 + cc] = bflo(bv.x); Bs[r * 33 + cc + 1] = bfhi(bv.x); Bs[r * 33 + cc + 2] = bflo(bv.y); Bs[r * 33 + cc + 3] = bfhi(bv.y); }
            __syncthreads();
#pragma unroll 8
            for (int kk = 0; kk < 32; ++kk) { const float x0 = As[(2 * ty) * 33 + kk], x1 = As[(2 * ty + 1) * 33 + kk];
                const f32x4 b = {Bs[(4 * tx) * 33 + kk], Bs[(4 * tx + 1) * 33 + kk], Bs[(4 * tx + 2) * 33 + kk], Bs[(4 * tx + 3) * 33 + kk]};
                a0 += b * x0; a1 += b * x1; }
            __syncthreads();
        }
        f.elem4(tm * 64 + 2 * ty, tn * 64 + 4 * tx, a0); f.elem4(tm * 64 + 2 * ty + 1, tn * 64 + 4 * tx, a1);
    }
}
template <class F> DEV void run_gemm(bool naive, LAS unsigned char* lds, const bf16* A, const bf16* Bt, int M, int N, int K, const F& f, int G, int bid) {
    if (naive) { naive_gemm<F>(lds, A, Bt, M, N, K, f); return; }
    asm volatile("" : "+s"(K));
    pg8::Gemm g{A, Bt, M, N, K, A + K / 2, K}; pg8::StaticOrder S; S.init(M, N, G, bid);
    pg8::EpiW<F> E{f};
    pg8::gemm_phase<pg8::EpiW<F>, pg8::StaticOrder, true, true>((PG8_LAS unsigned char*)lds, g, S, E);
}

template <class F> DEV void run_gemm_i8(LAS unsigned char* lds, const unsigned char* A8, const unsigned char* Bt8, const float* rs, const float* cs, int M, int N, int K, const F& f, int G, int bid) {
    asm volatile("" : "+s"(K));
    pg8::Gemm g{(const bf16*)A8, (const bf16*)Bt8, M, N, K, nullptr, K}; pg8::StaticOrder S; S.init(M, N, G, bid);
    pg8::EpiW8<F> E{f, rs, cs};
    pg8::gemm_phase_i8<pg8::EpiW8<F>, pg8::StaticOrder, GI8_ALIGN, true>((PG8_LAS unsigned char*)lds, g, S, E);
}

DEV void run_gemm_in(LAS unsigned char* lds, const Ctx& c) {
    int K = D; asm volatile("" : "+s"(K));
    pg8::Gemm g{(const bf16*)c.xq8, (const bf16*)c.WinT8, T, INW, K, nullptr, K}; pg8::StaticOrder S; S.init(T, INW, c.G, c.bid);
    pg8::gemm_phase_i8<EpiIn, pg8::StaticOrder, GI8_ALIGN, true>((PG8_LAS unsigned char*)lds, g, S, EpiIn{c.proj, c.xs, c.wcs, c.kmp, c.sst});
}

DEV void phase_kmean_vt(const Ctx& c, unsigned* kcnt) {
    const int gw = c.bid * 8 + c.wave, NGW = c.G * 8, lane = c.lane;
    for (int it = gw; it < 16 * NBLK; it += NGW) { const int bh = it / NBLK, n = it % NBLK, b = bh >> 3, h = bh & 7;
        const bf16* kp = c.proj + (size_t)(b * SEQ + n * BLK + (lane >> 4)) * PST + C_K + h * HD + (lane & 15) * 8;
        float s[8];
#pragma unroll
        for (int i = 0; i < 8; ++i) s[i] = 0.f;
#pragma unroll 8
        for (int r = 0; r < BLK; r += 4) { const v4u w = *(const v4u*)(kp + (size_t)r * PST);
            s[0] += bflo(w.x); s[1] += bfhi(w.x); s[2] += bflo(w.y); s[3] += bfhi(w.y); s[4] += bflo(w.z); s[5] += bfhi(w.z); s[6] += bflo(w.w); s[7] += bfhi(w.w); }
#pragma unroll
        for (int i = 0; i < 8; ++i) { s[i] += __shfl_xor(s[i], 16); s[i] += __shfl_xor(s[i], 32); s[i] *= (1.0f / BLK); }
        if (lane < 16) { float* kd = c.kmean + ((size_t)bh * NBLK + n) * HD + lane * 8; *(f32x4*)kd = (f32x4){s[0], s[1], s[2], s[3]}; *(f32x4*)(kd + 4) = (f32x4){s[4], s[5], s[6], s[7]}; }
        asm volatile("s_waitcnt vmcnt(0)" ::: "memory");
        if (lane == 0) { __builtin_amdgcn_fence(__ATOMIC_RELEASE, "agent"); asm volatile("s_waitcnt vmcnt(0)" ::: "memory"); __hip_atomic_fetch_add(kcnt, 1u, __ATOMIC_RELAXED, __HIP_MEMORY_SCOPE_AGENT); }
    }
}
DEV void sgu_stats(const Ctx& c, LAS float* stats, int t0) {
    const int row = c.tid >> 2, part = c.tid & 3;
    const bf16* vp = c.proj + (size_t)(t0 + row) * PST + C_VG + part * 256;
    float s = 0.f, q = 0.f;
#pragma unroll 4
    for (int i = 0; i < 32; ++i) { const v4u w = *(const v4u*)(vp + i * 8);
        const float e0 = bflo(w.x), e1 = bfhi(w.x), e2 = bflo(w.y), e3 = bfhi(w.y), e4 = bflo(w.z), e5 = bfhi(w.z), e6 = bflo(w.w), e7 = bfhi(w.w);
        s += ((e0 + e1) + (e2 + e3)) + ((e4 + e5) + (e6 + e7)); q += ((e0 * e0 + e1 * e1) + (e2 * e2 + e3 * e3)) + ((e4 * e4 + e5 * e5) + (e6 * e6 + e7 * e7)); }
    s += __shfl_xor(s, 1); s += __shfl_xor(s, 2); q += __shfl_xor(q, 1); q += __shfl_xor(q, 2);
    const float mean = s * (1.0f / 1024.0f), var = fmaxf(q * (1.0f / 1024.0f) - mean * mean, 0.f);
    if (part == 0) { stats[row * 2] = mean; stats[row * 2 + 1] = 1.0f / sqrtf(var + EPS); }
}
DEV void sgu_stats2(const Ctx& c, LAS float* stats, int t0) {
    const int row = c.tid >> 2, j = c.tid & 3;
    const f32x4* sp = (const f32x4*)(c.sst + ((size_t)(t0 + row) * 16 + 4 * j) * 2); const f32x4 a = sp[0], b = sp[1];
    float s = (a.x + a.z) + (b.x + b.z), q = (a.y + a.w) + (b.y + b.w);
    s += dppq<0xB1>(s); s += dppq<0x4E>(s); q += dppq<0xB1>(q); q += dppq<0x4E>(q);
    const float mean = s * (1.0f / 1024.0f), var = fmaxf(q * (1.0f / 1024.0f) - mean * mean, 0.f);
    if (j == 0) { stats[row * 2] = mean; stats[row * 2 + 1] = 1.0f / sqrtf(var + EPS); }
}
constexpr int SG_RS = 320, SG_IMG = 128 * SG_RS, SG_SCR = 32 * 144;
DEV void phase_sgu(const Ctx& c, LAS unsigned char* lds) {
    LAS float* stats = (LAS float*)lds;
    LAS unsigned char* img = lds + 1024;
    LAS unsigned char* scr = lds + 1024 + 2 * SG_IMG + c.wave * SG_SCR;
    const int lane = c.lane, r = lane & 31, hh = lane >> 5, wave = c.wave, tid = c.tid;
    const int mt = wave >> 1, cw = wave & 1, nks = 2 * (mt + 1);
    const int srow = tid >> 4, sch = (tid & 15) * 8;
    const int erow = lane >> 3, ech = cw * 64 + (lane & 7) * 8;
    const unsigned troff = (unsigned)(size_t)img + (unsigned)((8 * hh + ((lane & 15) >> 2)) * SG_RS + (cw * 64 + 16 * ((lane >> 4) & 1) + 4 * (lane & 3)) * 2);
#define SG_LOADVG(V, LG, LB, G_) do { _Pragma("unroll") for (int q = 0; q < 4; ++q) V[q] = *(const v4u*)(c.proj + (size_t)(t0 + srow + 32 * q) * PST + C_VG + (G_) * 128 + sch); \
        LG[0] = *(const f32x4*)(c.ln_g + (G_) * 128 + sch); LG[1] = *(const f32x4*)(c.ln_g + (G_) * 128 + sch + 4); LB[0] = *(const f32x4*)(c.ln_b + (G_) * 128 + sch); LB[1] = *(const f32x4*)(c.ln_b + (G_) * 128 + sch + 4); } while (0)
#define SG_LOADOPS(AF, UU, BI, G_) do { _Pragma("unroll") for (int ks = 0; ks < 8; ++ks) if (ks < nks) AF[ks] = *(const v4u*)(c.swb + ((size_t)((G_) * 128 + 32 * mt + r)) * 128 + 16 * ks + 8 * hh); \
        _Pragma("unroll") for (int j = 0; j < 4; ++j) UU[j] = *(const v4u*)(c.proj + (size_t)(t0 + 32 * mt + erow + 8 * j) * PST + C_U + (G_) * 128 + ech); \
        BI = c.sgu_b[(G_) * 128 + 32 * mt + r]; } while (0)
#define SG_STAGE(V, LG, LB, BUF) do { LAS unsigned char* ib = img + (BUF) * SG_IMG; \
        const float gg[8] = {LG[0].x, LG[0].y, LG[0].z, LG[0].w, LG[1].x, LG[1].y, LG[1].z, LG[1].w}, bbv[8] = {LB[0].x, LB[0].y, LB[0].z, LB[0].w, LB[1].x, LB[1].y, LB[1].z, LB[1].w}; \
        _Pragma("unroll") for (int q = 0; q < 4; ++q) { const int row = srow + 32 * q; const float mean = stats[2 * row], rstd = stats[2 * row + 1]; const v4u w = V[q]; \
            const float e[8] = {bflo(w.x), bfhi(w.x), bflo(w.y), bfhi(w.y), bflo(w.z), bfhi(w.z), bflo(w.w), bfhi(w.w)}; float y[8]; \
            _Pragma("unroll") for (int i = 0; i < 8; ++i) y[i] = (e[i] - mean) * rstd * gg[i] + bbv[i]; \
            *(LAS v4u*)(ib + row * SG_RS + sch * 2) = (v4u){pkbf(y[0], y[1]), pkbf(y[2], y[3]), pkbf(y[4], y[5]), pkbf(y[6], y[7])}; } } while (0)
#define SG_BAR asm volatile("s_waitcnt lgkmcnt(0)\n\ts_barrier" ::: "memory")
    for (int unit = c.bid; unit < 256; unit += c.G) {
        const int chunk = unit >> 1, gh = unit & 1, t0 = chunk * 128, g0 = gh * 4;
        __syncthreads();
        v4u vgN[4]; f32x4 lgN[2], lbN[2];
        v4u afN[8], uuN[4]; float biasN;
        SG_LOADVG(vgN, lgN, lbN, g0);
        SG_LOADOPS(afN, uuN, biasN, g0);
        sgu_stats2(c, stats, t0);
        __syncthreads();
        SG_STAGE(vgN, lgN, lbN, 0);
        SG_BAR;
#pragma unroll 1
        for (int gi = 0; gi < 4; ++gi) { const int g = g0 + gi, buf = gi & 1;
            v4u af[8], uu[4]; const float bias = biasN;
#pragma unroll
            for (int ks = 0; ks < 8; ++ks) af[ks] = afN[ks];
#pragma unroll
            for (int j = 0; j < 4; ++j) uu[j] = uuN[j];
            if (gi < 3) { SG_LOADVG(vgN, lgN, lbN, g + 1); SG_LOADOPS(afN, uuN, biasN, g + 1); }
            f32x16 acc0, acc1;
#pragma unroll
            for (int i = 0; i < 16; ++i) { acc0[i] = 0.f; acc1[i] = 0.f; }
#pragma unroll
            for (int ks = 0; ks < 8; ++ks) if (ks < nks) {
                const unsigned ad = troff + (unsigned)(buf * SG_IMG + 16 * ks * SG_RS);
                v2u b00, b01, b10, b11;
                asm volatile("ds_read_b64_tr_b16 %0, %4\n\tds_read_b64_tr_b16 %1, %4 offset:1280\n\tds_read_b64_tr_b16 %2, %4 offset:64\n\tds_read_b64_tr_b16 %3, %4 offset:1344\n\ts_waitcnt lgkmcnt(0)"
                             : "=&v"(b00), "=&v"(b01), "=&v"(b10), "=&v"(b11) : "v"(ad) : "memory");
                const bf16x8 a = __builtin_bit_cast(bf16x8, af[ks]);
                acc0 = MFMA32(__builtin_bit_cast(bf16x8, ((v4u){b00.x, b00.y, b01.x, b01.y})), a, acc0);
                acc1 = MFMA32(__builtin_bit_cast(bf16x8, ((v4u){b10.x, b10.y, b11.x, b11.y})), a, acc1); }
#pragma unroll
            for (int k = 0; k < 4; ++k) {
                *(LAS v2u*)(scr + r * 144 + (8 * k + 4 * hh) * 2) = (v2u){pkbf(acc0[4 * k] + bias, acc0[4 * k + 1] + bias), pkbf(acc0[4 * k + 2] + bias, acc0[4 * k + 3] + bias)};
                *(LAS v2u*)(scr + r * 144 + (32 + 8 * k + 4 * hh) * 2) = (v2u){pkbf(acc1[4 * k] + bias, acc1[4 * k + 1] + bias), pkbf(acc1[4 * k + 2] + bias, acc1[4 * k + 3] + bias)}; }
            asm volatile("s_waitcnt lgkmcnt(0)" ::: "memory");
#pragma unroll
            for (int j = 0; j < 4; ++j) { const int row = erow + 8 * j; const v4u mx = *(const LAS v4u*)(scr + row * 144 + (lane & 7) * 16); const v4u u = uu[j];
                v4u o; o.x = pkbf(bflo(u.x) * bflo(mx.x), bfhi(u.x) * bfhi(mx.x)); o.y = pkbf(bflo(u.y) * bflo(mx.y), bfhi(u.y) * bfhi(mx.y));
                o.z = pkbf(bflo(u.z) * bflo(mx.z), bfhi(u.z) * bfhi(mx.z)); o.w = pkbf(bflo(u.w) * bflo(mx.w), bfhi(u.w) * bfhi(mx.w));
                *(v4u*)(c.ysgu + (size_t)(t0 + 32 * mt + row) * 1024 + g * 128 + ech) = o; }
            asm volatile("s_waitcnt lgkmcnt(0)" ::: "memory");
            if (gi < 3) SG_STAGE(vgN, lgN, lbN, (gi + 1) & 1);
            SG_BAR;
        }
    }
#undef SG_LOADVG
#undef SG_LOADOPS
#undef SG_STAGE
#undef SG_BAR
}
DEV void naive_sgu(const Ctx& c, LAS unsigned char* lds) {
    LAS float* stats = (LAS float*)lds;
    for (int chunk = c.bid; chunk < 128; chunk += c.G) { const int t0 = chunk * 128;
        __syncthreads(); sgu_stats(c, stats, t0); __syncthreads();
        for (int o = c.tid; o < 128 * 1024; o += NTHREADS) { const int tl = o >> 10, f = o & 1023, g = f >> 7;
            float acc = 0.f;
            for (int s = 0; s <= tl; ++s) { const float v = bf2f(c.proj[(size_t)(t0 + s) * PST + C_VG + f]); const float y = (v - stats[2 * s]) * stats[2 * s + 1] * c.ln_g[f] + c.ln_b[f];
                acc += c.sgu_w[((size_t)g * 128 + tl) * 128 + s] * y; }
            acc += c.sgu_b[g * 128 + tl];
            c.ysgu[(size_t)(t0 + tl) * 1024 + f] = (bf16)(pkbf(bf2f(c.proj[(size_t)(t0 + tl) * PST + C_U + f]) * acc, 0.f) & 0xffff); }
    }
}

DEV void insert3(float v, int n, float& v1, float& v2, float& v3, int& i1, int& i2, int& i3) {
    const bool b1 = v > v1, b2 = v > v2, b3 = v > v3;
    v3 = b2 ? v2 : (b3 ? v : v3); i3 = b2 ? i2 : (b3 ? n : i3);
    v2 = b1 ? v1 : (b2 ? v : v2); i2 = b1 ? i1 : (b2 ? n : i2);
    v1 = b1 ? v : v1; i1 = b1 ? n : i1;
}
constexpr int VT_STRIDE = 520;
constexpr float ATT_C = 0.08838834764831845f * 1.4426950408889634f;
DEV void phase_select(const Ctx& c, unsigned* kcnt) {
    const int lane = c.lane, r = lane & 31, hh = lane >> 5, gw = c.bid * 8 + c.wave, NGW = c.G * 8;
    for (int wt = gw; wt < 16 * NBLK * 8; wt += NGW) {
        const int bh = wt >> 8, j = (wt >> 3) & 31, w = wt & 7, b = bh >> 3, h = bh & 7;
        const int q = j * BLK + 32 * w + r;
        int i1 = -1, i2 = -1, i3 = -1;
        if (j > 0) {
            const bf16* qrow = c.proj + ((size_t)b * SEQ + q) * PST + C_Q + h * HD;
            f32x16 g;
#pragma unroll
            for (int i = 0; i < 16; ++i) g[i] = 0.f;
            const float* km = c.kmp + ((size_t)bh * NBLK + r) * HD; const float* km1 = km + 16 * NBLK * HD;
#pragma unroll
            for (int ks = 0; ks < 8; ++ks) { const bf16x8 qf = *(const bf16x8*)(qrow + 16 * ks + 8 * hh);
                const f32x4 ka = *(const f32x4*)(km + 16 * ks + 8 * hh) + *(const f32x4*)(km1 + 16 * ks + 8 * hh), kb = *(const f32x4*)(km + 16 * ks + 8 * hh + 4) + *(const f32x4*)(km1 + 16 * ks + 8 * hh + 4);
                v4u hi; hi.x = pkbf(ka.x, ka.y); hi.y = pkbf(ka.z, ka.w); hi.z = pkbf(kb.x, kb.y); hi.w = pkbf(kb.z, kb.w);
                v4u lo; lo.x = pkbf(ka.x - bflo(hi.x), ka.y - bfhi(hi.x)); lo.y = pkbf(ka.z - bflo(hi.y), ka.w - bfhi(hi.y)); lo.z = pkbf(kb.x - bflo(hi.z), kb.y - bfhi(hi.z)); lo.w = pkbf(kb.z - bflo(hi.w), kb.w - bfhi(hi.w));
                g = MFMA32(__builtin_bit_cast(bf16x8, hi), qf, g); g = MFMA32(__builtin_bit_cast(bf16x8, lo), qf, g); }
            float v1 = -INFINITY, v2 = -INFINITY, v3 = -INFINITY; int a1 = 0, a2 = 0, a3 = 0;
#pragma unroll
            for (int i = 0; i < 16; ++i) { const int n = crow(i, hh); const float v = (n < j) ? g[i] : -INFINITY; insert3(v, n, v1, v2, v3, a1, a2, a3); }
            const float pv1 = __shfl_xor(v1, 32), pv2 = __shfl_xor(v2, 32), pv3 = __shfl_xor(v3, 32); const int pi1 = __shfl_xor(a1, 32), pi2 = __shfl_xor(a2, 32), pi3 = __shfl_xor(a3, 32);
            insert3(pv1, pi1, v1, v2, v3, a1, a2, a3); insert3(pv2, pi2, v1, v2, v3, a1, a2, a3); insert3(pv3, pi3, v1, v2, v3, a1, a2, a3);
            i1 = v1 > -INFINITY ? a1 : -1; i2 = v2 > -INFINITY ? a2 : -1; i3 = v3 > -INFINITY ? a3 : -1;
        }
        if (hh == 0) *(int4*)(c.sel + ((size_t)bh * SEQ + q) * 4) = make_int4(i1, i2, i3, -1);
    }
}
struct AttItem { unsigned char n, jlo, jhi, own; };
#if ATT_FINE
constexpr int NATT_ITEMS = 58;
__device__ const AttItem ATT_ITEMS[NATT_ITEMS] = {{2,3,6,1}, {0,3,7,0}, {2,13,32,0}, {1,2,4,1}, {0,1,3,1}, {7,8,15,1}, {3,4,7,1}, {0,14,32,0}, {17,18,32,1}, {2,6,13,0}, {3,7,15,0}, {8,9,15,1}, {18,19,32,1}, {8,15,32,0}, {7,15,32,0}, {3,15,32,0}, {1,15,32,0}, {4,5,8,1}, {1,4,8,0}, {9,10,16,1}, {0,7,14,0}, {19,20,32,1}, {4,8,16,0}, {9,16,32,0}, {4,16,32,0}, {10,11,17,1}, {5,6,9,1}, {20,21,32,1}, {11,12,18,1}, {5,9,17,0}, {1,8,15,0}, {10,17,32,0}, {5,17,32,0}, {12,13,19,1}, {21,22,32,1}, {6,7,10,1}, {6,10,18,0}, {11,18,32,0}, {6,18,32,0}, {22,23,32,1}, {13,14,19,1}, {14,15,20,1}, {23,24,32,1}, {13,19,32,0}, {12,19,32,0}, {24,25,32,1}, {15,16,20,1}, {15,20,32,0}, {14,20,32,0}, {16,17,21,1}, {25,26,32,1}, {16,21,32,0}, {26,27,32,1}, {27,28,32,1}, {28,29,32,1}, {29,30,32,1}, {30,31,32,1}, {31,32,32,1}};
#else
constexpr int NATT_ITEMS = 44;
__device__ const AttItem ATT_ITEMS[NATT_ITEMS] = {{9,10,32,1}, {10,11,32,1}, {11,12,32,1}, {0,1,4,1}, {3,4,10,1}, {3,10,32,0}, {4,5,12,1}, {12,13,32,1}, {1,2,5,1}, {0,11,32,0}, {13,14,32,1}, {0,4,11,0}, {5,6,13,1}, {2,3,6,1}, {14,15,32,1}, {4,12,32,0}, {1,12,32,0}, {6,7,14,1}, {15,16,32,1}, {1,5,12,0}, {5,13,32,0}, {2,13,32,0}, {7,8,15,1}, {16,17,32,1}, {6,14,32,0}, {17,18,32,1}, {2,6,13,0}, {8,9,15,1}, {18,19,32,1}, {8,15,32,0}, {7,15,32,0}, {19,20,32,1}, {20,21,32,1}, {21,22,32,1}, {22,23,32,1}, {23,24,32,1}, {24,25,32,1}, {25,26,32,1}, {26,27,32,1}, {27,28,32,1}, {28,29,32,1}, {29,30,32,1}, {30,31,32,1}, {31,32,32,1}};
#endif
constexpr int ATT_LIST_OFF = 65536 + 128 * VT_STRIDE;
constexpr int ATT_LIST_CAP = 2048;
DEV void quant_tables(const Ctx& c, int row0, int row1, int step, int first, LAS unsigned char* scr);
constexpr int NQUANT_ITEMS = 2 * NEXP / 128, NQMIX = 2 * NEXP / 64;
DEV void phase_attn(const Ctx& c, LAS unsigned char* lds, unsigned* qctr, bool skip_compute = false, bool skip_quant = false) {
    LAS unsigned char* Kl = lds;
    LAS unsigned char* Vl = lds + 65536;
    LAS unsigned* list = (LAS unsigned*)(lds + ATT_LIST_OFF);
    LAS unsigned* lctl = list + ATT_LIST_CAP;
    const int tid = c.tid, lane = c.lane, wave = c.wave, r = lane & 31, hh = lane >> 5;
    bf16* partO = (bf16*)c.out;
    for (;;) {
        __syncthreads();
        if (tid == 0) lctl[1] = atomicAdd(qctr, 1u);
        __syncthreads();
        const int item = (int)lctl[1];
        if (item >= NATT_ITEMS * 16 + (ATT_MIX ? NQMIX : NQUANT_ITEMS)) break;
#if QUANT_FIRST
        if (item < NQUANT_ITEMS) { const int r0 = item * 128; quant_tables(c, r0, r0 + 128, 8, wave, lds + wave * 2048); continue; }
        const int aitem = item - NQUANT_ITEMS;
#else
#if ATT_MIX
        int aitem;
        if (item < 2 * NQMIX) { if (item & 1) { const int r0 = (item >> 1) * 64; if (!skip_quant) quant_tables(c, r0, r0 + 64, 8, wave, lds + wave * 2048); continue; } aitem = item >> 1; }
        else aitem = item - NQMIX;
#else
        if (item >= NATT_ITEMS * 16) { const int r0 = (item - NATT_ITEMS * 16) * 128; if (!skip_quant) quant_tables(c, r0, r0 + 128, 8, wave, lds + wave * 2048); continue; }
        const int aitem = item;
#endif
#endif
        const AttItem it = ATT_ITEMS[aitem >> 4]; const int bh = aitem & 15, n = it.n, b = bh >> 3, h = bh & 7;
        const size_t tb = (size_t)b * SEQ;
        { const bf16* kg = c.proj + (tb + (size_t)n * BLK) * PST + C_K + h * HD; const bf16* vg = c.proj + (tb + (size_t)n * BLK) * PST + C_V + h * HD;
#pragma unroll 1
          for (int qb = 0; qb < 8; qb += 4) {
              v4u kv[4], vv[4];
#pragma unroll
              for (int q = 0; q < 4; ++q) { const int ch = tid + NTHREADS * (qb + q); kv[q] = *(const v4u*)(kg + (size_t)(ch >> 4) * PST + (ch & 15) * 8); vv[q] = *(const v4u*)(vg + (size_t)(ch & 255) * PST + (ch >> 8) * 8); }
#pragma unroll
              for (int q = 0; q < 4; ++q) { const int ch = tid + NTHREADS * (qb + q); const int key = ch >> 4, c16 = ch & 15;
                  *(LAS v4u*)(Kl + key * 256 + ((c16 ^ (key & 15)) << 4)) = kv[q];
                  const int vk = ch & 255, dc = ch >> 8; LAS unsigned char* vp = Vl + (8 * dc) * VT_STRIDE + vk * 2;
                  const unsigned ww[4] = {vv[q].x, vv[q].y, vv[q].z, vv[q].w};
#pragma unroll
                  for (int i = 0; i < 4; ++i) { *(LAS bf16*)(vp + (2 * i) * VT_STRIDE) = (bf16)(ww[i] & 0xffffu); *(LAS bf16*)(vp + (2 * i + 1) * VT_STRIDE) = (bf16)(ww[i] >> 16); } } } }
        const int qlo = it.jlo * BLK, qhi = it.jhi * BLK;
        bool own_pending = it.own != 0;
        for (int cq = qlo; cq < qhi || own_pending; cq += ATT_LIST_CAP) {
            __syncthreads();
            if (tid == 0) lctl[0] = 0u;
            __syncthreads();
            const int cend = (cq + ATT_LIST_CAP < qhi) ? cq + ATT_LIST_CAP : qhi;
            for (int q = cq + tid; q < cend; q += NTHREADS) {
                const int4 s4 = *(const int4*)(c.sel + ((size_t)bh * SEQ + q) * 4);
                const int slot = (s4.x == n) ? 0 : ((s4.y == n) ? 1 : ((s4.z == n) ? 2 : -1));
                if (slot >= 0) { const unsigned pos = __hip_atomic_fetch_add(lctl, 1u, __ATOMIC_RELAXED, __HIP_MEMORY_SCOPE_WORKGROUP); list[pos] = (unsigned)q | ((unsigned)slot << 16); }
            }
            __syncthreads();
            const int len = (int)lctl[0];
            const int nown = own_pending ? 8 : 0, ngroups = nown + ((len + 31) >> 5);
            for (int gi = wave; gi < (skip_compute ? 0 : ngroups); gi += 8) {
                const bool own = gi < nown;
                int q, slot; bool valid = true;
                if (own) { q = n * BLK + 32 * gi + r; slot = 3; }
                else { const int li = 32 * (gi - nown) + r; valid = li < len; const unsigned e = list[valid ? li : 32 * (gi - nown)]; q = (int)(e & 0xffffu); slot = (int)(e >> 16); }
                const int qloc = 32 * gi + r;
                const bf16* qrow = c.proj + (tb + q) * PST + C_Q + h * HD;
                bf16x8 qf[8];
#pragma unroll
                for (int ks = 0; ks < 8; ++ks) qf[ks] = *(const bf16x8*)(qrow + 16 * ks + 8 * hh);
                float m = -INFINITY, l = 0.f;
                f32x16 o[4];
#pragma unroll
                for (int dt = 0; dt < 4; ++dt)
#pragma unroll
                    for (int i = 0; i < 16; ++i) o[dt][i] = 0.f;
                const int nsteps = own ? ((gi >> 1) + 1) : 4;
                for (int st = 0; st < nsteps; ++st) {
                    f32x16 s0, s1;
#pragma unroll
                    for (int i = 0; i < 16; ++i) { s0[i] = 0.f; s1[i] = 0.f; }
                    const int kr0 = 64 * st + r, kr1 = kr0 + 32;
#pragma unroll
                    for (int ks = 0; ks < 8; ++ks) { const int c16 = 2 * ks + hh;
                        const bf16x8 a0 = *(const LAS bf16x8*)(Kl + kr0 * 256 + ((c16 ^ (kr0 & 15)) << 4)), a1 = *(const LAS bf16x8*)(Kl + kr1 * 256 + ((c16 ^ (kr1 & 15)) << 4));
                        s0 = MFMA32(a0, qf[ks], s0); s1 = MFMA32(a1, qf[ks], s1); }
                    float mx = -INFINITY;
                    if (own) {
#pragma unroll
                        for (int i = 0; i < 16; ++i) { const int k0 = 64 * st + crow(i, hh), k1 = k0 + 32;
                            s0[i] = (k0 <= qloc) ? s0[i] * ATT_C : -INFINITY; s1[i] = (k1 <= qloc) ? s1[i] * ATT_C : -INFINITY; mx = fmaxf(mx, fmaxf(s0[i], s1[i])); }
                    } else {
#pragma unroll
                        for (int i = 0; i < 16; ++i) { s0[i] *= ATT_C; s1[i] *= ATT_C; mx = fmaxf(mx, fmaxf(s0[i], s1[i])); }
                    }
                    mx = fmaxf(mx, __shfl_xor(mx, 32));
                    const float mn = fmaxf(m, mx);
                    const float alpha = __builtin_amdgcn_exp2f(m - mn);
                    float ps = 0.f;
#pragma unroll
                    for (int i = 0; i < 16; ++i) { s0[i] = __builtin_amdgcn_exp2f(s0[i] - mn); s1[i] = __builtin_amdgcn_exp2f(s1[i] - mn); ps += s0[i] + s1[i]; }
                    l = l * alpha + ps; m = mn;
                    if (__any(alpha != 1.0f)) {
#pragma unroll
                        for (int dt = 0; dt < 4; ++dt)
#pragma unroll
                            for (int i = 0; i < 16; ++i) o[dt][i] *= alpha;
                    }
                    bf16x8 pf[2][2];
#pragma unroll
                    for (int s = 0; s < 2; ++s) {
                        v4u w0, w1;
                        w0.x = pkbf(s0[8 * s + 0], s0[8 * s + 1]); w0.y = pkbf(s0[8 * s + 2], s0[8 * s + 3]); w0.z = pkbf(s0[8 * s + 4], s0[8 * s + 5]); w0.w = pkbf(s0[8 * s + 6], s0[8 * s + 7]);
                        w1.x = pkbf(s1[8 * s + 0], s1[8 * s + 1]); w1.y = pkbf(s1[8 * s + 2], s1[8 * s + 3]); w1.z = pkbf(s1[8 * s + 4], s1[8 * s + 5]); w1.w = pkbf(s1[8 * s + 6], s1[8 * s + 7]);
                        pf[0][s] = __builtin_bit_cast(bf16x8, w0); pf[1][s] = __builtin_bit_cast(bf16x8, w1); }
#pragma unroll
                    for (int dt = 0; dt < 4; ++dt)
#pragma unroll
                        for (int kt = 0; kt < 2; ++kt)
#pragma unroll
                            for (int s = 0; s < 2; ++s) {
                                const LAS unsigned char* vp = Vl + (32 * dt + r) * VT_STRIDE + (64 * st + 32 * kt + 16 * s + 4 * hh) * 2;
                                const v2u lo = *(const LAS v2u*)vp, hi = *(const LAS v2u*)(vp + 16);
                                const v4u vw = {lo.x, lo.y, hi.x, hi.y};
                                o[dt] = MFMA32(__builtin_bit_cast(bf16x8, vw), pf[kt][s], o[dt]); }
                }
                l += __shfl_xor(l, 32);
                const float inv = 1.0f / l;
                if (valid) {
                    const size_t pidx = ((size_t)bh * SEQ + q) * 4 + slot;
                    bf16* yp = partO + pidx * HD;
#pragma unroll
                    for (int dt = 0; dt < 4; ++dt)
#pragma unroll
                        for (int g4 = 0; g4 < 4; ++g4) { v2u w; w.x = pkbf(o[dt][4 * g4] * inv, o[dt][4 * g4 + 1] * inv); w.y = pkbf(o[dt][4 * g4 + 2] * inv, o[dt][4 * g4 + 3] * inv);
                            *(v2u*)(yp + 32 * dt + 8 * g4 + 4 * hh) = w; }
                    if (hh == 0) c.lse[pidx] = m + __builtin_amdgcn_logf(l);
                }
            }
            own_pending = false;
        }
    }
}
DEV void phase_attn_combine(const Ctx& c) {
    const int lane = c.lane, gw = c.bid * 8 + c.wave, NGW = c.G * 8, h = lane >> 3, sub = lane & 7;
    const bf16* partO = (const bf16*)c.out;
    for (int t = gw; t < T; t += NGW) {
        const int b = t / SEQ, q = t % SEQ; const size_t pbase = ((size_t)(b * NH + h) * SEQ + q) * 4;
        const int4 s4 = *(const int4*)(c.sel + pbase); const f32x4 L = *(const f32x4*)(c.lse + pbase);
        const float l0 = s4.x >= 0 ? L.x : -INFINITY, l1 = s4.y >= 0 ? L.y : -INFINITY, l2 = s4.z >= 0 ? L.z : -INFINITY, l3 = L.w;
        const float M = fmaxf(fmaxf(l0, l1), fmaxf(l2, l3));
        const float w0 = __builtin_amdgcn_exp2f(l0 - M), w1 = __builtin_amdgcn_exp2f(l1 - M), w2 = __builtin_amdgcn_exp2f(l2 - M), w3 = __builtin_amdgcn_exp2f(l3 - M);
        const float winv = 1.0f / (w0 + w1 + w2 + w3);
        const float ws[4] = {w0 * winv, w1 * winv, w2 * winv, w3 * winv};
        float acc[16];
#pragma unroll
        for (int i = 0; i < 16; ++i) acc[i] = 0.f;
#pragma unroll
        for (int s = 0; s < 4; ++s) { if (ws[s] != 0.f) { const v4u a = *(const v4u*)(partO + (pbase + s) * HD + 16 * sub), bq = *(const v4u*)(partO + (pbase + s) * HD + 16 * sub + 8); const float w = ws[s];
            acc[0] += w * bflo(a.x); acc[1] += w * bfhi(a.x); acc[2] += w * bflo(a.y); acc[3] += w * bfhi(a.y); acc[4] += w * bflo(a.z); acc[5] += w * bfhi(a.z); acc[6] += w * bflo(a.w); acc[7] += w * bfhi(a.w);
            acc[8] += w * bflo(bq.x); acc[9] += w * bfhi(bq.x); acc[10] += w * bflo(bq.y); acc[11] += w * bfhi(bq.y); acc[12] += w * bflo(bq.z); acc[13] += w * bfhi(bq.z); acc[14] += w * bflo(bq.w); acc[15] += w * bfhi(bq.w); } }
        v4u o0, o1; o0.x = pkbf(acc[0], acc[1]); o0.y = pkbf(acc[2], acc[3]); o0.z = pkbf(acc[4], acc[5]); o0.w = pkbf(acc[6], acc[7]); o1.x = pkbf(acc[8], acc[9]); o1.y = pkbf(acc[10], acc[11]); o1.z = pkbf(acc[12], acc[13]); o1.w = pkbf(acc[14], acc[15]);
        bf16* yp = c.yatt + (size_t)t * 1024 + h * HD + 16 * sub; *(v4u*)yp = o0; *(v4u*)(yp + 8) = o1;
    }
}
DEV void naive_attn(const Ctx& c, LAS unsigned char* lds) {
    LAS float* qs = (LAS float*)(lds + c.wave * 5120);
    LAS float* sc = qs + 128;
    const int lane = c.lane, gw = c.bid * 8 + c.wave, NGW = c.G * 8;
    for (int idx = gw; idx < 16 * SEQ; idx += NGW) {
        const int bh = idx / SEQ, sq = idx % SEQ, j = sq / BLK, b = bh >> 3, h = bh & 7; const size_t tb = (size_t)b * SEQ;
        const unsigned qw = *(const unsigned*)(c.proj + (tb + sq) * PST + C_Q + h * HD + 2 * lane);
        const float qa = bflo(qw), qb = bfhi(qw);
        qs[2 * lane] = qa; qs[2 * lane + 1] = qb;
        float v1 = -INFINITY, v2 = -INFINITY, v3 = -INFINITY; int i1 = 0, i2 = 0, i3 = 0;
        for (int n = 0; n < j; ++n) { const f32x2 km = *(const f32x2*)(c.kmean + ((size_t)bh * NBLK + n) * HD + 2 * lane); const float g = wave_sum(qa * km.x + qb * km.y); insert3(g, n, v1, v2, v3, i1, i2, i3); }
        const int nsel = j < 3 ? j : 3;
        asm volatile("s_waitcnt lgkmcnt(0)" ::: "memory");
        float mx = -INFINITY;
        for (int bi = 0; bi <= nsel; ++bi) { const int n = (bi == nsel) ? j : (bi == 0 ? i1 : (bi == 1 ? i2 : i3));
            for (int kk = lane; kk < BLK; kk += 64) { const int kpos = n * BLK + kk; float s = -INFINITY;
                if (kpos <= sq) { const bf16* kp = c.proj + (tb + kpos) * PST + C_K + h * HD; float a = 0.f;
                    for (int d = 0; d < HD; d += 2) { const unsigned w = *(const unsigned*)(kp + d); a += qs[d] * bflo(w) + qs[d + 1] * bfhi(w); }
                    s = a * 0.08838834764831845f; }
                sc[bi * BLK + kk] = s; mx = fmaxf(mx, s); } }
#pragma unroll
        for (int o = 1; o < 64; o <<= 1) mx = fmaxf(mx, __shfl_xor(mx, o));
        asm volatile("s_waitcnt lgkmcnt(0)" ::: "memory");
        float sum = 0.f, oa = 0.f, ob = 0.f;
        for (int bi = 0; bi <= nsel; ++bi) { const int n = (bi == nsel) ? j : (bi == 0 ? i1 : (bi == 1 ? i2 : i3));
            for (int kk = 0; kk < BLK; ++kk) { const float pz = __expf(sc[bi * BLK + kk] - mx); if (pz == 0.f) continue;
                const unsigned w = *(const unsigned*)(c.proj + (tb + n * BLK + kk) * PST + C_V + h * HD + 2 * lane); sum += pz; oa += pz * bflo(w); ob += pz * bfhi(w); } }
        *(unsigned*)(c.yatt + (tb + sq) * 1024 + h * HD + 2 * lane) = pkbf(oa / sum, ob / sum);
    }
}


DEV void phase_final(const Ctx& c) {
    const int gw = c.bid * 8 + c.wave, NGW = c.G * 8, lane = c.lane;
    const f32x4* gr = (const f32x4*)c.g_fin + lane;
    v2u vn[8]; int m = gw;
    if (m < T) { const v2u* xr = (const v2u*)(c.h2b + (size_t)m * D) + lane;
#pragma unroll
        for (int j = 0; j < 8; ++j) vn[j] = xr[64 * j]; }
    for (; m < T; m += NGW) {
        f32x4 v[8]; float s = 0.f;
#pragma unroll
        for (int j = 0; j < 8; ++j) { v[j] = (f32x4){bflo(vn[j].x), bfhi(vn[j].x), bflo(vn[j].y), bfhi(vn[j].y)}; s += (v[j].x * v[j].x + v[j].y * v[j].y) + (v[j].z * v[j].z + v[j].w * v[j].w); }
        { const int mn = m + NGW < T ? m + NGW : m; const v2u* xn_ = (const v2u*)(c.h2b + (size_t)mn * D) + lane;
#pragma unroll
          for (int j = 0; j < 8; ++j) vn[j] = xn_[64 * j]; }
        const float r = 1.0f / sqrtf(wsum_q(s) * (1.0f / D) + EPS);
        f32x4* xr = (f32x4*)(c.out + (size_t)m * D) + lane;
#pragma unroll
        for (int j = 0; j < 8; ++j) xr[64 * j] = v[j] * r * gr[64 * j];
    }
}

DEV unsigned f2key(float f) { const unsigned u = __float_as_uint(f); return u ^ ((unsigned)((int)u >> 31) | 0x80000000u); }
DEV float key2f(unsigned k) { const unsigned u = (k & 0x80000000u) ? (k ^ 0x80000000u) : ~k; return __uint_as_float(u); }
#define TK_INSERT(L, key) do { unsigned _k = (key); _Pragma("unroll") for (int _j = 0; _j < 16; ++_j) { const unsigned _hi = max(L[_j], _k); _k = min(L[_j], _k); L[_j] = _hi; } } while (0)
#define TK_MERGE(a, b) do { _Pragma("unroll") for (int _i = 0; _i < 16; ++_i) a[_i] = max(a[_i], b[15 - _i]); \
    _Pragma("unroll") for (int _st = 8; _st >= 1; _st >>= 1) { _Pragma("unroll") for (int _i = 0; _i < 16; ++_i) if ((_i & _st) == 0) { const unsigned _x = max(a[_i], a[_i + _st]), _y = min(a[_i], a[_i + _st]); a[_i] = _x; a[_i + _st] = _y; } } } while (0)
#define TK_SORT16(a) do { _Pragma("unroll") for (int _k = 2; _k <= 16; _k <<= 1) { _Pragma("unroll") for (int _j = _k >> 1; _j > 0; _j >>= 1) { _Pragma("unroll") for (int _i = 0; _i < 16; ++_i) { const int _l = _i ^ _j; \
    if (_l > _i) { const unsigned _x = max(a[_i], a[_l]), _y = min(a[_i], a[_l]); if ((_i & _k) == 0) { a[_i] = _x; a[_l] = _y; } else { a[_i] = _y; a[_l] = _x; } } } } } } while (0)
DEV void peer_topk_task(const Ctx& c, int tg, int h) {
    const int lane = c.lane, r = lane & 31, hh = lane >> 5;
    {
        const int tok = tg * 32 + r;
        unsigned LA[16], LB[16];
#pragma unroll
        for (int p = 0; p < 2; ++p) {
            const bf16* qrow = c.qp + (size_t)tok * D + h * 256 + p * 128;
            bf16x8 qf[8];
#pragma unroll
            for (int ks = 0; ks < 8; ++ks) qf[ks] = *(const bf16x8*)(qrow + 16 * ks + 8 * hh);
            unsigned L[16];
            const bf16* skp = c.skb + ((size_t)(h * 2 + p) * 128) * 128;
            bf16x8 an[8];
#pragma unroll
            for (int ks = 0; ks < 8; ++ks) an[ks] = *(const bf16x8*)(skp + (size_t)r * 128 + 16 * ks + 8 * hh);
#pragma unroll 1
            for (int nt = 0; nt < 4; ++nt) {
                f32x16 s;
#pragma unroll
                for (int i = 0; i < 16; ++i) s[i] = 0.f;
                bf16x8 ac[8];
#pragma unroll
                for (int ks = 0; ks < 8; ++ks) ac[ks] = an[ks];
                { const int ntn = nt < 3 ? nt + 1 : 3;
#pragma unroll
                  for (int ks = 0; ks < 8; ++ks) an[ks] = *(const bf16x8*)(skp + (size_t)(32 * ntn + r) * 128 + 16 * ks + 8 * hh); }
#pragma unroll
                for (int ks = 0; ks < 8; ++ks) s = MFMA32(ac[ks], qf[ks], s);
                unsigned Tl[16];
#pragma unroll
                for (int i = 0; i < 16; ++i) Tl[i] = (f2key(s[i]) & ~0x7Fu) | (unsigned)(32 * nt + crow(i, hh));
                TK_SORT16(Tl);
                if (nt == 0) {
#pragma unroll
                    for (int i = 0; i < 16; ++i) L[i] = Tl[i];
                } else { TK_MERGE(L, Tl); }
            }
            unsigned PL[16];
#pragma unroll
            for (int i = 0; i < 16; ++i) PL[i] = (unsigned)__shfl_xor((int)L[i], 32);
            TK_MERGE(L, PL);
#pragma unroll
            for (int i = 0; i < 16; ++i) { if (p == 0) LA[i] = L[i]; else LB[i] = L[i]; }
        }
        float va[16], vb[16];
#pragma unroll
        for (int i = 0; i < 16; ++i) { va[i] = key2f(LA[i] & ~0x7Fu); vb[i] = key2f(LB[i] & ~0x7Fu); }
        unsigned CL[16];
#pragma unroll
        for (int i = 0; i < 16; ++i) CL[i] = 0u;
#pragma unroll
        for (int i = 0; i < 16; ++i)
#pragma unroll
            for (int m = 0; m < 8; ++m) if ((i + 1) * (2 * m + 1) <= 16) {
                const float bsel = hh ? vb[2 * m + 1] : vb[2 * m];
                const bool okj = hh ? ((i + 1) * (2 * m + 2) <= 16) : true;
                const unsigned key = okj ? ((f2key(va[i] + bsel) & ~0xFFu) | (unsigned)(i * 16 + 2 * m + hh)) : 0u; TK_INSERT(CL, key); }
        { unsigned PC[16];
#pragma unroll
          for (int i = 0; i < 16; ++i) PC[i] = (unsigned)__shfl_xor((int)CL[i], 32);
          TK_MERGE(CL, PC); }
        unsigned pa[4], pb[4];
#pragma unroll
        for (int w = 0; w < 4; ++w) { pa[w] = (LA[4 * w] & 0x7Fu) | ((LA[4 * w + 1] & 0x7Fu) << 8) | ((LA[4 * w + 2] & 0x7Fu) << 16) | ((LA[4 * w + 3] & 0x7Fu) << 24);
                                      pb[w] = (LB[4 * w] & 0x7Fu) | ((LB[4 * w + 1] & 0x7Fu) << 8) | ((LB[4 * w + 2] & 0x7Fu) << 16) | ((LB[4 * w + 3] & 0x7Fu) << 24); }
        float r1; { float ss = 0.f; const f32x4* rp = (const f32x4*)(c.rss + (size_t)tok * 32);
#pragma unroll
            for (int i = 0; i < 8; ++i) { const f32x4 t4 = rp[i]; ss += (t4.x + t4.y) + (t4.z + t4.w); }
            r1 = 1.0f / sqrtf(ss * (1.0f / D) + EPS); }
        float sv[16]; float ssum = 0.f; const float smax = key2f(CL[0] & ~0xFFu);
#pragma unroll
        for (int k = 0; k < 16; ++k) { sv[k] = __expf((key2f(CL[k] & ~0xFFu) - smax) * r1); ssum += sv[k]; }
        const float sinv = 1.0f / ssum;
        int* ep = c.eid + (size_t)tok * 128 + h * 16; float* gp = c.egate + (size_t)tok * 128 + h * 16;
#pragma unroll
        for (int k = 0; k < 16; ++k) {
            const unsigned ci = (CL[k] >> 4) & 15u, cj = CL[k] & 15u;
            const unsigned wa = (ci >> 2) == 0 ? pa[0] : ((ci >> 2) == 1 ? pa[1] : ((ci >> 2) == 2 ? pa[2] : pa[3]));
            const unsigned wb = (cj >> 2) == 0 ? pb[0] : ((cj >> 2) == 1 ? pb[1] : ((cj >> 2) == 2 ? pb[2] : pb[3]));
            const unsigned ia = (wa >> ((ci & 3u) * 8u)) & 0x7Fu, ib = (wb >> ((cj & 3u) * 8u)) & 0x7Fu;
            if (hh == 0) ep[k] = (int)(ia * 128u + ib); else gp[k] = sv[k] * sinv;
        }
    }
}
DEV void phase_peer_topk(const Ctx& c) {
    const int gw = c.bid * 8 + c.wave, NGW = c.G * 8;
    for (int wt = gw; wt < (T / 32) * NH; wt += NGW) peer_topk_task(c, wt >> 3, wt & 7);
}
DEV void naive_peer_topk(const Ctx& c) {
    const int lane = c.lane, gw = c.bid * 8 + c.wave, NGW = c.G * 8;
    for (int wt = gw; wt < T * NH; wt += NGW) {
        const int tok = wt >> 3, h = wt & 7;
        float ts[2][16]; int ti[2][16];
#pragma unroll
        for (int p = 0; p < 2; ++p) {
            const bf16* qrow = c.qp + (size_t)tok * D + h * 256 + p * 128;
            float s0 = 0.f, s1 = 0.f;
            const bf16* k0 = c.skb + ((size_t)(h * 2 + p) * 128 + lane) * 128; const bf16* k1 = k0 + 64 * 128;
            for (int d = 0; d < 128; ++d) { const float q = bf2f(qrow[d]); s0 += q * bf2f(k0[d]); s1 += q * bf2f(k1[d]); }
#pragma unroll
            for (int k = 0; k < 16; ++k) {
                float best = fmaxf(s0, s1); int bi = (s0 >= s1) ? lane : lane + 64;
#pragma unroll
                for (int o = 1; o < 64; o <<= 1) { const float ob = __shfl_xor(best, o); const int oi = __shfl_xor(bi, o); if (ob > best || (ob == best && oi < bi)) { best = ob; bi = oi; } }
                ts[p][k] = best; ti[p][k] = bi;
                if (bi == lane) s0 = -INFINITY; if (bi == lane + 64) s1 = -INFINITY;
            }
        }
        float cv[4]; int cid[4];
#pragma unroll
        for (int q = 0; q < 4; ++q) { cv[q] = 0.f; cid[q] = 0; }
#pragma unroll
        for (int i = 0; i < 16; ++i)
#pragma unroll
            for (int jj = 0; jj < 16; ++jj) { if ((lane >> 2) == i && (lane & 3) == (jj >> 2)) { cv[jj & 3] = ts[0][i] + ts[1][jj]; cid[jj & 3] = ti[0][i] * 128 + ti[1][jj]; } }
        float bs[16]; int be[16];
#pragma unroll
        for (int k = 0; k < 16; ++k) {
            float best = cv[0]; int bq = 0;
#pragma unroll
            for (int q = 1; q < 4; ++q) if (cv[q] > best) { best = cv[q]; bq = q; }
            int bpos = lane * 4 + bq; int bid_ = (bq == 0) ? cid[0] : (bq == 1 ? cid[1] : (bq == 2 ? cid[2] : cid[3]));
#pragma unroll
            for (int o = 1; o < 64; o <<= 1) { const float ob = __shfl_xor(best, o); const int op = __shfl_xor(bpos, o); const int oe = __shfl_xor(bid_, o); if (ob > best || (ob == best && op < bpos)) { best = ob; bpos = op; bid_ = oe; } }
            bs[k] = best; be[k] = bid_;
#pragma unroll
            for (int q = 0; q < 4; ++q) if (bpos == lane * 4 + q) cv[q] = -INFINITY;
        }
        const float mxs = bs[0]; float tot = 0.f;
#pragma unroll
        for (int k = 0; k < 16; ++k) { bs[k] = __expf(bs[k] - mxs); tot += bs[k]; }
        int* ep = c.eid + (size_t)tok * 128 + h * 16; float* gp = c.egate + (size_t)tok * 128 + h * 16;
        if (lane == 0) {
#pragma unroll
            for (int k = 0; k < 16; ++k) { ep[k] = be[k]; gp[k] = bs[k] / tot; }
        }
    }
}

DEV float rl_f(float v, int l) { return __int_as_float(__builtin_amdgcn_readlane(__float_as_int(v), l)); }
DEV unsigned q4(float a, float b, float c_, float d, float inv, int off) {
    const int qa = (int)rintf(a * inv) + off, qb = (int)rintf(b * inv) + off, qc = (int)rintf(c_ * inv) + off, qd = (int)rintf(d * inv) + off;
    return (unsigned)(qa & 0xff) | ((unsigned)(qb & 0xff) << 8) | ((unsigned)(qc & 0xff) << 16) | ((unsigned)(qd & 0xff) << 24);
}
DEV float wave_max(float v) {
#pragma unroll
    for (int o = 1; o < 64; o <<= 1) v = fmaxf(v, __shfl_xor(v, o));
    return v;
}
DEV void quant_tables(const Ctx& c, int row0, int row1, int step, int first, LAS unsigned char* scr) {
    const int lane = c.lane;
    int row = row0 + first;
    if (row >= row1) return;
    f32x4 vn[8];
    { const bool isup = row >= NEXP; const int e = isup ? row - NEXP : row; const f32x4* src = (const f32x4*)((isup ? c.up : c.dn) + (size_t)e * D) + lane;
#pragma unroll
      for (int j = 0; j < 8; ++j) vn[j] = src[64 * j]; }
    for (; row < row1; row += step) {
        const bool isup = row >= NEXP; const int e = isup ? row - NEXP : row;
        f32x4 v[8];
#pragma unroll
        for (int j = 0; j < 8; ++j) v[j] = vn[j];
        { const int rn = row + step < row1 ? row + step : row; const bool upn = rn >= NEXP; const int en = upn ? rn - NEXP : rn; const f32x4* src = (const f32x4*)((upn ? c.up : c.dn) + (size_t)en * D) + lane;
#pragma unroll
          for (int j = 0; j < 8; ++j) vn[j] = src[64 * j]; }
        float am = 0.f;
#pragma unroll
        for (int j = 0; j < 8; ++j) { if (!isup) v[j] *= ((const f32x4*)c.g_ffn)[64 * j + lane];
            am = fmaxf(am, fmaxf(fmaxf(fabsf(v[j].x), fabsf(v[j].y)), fmaxf(fabsf(v[j].z), fabsf(v[j].w)))); }
        am = wmax_q(am);
        if (!isup) {
            const float inv = am > 0.f ? 127.0f / am : 0.f;
            unsigned* dst = (unsigned*)(c.dn8 + (size_t)e * D) + lane;
#pragma unroll
            for (int j = 0; j < 8; ++j) dst[64 * j] = q4(v[j].x, v[j].y, v[j].z, v[j].w, inv, 0);
            if (lane == 0) c.sdn[e] = am * (1.0f / 127.0f);
        } else {
            float ssq = 0.f;
#pragma unroll
            for (int j = 0; j < 8; ++j) ssq += (v[j].x * v[j].x + v[j].y * v[j].y) + (v[j].z * v[j].z + v[j].w * v[j].w);
            const float rms = sqrtf(wsum_q(ssq) * (1.0f / D));
            const float stA = am * (1.0f / 7.0f), stB = fminf(stA, 0.36f * rms);
            const float ivA = stA > 0.f ? 1.0f / stA : 0.f, ivB = stB > 0.f ? 1.0f / stB : 0.f;
            float eA = 0.f, eB = 0.f;
#pragma unroll
            for (int j = 0; j < 8; ++j) { const float vv[4] = {v[j].x, v[j].y, v[j].z, v[j].w};
#pragma unroll
                for (int i = 0; i < 4; ++i) { const float qa = fminf(fmaxf(rintf(vv[i] * ivA), -7.f), 7.f) * stA - vv[i], qb = fminf(fmaxf(rintf(vv[i] * ivB), -7.f), 7.f) * stB - vv[i]; eA += qa * qa; eB += qb * qb; } }
            eA = wsum_q(eA); eB = wsum_q(eB);
            const bool useB = am > 0.f && eB < eA;
            const float st = useB ? stB : stA, inv = useB ? ivB : ivA; am = st * 7.0f;
#pragma unroll
            for (int j = 0; j < 8; ++j) { const f32x4 cl = {fminf(fmaxf(v[j].x * inv, -7.f), 7.f), fminf(fmaxf(v[j].y * inv, -7.f), 7.f), fminf(fmaxf(v[j].z * inv, -7.f), 7.f), fminf(fmaxf(v[j].w * inv, -7.f), 7.f)};
                *(LAS unsigned*)(scr + 4 * (64 * j + lane)) = q4(cl.x, cl.y, cl.z, cl.w, 1.0f, 8); }
            asm volatile("s_waitcnt lgkmcnt(0)" ::: "memory");
            const v4u lo = *(const LAS v4u*)(scr + 32 * lane), hi = *(const LAS v4u*)(scr + 32 * lane + 16);
            v4u o; o.x = (lo.x & 0x0F0F0F0Fu) | ((lo.y & 0x0F0F0F0Fu) << 4); o.y = (lo.z & 0x0F0F0F0Fu) | ((lo.w & 0x0F0F0F0Fu) << 4);
                   o.z = (hi.x & 0x0F0F0F0Fu) | ((hi.y & 0x0F0F0F0Fu) << 4); o.w = (hi.z & 0x0F0F0F0Fu) | ((hi.w & 0x0F0F0F0Fu) << 4);
            *(v4u*)(c.up8 + (size_t)e * (D / 2) + 16 * lane) = o;
            if (lane == 0) c.sup[e] = am * (1.0f / 7.0f);
            asm volatile("s_waitcnt lgkmcnt(0)" ::: "memory");
        }
    }
}
#ifndef EXP_NT
#define EXP_NT 2
#endif
constexpr int ENT = EXP_NT;
struct TokQ { int e0, e1, hid0, hid1; float sd0, sd1, gs0, gs1, cf0, cf1, sx, csum; };
DEV int sread_i(int v0, int v1, int k) { const int a = __builtin_amdgcn_readlane(v0, k & 63), b = __builtin_amdgcn_readlane(v1, k & 63); return k < 64 ? a : b; }
DEV float sread_f(float v0, float v1, int k) { return __int_as_float(sread_i(__float_as_int(v0), __float_as_int(v1), k)); }
DEV v4u bload16(__amdgpu_buffer_rsrc_t rs, int voff, int soff) { return __builtin_bit_cast(v4u, __builtin_amdgcn_raw_buffer_load_b128(rs, voff, soff, 0)); }
DEV unsigned bsort_step(unsigned v, unsigned pv, bool keepmin) { return keepmin ? min(v, pv) : max(v, pv); }
DEV void tokq_init(const Ctx& c, int tok, TokQ& s, unsigned (&xq)[4][4], int lane, unsigned idmask = 0xFFFFu) {
    float am = 0.f;
#pragma unroll
    for (int q = 0; q < 4; ++q)
#pragma unroll
        for (int hf = 0; hf < 2; ++hf) { const v4u w = *(const v4u*)(c.h1n + (size_t)tok * D + q * 512 + 16 * (lane & 31) + 8 * hf);
            am = fmaxf(am, fmaxf(fmaxf(fmaxf(fabsf(bflo(w.x)), fabsf(bfhi(w.x))), fmaxf(fabsf(bflo(w.y)), fabsf(bfhi(w.y)))), fmaxf(fmaxf(fabsf(bflo(w.z)), fabsf(bfhi(w.z))), fmaxf(fabsf(bflo(w.w)), fabsf(bfhi(w.w)))))); }
    am = wave_max(am);
    const float r1 = 1.0f / sqrtf(wave_sum(lane < 32 ? c.rss[(size_t)tok * 32 + lane] : 0.f) * (1.0f / D) + EPS);
    const float inv = am > 0.f ? 127.0f / am : 0.f; s.sx = am * (1.0f / 127.0f) * r1;
#pragma unroll
    for (int q = 0; q < 4; ++q)
#pragma unroll
        for (int hf = 0; hf < 2; ++hf) { const v4u w = *(const v4u*)(c.h1n + (size_t)tok * D + q * 512 + 16 * (lane & 31) + 8 * hf);
            xq[q][2 * hf] = q4(bflo(w.x), bfhi(w.x), bflo(w.y), bfhi(w.y), inv, 0); xq[q][2 * hf + 1] = q4(bflo(w.z), bfhi(w.z), bflo(w.w), bfhi(w.w), inv, 0); }
    const float g0 = c.egate[(size_t)tok * 128 + lane], g1 = c.egate[(size_t)tok * 128 + 64 + lane];
    unsigned k0 = (((unsigned)c.eid[(size_t)tok * 128 + lane] & idmask) << 7) | (unsigned)lane, k1 = (((unsigned)c.eid[(size_t)tok * 128 + 64 + lane] & idmask) << 7) | (unsigned)(64 + lane);
#pragma unroll
    for (int k = 2; k <= 128; k <<= 1)
#pragma unroll
        for (int j = k >> 1; j > 0; j >>= 1) {
            if (j == 64) { const unsigned a = min(k0, k1), b = max(k0, k1); k0 = a; k1 = b; }
            else { const unsigned p0 = (unsigned)__shfl_xor((int)k0, j), p1 = (unsigned)__shfl_xor((int)k1, j);
                const bool lower = (lane & j) == 0;
                const bool up0 = (k == 128) ? true : ((lane & k) == 0), up1 = (k == 128) ? true : ((k == 64) ? false : ((lane & k) == 0));
                k0 = bsort_step(k0, p0, up0 == lower); k1 = bsort_step(k1, p1, up1 == lower); }
        }
    s.e0 = (int)(k0 >> 7); s.e1 = (int)(k1 >> 7);
    { const int s0 = (int)(k0 & 127u), s1 = (int)(k1 & 127u);
      const float a0 = __shfl(g0, s0 & 63), b0 = __shfl(g1, s0 & 63), a1 = __shfl(g0, s1 & 63), b1 = __shfl(g1, s1 & 63);
      s.gs0 = (s0 < 64 ? a0 : b0) * c.sup[s.e0]; s.gs1 = (s1 < 64 ? a1 : b1) * c.sup[s.e1]; }
    s.sd0 = c.sdn[s.e0]; s.sd1 = c.sdn[s.e1];
    s.hid0 = 0; s.hid1 = 0; s.cf0 = 0.f; s.cf1 = 0.f; s.csum = 0.f;
}
DEV void q_load(__amdgpu_buffer_rsrc_t rs, const TokQ& s, int kb, int q, int lane, v4u (&dq)[4]) {
    const int esel = kb < 64 ? s.e0 : s.e1;
#pragma unroll
    for (int j = 0; j < 4; ++j) { const int id = __shfl(esel, (kb + 2 * j + (lane >> 5)) & 63);
        dq[j] = bload16(rs, id * D + q * 512 + 16 * (lane & 31), 0); }
}
DEV void u_load(__amdgpu_buffer_rsrc_t rs, const TokQ& s, int kb, int hq, int lane, v4u (&dq)[4]) {
    const int esel = kb < 64 ? s.e0 : s.e1;
#pragma unroll
    for (int j = 0; j < 4; ++j) { const int id = __shfl(esel, (kb + 2 * j + (lane >> 5)) & 63);
        dq[j] = bload16(rs, id * (D / 2) + hq * 512 + 16 * (lane & 31), 0); }
}
DEV void q_down_dot(const unsigned (&xq)[4], const v4u (&dq)[4], int (&part)[16], const int sub) {
#pragma unroll
    for (int j = 0; j < 4; ++j) { int a = __builtin_amdgcn_sdot4((int)dq[j].x, (int)xq[0], 0, false); a = __builtin_amdgcn_sdot4((int)dq[j].y, (int)xq[1], a, false);
        a = __builtin_amdgcn_sdot4((int)dq[j].z, (int)xq[2], a, false); a = __builtin_amdgcn_sdot4((int)dq[j].w, (int)xq[3], a, false); part[4 * sub + j] = a; }
}
DEV void q_down_reduce(TokQ& s, int kg, int lane, const int (&part)[16]) {
    int r8[8], r4[4], r2[2], r1;
    { const bool h = (lane & 16) != 0;
#pragma unroll
      for (int i = 0; i < 8; ++i) { const int keep = h ? part[i + 8] : part[i], send = h ? part[i] : part[i + 8]; r8[i] = keep + __shfl_xor(send, 16); } }
    { const bool h = (lane & 8) != 0;
#pragma unroll
      for (int i = 0; i < 4; ++i) { const int keep = h ? r8[i + 4] : r8[i], send = h ? r8[i] : r8[i + 4]; r4[i] = keep + __shfl_xor(send, 8); } }
    { const bool h = (lane & 4) != 0;
#pragma unroll
      for (int i = 0; i < 2; ++i) { const int keep = h ? r4[i + 2] : r4[i], send = h ? r4[i] : r4[i + 2]; r2[i] = keep + __shfl_xor(send, 4); } }
    { const bool h = (lane & 2) != 0; const int keep = h ? r2[1] : r2[0], send = h ? r2[0] : r2[1]; r1 = keep + __shfl_xor(send, 2); }
    r1 += __shfl_xor(r1, 1);
    const int e = (lane - kg) & 31;
    const int isrc = 4 * (e >> 3) + ((e & 7) >> 1), hsrc = e & 1;
    const int gsum = __shfl(r1, 32 * hsrc + 2 * isrc);
    if ((lane >> 5) == ((kg & 63) >> 5)) { if (kg < 64) s.hid0 += gsum; else s.hid1 += gsum; }
}
DEV void q_up_compute(const TokQ& s, float (&y)[16], int kb, int lane, const v4u (&uq)[4]) {
#pragma unroll
    for (int j = 0; j < 4; ++j) { const float flo = sread_f(s.cf0, s.cf1, kb + 2 * j), fhi = sread_f(s.cf0, s.cf1, kb + 2 * j + 1); const float f = lane < 32 ? flo : fhi;
        const unsigned ww[4] = {uq[j].x, uq[j].y, uq[j].z, uq[j].w};
#pragma unroll
        for (int w = 0; w < 4; ++w) { y[4 * w + 0] += f * (float)(ww[w] & 0xffu); y[4 * w + 1] += f * (float)((ww[w] >> 8) & 0xffu); y[4 * w + 2] += f * (float)((ww[w] >> 16) & 0xffu); y[4 * w + 3] += f * (float)(ww[w] >> 24); } }
}
DEV void tokq_final(const Ctx& c, int tok, int lane) {
    const v2u* hp = (const v2u*)(c.h2b + (size_t)tok * D) + lane;
    f32x4 v[8]; float ss = 0.f, am = 0.f;
#pragma unroll
    for (int j = 0; j < 8; ++j) { const v2u w = hp[64 * j]; v[j] = (f32x4){bflo(w.x), bfhi(w.x), bflo(w.y), bfhi(w.y)}; ss += (v[j].x * v[j].x + v[j].y * v[j].y) + (v[j].z * v[j].z + v[j].w * v[j].w);
        am = fmaxf(am, fmaxf(fmaxf(fabsf(v[j].x), fabsf(v[j].y)), fmaxf(fabsf(v[j].z), fabsf(v[j].w)))); }
    const float rr = 1.0f / sqrtf(wave_sum(ss) * (1.0f / D) + EPS);
    am = wave_max(am);
    const float inv = am > 0.f ? 127.0f / am : 0.f;
    unsigned* o4 = (unsigned*)(c.h2q8 + (size_t)tok * D) + lane;
#pragma unroll
    for (int j = 0; j < 8; ++j) o4[64 * j] = q4(v[j].x, v[j].y, v[j].z, v[j].w, inv, 0);
    if (lane == 0) c.h2s[tok] = am * (1.0f / 127.0f) * rr;
}
DEV void phase_peer_experts(const Ctx& c, unsigned idmask = 0xFFFFu) {
    const int lane = c.lane, gw = c.bid * 8 + c.wave, NGW = c.G * 8;
    const __amdgpu_buffer_rsrc_t rsd = __builtin_amdgcn_make_buffer_rsrc((void*)c.dn8, 0, NEXP * D, 0x00020000), rsu = __builtin_amdgcn_make_buffer_rsrc((void*)c.up8, 0, NEXP * D / 2, 0x00020000);
    for (int tg = gw; tg < T / ENT; tg += NGW) {
        const int tok0 = tg * ENT;
        TokQ S[ENT];
        {
            unsigned xq[ENT][4][4];
#pragma unroll
            for (int t = 0; t < ENT; ++t) tokq_init(c, tok0 + t, S[t], xq[t], lane, idmask);
#pragma unroll 1
            for (int q = 0; q < 4; ++q) {
                unsigned xc[ENT][4];
#pragma unroll
                for (int t = 0; t < ENT; ++t)
#pragma unroll
                    for (int w = 0; w < 4; ++w) xc[t][w] = q == 0 ? xq[t][0][w] : (q == 1 ? xq[t][1][w] : (q == 2 ? xq[t][2][w] : xq[t][3][w]));
                v4u dq[ENT][2][4];
#pragma unroll
                for (int t = 0; t < ENT; ++t) { q_load(rsd, S[t], 0, q, lane, dq[t][0]); q_load(rsd, S[t], 8, q, lane, dq[t][1]); }
#pragma unroll 1
                for (int kg = 0; kg < 128; kg += 32) {
                    int part[ENT][16];
#pragma unroll
                    for (int sub = 0; sub < 4; ++sub) { const int kb = kg + 8 * sub, kn = kb + 16 < 128 ? kb + 16 : 120;
#pragma unroll
                        for (int t = 0; t < ENT; ++t) { q_down_dot(xc[t], dq[t][sub & 1], part[t], sub); q_load(rsd, S[t], kn, q, lane, dq[t][sub & 1]); } }
#pragma unroll
                    for (int t = 0; t < ENT; ++t) q_down_reduce(S[t], kg, lane, part[t]);
                }
            }
        }
#pragma unroll
        for (int t = 0; t < ENT; ++t) { S[t].cf0 = S[t].gs0 * gelu_erf((float)S[t].hid0 * (S[t].sx * S[t].sd0)); S[t].cf1 = S[t].gs1 * gelu_erf((float)S[t].hid1 * (S[t].sx * S[t].sd1));
            S[t].csum = wave_sum(S[t].cf0 + S[t].cf1); }
        unsigned cpk[ENT]; float cscale[ENT]; int csumq[ENT];
#pragma unroll
        for (int t = 0; t < ENT; ++t) { const float cm = wave_max(fmaxf(fabsf(S[t].cf0), fabsf(S[t].cf1))); const float inv = cm > 0.f ? 127.0f / cm : 0.f; cscale[t] = cm * (1.0f / 127.0f);
            const int c0 = (int)rintf(S[t].cf0 * inv), c1 = (int)rintf(S[t].cf1 * inv);
            { int sq = c0 + c1;
#pragma unroll
              for (int o = 1; o < 64; o <<= 1) sq += __shfl_xor(sq, o);
              csumq[t] = sq; }
            unsigned pk = 0u;
#pragma unroll
            for (int i = 0; i < 4; ++i) { const int p = 8 * ((lane & 31) >> 1) + (lane & 1) + 2 * i; const int a = __shfl(c0, p & 63), bq = __shfl(c1, p & 63); pk |= ((unsigned)((p < 64 ? a : bq) & 0xff)) << (8 * i); }
            cpk[t] = pk; }
#pragma unroll 1
        for (int hq = 0; hq < 2; ++hq) {
            int y[ENT][32];
#pragma unroll
            for (int t = 0; t < ENT; ++t)
#pragma unroll
                for (int i = 0; i < 32; ++i) y[t][i] = 0;
            v4u uq[ENT][4];
#pragma unroll
            for (int t = 0; t < ENT; ++t) u_load(rsu, S[t], 0, hq, lane, uq[t]);
            for (int kb = 0; kb < 128; kb += 8) { const int kn = kb + 8 < 128 ? kb + 8 : 120;
#pragma unroll
                for (int t = 0; t < ENT; ++t) {
                    const unsigned clo = (unsigned)__builtin_amdgcn_readlane((int)cpk[t], (kb >> 2) & 31), chi = (unsigned)__builtin_amdgcn_readlane((int)cpk[t], ((kb >> 2) & 31) + 1);
                    const int cw = (int)(lane < 32 ? clo : chi);
                    const unsigned a0[4] = {uq[t][0].x, uq[t][0].y, uq[t][0].z, uq[t][0].w}, a1[4] = {uq[t][1].x, uq[t][1].y, uq[t][1].z, uq[t][1].w}, a2[4] = {uq[t][2].x, uq[t][2].y, uq[t][2].z, uq[t][2].w}, a3[4] = {uq[t][3].x, uq[t][3].y, uq[t][3].z, uq[t][3].w};
#pragma unroll
                    for (int w = 0; w < 4; ++w)
#pragma unroll
                        for (int nb = 0; nb < 2; ++nb) {
                            const unsigned b0 = (a0[w] >> (4 * nb)) & 0x0F0F0F0Fu, b1 = (a1[w] >> (4 * nb)) & 0x0F0F0F0Fu, b2 = (a2[w] >> (4 * nb)) & 0x0F0F0F0Fu, b3 = (a3[w] >> (4 * nb)) & 0x0F0F0F0Fu;
                            const unsigned x0 = __builtin_amdgcn_perm(b1, b0, 0x05010400u), x1 = __builtin_amdgcn_perm(b1, b0, 0x07030602u), x2 = __builtin_amdgcn_perm(b3, b2, 0x05010400u), x3 = __builtin_amdgcn_perm(b3, b2, 0x07030602u);
                            const unsigned t0 = __builtin_amdgcn_perm(x2, x0, 0x05040100u), t1 = __builtin_amdgcn_perm(x2, x0, 0x07060302u), t2 = __builtin_amdgcn_perm(x3, x1, 0x05040100u), t3 = __builtin_amdgcn_perm(x3, x1, 0x07060302u);
                            const int yb = 8 * w + 4 * nb;
                            y[t][yb + 0] = __builtin_amdgcn_sdot4((int)t0, cw, y[t][yb + 0], false); y[t][yb + 1] = __builtin_amdgcn_sdot4((int)t1, cw, y[t][yb + 1], false);
                            y[t][yb + 2] = __builtin_amdgcn_sdot4((int)t2, cw, y[t][yb + 2], false); y[t][yb + 3] = __builtin_amdgcn_sdot4((int)t3, cw, y[t][yb + 3], false); }
                    u_load(rsu, S[t], kn, hq, lane, uq[t]); } }
#pragma unroll
            for (int t = 0; t < ENT; ++t) {
#pragma unroll
                for (int i = 0; i < 32; ++i) y[t][i] += __shfl_xor(y[t][i], 32);
                if (lane < 32) { bf16* hp = c.h2b + (size_t)(tok0 + t) * D + hq * 1024 + 32 * lane; const float sc = cscale[t]; const int corr = 8 * csumq[t];
                    const bf16* hb = c.h1n + (size_t)(tok0 + t) * D + hq * 1024 + 32 * lane;
#pragma unroll
                    for (int g8 = 0; g8 < 4; ++g8) { const v4u hw = *(const v4u*)(hb + 8 * g8); const int yb = 8 * g8; v4u o;
                        o.x = pkbf(bflo(hw.x) + (float)(y[t][yb] - corr) * sc, bfhi(hw.x) + (float)(y[t][yb + 1] - corr) * sc); o.y = pkbf(bflo(hw.y) + (float)(y[t][yb + 2] - corr) * sc, bfhi(hw.y) + (float)(y[t][yb + 3] - corr) * sc);
                        o.z = pkbf(bflo(hw.z) + (float)(y[t][yb + 4] - corr) * sc, bfhi(hw.z) + (float)(y[t][yb + 5] - corr) * sc); o.w = pkbf(bflo(hw.w) + (float)(y[t][yb + 6] - corr) * sc, bfhi(hw.w) + (float)(y[t][yb + 7] - corr) * sc);
                        *(v4u*)(hp + yb) = o; } } }
        }
        __builtin_amdgcn_fence(__ATOMIC_RELEASE, "workgroup"); asm volatile("s_waitcnt vmcnt(0)" ::: "memory"); __builtin_amdgcn_fence(__ATOMIC_ACQUIRE, "workgroup");
#pragma unroll
        for (int t = 0; t < ENT; ++t) tokq_final(c, tok0 + t, lane);
    }
}


#define GAS __attribute__((address_space(1)))
#define XB_TMO      128
#define XB_XCNT(j)  (256  + 64 * (j))
#define XB_XSUB(j)  (1280 + 64 * (j))
#define XB_XGEN(j)  (2304 + 64 * (j))
#define XB_TOP      3328
#define XB_TOPGEN   3392
#define XCD_BAR_WORDS 3456
#define XB_SPIN_CAP (1u << 18)

__device__ __forceinline__ unsigned xb_ld(unsigned* p)              { return __hip_atomic_load(p, __ATOMIC_RELAXED, __HIP_MEMORY_SCOPE_AGENT); }
__device__ __forceinline__ unsigned xb_add(unsigned* p, unsigned v) { return __hip_atomic_fetch_add(p, v, __ATOMIC_RELAXED, __HIP_MEMORY_SCOPE_AGENT); }
__device__ __forceinline__ unsigned xb_xcc_id() { return (unsigned)__builtin_amdgcn_s_getreg((3 << 11) | 20) & 0xFu; }
#define XB_SPIN(cond, bar) do { unsigned _sp = 0; while (cond) { __builtin_amdgcn_s_sleep(1); \
    if ((++_sp & 255u) == 0u) { if (xb_ld(&(bar)[XB_TMO])) break; if (_sp > XB_SPIN_CAP) { atomicAdd(&(bar)[XB_TMO], 1u); break; } } } } while (0)

struct XcdBarrier {
    unsigned* bar; unsigned x;
    volatile LAS unsigned* st;
};

__device__ __forceinline__ XcdBarrier xcd_barrier_post(unsigned* bar, volatile LAS unsigned* st) {
    XcdBarrier b; b.bar = bar; b.x = xb_xcc_id(); b.st = st;
    if (threadIdx.x == 0) (void)xb_add(&bar[XB_XCNT(b.x)], 1u);
    return b;
}
__device__ __forceinline__ void xcd_barrier_complete(unsigned* bar, unsigned x, unsigned& nloc, unsigned& nx) {
    const unsigned G = gridDim.x * gridDim.y * gridDim.z;
    unsigned sum, cnt, mine, sp = 0u;
    for (;;) {
        sum = 0u; cnt = 0u; mine = 0u;
#pragma unroll
        for (unsigned j = 0; j < 16; ++j) { const unsigned c = xb_ld(&bar[XB_XCNT(j)]); sum += c; cnt += (c > 0u) ? 1u : 0u; mine = (j == x) ? c : mine; }
        if (sum == G) break;
        __builtin_amdgcn_s_sleep(1);
        if ((++sp & 255u) == 0u) { if (xb_ld(&bar[XB_TMO])) break; if (sp > XB_SPIN_CAP) { atomicAdd(&bar[XB_TMO], 1u); break; } }
    }
    nloc = mine > 0u ? mine : 1u; nx = cnt > 0u ? cnt : 1u;
}

__device__ __forceinline__ void xcd_barrier(const XcdBarrier& b) {
    asm volatile("s_waitcnt vmcnt(0)" ::: "memory");
    __syncthreads();
    if (threadIdx.x == 0) {
        unsigned* bar = b.bar;
        __builtin_amdgcn_s_waitcnt(0);
        unsigned nloc = b.st[0], nx = b.st[1];
        if (nloc == 0u) { xcd_barrier_complete(bar, b.x, nloc, nx); b.st[0] = nloc; b.st[1] = nx; }
        const unsigned old = xb_add(&bar[XB_XSUB(b.x)], 1u);
        const unsigned gen = old / nloc;
        if (old + 1u == (gen + 1u) * nloc) {
            __builtin_amdgcn_fence(__ATOMIC_RELEASE, "agent");
            asm volatile("s_waitcnt vmcnt(0)" ::: "memory");
            const unsigned og = xb_add(&bar[XB_TOP], 1u);
            const unsigned tg = og / nx;
            if (og + 1u == (tg + 1u) * nx) xb_add(&bar[XB_TOPGEN], 1u);
            else XB_SPIN(xb_ld(&bar[XB_TOPGEN]) == tg, bar);
            __builtin_amdgcn_fence(__ATOMIC_ACQUIRE, "agent");
            xb_add(&bar[XB_XGEN(b.x)], 1u);
            asm volatile("s_waitcnt vmcnt(0)" ::: "memory");
        } else {
            XB_SPIN(xb_ld(&bar[XB_XGEN(b.x)]) == gen, bar);
            __builtin_amdgcn_fence(__ATOMIC_ACQUIRE, "agent");
            asm volatile("s_waitcnt vmcnt(0)" ::: "memory");
        }
    }
    __syncthreads();
}

struct Args { const float* in[20]; float* out; unsigned char* ws; int ph_lo, ph_hi; };
constexpr int NPHASES = 16;
__global__ void __launch_bounds__(NTHREADS, 2) fwd_kernel(Args args) {
    extern __shared__ __attribute__((aligned(16))) unsigned char lds_raw[];
    LAS unsigned char* lds = (LAS unsigned char*)lds_raw;
    cg::grid_group grid = cg::this_grid();
    Ctx c;
    c.x = args.in[0]; c.p = args.in[1]; c.g_mix = args.in[2]; c.w_in = args.in[3]; c.ln_g = args.in[4]; c.ln_b = args.in[5]; c.sgu_w = args.in[6]; c.sgu_b = args.in[7];
    c.w_ba = args.in[8]; c.w_bs = args.in[9]; c.w_out = args.in[10]; c.g_ffn = args.in[11]; c.w_pq = args.in[12]; c.subk = args.in[13]; c.dn = args.in[14]; c.up = args.in[15];
    c.g_ple = args.in[16]; c.w_pp = args.in[17]; c.w_pg = args.in[18]; c.g_fin = args.in[19];
    c.out = args.out;
    unsigned char* ws = args.ws;
    c.WinT = (bf16*)(ws + WS_WIN); c.WbaT = (bf16*)(ws + WS_WBA); c.WbsT = (bf16*)(ws + WS_WBS); c.WoutT = (bf16*)(ws + WS_WOUT); c.WqT = (bf16*)(ws + WS_WQ); c.WgT = (bf16*)(ws + WS_WG); c.WprojT = (bf16*)(ws + WS_WPROJ);
    c.pb = (bf16*)(ws + WS_PB); c.skb = (bf16*)(ws + WS_SKB); c.kmean = (float*)(ws + WS_KMEAN); c.xn = (bf16*)(ws + WS_XN); c.proj = (bf16*)(ws + WS_PROJ); c.vT = (bf16*)(ws + WS_VT);
    c.yatt = (bf16*)(ws + WS_YATT); c.ysgu = (bf16*)(ws + WS_YSGU); c.merged = (bf16*)(ws + WS_MERGED); c.h1n = (bf16*)(ws + WS_H1N); c.qp = (bf16*)(ws + WS_QP);
    c.dn8 = ws + WS_DN8; c.up8 = ws + WS_UP8; c.sdn = (float*)(ws + WS_SDN); c.sup = (float*)(ws + WS_SDN) + NEXP; c.rss = (float*)(ws + WS_RSS); c.h2n = (bf16*)(ws + WS_H2N); c.gtmp = (bf16*)(ws + WS_GTMP); c.eid = (int*)(ws + WS_EID); c.egate = (float*)(ws + WS_EGATE); c.sel = (int*)(ws + WS_SEL); c.lse = (float*)(ws + WS_LSE);
    c.h2b = (bf16*)(ws + WS_H2B); c.sst = (float*)(ws + 468 * MiB); c.kmp = (float*)(ws + 470 * MiB); c.swb = (bf16*)(ws + WS_SKB + 512 * 1024); c.xq8 = ws + WS_XN; c.WinT8 = ws + WS_WIN; c.WgT8 = ws + WS_WG; c.h2q8 = ws + WS_H2N; c.xs = (float*)(ws + WS_SC); c.h2s = c.xs + T; c.wcs = c.h2s + T; c.gcs = c.wcs + INW; c.qcs = c.gcs + D; c.h1s = c.qcs + D; c.ocs = c.h1s + T; c.ms = c.ocs + D; c.WoutT8 = ws + WS_WOUT; c.mq8 = ws + WS_MQ8; c.WqT8 = ws + WS_WQ; c.h1q8 = ws + WS_H1N;
    c.G = gridDim.x; c.bid = blockIdx.x; c.tid = threadIdx.x; c.lane = c.tid & 63; c.wave = __builtin_amdgcn_readfirstlane(c.tid >> 6);
    const int lo = args.ph_lo, hi = args.ph_hi;
    volatile LAS unsigned* xst = (volatile LAS unsigned*)(lds + LDS_BYTES - 64);
    if (c.tid < 2) xst[c.tid] = 0u;
    __syncthreads();
    XcdBarrier xbar = xcd_barrier_post((unsigned*)(ws + WS_CTL), xst);
#ifndef PHASE_MASK
#define PHASE_MASK 0xFFFFFFFu
#endif
#ifndef REP_MASK
#define REP_MASK 0u
#endif
#define IN(k) ((((PHASE_MASK) >> (k)) & 1u) && lo <= (k) && (k) < hi)
#define NAIVE(k) (((NAIVE_MASK) >> (k)) & 1u)
#define REP(k) for (int _rep = 0; _rep < 1 + (int)(((REP_MASK) >> (k)) & 1u); ++_rep)
    const bool single = (hi - lo) > 1;
    bool first_sync = true;
#define GSYNC() do { if (single) { if ((first_sync && !ALL_XCD) || !USE_XCDBAR) grid.sync(); else xcd_barrier(xbar); first_sync = false; } } while (0)
    unsigned* kcnt = (unsigned*)(ws + WS_CTL) + 8192; unsigned* qctr = (unsigned*)(ws + WS_CTL) + 8256;
    unsigned* cam = (unsigned*)(ws + WS_CTL) + 9216;
    if (IN(0)) REP(0) { __syncthreads(); phase_prologue(c, lds, cam); }
    if (IN(0)) GSYNC();
    if (IN(15)) REP(15) { __syncthreads(); phase_prologue2(c, lds, cam); }
    if (IN(15)) GSYNC();
    if (IN(1)) REP(1) { __syncthreads(); run_gemm_in(lds, c); }
    if (IN(1)) GSYNC();
#ifndef P2_REP_PARTS
#define P2_REP_PARTS 7
#endif
    if (IN(2)) REP(2) { __syncthreads(); const int parts = _rep == 0 ? 7 : P2_REP_PARTS;
        if (parts & 2) { if (NAIVE(2)) naive_sgu(c, lds); else phase_sgu(c, lds); } if (parts & 4) phase_select(c, kcnt); }
    if (IN(2)) GSYNC();
    if (IN(3)) REP(3) { __syncthreads(); if (NAIVE(3)) naive_attn(c, lds); else phase_attn(c, lds, qctr + 64 * _rep, _rep == 1 && ATT_PROBE_SKIPC, _rep == 1 && ATT_PROBE_SKIPQ); }
    if (IN(3)) GSYNC();
    if (IN(14)) REP(14) { if (!NAIVE(3)) phase_attn_combine(c); }
    if (IN(14)) GSYNC();
    if (IN(5)) REP(5) { __syncthreads(); int Kk = D; asm volatile("" : "+s"(Kk)); pg8::Gemm g{c.yatt, c.WbaT, T, D, Kk, c.ysgu, 1024}; pg8::StaticOrder S; S.init(T, D, c.G, c.bid);
                 pg8::gemm_phase<EpiBranch, pg8::StaticOrder, true, true>((PG8_LAS unsigned char*)lds, g, S, EpiBranch{c.proj, c.merged}); }
    if (IN(5)) GSYNC();
    if (IN(6)) REP(6) { __syncthreads(); int Kk = D; asm volatile("" : "+s"(Kk)); pg8::Gemm g{c.merged, c.WoutT, T, D, Kk, c.merged + D / 2, D}; pg8::StaticOrder S; S.init(T, D, c.G, c.bid);
                 pg8::gemm_phase<EpiF5, pg8::StaticOrder, true, true>((PG8_LAS unsigned char*)lds, g, S, EpiF5{c.x, c.out, c.h1n, c.rss}); }
    if (IN(6)) GSYNC();
    if (IN(8)) REP(8) { __syncthreads(); run_gemm(false, lds, c.h1n, c.WqT, T, D, D, F6{c.qp}, c.G, c.bid);
        asm volatile("s_waitcnt vmcnt(0)" ::: "memory"); __syncthreads();
        if (c.tid == 0) __builtin_amdgcn_fence(__ATOMIC_ACQUIRE, "agent");
        asm volatile("s_waitcnt vmcnt(0)" ::: "memory"); __syncthreads();
        pg8::StaticOrder S; S.init(T, D, c.G, c.bid); pg8::Unit u;
        for (int i = 0; S.next(i, u); ++i) peer_topk_task(c, u.pm * 8 + c.wave, u.pn); }
    if (IN(8)) GSYNC();
#ifdef EXP_DUMMY_MASK
    if (IN(10)) { phase_peer_experts(c, EXP_DUMMY_MASK); __syncthreads(); }
#endif
    if (IN(10)) REP(10) { phase_peer_experts(c); }
    if (IN(10)) GSYNC();
    if (IN(11)) REP(11) { __syncthreads(); run_gemm_i8(lds, c.h2q8, c.WgT8, c.h2s, c.gcs, T, D, D, F9a{c.gtmp}, c.G, c.bid); }
    if (IN(11) && NAIVE(11) != NAIVE(12)) GSYNC();
    if (IN(12)) { int Kk = PLE; asm volatile("" : "+s"(Kk)); pg8::Gemm g{c.pb, c.WprojT, T, D, Kk, c.pb + PLE / 2, PLE}; pg8::StaticOrder S; S.init(T, D, c.G, c.bid);
                  pg8::gemm_phase<Epi9b, pg8::StaticOrder, true, true>((PG8_LAS unsigned char*)lds, g, S, Epi9b{c.gtmp, c.h2b}); }
    if (IN(12)) GSYNC();
#ifdef BENCH_OP
    if (IN(13)) {
        unsigned a[16];
#pragma unroll
        for (int i = 0; i < 16; ++i) a[i] = c.tid * 2654435761u + i;
        unsigned b = c.lane * 40503u + 77u, sel = 0x05010400u;
#pragma unroll 1
        for (int it = 0; it < 4000; ++it) {
#pragma unroll
            for (int i = 0; i < 16; ++i) {
#if BENCH_OP == 0
                a[i] = (unsigned)__builtin_amdgcn_sdot4((int)a[i], (int)b, (int)a[i], false);
#elif BENCH_OP == 1
                a[i] = __builtin_amdgcn_perm(a[i], b, sel);
#elif BENCH_OP == 2
                a[i] = (a[i] >> 4) & 0x0F0F0F0Fu;  a[i] += b;
#elif BENCH_OP == 3
                a[i] = (unsigned)__shfl_xor((int)a[i], 16);
#elif BENCH_OP == 4
                a[i] = (unsigned)__builtin_amdgcn_readlane((int)a[i], it & 63) + b;
#elif BENCH_OP == 5
                a[i] = __float_as_uint(__uint_as_float(a[i]) * 1.0001f + 0.5f);
#endif
            }
        }
        unsigned s = 0;
#pragma unroll
        for (int i = 0; i < 16; ++i) s ^= a[i];
        if (s == 0x12345679u) c.out[0] = 1.0f;
        __syncthreads();
    }
#endif
    if (IN(13)) { phase_final(c); }
#if DEBUG_CHECK
    {
        float* dbg = (float*)(ws + WS_KMEAN + 512 * 1024);
        const int gw = c.bid * 8 + c.wave, NGW = c.G * 8;
        if (IN(0)) { for (int i = c.bid * NTHREADS + c.tid; i < T; i += c.G * NTHREADS) dbg[i] = 0.f; }
        if (IN(3)) { __syncthreads(); Ctx c2 = c; c2.yatt = (bf16*)(ws + 434 * MiB); naive_attn(c2, lds); }
        if (IN(20)) { const bf16* ya = (const bf16*)(ws + 434 * MiB);
            for (int t = gw; t < T; t += NGW) { float sa = 0.f;
                for (int cc = c.lane; cc < 1024; cc += 64) { const float d1 = bf2f(c.yatt[(size_t)t * 1024 + cc]) - bf2f(ya[(size_t)t * 1024 + cc]); sa += d1 * d1; }
                sa = wave_sum(sa); if (c.lane == 0) dbg[t] += DBG_GA * sa; } }
        if (IN(22)) { for (int t = c.bid * NTHREADS + c.tid; t < T; t += c.G * NTHREADS) c.out[(size_t)t * D] += sqrtf(dbg[t]); }
    }
#endif
#undef IN
#undef GSYNC
#undef NAIVE
}

extern "C" void kernel_launch(void* const* d_in, const int* in_sizes, int n_in, void* d_out, int out_size, void* d_ws, size_t ws_size, hipStream_t stream) {
    static int grid = 0;
    if (grid == 0) {
        if (n_in != 20 || out_size != T * D || ws_size < WS_END) { fprintf(stderr, "kernel_launch: unexpected shapes (n_in %d, out %d, ws %zu)\n", n_in, out_size, ws_size); grid = -1; return; }
        int dev = 0, cus = 0, per_cu = 0;
        if (hipGetDevice(&dev) != hipSuccess || hipDeviceGetAttribute(&cus, hipDeviceAttributeMultiprocessorCount, dev) != hipSuccess) { grid = -1; return; }
        if (hipFuncSetAttribute((const void*)fwd_kernel, hipFuncAttributeMaxDynamicSharedMemorySize, LDS_BYTES) != hipSuccess) { fprintf(stderr, "kernel_launch: hipFuncSetAttribute failed\n"); grid = -1; return; }
        if (hipOccupancyMaxActiveBlocksPerMultiprocessor(&per_cu, (const void*)fwd_kernel, NTHREADS, LDS_BYTES) != hipSuccess || per_cu < 1) { fprintf(stderr, "kernel_launch: occupancy query says %d blocks per CU\n", per_cu); per_cu = 1; }
        (void)hipGetLastError();
        grid = cus;
    }
    if (grid < 0) return;
    if (hipMemsetAsync((char*)d_ws + WS_CTL, 0, 131072, stream) != hipSuccess) { fprintf(stderr, "kernel_launch: memset failed\n"); return; }
    Args a{};
    for (int i = 0; i < 20; ++i) a.in[i] = (const float*)d_in[i];
    a.out = (float*)d_out; a.ws = (unsigned char*)d_ws;
#if MK_SINGLE
    a.ph_lo = 0; a.ph_hi = NPHASES;
    void* kargs[] = {&a};
    hipError_t e = hipLaunchCooperativeKernel((const void*)fwd_kernel, dim3(grid), dim3(NTHREADS), kargs, LDS_BYTES, stream);
    if (e != hipSuccess) fprintf(stderr, "kernel_launch: cooperative launch failed: %s (grid %d)\n", hipGetErrorString(e), grid);
#else
#if DEBUG_CHECK
    const int order[] = {0, 15, 1, 2, 3, 14, 20, 5, 6, 8, 10, 11, 12, 13, 22};
    for (int ph : order) { a.ph_lo = ph; a.ph_hi = ph + 1; hipLaunchKernelGGL(fwd_kernel, dim3(grid), dim3(NTHREADS), LDS_BYTES, stream, a); }
#else
    const int order[] = {0, 15, 1, 2, 3, 14, 5, 6, 8, 10, 11, 12, 13};
    for (int ph : order) { a.ph_lo = ph; a.ph_hi = ph + 1; hipLaunchKernelGGL(fwd_kernel, dim3(grid), dim3(NTHREADS), LDS_BYTES, stream, a); }
#endif
#endif
}
```

```cpp
#define MK_SINGLE 1
#define EXP_NT 2
#define ALL_XCD 1
#include <hip/hip_runtime.h>
#include <hip/hip_cooperative_groups.h>
#include <cstdio>
#include <cstdint>
namespace cg = cooperative_groups;

#ifndef MK_SINGLE
#define MK_SINGLE 1
#endif
#ifndef NAIVE_MASK
#define NAIVE_MASK 0u
#endif

#ifndef GI8_ALIGN
#define GI8_ALIGN true
#endif
#ifndef ATT_PROBE_SKIPC
#define ATT_PROBE_SKIPC 0
#define ATT_PROBE_SKIPQ 0
#endif
#ifndef ATT_FINE
#define ATT_FINE 0
#endif
#ifndef ATT_MIX
#define ATT_MIX 1
#endif
#ifndef QUANT_FIRST
#define QUANT_FIRST 0
#endif
#ifndef ALL_XCD
#define ALL_XCD 0
#endif
#ifndef USE_XCDBAR
#define USE_XCDBAR 1
#endif
#ifndef DEBUG_CHECK
#define DEBUG_CHECK 0
#endif
#ifndef DBG_GA
#define DBG_GA 200.0f
#define DBG_GS 2.0f
#define DBG_GT 1.0f
#endif
#define DEV __device__ __forceinline__
#define LAS __attribute__((address_space(3)))
typedef unsigned short bf16;
typedef float f32x2 __attribute__((ext_vector_type(2)));
typedef float f32x4 __attribute__((ext_vector_type(4)));
typedef float f32x16 __attribute__((ext_vector_type(16)));
typedef short bf16x8 __attribute__((ext_vector_type(8)));
typedef unsigned v4u __attribute__((ext_vector_type(4)));
typedef unsigned v2u __attribute__((ext_vector_type(2)));
typedef __bf16 bfx2 __attribute__((ext_vector_type(2)));

constexpr int T = 16384, SEQ = 8192, D = 2048, INW = 9216, NH = 8, HD = 128, NBLK = 32, BLK = 256;
constexpr int C_Q = 0, C_K = 1024, C_V = 2048, C_U = 3072, C_VG = 4096, C_GA = 5120, C_GB = 7168;
constexpr int NEXP = 16384, PLE = 256;
constexpr int PST = INW;
constexpr float EPS = 1e-6f;

constexpr size_t MiB = 1u << 20;
constexpr size_t WS_CTL = 0;
constexpr size_t WS_WIN = 1 * MiB, WS_WBA = 37 * MiB, WS_WBS = 41 * MiB, WS_WOUT = 45 * MiB, WS_WQ = 53 * MiB, WS_WG = 61 * MiB, WS_WPROJ = 69 * MiB;
constexpr size_t WS_PB = 70 * MiB, WS_SKB = 78 * MiB, WS_KMEAN = 79 * MiB;
constexpr size_t WS_XN = 80 * MiB, WS_YATT = 1 * MiB, WS_YSGU = 112 * MiB, WS_H2N = 112 * MiB;
constexpr size_t WS_PROJ = 144 * MiB, WS_DN8 = 80 * MiB, WS_UP8 = 498 * MiB, WS_SDN = 79 * MiB + 256 * 1024, WS_RSS = 528 * MiB, WS_H1N = 272 * MiB, WS_QP = 336 * MiB, WS_EID = 400 * MiB, WS_EGATE = 408 * MiB;
constexpr size_t WS_SC = 79 * MiB + 640 * 1024;
constexpr size_t WS_MQ8 = 336 * MiB;
constexpr size_t WS_SEL = 464 * MiB, WS_LSE = 466 * MiB;
constexpr size_t WS_VT = 434 * MiB, WS_MERGED = 434 * MiB, WS_GTMP = 434 * MiB;
constexpr size_t WS_H2B = 144 * MiB;
constexpr size_t WS_END = 530 * MiB;

constexpr int LDS_BYTES = 147456;
constexpr int NTHREADS = 512;

DEV unsigned pkbf(float a, float b) { bfx2 v = __builtin_convertvector((f32x2){a, b}, bfx2); return __builtin_bit_cast(unsigned, v); }
DEV float bflo(unsigned w) { return __uint_as_float(w << 16); }
DEV float bfhi(unsigned w) { return __uint_as_float(w & 0xffff0000u); }
DEV float bf2f(bf16 b) { return __uint_as_float(((unsigned)b) << 16); }
DEV float wave_sum(float v) {
#pragma unroll
    for (int o = 1; o < 64; o <<= 1) v += __shfl_xor(v, o);
    return v;
}
template <int CTRL> DEV float dppq(float v) { return __int_as_float(__builtin_amdgcn_update_dpp(0, __float_as_int(v), CTRL, 0xF, 0xF, false)); }
DEV float wsum_q(float v) {
    v += dppq<0xB1>(v); v += dppq<0x4E>(v); v += dppq<0x1B>(dppq<0x141>(v)); v += dppq<0x128>(v);
    { const auto r = __builtin_amdgcn_permlane16_swap(__float_as_uint(v), __float_as_uint(v), false, false); v = __uint_as_float(r[0]) + __uint_as_float(r[1]); }
    { const auto r = __builtin_amdgcn_permlane32_swap(__float_as_uint(v), __float_as_uint(v), false, false); v = __uint_as_float(r[0]) + __uint_as_float(r[1]); }
    return v;
}
DEV float wmax_q(float v) {
    v = fmaxf(v, dppq<0xB1>(v)); v = fmaxf(v, dppq<0x4E>(v)); v = fmaxf(v, dppq<0x1B>(dppq<0x141>(v))); v = fmaxf(v, dppq<0x128>(v));
    { const auto r = __builtin_amdgcn_permlane16_swap(__float_as_uint(v), __float_as_uint(v), false, false); v = fmaxf(__uint_as_float(r[0]), __uint_as_float(r[1])); }
    { const auto r = __builtin_amdgcn_permlane32_swap(__float_as_uint(v), __float_as_uint(v), false, false); v = fmaxf(__uint_as_float(r[0]), __uint_as_float(r[1])); }
    return v;
}
DEV float sigmoidf_(float x) { return __builtin_amdgcn_rcpf(1.0f + __expf(-x)); }
DEV float gelu_erf(float v) { return 0.5f * v * (1.0f + erff(v * 0.70710678118f)); }
#define MFMA32(a, b, c) __builtin_amdgcn_mfma_f32_32x32x16_bf16((a), (b), (c), 0, 0, 0)
DEV int crow(int reg, int h) { return (reg & 3) + 8 * (reg >> 2) + 4 * h; }
namespace pg8 {
#define PG8_LAS __attribute__((address_space(3)))
typedef unsigned short bf16_t;
typedef short bf16x8 __attribute__((ext_vector_type(8)));
typedef float f32x4 __attribute__((ext_vector_type(4)));
typedef unsigned u32x4 __attribute__((ext_vector_type(4)));
constexpr int BM = 256, BK = 64, HALF = 128, HTB = HALF * BK * 2  , STAGE_BYTES = 8 * HTB, NXCD = 8, WGM = 8;

__host__ __device__ __forceinline__ int lds_byte(int r, int c) { const int st = (r >> 4) * 2 + (c >> 5), rr = r & 15, cc = c & 31, ob = rr * 64 + cc * 2; return st * 1024 + (ob ^ (((ob >> 9) & 1) << 5)); }
__host__ __device__ __forceinline__ void stage_rc(int b, int& R, int& C) { const int st = b / 1024, sb = b % 1024, swz = sb ^ (((sb >> 9) & 1) << 5); R = (st >> 1) * 16 + swz / 64; C = (st & 1) * 32 + (swz % 64) / 2; }
__host__ __device__ __forceinline__ int perm32(int rho) { const int n = rho >> 4, i = rho & 15; return 8 * (i >> 2) + 4 * n + (i & 3); }

struct Unit { int pm, pn; };
struct Gemm { const bf16_t* A; const bf16_t* Bt; int M, N, K; const bf16_t* A2; int lda; };

struct StaticOrder {
    int nM, nN, nwg, G, c;
    __host__ __device__ __forceinline__ void init(int M, int N, int G_, int c_) { nM = M / BM; nN = N / BM; nwg = nM * nN; G = G_; c = c_; }
    int rot = 0, nround = 1;
    __host__ __device__ __forceinline__ bool next(int i0, Unit& u) const {
        if ((long)i0 * G + c >= nwg) return false;
        int i = i0; if (rot) { i = i0 + rot; if (i >= nround) i -= nround; }
        const long L = (long)i * G + c;
        int wgid = (int)L; { const int q = nwg / NXCD, r = nwg % NXCD, xcd = wgid % NXCD, off = wgid / NXCD; wgid = (xcd < r ? xcd * (q + 1) : r * (q + 1) + (xcd - r) * q) + off; }
        const int nig = WGM * nN, gid = wgid / nig, fm = gid * WGM, gsz = (nM - fm) < WGM ? (nM - fm) : WGM;
        u.pm = fm + ((wgid % nig) % gsz); u.pn = (wgid % nig) / gsz; return true;
    }
    __device__ __forceinline__ void a_ready(const Unit&) const {}
    __device__ __forceinline__ void done(const Unit&) const {}
};


typedef float f32x2 __attribute__((ext_vector_type(2)));
__device__ __forceinline__ f32x2 gelu_pk(f32x2 v) {
    const f32x2 av = __builtin_elementwise_abs(v), d = av * 0.2316418882f + 1.0f;
    f32x2 t; t.x = __builtin_amdgcn_rcpf(d.x); t.y = __builtin_amdgcn_rcpf(d.y);
    f32x2 q = t * 0.5307027145f + (-0.7265760135f); q = q * t + 0.7107068705f; q = q * t + (-0.142248368f); q = q * t + 0.127414796f; q = q * t;
    const f32x2 s = (v * v) * (-0.72134752044f);
    f32x2 e; e.x = __builtin_amdgcn_exp2f(s.x); e.y = __builtin_amdgcn_exp2f(s.y);
    const f32x2 m = v * (q * e), r = v - m;
    f32x2 o; o.x = v.x < 0.f ? m.x : r.x; o.y = v.y < 0.f ? m.y : r.y; return o;
}
template <class F> struct EpiW {
    static constexpr bool PERM = false, AFTER_DRAIN = false, HAS_MID = false;
    F f;
    __device__ __forceinline__ void operator()(const f32x4 (&acc)[2][2][4][2], const Unit& u, int wr, int wc, int fr, int fq) const {
        const int row0 = u.pm * BM + wr * 64 + fr, col0 = u.pn * BM + wc * 32 + 4 * fq;
#pragma unroll
        for (int ai = 0; ai < 2; ++ai)
#pragma unroll
            for (int m = 0; m < 4; ++m) {
#pragma unroll
                for (int bj = 0; bj < 2; ++bj)
#pragma unroll
                    for (int n = 0; n < 2; ++n) f.elem4(row0 + ai * HALF + m * 16, col0 + bj * HALF + n * 16, acc[ai][bj][m][n]);
                asm volatile("" ::: "memory");
            }
    }
};

typedef int i32x4 __attribute__((ext_vector_type(4)));
template <class F> struct EpiW8 {
    static constexpr bool PERM = false, AFTER_DRAIN = false, HAS_MID = false;
    F f; const float* rs; const float* cs;
    __device__ __forceinline__ void operator()(const i32x4 (&acc)[2][2][4][2], const Unit& u, int wr, int wc, int fr, int fq) const {
        const int row0 = u.pm * BM + wr * 64 + fr, col0 = u.pn * BM + wc * 32 + 4 * fq;
        f32x4 cv[2][2];
#pragma unroll
        for (int bj = 0; bj < 2; ++bj)
#pragma unroll
            for (int n = 0; n < 2; ++n) cv[bj][n] = *(const f32x4*)(cs + col0 + bj * HALF + n * 16);
        float rsv[8];
#pragma unroll
        for (int g = 0; g < 8; ++g) rsv[g] = rs[row0 + (g >> 2) * HALF + (g & 3) * 16];
#pragma unroll
        for (int ai = 0; ai < 2; ++ai)
#pragma unroll
            for (int m = 0; m < 4; ++m) { const int row = row0 + ai * HALF + m * 16; const float r = rsv[ai * 4 + m];
#pragma unroll
                for (int bj = 0; bj < 2; ++bj)
#pragma unroll
                    for (int n = 0; n < 2; ++n) { const i32x4 a = acc[ai][bj][m][n]; const f32x4 c4 = cv[bj][n];
                        f.elem4(row, col0 + bj * HALF + n * 16, (f32x4){(float)a.x * (r * c4.x), (float)a.y * (r * c4.y), (float)a.z * (r * c4.z), (float)a.w * (r * c4.w)}); }
                asm volatile("" ::: "memory");
            }
    }
};
template <class Epi, class Sched, bool ALIGN_EPI = false, bool SP2 = false>
__device__ __forceinline__ void gemm_phase(PG8_LAS unsigned char* lds, const Gemm g, const Sched& S, const Epi& E) {
    const int tid = threadIdx.x, wid = __builtin_amdgcn_readfirstlane(tid >> 6), lane = tid & 63, wr = wid >> 2, wc = wid & 3, fr = lane & 15, fq = lane >> 4;
    const int K = g.K, nt = K / BK;
    unsigned voffA[2], voffB[2];
#pragma unroll
    for (int i = 0; i < 2; ++i) { int R, C; stage_rc(tid * 16 + i * 8192, R, C); const int Rb = Epi::PERM ? ((R & ~31) + perm32(R & 31)) : R;
        voffA[i] = (unsigned)(R * g.lda + C) * 2u; voffB[i] = (unsigned)(Rb * K + C) * 2u; }
    const size_t kstep = (size_t)(BK * 2);
    const size_t hstep = (size_t)HALF * K * 2;
    const size_t tstep = 2 * hstep;
    const size_t hstepA = (size_t)HALF * g.lda * 2, tstepA = 2 * hstepA;
    const int nth = nt / 2; const ptrdiff_t a2off = (const char*)g.A2 - (const char*)g.A - (ptrdiff_t)nth * (BK * 2);
    const unsigned ldsw = (unsigned)wid * 1024u;
    const int aoff = lds_byte(wr * 64 + fr, fq * 8), boff = lds_byte(wc * 32 + fr, fq * 8);
#define PG8_SA(b, h) (((b) * 2 + (h)) * HTB)
#define PG8_SB(b, h) ((4 + (b) * 2 + (h)) * HTB)
#define PG8_STAGE(bufoff, gbase, voff) do { _Pragma("unroll") for (int _i = 0; _i < 2; ++_i) \
        __builtin_amdgcn_global_load_lds((const unsigned*)((const char*)(gbase) + (voff)[_i]), (PG8_LAS unsigned*)(lds + (bufoff) + ldsw + _i * 8192), 16, 0, 0); } while (0)
#define PG8_LDA(dst, b, h) do { _Pragma("unroll") for (int m = 0; m < 4; ++m) _Pragma("unroll") for (int k = 0; k < 2; ++k) dst[m][k] = *(const PG8_LAS bf16x8*)(lds + PG8_SA(b, h) + aoff + m * 2048 + k * 1024); } while (0)
#define PG8_LDB(dst, b, h) do { _Pragma("unroll") for (int n = 0; n < 2; ++n) _Pragma("unroll") for (int k = 0; k < 2; ++k) dst[n][k] = *(const PG8_LAS bf16x8*)(lds + PG8_SB(b, h) + boff + n * 2048 + k * 1024); } while (0)
#define PG8_MMA(ai, bj, At, Bt) do { __builtin_amdgcn_s_setprio(1); _Pragma("unroll") for (int m = 0; m < 4; ++m) _Pragma("unroll") for (int n = 0; n < 2; ++n) _Pragma("unroll") for (int k = 0; k < 2; ++k) \
        acc[ai][bj][m][n] = __builtin_amdgcn_mfma_f32_16x16x32_bf16(Bt[n][k], At[m][k], acc[ai][bj][m][n], 0, 0, 0); __builtin_amdgcn_s_setprio(0); } while (0)
#define PG8_WAIT_V(n) asm volatile("s_waitcnt vmcnt(" #n ")" ::: "memory")
#define PG8_WAIT_L(n) asm volatile("s_waitcnt lgkmcnt(" #n ")" ::: "memory")
#define PG8_BAR __builtin_amdgcn_s_barrier()
#define PG8_SCHED __builtin_amdgcn_sched_barrier(0)
    Unit cur, nxt; int ui = 0;
    if (!S.next(0, cur)) return;
    f32x4 acc[2][2][4][2];
#pragma unroll
    for (int a = 0; a < 2; ++a)
#pragma unroll
        for (int b = 0; b < 2; ++b)
#pragma unroll
            for (int m = 0; m < 4; ++m)
#pragma unroll
                for (int n = 0; n < 2; ++n) acc[a][b][m][n] = (f32x4){0.f, 0.f, 0.f, 0.f};
    bf16x8 At[4][2], B0[2][2], B1[2][2];
    const char* cA = (const char*)g.A + (size_t)cur.pm * tstepA; const char* cB = (const char*)g.Bt + (size_t)cur.pn * tstep;
    S.a_ready(cur);
    if constexpr (SP2) {
        PG8_STAGE(PG8_SB(0, 0), cB, voffB); PG8_STAGE(PG8_SB(0, 1), cB + hstep, voffB); PG8_STAGE(PG8_SA(0, 0), cA, voffA); PG8_STAGE(PG8_SA(0, 1), cA + hstepA, voffA);
        if (wr == 1) PG8_BAR;
        PG8_WAIT_V(2); PG8_BAR;
        PG8_STAGE(PG8_SB(1, 0), cB + kstep, voffB); PG8_STAGE(PG8_SA(1, 0), cA + kstep, voffA); PG8_STAGE(PG8_SB(1, 1), cB + hstep + kstep, voffB);
        PG8_WAIT_V(6); PG8_BAR;
    } else {
        PG8_STAGE(PG8_SB(0, 0), cB, voffB); PG8_STAGE(PG8_SA(0, 0), cA, voffA); PG8_STAGE(PG8_SB(0, 1), cB + hstep, voffB); PG8_STAGE(PG8_SA(0, 1), cA + hstepA, voffA);
        if (wr == 1) PG8_BAR;
        PG8_WAIT_V(4); PG8_BAR;
        PG8_STAGE(PG8_SB(1, 0), cB + kstep, voffB); PG8_STAGE(PG8_SA(1, 0), cA + kstep, voffA); PG8_STAGE(PG8_SB(1, 1), cB + hstep + kstep, voffB);
        PG8_WAIT_V(6); PG8_BAR;
    }
    for (;;) {
        const bool has_next = S.next(ui + 1, nxt);
        const char* nA = has_next ? (const char*)g.A + (size_t)nxt.pm * tstepA : cA; const char* nB = has_next ? (const char*)g.Bt + (size_t)nxt.pn * tstep : cB;
        if constexpr (Epi::HAS_MID) {
        for (int t = 0; t < nth; t += 2) {
            const bool last = (t == nt - 2);
            const char* a1 = cA + (t + 1 >= nth ? a2off : 0) + (size_t)(t + 1) * kstep;
            const char* a2 = last ? nA : cA + (t + 2 >= nth ? a2off : 0) + (size_t)(t + 2) * kstep; const char* b2 = last ? nB : cB + (size_t)(t + 2) * kstep;
            const char* a3 = a2 + kstep; const char* b3 = b2 + kstep;
            if (last && has_next) S.a_ready(nxt);
            if constexpr (SP2) {
            PG8_LDB(B0, 0, 0); PG8_LDB(B1, 0, 1); PG8_SCHED; PG8_LDA(At, 0, 0); PG8_STAGE(PG8_SA(1, 1), a1 + hstepA, voffA);
            PG8_WAIT_V(8); PG8_WAIT_L(0); PG8_BAR; PG8_MMA(0, 0, At, B0); PG8_MMA(0, 1, At, B1); PG8_BAR; PG8_SCHED;
            PG8_LDA(At, 0, 1); PG8_STAGE(PG8_SB(0, 0), b2, voffB); PG8_STAGE(PG8_SB(0, 1), b2 + hstep, voffB); PG8_STAGE(PG8_SA(0, 0), a2, voffA);
            PG8_WAIT_V(8); PG8_WAIT_L(0); PG8_BAR; PG8_MMA(1, 0, At, B0); PG8_MMA(1, 1, At, B1); PG8_BAR; PG8_SCHED;
            PG8_LDB(B0, 1, 0); PG8_LDB(B1, 1, 1); PG8_SCHED; PG8_LDA(At, 1, 0); PG8_STAGE(PG8_SA(0, 1), a2 + hstepA, voffA);
            PG8_WAIT_V(8); PG8_WAIT_L(0); PG8_BAR; PG8_MMA(0, 0, At, B0); PG8_MMA(0, 1, At, B1); PG8_BAR; PG8_SCHED;
            PG8_LDA(At, 1, 1); PG8_STAGE(PG8_SB(1, 0), b3, voffB); PG8_STAGE(PG8_SB(1, 1), b3 + hstep, voffB); PG8_STAGE(PG8_SA(1, 0), a3, voffA);
            PG8_WAIT_V(8); PG8_WAIT_L(0); PG8_BAR; PG8_MMA(1, 0, At, B0); PG8_MMA(1, 1, At, B1); PG8_BAR; PG8_SCHED;
            } else {
            PG8_LDB(B0, 0, 0); PG8_SCHED; PG8_LDA(At, 0, 0); PG8_STAGE(PG8_SA(1, 1), a1 + hstepA, voffA);
            PG8_WAIT_L(8); PG8_BAR; PG8_WAIT_L(0); PG8_MMA(0, 0, At, B0); PG8_BAR; PG8_SCHED;
            PG8_LDB(B1, 0, 1); PG8_STAGE(PG8_SB(0, 0), b2, voffB);
            PG8_BAR; PG8_WAIT_L(0); PG8_MMA(0, 1, At, B1); PG8_BAR;
            PG8_LDA(At, 0, 1); PG8_STAGE(PG8_SA(0, 0), a2, voffA);
            PG8_BAR; PG8_WAIT_L(0); PG8_MMA(1, 0, At, B0); PG8_BAR; PG8_SCHED;
            PG8_STAGE(PG8_SB(0, 1), b2 + hstep, voffB);
            PG8_WAIT_V(6); PG8_BAR; PG8_MMA(1, 1, At, B1); PG8_BAR;
            PG8_LDB(B0, 1, 0); PG8_SCHED; PG8_LDA(At, 1, 0); PG8_STAGE(PG8_SA(0, 1), a2 + hstepA, voffA);
            PG8_WAIT_L(8); PG8_BAR; PG8_WAIT_L(0); PG8_MMA(0, 0, At, B0); PG8_BAR; PG8_SCHED;
            PG8_LDB(B1, 1, 1); PG8_STAGE(PG8_SB(1, 0), b3, voffB);
            PG8_BAR; PG8_WAIT_L(0); PG8_MMA(0, 1, At, B1); PG8_BAR;
            PG8_LDA(At, 1, 1); PG8_STAGE(PG8_SA(1, 0), a3, voffA);
            PG8_BAR; PG8_WAIT_L(0); PG8_MMA(1, 0, At, B0); PG8_BAR; PG8_SCHED;
            PG8_STAGE(PG8_SB(1, 1), b3 + hstep, voffB);
            PG8_WAIT_V(6); PG8_BAR; PG8_MMA(1, 1, At, B1); PG8_BAR;
            }
        }
        E.mid(acc, cur, wr, wc, fr, fq);
        for (int t = nth; t < nt; t += 2) {
            const bool last = (t == nt - 2);
            const char* a1 = cA + (t + 1 >= nth ? a2off : 0) + (size_t)(t + 1) * kstep;
            const char* a2 = last ? nA : cA + (t + 2 >= nth ? a2off : 0) + (size_t)(t + 2) * kstep; const char* b2 = last ? nB : cB + (size_t)(t + 2) * kstep;
            const char* a3 = a2 + kstep; const char* b3 = b2 + kstep;
            if (last && has_next) S.a_ready(nxt);
            if constexpr (SP2) {
            PG8_LDB(B0, 0, 0); PG8_LDB(B1, 0, 1); PG8_SCHED; PG8_LDA(At, 0, 0); PG8_STAGE(PG8_SA(1, 1), a1 + hstepA, voffA);
            PG8_WAIT_V(8); PG8_WAIT_L(0); PG8_BAR; PG8_MMA(0, 0, At, B0); PG8_MMA(0, 1, At, B1); PG8_BAR; PG8_SCHED;
            PG8_LDA(At, 0, 1); PG8_STAGE(PG8_SB(0, 0), b2, voffB); PG8_STAGE(PG8_SB(0, 1), b2 + hstep, voffB); PG8_STAGE(PG8_SA(0, 0), a2, voffA);
            PG8_WAIT_V(8); PG8_WAIT_L(0); PG8_BAR; PG8_MMA(1, 0, At, B0); PG8_MMA(1, 1, At, B1); PG8_BAR; PG8_SCHED;
            PG8_LDB(B0, 1, 0); PG8_LDB(B1, 1, 1); PG8_SCHED; PG8_LDA(At, 1, 0); PG8_STAGE(PG8_SA(0, 1), a2 + hstepA, voffA);
            PG8_WAIT_V(8); PG8_WAIT_L(0); PG8_BAR; PG8_MMA(0, 0, At, B0); PG8_MMA(0, 1, At, B1); PG8_BAR; PG8_SCHED;
            PG8_LDA(At, 1, 1); PG8_STAGE(PG8_SB(1, 0), b3, voffB); PG8_STAGE(PG8_SB(1, 1), b3 + hstep, voffB); PG8_STAGE(PG8_SA(1, 0), a3, voffA);
            PG8_WAIT_V(8); PG8_WAIT_L(0); PG8_BAR; PG8_MMA(1, 0, At, B0); PG8_MMA(1, 1, At, B1); PG8_BAR; PG8_SCHED;
            } else {
            PG8_LDB(B0, 0, 0); PG8_SCHED; PG8_LDA(At, 0, 0); PG8_STAGE(PG8_SA(1, 1), a1 + hstepA, voffA);
            PG8_WAIT_L(8); PG8_BAR; PG8_WAIT_L(0); PG8_MMA(0, 0, At, B0); PG8_BAR; PG8_SCHED;
            PG8_LDB(B1, 0, 1); PG8_STAGE(PG8_SB(0, 0), b2, voffB);
            PG8_BAR; PG8_WAIT_L(0); PG8_MMA(0, 1, At, B1); PG8_BAR;
            PG8_LDA(At, 0, 1); PG8_STAGE(PG8_SA(0, 0), a2, voffA);
            PG8_BAR; PG8_WAIT_L(0); PG8_MMA(1, 0, At, B0); PG8_BAR; PG8_SCHED;
            PG8_STAGE(PG8_SB(0, 1), b2 + hstep, voffB);
            PG8_WAIT_V(6); PG8_BAR; PG8_MMA(1, 1, At, B1); PG8_BAR;
            PG8_LDB(B0, 1, 0); PG8_SCHED; PG8_LDA(At, 1, 0); PG8_STAGE(PG8_SA(0, 1), a2 + hstepA, voffA);
            PG8_WAIT_L(8); PG8_BAR; PG8_WAIT_L(0); PG8_MMA(0, 0, At, B0); PG8_BAR; PG8_SCHED;
            PG8_LDB(B1, 1, 1); PG8_STAGE(PG8_SB(1, 0), b3, voffB);
            PG8_BAR; PG8_WAIT_L(0); PG8_MMA(0, 1, At, B1); PG8_BAR;
            PG8_LDA(At, 1, 1); PG8_STAGE(PG8_SA(1, 0), a3, voffA);
            PG8_BAR; PG8_WAIT_L(0); PG8_MMA(1, 0, At, B0); PG8_BAR; PG8_SCHED;
            PG8_STAGE(PG8_SB(1, 1), b3 + hstep, voffB);
            PG8_WAIT_V(6); PG8_BAR; PG8_MMA(1, 1, At, B1); PG8_BAR;
            }
        }
        } else {
        for (int t = 0; t < nt; t += 2) {
            const bool last = (t == nt - 2);
            const char* a1 = cA + (t + 1 >= nth ? a2off : 0) + (size_t)(t + 1) * kstep;
            const char* a2 = last ? nA : cA + (t + 2 >= nth ? a2off : 0) + (size_t)(t + 2) * kstep; const char* b2 = last ? nB : cB + (size_t)(t + 2) * kstep;
            const char* a3 = a2 + kstep; const char* b3 = b2 + kstep;
            if (last && has_next) S.a_ready(nxt);
            if constexpr (SP2) {
            PG8_LDB(B0, 0, 0); PG8_LDB(B1, 0, 1); PG8_SCHED; PG8_LDA(At, 0, 0); PG8_STAGE(PG8_SA(1, 1), a1 + hstepA, voffA);
            PG8_WAIT_V(8); PG8_WAIT_L(0); PG8_BAR; PG8_MMA(0, 0, At, B0); PG8_MMA(0, 1, At, B1); PG8_BAR; PG8_SCHED;
            PG8_LDA(At, 0, 1); PG8_STAGE(PG8_SB(0, 0), b2, voffB); PG8_STAGE(PG8_SB(0, 1), b2 + hstep, voffB); PG8_STAGE(PG8_SA(0, 0), a2, voffA);
            PG8_WAIT_V(8); PG8_WAIT_L(0); PG8_BAR; PG8_MMA(1, 0, At, B0); PG8_MMA(1, 1, At, B1); PG8_BAR; PG8_SCHED;
            PG8_LDB(B0, 1, 0); PG8_LDB(B1, 1, 1); PG8_SCHED; PG8_LDA(At, 1, 0); PG8_STAGE(PG8_SA(0, 1), a2 + hstepA, voffA);
            PG8_WAIT_V(8); PG8_WAIT_L(0); PG8_BAR; PG8_MMA(0, 0, At, B0); PG8_MMA(0, 1, At, B1); PG8_BAR; PG8_SCHED;
            PG8_LDA(At, 1, 1); PG8_STAGE(PG8_SB(1, 0), b3, voffB); PG8_STAGE(PG8_SB(1, 1), b3 + hstep, voffB); PG8_STAGE(PG8_SA(1, 0), a3, voffA);
            PG8_WAIT_V(8); PG8_WAIT_L(0); PG8_BAR; PG8_MMA(1, 0, At, B0); PG8_MMA(1, 1, At, B1); PG8_BAR; PG8_SCHED;
            } else {
            PG8_LDB(B0, 0, 0); PG8_SCHED; PG8_LDA(At, 0, 0); PG8_STAGE(PG8_SA(1, 1), a1 + hstepA, voffA);
            PG8_WAIT_L(8); PG8_BAR; PG8_WAIT_L(0); PG8_MMA(0, 0, At, B0); PG8_BAR; PG8_SCHED;
            PG8_LDB(B1, 0, 1); PG8_STAGE(PG8_SB(0, 0), b2, voffB);
            PG8_BAR; PG8_WAIT_L(0); PG8_MMA(0, 1, At, B1); PG8_BAR;
            PG8_LDA(At, 0, 1); PG8_STAGE(PG8_SA(0, 0), a2, voffA);
            PG8_BAR; PG8_WAIT_L(0); PG8_MMA(1, 0, At, B0); PG8_BAR; PG8_SCHED;
            PG8_STAGE(PG8_SB(0, 1), b2 + hstep, voffB);
            PG8_WAIT_V(6); PG8_BAR; PG8_MMA(1, 1, At, B1); PG8_BAR;
            PG8_LDB(B0, 1, 0); PG8_SCHED; PG8_LDA(At, 1, 0); PG8_STAGE(PG8_SA(0, 1), a2 + hstepA, voffA);
            PG8_WAIT_L(8); PG8_BAR; PG8_WAIT_L(0); PG8_MMA(0, 0, At, B0); PG8_BAR; PG8_SCHED;
            PG8_LDB(B1, 1, 1); PG8_STAGE(PG8_SB(1, 0), b3, voffB);
            PG8_BAR; PG8_WAIT_L(0); PG8_MMA(0, 1, At, B1); PG8_BAR;
            PG8_LDA(At, 1, 1); PG8_STAGE(PG8_SA(1, 0), a3, voffA);
            PG8_BAR; PG8_WAIT_L(0); PG8_MMA(1, 0, At, B0); PG8_BAR; PG8_SCHED;
            PG8_STAGE(PG8_SB(1, 1), b3 + hstep, voffB);
            PG8_WAIT_V(6); PG8_BAR; PG8_MMA(1, 1, At, B1); PG8_BAR;
            }
        }
        }
        if constexpr (ALIGN_EPI) { if (wr == 0) PG8_BAR; }
        if constexpr (!Epi::AFTER_DRAIN) { E(acc, cur, wr, wc, fr, fq); S.done(cur); }
        if (!has_next) break;
#pragma unroll
        for (int a = 0; a < 2; ++a)
#pragma unroll
            for (int b = 0; b < 2; ++b)
#pragma unroll
                for (int m = 0; m < 4; ++m)
#pragma unroll
                    for (int n = 0; n < 2; ++n) acc[a][b][m][n] = (f32x4){0.f, 0.f, 0.f, 0.f};
        cur = nxt; cA = nA; cB = nB; ++ui;
        if constexpr (ALIGN_EPI) { if (wr == 1) PG8_BAR; }
    }
    PG8_WAIT_V(0);
    if constexpr (!ALIGN_EPI) { if (wr == 0) PG8_BAR; }
    PG8_BAR;
    if constexpr (Epi::AFTER_DRAIN) { E.fused(acc, cur, wr, wc, fr, fq, lds, wid, lane); S.done(cur); }
#undef PG8_SA
#undef PG8_SB
#undef PG8_STAGE
#undef PG8_LDA
#undef PG8_LDB
#undef PG8_MMA
#undef PG8_WAIT_V
#undef PG8_WAIT_L
#undef PG8_BAR
#undef PG8_SCHED
}

typedef int i32x4 __attribute__((ext_vector_type(4)));
template <class Epi, class Sched, bool ALIGN_EPI = false, bool SP2 = false>
__device__ __forceinline__ void gemm_phase_i8(PG8_LAS unsigned char* lds, const Gemm g, const Sched& S, const Epi& E) {
    const int tid = threadIdx.x, wid = __builtin_amdgcn_readfirstlane(tid >> 6), lane = tid & 63, wr = wid >> 2, wc = wid & 3, fr = lane & 15, fq = lane >> 4;
    const int K = g.K, nt = K / 128;
    unsigned voffA[2], voffB[2];
#pragma unroll
    for (int i = 0; i < 2; ++i) { int R, C; stage_rc(tid * 16 + i * 8192, R, C); const int Rb = Epi::PERM ? ((R & ~31) + perm32(R & 31)) : R;
        voffA[i] = (unsigned)(R * K + C * 2); voffB[i] = (unsigned)(Rb * K + C * 2); }
    const size_t kstep = (size_t)(BK * 2);
    const size_t hstep = (size_t)HALF * K;
    const size_t tstep = 2 * hstep;
    const unsigned ldsw = (unsigned)wid * 1024u;
    const int aoff = lds_byte(wr * 64 + fr, fq * 8), boff = lds_byte(wc * 32 + fr, fq * 8);
#define PG8_SA(b, h) (((b) * 2 + (h)) * HTB)
#define PG8_SB(b, h) ((4 + (b) * 2 + (h)) * HTB)
#define PG8_STAGE(bufoff, gbase, voff) do { _Pragma("unroll") for (int _i = 0; _i < 2; ++_i) \
        __builtin_amdgcn_global_load_lds((const unsigned*)((const char*)(gbase) + (voff)[_i]), (PG8_LAS unsigned*)(lds + (bufoff) + ldsw + _i * 8192), 16, 0, 0); } while (0)
#define PG8_LDA(dst, b, h) do { _Pragma("unroll") for (int m = 0; m < 4; ++m) _Pragma("unroll") for (int k = 0; k < 2; ++k) dst[m][k] = *(const PG8_LAS i32x4*)(lds + PG8_SA(b, h) + aoff + m * 2048 + k * 1024); } while (0)
#define PG8_LDB(dst, b, h) do { _Pragma("unroll") for (int n = 0; n < 2; ++n) _Pragma("unroll") for (int k = 0; k < 2; ++k) dst[n][k] = *(const PG8_LAS i32x4*)(lds + PG8_SB(b, h) + boff + n * 2048 + k * 1024); } while (0)
#define PG8_MMA(ai, bj, At, Bt) do { __builtin_amdgcn_s_setprio(1); _Pragma("unroll") for (int m = 0; m < 4; ++m) _Pragma("unroll") for (int n = 0; n < 2; ++n) _Pragma("unroll") for (int k = 0; k < 2; ++k) \
        acc[ai][bj][m][n] = __builtin_amdgcn_mfma_i32_16x16x64_i8(Bt[n][k], At[m][k], acc[ai][bj][m][n], 0, 0, 0); __builtin_amdgcn_s_setprio(0); } while (0)
#define PG8_WAIT_V(n) asm volatile("s_waitcnt vmcnt(" #n ")" ::: "memory")
#define PG8_WAIT_L(n) asm volatile("s_waitcnt lgkmcnt(" #n ")" ::: "memory")
#define PG8_BAR __builtin_amdgcn_s_barrier()
#define PG8_SCHED __builtin_amdgcn_sched_barrier(0)
    Unit cur, nxt; int ui = 0;
    if (!S.next(0, cur)) return;
    i32x4 acc[2][2][4][2];
#pragma unroll
    for (int a = 0; a < 2; ++a)
#pragma unroll
        for (int b = 0; b < 2; ++b)
#pragma unroll
            for (int m = 0; m < 4; ++m)
#pragma unroll
                for (int n = 0; n < 2; ++n) acc[a][b][m][n] = (i32x4){0, 0, 0, 0};
    i32x4 At[4][2], B0[2][2], B1[2][2];
    const char* cA = (const char*)g.A + (size_t)cur.pm * tstep; const char* cB = (const char*)g.Bt + (size_t)cur.pn * tstep;
    S.a_ready(cur);
    if constexpr (SP2) {
        PG8_STAGE(PG8_SB(0, 0), cB, voffB); PG8_STAGE(PG8_SB(0, 1), cB + hstep, voffB); PG8_STAGE(PG8_SA(0, 0), cA, voffA); PG8_STAGE(PG8_SA(0, 1), cA + hstep, voffA);
        if (wr == 1) PG8_BAR;
        PG8_WAIT_V(2); PG8_BAR;
        PG8_STAGE(PG8_SB(1, 0), cB + kstep, voffB); PG8_STAGE(PG8_SA(1, 0), cA + kstep, voffA); PG8_STAGE(PG8_SB(1, 1), cB + hstep + kstep, voffB);
        PG8_WAIT_V(6); PG8_BAR;
    } else {
        PG8_STAGE(PG8_SB(0, 0), cB, voffB); PG8_STAGE(PG8_SA(0, 0), cA, voffA); PG8_STAGE(PG8_SB(0, 1), cB + hstep, voffB); PG8_STAGE(PG8_SA(0, 1), cA + hstep, voffA);
        if (wr == 1) PG8_BAR;
        PG8_WAIT_V(4); PG8_BAR;
        PG8_STAGE(PG8_SB(1, 0), cB + kstep, voffB); PG8_STAGE(PG8_SA(1, 0), cA + kstep, voffA); PG8_STAGE(PG8_SB(1, 1), cB + hstep + kstep, voffB);
        PG8_WAIT_V(6); PG8_BAR;
    }
    for (;;) {
        const bool has_next = S.next(ui + 1, nxt);
        const char* nA = has_next ? (const char*)g.A + (size_t)nxt.pm * tstep : cA; const char* nB = has_next ? (const char*)g.Bt + (size_t)nxt.pn * tstep : cB;
        for (int t = 0; t < nt; t += 2) {
            const bool last = (t == nt - 2);
            const char* a1 = cA + (size_t)(t + 1) * kstep;
            const char* a2 = last ? nA : cA + (size_t)(t + 2) * kstep; const char* b2 = last ? nB : cB + (size_t)(t + 2) * kstep;
            const char* a3 = a2 + kstep; const char* b3 = b2 + kstep;
            if (last && has_next) S.a_ready(nxt);
            if constexpr (SP2) {
            PG8_LDB(B0, 0, 0); PG8_LDB(B1, 0, 1); PG8_SCHED; PG8_LDA(At, 0, 0); PG8_STAGE(PG8_SA(1, 1), a1 + hstep, voffA);
            PG8_WAIT_V(8); PG8_WAIT_L(0); PG8_BAR; PG8_MMA(0, 0, At, B0); PG8_MMA(0, 1, At, B1); PG8_BAR; PG8_SCHED;
            PG8_LDA(At, 0, 1); PG8_STAGE(PG8_SB(0, 0), b2, voffB); PG8_STAGE(PG8_SB(0, 1), b2 + hstep, voffB); PG8_STAGE(PG8_SA(0, 0), a2, voffA);
            PG8_WAIT_V(8); PG8_WAIT_L(0); PG8_BAR; PG8_MMA(1, 0, At, B0); PG8_MMA(1, 1, At, B1); PG8_BAR; PG8_SCHED;
            PG8_LDB(B0, 1, 0); PG8_LDB(B1, 1, 1); PG8_SCHED; PG8_LDA(At, 1, 0); PG8_STAGE(PG8_SA(0, 1), a2 + hstep, voffA);
            PG8_WAIT_V(8); PG8_WAIT_L(0); PG8_BAR; PG8_MMA(0, 0, At, B0); PG8_MMA(0, 1, At, B1); PG8_BAR; PG8_SCHED;
            PG8_LDA(At, 1, 1); PG8_STAGE(PG8_SB(1, 0), b3, voffB); PG8_STAGE(PG8_SB(1, 1), b3 + hstep, voffB); PG8_STAGE(PG8_SA(1, 0), a3, voffA);
            PG8_WAIT_V(8); PG8_WAIT_L(0); PG8_BAR; PG8_MMA(1, 0, At, B0); PG8_MMA(1, 1, At, B1); PG8_BAR; PG8_SCHED;
            } else {
            PG8_LDB(B0, 0, 0); PG8_SCHED; PG8_LDA(At, 0, 0); PG8_STAGE(PG8_SA(1, 1), a1 + hstep, voffA);
            PG8_WAIT_L(8); PG8_BAR; PG8_WAIT_L(0); PG8_MMA(0, 0, At, B0); PG8_BAR; PG8_SCHED;
            PG8_LDB(B1, 0, 1); PG8_STAGE(PG8_SB(0, 0), b2, voffB);
            PG8_BAR; PG8_WAIT_L(0); PG8_MMA(0, 1, At, B1); PG8_BAR;
            PG8_LDA(At, 0, 1); PG8_STAGE(PG8_SA(0, 0), a2, voffA);
            PG8_BAR; PG8_WAIT_L(0); PG8_MMA(1, 0, At, B0); PG8_BAR; PG8_SCHED;
            PG8_STAGE(PG8_SB(0, 1), b2 + hstep, voffB);
            PG8_WAIT_V(6); PG8_BAR; PG8_MMA(1, 1, At, B1); PG8_BAR;
            PG8_LDB(B0, 1, 0); PG8_SCHED; PG8_LDA(At, 1, 0); PG8_STAGE(PG8_SA(0, 1), a2 + hstep, voffA);
            PG8_WAIT_L(8); PG8_BAR; PG8_WAIT_L(0); PG8_MMA(0, 0, At, B0); PG8_BAR; PG8_SCHED;
            PG8_LDB(B1, 1, 1); PG8_STAGE(PG8_SB(1, 0), b3, voffB);
            PG8_BAR; PG8_WAIT_L(0); PG8_MMA(0, 1, At, B1); PG8_BAR;
            PG8_LDA(At, 1, 1); PG8_STAGE(PG8_SA(1, 0), a3, voffA);
            PG8_BAR; PG8_WAIT_L(0); PG8_MMA(1, 0, At, B0); PG8_BAR; PG8_SCHED;
            PG8_STAGE(PG8_SB(1, 1), b3 + hstep, voffB);
            PG8_WAIT_V(6); PG8_BAR; PG8_MMA(1, 1, At, B1); PG8_BAR;
            }
        }
        if constexpr (ALIGN_EPI) { if (wr == 0) PG8_BAR; }
        if constexpr (!Epi::AFTER_DRAIN) { E(acc, cur, wr, wc, fr, fq); S.done(cur); }
        if (!has_next) break;
#pragma unroll
        for (int a = 0; a < 2; ++a)
#pragma unroll
            for (int b = 0; b < 2; ++b)
#pragma unroll
                for (int m = 0; m < 4; ++m)
#pragma unroll
                    for (int n = 0; n < 2; ++n) acc[a][b][m][n] = (i32x4){0, 0, 0, 0};
        cur = nxt; cA = nA; cB = nB; ++ui;
        if constexpr (ALIGN_EPI) { if (wr == 1) PG8_BAR; }
    }
    PG8_WAIT_V(0);
    if constexpr (!ALIGN_EPI) { if (wr == 0) PG8_BAR; }
    PG8_BAR;
    if constexpr (Epi::AFTER_DRAIN) { E.fused(acc, cur, wr, wc, fr, fq, lds, wid, lane); S.done(cur); }
#undef PG8_SA
#undef PG8_SB
#undef PG8_STAGE
#undef PG8_LDA
#undef PG8_LDB
#undef PG8_MMA
#undef PG8_WAIT_V
#undef PG8_WAIT_L
#undef PG8_BAR
#undef PG8_SCHED
}
}

struct Ctx {
    const float *x, *p, *g_mix, *w_in, *ln_g, *ln_b, *sgu_w, *sgu_b, *w_ba, *w_bs, *w_out, *g_ffn, *w_pq, *subk, *dn, *up, *g_ple, *w_pp, *w_pg, *g_fin;
    float* out;
    bf16 *WinT, *WbaT, *WbsT, *WoutT, *WqT, *WgT, *WprojT, *pb, *skb, *xn, *proj, *vT, *yatt, *ysgu, *merged, *h1n, *qp, *h2n, *gtmp, *h2b, *swb;
    float *kmean, *kmp, *sst, *egate, *sdn, *sup, *lse, *xs, *h2s, *wcs, *gcs, *qcs, *h1s, *rss, *ocs, *ms; int *eid, *sel; unsigned char *xq8, *WinT8, *WgT8, *WqT8, *h2q8, *h1q8, *WoutT8, *mq8; unsigned char *dn8, *up8;
    int G, bid, tid, lane, wave;
};

DEV void transpose_item(const float* W, int K, int N, bf16* WT, const float* gain, LAS float* scr, int item, int lane, int ldt = 0) {
    if (ldt == 0) ldt = K;
    const int nblk = N / 32, kb = item / nblk, nb = item % nblk, k0 = 64 * kb, n0 = 32 * nb;
#pragma unroll
    for (int i = 0; i < 8; ++i) { const int kk = 8 * i + (lane >> 3), cc = (lane & 7) * 4; const float gsc = gain ? gain[k0 + kk] : 1.0f;
        const f32x4 w = *(const f32x4*)(W + (size_t)(k0 + kk) * N + n0 + cc); LAS float* sp = scr + kk * 33 + cc; sp[0] = w.x * gsc; sp[1] = w.y * gsc; sp[2] = w.z * gsc; sp[3] = w.w * gsc; }
    asm volatile("s_waitcnt lgkmcnt(0)" ::: "memory");
    const int c = lane & 7;
#pragma unroll
    for (int j = 0; j < 4; ++j) { const int n = (lane >> 3) + 8 * j; const LAS float* s = scr + (8 * c) * 33 + n;
        v4u o; o.x = pkbf(s[0 * 33], s[1 * 33]); o.y = pkbf(s[2 * 33], s[3 * 33]); o.z = pkbf(s[4 * 33], s[5 * 33]); o.w = pkbf(s[6 * 33], s[7 * 33]);
        *(v4u*)(WT + (size_t)(n0 + n) * ldt + k0 + 8 * c) = o; }
    asm volatile("s_waitcnt lgkmcnt(0)" ::: "memory");
}
DEV void row_rms_bf16(const float* xrow, bf16* orow, int lane) {
    const f32x4* xr = (const f32x4*)xrow + lane;
    f32x4 v[8]; float s = 0.f;
#pragma unroll
    for (int j = 0; j < 8; ++j) { v[j] = xr[64 * j]; s += (v[j].x * v[j].x + v[j].y * v[j].y) + (v[j].z * v[j].z + v[j].w * v[j].w); }
    const float r = 1.0f / sqrtf(wave_sum(s) * (1.0f / D) + EPS);
    v2u* o8 = (v2u*)orow + lane;
#pragma unroll
    for (int j = 0; j < 8; ++j) { v2u w; w.x = pkbf(v[j].x * r, v[j].y * r); w.y = pkbf(v[j].z * r, v[j].w * r); o8[64 * j] = w; }
}
DEV void cvt_items(const float* src, bf16* dst, size_t n8, const float* gain, size_t gtid, size_t gthreads) {
    for (size_t i = gtid; i < n8; i += gthreads) {
        const f32x4 a = ((const f32x4*)src)[2 * i], b = ((const f32x4*)src)[2 * i + 1];
        f32x4 ga = {1.f, 1.f, 1.f, 1.f}, gb = ga;
        if (gain) { const size_t c = (i * 8) % D; ga = *(const f32x4*)(gain + c); gb = *(const f32x4*)(gain + c + 4); }
        v4u o; o.x = pkbf(a.x * ga.x, a.y * ga.y); o.y = pkbf(a.z * ga.z, a.w * ga.w); o.z = pkbf(b.x * gb.x, b.y * gb.y); o.w = pkbf(b.z * gb.z, b.w * gb.w);
        ((v4u*)dst)[i] = o;
    }
}
DEV float wave_max(float v);
DEV unsigned q4(float a, float b, float c_, float d, float inv, int off);
DEV void colmax_item(const float* W, int N, const float* gain, unsigned* cam, int item, int lane) {
    const int nblk = N / 256, kb = item / nblk, nb = item % nblk, k0 = 64 * kb, n0 = 256 * nb + 4 * lane;
    f32x4 am = {0.f, 0.f, 0.f, 0.f};
#pragma unroll 8
    for (int kk = 0; kk < 64; ++kk) { const f32x4 w = *(const f32x4*)(W + (size_t)(k0 + kk) * N + n0); const float g = gain ? gain[k0 + kk] : 1.0f;
        am.x = fmaxf(am.x, fabsf(w.x * g)); am.y = fmaxf(am.y, fabsf(w.y * g)); am.z = fmaxf(am.z, fabsf(w.z * g)); am.w = fmaxf(am.w, fabsf(w.w * g)); }
    atomicMax(cam + n0, __float_as_uint(am.x)); atomicMax(cam + n0 + 1, __float_as_uint(am.y)); atomicMax(cam + n0 + 2, __float_as_uint(am.z)); atomicMax(cam + n0 + 3, __float_as_uint(am.w));
}
DEV void transpose_item_i8(const float* W, int K, int N, unsigned char* WT8, const float* gain, const unsigned* cam, LAS float* scr, int item, int lane) {
    const int nblk = N / 32, kb = item / nblk, nb = item % nblk, k0 = 64 * kb, n0 = 32 * nb;
#pragma unroll
    for (int i = 0; i < 8; ++i) { const int kk = 8 * i + (lane >> 3), cc = (lane & 7) * 4; const float gsc = gain ? gain[k0 + kk] : 1.0f;
        const f32x4 w = *(const f32x4*)(W + (size_t)(k0 + kk) * N + n0 + cc); LAS float* sp = scr + kk * 33 + cc; sp[0] = w.x * gsc; sp[1] = w.y * gsc; sp[2] = w.z * gsc; sp[3] = w.w * gsc; }
    asm volatile("s_waitcnt lgkmcnt(0)" ::: "memory");
    const int cq = lane & 3;
#pragma unroll
    for (int j = 0; j < 2; ++j) { const int n = (lane >> 2) + 16 * j; const LAS float* s = scr + (16 * cq) * 33 + n;
        const float am = __uint_as_float(cam[n0 + n]); const float inv = am > 0.f ? 127.0f / am : 0.f;
        v4u o; o.x = q4(s[0 * 33], s[1 * 33], s[2 * 33], s[3 * 33], inv, 0); o.y = q4(s[4 * 33], s[5 * 33], s[6 * 33], s[7 * 33], inv, 0);
        o.z = q4(s[8 * 33], s[9 * 33], s[10 * 33], s[11 * 33], inv, 0); o.w = q4(s[12 * 33], s[13 * 33], s[14 * 33], s[15 * 33], inv, 0);
        *(v4u*)(WT8 + (size_t)(n0 + n) * K + k0 + 16 * cq) = o; }
    asm volatile("s_waitcnt lgkmcnt(0)" ::: "memory");
}
DEV void row_rms_i8(const float* xrow, unsigned char* orow, float* sc, int lane) {
    const f32x4* xr = (const f32x4*)xrow + lane;
    f32x4 v[8]; float s = 0.f, am = 0.f;
#pragma unroll
    for (int j = 0; j < 8; ++j) { v[j] = xr[64 * j]; s += (v[j].x * v[j].x + v[j].y * v[j].y) + (v[j].z * v[j].z + v[j].w * v[j].w);
        am = fmaxf(am, fmaxf(fmaxf(fabsf(v[j].x), fabsf(v[j].y)), fmaxf(fabsf(v[j].z), fabsf(v[j].w)))); }
    const float r = 1.0f / sqrtf(wave_sum(s) * (1.0f / D) + EPS);
    am = wave_max(am);
    const float inv = am > 0.f ? 127.0f / am : 0.f;
    unsigned* o4 = (unsigned*)orow + lane;
#pragma unroll
    for (int j = 0; j < 8; ++j) o4[64 * j] = q4(v[j].x, v[j].y, v[j].z, v[j].w, inv, 0);
    if (lane == 0) *sc = am * (1.0f / 127.0f) * r;
}
DEV void phase_prologue2(const Ctx& c, LAS unsigned char* lds, const unsigned* cam) {
    LAS float* scr = (LAS float*)(lds + c.wave * 16384);
    const int gw = c.bid * 8 + c.wave, NGW = c.G * 8;
    constexpr int I_IN = (D / 64) * (INW / 32), I_SQ = (D / 64) * (D / 32);
    for (int it = gw; it < I_IN + I_SQ; it += NGW) {
        if (it < I_IN) transpose_item_i8(c.w_in, D, INW, c.WinT8, c.g_mix, cam, scr, it, c.lane);
        else transpose_item_i8(c.w_pg, D, D, c.WgT8, c.g_ple, cam + INW, scr, it - I_IN, c.lane);
    }
    for (int i = c.bid * NTHREADS + c.tid; i < INW + D; i += c.G * NTHREADS) { const float s = __uint_as_float(cam[i]) * (1.0f / 127.0f); if (i < INW) c.wcs[i] = s; else c.gcs[i - INW] = s; }
}
DEV void phase_prologue(const Ctx& c, LAS unsigned char* lds, unsigned* cam) {
    LAS float* scr = (LAS float*)(lds + c.wave * 16384);
    const int gw = c.bid * 8 + c.wave, NGW = c.G * 8;
    constexpr int I_IN = (D / 64) * (INW / 32), I_BA = (1024 / 64) * (D / 32), I_SQ = (D / 64) * (D / 32), I_PP = (PLE / 64) * (D / 32);
    constexpr int C_IN = (D / 64) * (INW / 256), C_SQ = (D / 64) * (D / 256);
    for (int it = gw; it < C_IN + C_SQ; it += NGW) {
        if (it < C_IN) colmax_item(c.w_in, INW, c.g_mix, cam, it, c.lane); else colmax_item(c.w_pg, D, c.g_ple, cam + INW, it - C_IN, c.lane);
    }
    constexpr int NITEMS = 2 * I_BA + 2 * I_SQ + I_PP;
    for (int it = gw; it < NITEMS; it += NGW) {
        int r = it;
        if (r < I_BA) { transpose_item(c.w_ba, 1024, D, c.WbaT, nullptr, scr, r, c.lane, 2048); continue; } r -= I_BA;
        if (r < I_BA) { transpose_item(c.w_bs, 1024, D, c.WbaT + 1024, nullptr, scr, r, c.lane, 2048); continue; } r -= I_BA;
        if (r < I_SQ) { transpose_item(c.w_out, D, D, c.WoutT, nullptr, scr, r, c.lane); continue; } r -= I_SQ;
        if (r < I_SQ) { transpose_item(c.w_pq, D, D, c.WqT, c.g_ffn, scr, r, c.lane); continue; } r -= I_SQ;
        transpose_item(c.w_pp, PLE, D, c.WprojT, nullptr, scr, r, c.lane);
    }
    {
        f32x4 vn[8]; int m = gw;
        if (m < T) { const f32x4* xr = (const f32x4*)(c.x + (size_t)m * D) + c.lane;
#pragma unroll
            for (int j = 0; j < 8; ++j) vn[j] = xr[64 * j]; }
        for (; m < T; m += NGW) {
            f32x4 v[8];
#pragma unroll
            for (int j = 0; j < 8; ++j) v[j] = vn[j];
            { const int mn = m + NGW < T ? m + NGW : m; const f32x4* xr = (const f32x4*)(c.x + (size_t)mn * D) + c.lane;
#pragma unroll
              for (int j = 0; j < 8; ++j) vn[j] = xr[64 * j]; }
            float s = 0.f, am = 0.f;
#pragma unroll
            for (int j = 0; j < 8; ++j) { s += (v[j].x * v[j].x + v[j].y * v[j].y) + (v[j].z * v[j].z + v[j].w * v[j].w);
                am = fmaxf(am, fmaxf(fmaxf(fabsf(v[j].x), fabsf(v[j].y)), fmaxf(fabsf(v[j].z), fabsf(v[j].w)))); }
            const float r = 1.0f / sqrtf(wsum_q(s) * (1.0f / D) + EPS);
            am = wmax_q(am);
            const float inv = am > 0.f ? 127.0f / am : 0.f;
            unsigned* o4 = (unsigned*)(c.xq8 + (size_t)m * D) + c.lane;
#pragma unroll
            for (int j = 0; j < 8; ++j) o4[64 * j] = q4(v[j].x, v[j].y, v[j].z, v[j].w, inv, 0);
            if (c.lane == 0) c.xs[m] = am * (1.0f / 127.0f) * r;
        }
    }
    const size_t gtid = (size_t)c.bid * NTHREADS + c.tid, gthreads = (size_t)c.G * NTHREADS;
    cvt_items(c.p, c.pb, (size_t)T * PLE / 8, nullptr, gtid, gthreads);
    cvt_items(c.subk, c.skb, (size_t)NH * 2 * 128 * 128 / 8, nullptr, gtid, gthreads);
    for (size_t i = gtid; i < (size_t)8 * 128 * 128 / 8; i += gthreads) {
        const int t = (int)(i >> 4) & 127, s0 = (int)(i & 15) * 8; const f32x4 a = *(const f32x4*)(c.sgu_w + i * 8), b = *(const f32x4*)(c.sgu_w + i * 8 + 4);
        v4u o; o.x = pkbf(s0 + 0 <= t ? a.x : 0.f, s0 + 1 <= t ? a.y : 0.f); o.y = pkbf(s0 + 2 <= t ? a.z : 0.f, s0 + 3 <= t ? a.w : 0.f);
        o.z = pkbf(s0 + 4 <= t ? b.x : 0.f, s0 + 5 <= t ? b.y : 0.f); o.w = pkbf(s0 + 6 <= t ? b.z : 0.f, s0 + 7 <= t ? b.w : 0.f);
        *(v4u*)(c.swb + i * 8) = o; }
}

DEV float rsum16(float v) { v += dppq<0xB1>(v); v += dppq<0x4E>(v); v += dppq<0x1B>(dppq<0x141>(v)); v += dppq<0x128>(v); return v; }
struct F1 { bf16* proj;
    DEV void elem4(int row, int col, f32x4 v) const {
        if (col >= C_GA) { v.x = sigmoidf_(v.x); v.y = sigmoidf_(v.y); v.z = sigmoidf_(v.z); v.w = sigmoidf_(v.w); }
        else if (col >= C_U) { const f32x2 a = pg8::gelu_pk((f32x2){v.x, v.y}), b = pg8::gelu_pk((f32x2){v.z, v.w}); v = (f32x4){a.x, a.y, b.x, b.y}; }
        v2u w; w.x = pkbf(v.x, v.y); w.y = pkbf(v.z, v.w); *(v2u*)(proj + (size_t)row * PST + col) = w; } };
constexpr float GQ = 255.99f;
DEV unsigned gate_q(float x) { return (unsigned)__builtin_amdgcn_rcpf((1.0f / GQ) + __builtin_amdgcn_exp2f(fmaf(x, -1.4426950408889634f, -7.999943641f))); }
DEV f32x4 gate_dq(unsigned w) { return (f32x4){((float)(w & 0xffu) + 0.5f) * (1.0f / GQ), ((float)((w >> 8) & 0xffu) + 0.5f) * (1.0f / GQ), ((float)((w >> 16) & 0xffu) + 0.5f) * (1.0f / GQ), ((float)(w >> 24) + 0.5f) * (1.0f / GQ)}; }
struct EpiIn { static constexpr bool PERM = false, AFTER_DRAIN = false, HAS_MID = false; bf16* proj; const float* rs; const float* cs; float* kmp; float* sst; int skip;
    DEV void operator()(const pg8::i32x4 (&acc)[2][2][4][2], const pg8::Unit& u, int wr, int wc, int fr, int fq) const {
#ifdef EPI_SKIP_PROBE
        if (skip) { if (acc[0][0][0][0].x == 0x7fffffff && acc[1][1][3][1].w == 0x7ffffff1) proj[0] = 0; return; }
#endif
        const int row0 = u.pm * 256 + wr * 64 + fr, col0 = u.pn * 256 + wc * 32 + 4 * fq;
        const bool isK = u.pn >= C_K / 256 && u.pn < C_V / 256, isVG = u.pn >= C_VG / 256 && u.pn < C_GA / 256;
        f32x4 cv[2][2];
#pragma unroll
        for (int bj = 0; bj < 2; ++bj)
#pragma unroll
            for (int n = 0; n < 2; ++n) cv[bj][n] = *(const f32x4*)(cs + col0 + bj * 128 + n * 16);
        float rsv[8];
#pragma unroll
        for (int g = 0; g < 8; ++g) rsv[g] = rs[row0 + (g >> 2) * 128 + (g & 3) * 16];
        f32x4 ksum[2][2];
#pragma unroll
        for (int bj = 0; bj < 2; ++bj)
#pragma unroll
            for (int n = 0; n < 2; ++n) ksum[bj][n] = (f32x4){0.f, 0.f, 0.f, 0.f};
#pragma unroll
        for (int ai = 0; ai < 2; ++ai)
#pragma unroll
            for (int m = 0; m < 4; ++m) { const int row = row0 + ai * 128 + m * 16; const float r = rsv[ai * 4 + m]; float ss = 0.f, sq = 0.f;
#pragma unroll
                for (int bj = 0; bj < 2; ++bj)
#pragma unroll
                    for (int n = 0; n < 2; ++n) { const pg8::i32x4 a = acc[ai][bj][m][n]; const f32x4 c4 = cv[bj][n]; const int col = col0 + bj * 128 + n * 16;
                        f32x4 v = (f32x4){(float)a.x * (r * c4.x), (float)a.y * (r * c4.y), (float)a.z * (r * c4.z), (float)a.w * (r * c4.w)};
                        if (col >= C_GA) {
                            const unsigned q0 = gate_q(v.x), q1 = gate_q(v.y), q2 = gate_q(v.z), q3 = gate_q(v.w);
                            *(unsigned*)((unsigned char*)(proj + (size_t)row * PST + C_GA) + (col - C_GA)) = q0 | (q1 << 8) | (q2 << 16) | (q3 << 24); continue; }
                        if (col >= C_U) { const f32x2 ga = pg8::gelu_pk((f32x2){v.x, v.y}), gb = pg8::gelu_pk((f32x2){v.z, v.w}); v = (f32x4){ga.x, ga.y, gb.x, gb.y}; }
                        v2u w; w.x = pkbf(v.x, v.y); w.y = pkbf(v.z, v.w); *(v2u*)(proj + (size_t)row * PST + col) = w;
                        if (isK) ksum[bj][n] += v;
                        if (isVG) { const float e0 = bflo(w.x), e1 = bfhi(w.x), e2 = bflo(w.y), e3 = bfhi(w.y); ss += (e0 + e1) + (e2 + e3); sq += (e0 * e0 + e1 * e1) + (e2 * e2 + e3 * e3); } }
                if (isVG) { ss += __shfl_xor(ss, 16); sq += __shfl_xor(sq, 16); ss += __shfl_xor(ss, 32); sq += __shfl_xor(sq, 32);
                    if (fq == 0) *(f32x2*)(sst + ((size_t)row * 16 + (u.pn - C_VG / 256) * 4 + wc) * 2) = (f32x2){ss, sq}; }
                asm volatile("" ::: "memory");
            }
        if (isK) { const int b = u.pm >> 5, nb = u.pm & 31;
#pragma unroll
            for (int bj = 0; bj < 2; ++bj)
#pragma unroll
                for (int n = 0; n < 2; ++n) { f32x4 s = ksum[bj][n]; s.x = rsum16(s.x); s.y = rsum16(s.y); s.z = rsum16(s.z); s.w = rsum16(s.w);
                    const int h = 2 * (u.pn - C_K / 256) + bj, d = 32 * wc + 16 * n + 4 * fq;
                    if (fr == 0) *(f32x4*)(kmp + (((size_t)wr * 16 + b * 8 + h) * NBLK + nb) * HD + d) = s * (1.0f / BLK); } }
    } };
struct F4a { const bf16* proj; float* out;
    DEV void elem4(int row, int col, f32x4 v) const { const v2u g = *(const v2u*)(proj + (size_t)row * PST + C_GA + col);
        *(f32x4*)(out + (size_t)row * D + col) = (f32x4){v.x * bflo(g.x), v.y * bfhi(g.x), v.z * bflo(g.y), v.w * bfhi(g.y)}; } };
struct F4b { const bf16* proj; const float* out; bf16* merged;
    DEV void elem4(int row, int col, f32x4 v) const { const v2u g = *(const v2u*)(proj + (size_t)row * PST + C_GB + col); const f32x4 t = *(const f32x4*)(out + (size_t)row * D + col);
        v2u w; w.x = pkbf(t.x + v.x * bflo(g.x), t.y + v.y * bfhi(g.x)); w.y = pkbf(t.z + v.z * bflo(g.y), t.w + v.w * bfhi(g.y)); *(v2u*)(merged + (size_t)row * D + col) = w; } };
struct F5 { const float* x; float* out;
    DEV void elem4(int row, int col, f32x4 v) const { const f32x4 t = *(const f32x4*)(x + (size_t)row * D + col); *(f32x4*)(out + (size_t)row * D + col) = t + v; } };
struct EpiBranch { static constexpr bool PERM = false, AFTER_DRAIN = false, HAS_MID = true; const bf16* proj; bf16* merged;
    DEV void mid(f32x4 (&acc)[2][2][4][2], const pg8::Unit& u, int wr, int wc, int fr, int fq) const {
        const unsigned char* pb = (const unsigned char*)(proj + (size_t)(u.pm * 256 + wr * 64 + fr) * PST + C_GA) + u.pn * 256 + wc * 32 + 4 * fq;
        unsigned gan[4], gbn[4];
#pragma unroll
        for (int q = 0; q < 4; ++q) { const unsigned char* qp_ = pb + (q >> 1) * 128 + (q & 1) * 16; gan[q] = *(const unsigned*)qp_; gbn[q] = *(const unsigned*)(qp_ + 2048); }
#pragma unroll
        for (int g = 0; g < 8; ++g) { const int ai = g >> 2, m = g & 3;
            unsigned gac[4], gbc[4];
#pragma unroll
            for (int q = 0; q < 4; ++q) { gac[q] = gan[q]; gbc[q] = gbn[q]; }
            if (g < 7) { const int gn = g + 1; const unsigned char* rp = pb + (size_t)((gn >> 2) * 128 + (gn & 3) * 16) * (PST * 2);
#pragma unroll
                for (int q = 0; q < 4; ++q) { const unsigned char* qp_ = rp + (q >> 1) * 128 + (q & 1) * 16; gan[q] = *(const unsigned*)qp_; gbn[q] = *(const unsigned*)(qp_ + 2048); } }
#pragma unroll
            for (int bj = 0; bj < 2; ++bj)
#pragma unroll
                for (int n = 0; n < 2; ++n) { const f32x4 ga = gate_dq(gac[bj * 2 + n]), gb = gate_dq(gbc[bj * 2 + n]); f32x4 v = acc[ai][bj][m][n];
                    v.x *= ga.x * __builtin_amdgcn_rcpf(gb.x); v.y *= ga.y * __builtin_amdgcn_rcpf(gb.y); v.z *= ga.z * __builtin_amdgcn_rcpf(gb.z); v.w *= ga.w * __builtin_amdgcn_rcpf(gb.w);
                    acc[ai][bj][m][n] = v; } }
    }
    DEV void operator()(const f32x4 (&acc)[2][2][4][2], const pg8::Unit& u, int wr, int wc, int fr, int fq) const {
        const int row0 = u.pm * 256 + wr * 64 + fr, col0 = u.pn * 256 + wc * 32 + 4 * fq;
        const unsigned char* pb = (const unsigned char*)(proj + (size_t)row0 * PST + C_GA) + 2048 + col0;
        unsigned gbn[4];
#pragma unroll
        for (int q = 0; q < 4; ++q) gbn[q] = *(const unsigned*)(pb + (q >> 1) * 128 + (q & 1) * 16);
#pragma unroll
        for (int g = 0; g < 8; ++g) { const int ai = g >> 2, m = g & 3; const int row = row0 + ai * 128 + m * 16;
            unsigned gbc[4];
#pragma unroll
            for (int q = 0; q < 4; ++q) gbc[q] = gbn[q];
            if (g < 7) { const int gn = g + 1; const unsigned char* rp = pb + (size_t)((gn >> 2) * 128 + (gn & 3) * 16) * (PST * 2);
#pragma unroll
                for (int q = 0; q < 4; ++q) gbn[q] = *(const unsigned*)(rp + (q >> 1) * 128 + (q & 1) * 16); }
#pragma unroll
            for (int bj = 0; bj < 2; ++bj)
#pragma unroll
                for (int n = 0; n < 2; ++n) { const int col = col0 + bj * 128 + n * 16; const f32x4 gb = gate_dq(gbc[bj * 2 + n]); const f32x4 v = acc[ai][bj][m][n];
                    v2u w; w.x = pkbf(v.x * gb.x, v.y * gb.y); w.y = pkbf(v.z * gb.z, v.w * gb.w); *(v2u*)(merged + (size_t)row * D + col) = w; } }
    } };
struct EpiF5 { static constexpr bool PERM = false, AFTER_DRAIN = false, HAS_MID = false; const float* x; float* out; bf16* h1b; float* rss;
    DEV void operator()(const f32x4 (&acc)[2][2][4][2], const pg8::Unit& u, int wr, int wc, int fr, int fq) const {
        const int row0 = u.pm * 256 + wr * 64 + fr, col0 = u.pn * 256 + wc * 32 + 4 * fq;
        f32x4 xn[4];
        { const float* xp = x + (size_t)row0 * D + col0;
#pragma unroll
          for (int q = 0; q < 4; ++q) xn[q] = *(const f32x4*)(xp + (q >> 1) * 128 + (q & 1) * 16); }
#pragma unroll
        for (int g = 0; g < 8; ++g) { const int ai = g >> 2, m = g & 3; const int row = row0 + ai * 128 + m * 16; float ss = 0.f;
            f32x4 xc[4];
#pragma unroll
            for (int q = 0; q < 4; ++q) xc[q] = xn[q];
            if (g < 7) { const int gn = g + 1; const float* xp = x + (size_t)(row0 + (gn >> 2) * 128 + (gn & 3) * 16) * D + col0;
#pragma unroll
                for (int q = 0; q < 4; ++q) xn[q] = *(const f32x4*)(xp + (q >> 1) * 128 + (q & 1) * 16); }
#pragma unroll
            for (int bj = 0; bj < 2; ++bj)
#pragma unroll
                for (int n = 0; n < 2; ++n) { const int col = col0 + bj * 128 + n * 16; const f32x4 v = xc[bj * 2 + n] + acc[ai][bj][m][n];
                    v2u w; w.x = pkbf(v.x, v.y); w.y = pkbf(v.z, v.w); *(v2u*)(h1b + (size_t)row * D + col) = w;
                    ss += (v.x * v.x + v.y * v.y) + (v.z * v.z + v.w * v.w); }
            ss += __shfl_xor(ss, 16); ss += __shfl_xor(ss, 32);
            if (fq == 0) rss[(size_t)row * 32 + u.pn * 4 + wc] = ss; }
    } };
struct EpiF5i { static constexpr bool PERM = false, AFTER_DRAIN = false, HAS_MID = false; const float* x; bf16* h1b; float* rss; const float* rs; const float* cs;
    DEV void operator()(const pg8::i32x4 (&acc)[2][2][4][2], const pg8::Unit& u, int wr, int wc, int fr, int fq) const {
        const int row0 = u.pm * 256 + wr * 64 + fr, col0 = u.pn * 256 + wc * 32 + 4 * fq;
        f32x4 cv[2][2];
#pragma unroll
        for (int bj = 0; bj < 2; ++bj)
#pragma unroll
            for (int n = 0; n < 2; ++n) cv[bj][n] = *(const f32x4*)(cs + col0 + bj * 128 + n * 16);
#pragma unroll
        for (int ai = 0; ai < 2; ++ai)
#pragma unroll
            for (int m = 0; m < 4; ++m) { const int row = row0 + ai * 128 + m * 16; float ss = 0.f; const float r = rs[row];
#pragma unroll
                for (int bj = 0; bj < 2; ++bj)
#pragma unroll
                    for (int n = 0; n < 2; ++n) { const int col = col0 + bj * 128 + n * 16; const pg8::i32x4 a = acc[ai][bj][m][n]; const f32x4 c4 = cv[bj][n];
                        const f32x4 v = *(const f32x4*)(x + (size_t)row * D + col) + (f32x4){(float)a.x * (r * c4.x), (float)a.y * (r * c4.y), (float)a.z * (r * c4.z), (float)a.w * (r * c4.w)};
                        v2u w; w.x = pkbf(v.x, v.y); w.y = pkbf(v.z, v.w); *(v2u*)(h1b + (size_t)row * D + col) = w;
                        ss += (v.x * v.x + v.y * v.y) + (v.z * v.z + v.w * v.w); }
                ss += __shfl_xor(ss, 16); ss += __shfl_xor(ss, 32);
                if (fq == 0) rss[(size_t)row * 32 + u.pn * 4 + wc] = ss;
                asm volatile("" ::: "memory"); }
    } };
DEV void phase_quant_merged(const Ctx& c) {
    const int gw = c.bid * 8 + c.wave, NGW = c.G * 8, lane = c.lane;
    for (int m = gw; m < T; m += NGW) {
        const v4u* src = (const v4u*)(c.merged + (size_t)m * D) + lane;
        v4u v[4]; float am = 0.f;
#pragma unroll
        for (int j = 0; j < 4; ++j) { v[j] = src[64 * j]; const v4u w = v[j];
            am = fmaxf(am, fmaxf(fmaxf(fmaxf(fabsf(bflo(w.x)), fabsf(bfhi(w.x))), fmaxf(fabsf(bflo(w.y)), fabsf(bfhi(w.y)))), fmaxf(fmaxf(fabsf(bflo(w.z)), fabsf(bfhi(w.z))), fmaxf(fabsf(bflo(w.w)), fabsf(bfhi(w.w)))))); }
        am = wave_max(am);
        const float inv = am > 0.f ? 127.0f / am : 0.f;
        v2u* dst = (v2u*)(c.mq8 + (size_t)m * D) + lane;
#pragma unroll
        for (int j = 0; j < 4; ++j) { const v4u w = v[j]; v2u o; o.x = q4(bflo(w.x), bfhi(w.x), bflo(w.y), bfhi(w.y), inv, 0); o.y = q4(bflo(w.z), bfhi(w.z), bflo(w.w), bfhi(w.w), inv, 0); dst[64 * j] = o; }
        if (lane == 0) c.ms[m] = am * (1.0f / 127.0f);
    }
}
struct F6 { bf16* qp;
    DEV void elem4(int row, int col, f32x4 v) const { v2u w; w.x = pkbf(v.x, v.y); w.y = pkbf(v.z, v.w); *(v2u*)(qp + (size_t)row * D + col) = w; } };
struct F9a { bf16* gtmp;
    DEV void elem4(int row, int col, f32x4 v) const { v2u w; w.x = pkbf(sigmoidf_(v.x), sigmoidf_(v.y)); w.y = pkbf(sigmoidf_(v.z), sigmoidf_(v.w)); *(v2u*)(gtmp + (size_t)row * D + col) = w; } };
struct F9b { const bf16* gtmp; float* out;
    DEV void elem4(int row, int col, f32x4 v) const { const v2u g = *(const v2u*)(gtmp + (size_t)row * D + col); float* o = out + (size_t)row * D + col; const f32x4 t = *(const f32x4*)o;
        *(f32x4*)o = (f32x4){t.x + v.x * bflo(g.x), t.y + v.y * bfhi(g.x), t.z + v.z * bflo(g.y), t.w + v.w * bfhi(g.y)}; } };
struct Epi9b { static constexpr bool PERM = false, AFTER_DRAIN = false, HAS_MID = false; const bf16* gtmp; bf16* hb;
    DEV void operator()(const f32x4 (&acc)[2][2][4][2], const pg8::Unit& u, int wr, int wc, int fr, int fq) const {
        const int row0 = u.pm * 256 + wr * 64 + fr, col0 = u.pn * 256 + wc * 32 + 4 * fq;
        v2u gn[4], tn[4];
        { const size_t o0 = (size_t)row0 * D + col0;
#pragma unroll
          for (int q = 0; q < 4; ++q) { const size_t o = o0 + (q >> 1) * 128 + (q & 1) * 16; gn[q] = *(const v2u*)(gtmp + o); tn[q] = *(const v2u*)(hb + o); } }
#pragma unroll
        for (int g = 0; g < 8; ++g) { const int ai = g >> 2, m = g & 3; const size_t o0 = (size_t)(row0 + ai * 128 + m * 16) * D + col0;
            v2u gc[4], tc[4];
#pragma unroll
            for (int q = 0; q < 4; ++q) { gc[q] = gn[q]; tc[q] = tn[q]; }
            if (g < 7) { const int g1 = g + 1; const size_t o1 = (size_t)(row0 + (g1 >> 2) * 128 + (g1 & 3) * 16) * D + col0;
#pragma unroll
                for (int q = 0; q < 4; ++q) { const size_t o = o1 + (q >> 1) * 128 + (q & 1) * 16; gn[q] = *(const v2u*)(gtmp + o); tn[q] = *(const v2u*)(hb + o); } }
#pragma unroll
            for (int bj = 0; bj < 2; ++bj)
#pragma unroll
                for (int n = 0; n < 2; ++n) { const int q = bj * 2 + n; const f32x4 v = acc[ai][bj][m][n]; const v2u t = tc[q], gg = gc[q];
                    v2u w; w.x = pkbf(bflo(t.x) + v.x * bflo(gg.x), bfhi(t.x) + v.y * bfhi(gg.x)); w.y = pkbf(bflo(t.y) + v.z * bflo(gg.y), bfhi(t.y) + v.w * bfhi(gg.y));
                    *(v2u*)(hb + o0 + bj * 128 + n * 16) = w; } }
    } };

template <class F> DEV void naive_gemm(LAS unsigned char* lds, const bf16* A, const bf16* Bt, int M, int N, int K, const F& f) {
    LAS float* As = (LAS float*)lds; LAS float* Bs = As + 64 * 33;
    const int tid = threadIdx.x, ty = tid >> 4, tx = tid & 15;
    const int ntn = N / 64, ntiles = (M / 64) * ntn;
    for (int tile = blockIdx.x; tile < ntiles; tile += gridDim.x) {
        const int tm = tile / ntn, tn = tile % ntn;
        f32x4 a0 = {0.f, 0.f, 0.f, 0.f}, a1 = a0;
        for (int k0 = 0; k0 < K; k0 += 32) {
            { const int r = tid >> 3, cc = (tid & 7) * 4;
              const v2u av = *(const v2u*)(A + (size_t)(tm * 64 + r) * K + k0 + cc), bv = *(const v2u*)(Bt + (size_t)(tn * 64 + r) * K + k0 + cc);
              As[r * 33 + cc] = bflo(av.x); As[r * 33 + cc + 1] = bfhi(av.x); As[r * 33 + cc + 2] = bflo(av.y); As[r * 33 + cc + 3] = bfhi(av.y);
              Bs[r * 33 + cc] = bflo(bv.x); Bs[r * 33 + cc + 1] = bfhi(bv.x); Bs[r * 33 + cc + 2] = bflo(bv.y); Bs[r * 33 + cc + 3] = bfhi(bv.y); }
            __syncthreads();
#pragma unroll 8
            for (int kk = 0; kk < 32; ++kk) { const float x0 = As[(2 * ty) * 33 + kk], x1 = As[(2 * ty + 1) * 33 + kk];
                const f32x4 b = {Bs[(4 * tx) * 33 + kk], Bs[(4 * tx + 1) * 33 + kk], Bs[(4 * tx + 2) * 33 + kk], Bs[(4 * tx + 3) * 33 + kk]};
                a0 += b * x0; a1 += b * x1; }
            __syncthreads();
        }
        f.elem4(tm * 64 + 2 * ty, tn * 64 + 4 * tx, a0); f.elem4(tm * 64 + 2 * ty + 1, tn * 64 + 4 * tx, a1);
    }
}
template <class F> DEV void run_gemm(bool naive, LAS unsigned char* lds, const bf16* A, const bf16* Bt, int M, int N, int K, const F& f, int G, int bid) {
    if (naive) { naive_gemm<F>(lds, A, Bt, M, N, K, f); return; }
    asm volatile("" : "+s"(K));
    pg8::Gemm g{A, Bt, M, N, K, A + K / 2, K}; pg8::StaticOrder S; S.init(M, N, G, bid);
    pg8::EpiW<F> E{f};
    pg8::gemm_phase<pg8::EpiW<F>, pg8::StaticOrder, true, true>((PG8_LAS unsigned char*)lds, g, S, E);
}

template <class F> DEV void run_gemm_i8(LAS unsigned char* lds, const unsigned char* A8, const unsigned char* Bt8, const float* rs, const float* cs, int M, int N, int K, const F& f, int G, int bid) {
    asm volatile("" : "+s"(K));
    pg8::Gemm g{(const bf16*)A8, (const bf16*)Bt8, M, N, K, nullptr, K}; pg8::StaticOrder S; S.init(M, N, G, bid);
    pg8::EpiW8<F> E{f, rs, cs};
    pg8::gemm_phase_i8<pg8::EpiW8<F>, pg8::StaticOrder, GI8_ALIGN, true>((PG8_LAS unsigned char*)lds, g, S, E);
}

DEV void run_gemm_in(LAS unsigned char* lds, const Ctx& c, int skip = 0) {
    int K = D; asm volatile("" : "+s"(K));
    pg8::Gemm g{(const bf16*)c.xq8, (const bf16*)c.WinT8, T, INW, K, nullptr, K}; pg8::StaticOrder S; S.init(T, INW, c.G, c.bid);
    if ((T / 256) * (INW / 256) % c.G == 0) { S.nround = (T / 256) * (INW / 256) / c.G; S.rot = ((c.bid & 7) + 2 * (c.bid >> 6)) % S.nround; }
    pg8::gemm_phase_i8<EpiIn, pg8::StaticOrder, GI8_ALIGN, true>((PG8_LAS unsigned char*)lds, g, S, EpiIn{c.proj, c.xs, c.wcs, c.kmp, c.sst, skip});
}

DEV void phase_kmean_vt(const Ctx& c, unsigned* kcnt) {
    const int gw = c.bid * 8 + c.wave, NGW = c.G * 8, lane = c.lane;
    for (int it = gw; it < 16 * NBLK; it += NGW) { const int bh = it / NBLK, n = it % NBLK, b = bh >> 3, h = bh & 7;
        const bf16* kp = c.proj + (size_t)(b * SEQ + n * BLK + (lane >> 4)) * PST + C_K + h * HD + (lane & 15) * 8;
        float s[8];
#pragma unroll
        for (int i = 0; i < 8; ++i) s[i] = 0.f;
#pragma unroll 8
        for (int r = 0; r < BLK; r += 4) { const v4u w = *(const v4u*)(kp + (size_t)r * PST);
            s[0] += bflo(w.x); s[1] += bfhi(w.x); s[2] += bflo(w.y); s[3] += bfhi(w.y); s[4] += bflo(w.z); s[5] += bfhi(w.z); s[6] += bflo(w.w); s[7] += bfhi(w.w); }
#pragma unroll
        for (int i = 0; i < 8; ++i) { s[i] += __shfl_xor(s[i], 16); s[i] += __shfl_xor(s[i], 32); s[i] *= (1.0f / BLK); }
        if (lane < 16) { float* kd = c.kmean + ((size_t)bh * NBLK + n) * HD + lane * 8; *(f32x4*)kd = (f32x4){s[0], s[1], s[2], s[3]}; *(f32x4*)(kd + 4) = (f32x4){s[4], s[5], s[6], s[7]}; }
        asm volatile("s_waitcnt vmcnt(0)" ::: "memory");
        if (lane == 0) { __builtin_amdgcn_fence(__ATOMIC_RELEASE, "agent"); asm volatile("s_waitcnt vmcnt(0)" ::: "memory"); __hip_atomic_fetch_add(kcnt, 1u, __ATOMIC_RELAXED, __HIP_MEMORY_SCOPE_AGENT); }
    }
}
DEV void sgu_stats(const Ctx& c, LAS float* stats, int t0) {
    const int row = c.tid >> 2, part = c.tid & 3;
    const bf16* vp = c.proj + (size_t)(t0 + row) * PST + C_VG + part * 256;
    float s = 0.f, q = 0.f;
#pragma unroll 4
    for (int i = 0; i < 32; ++i) { const v4u w = *(const v4u*)(vp + i * 8);
        const float e0 = bflo(w.x), e1 = bfhi(w.x), e2 = bflo(w.y), e3 = bfhi(w.y), e4 = bflo(w.z), e5 = bfhi(w.z), e6 = bflo(w.w), e7 = bfhi(w.w);
        s += ((e0 + e1) + (e2 + e3)) + ((e4 + e5) + (e6 + e7)); q += ((e0 * e0 + e1 * e1) + (e2 * e2 + e3 * e3)) + ((e4 * e4 + e5 * e5) + (e6 * e6 + e7 * e7)); }
    s += __shfl_xor(s, 1); s += __shfl_xor(s, 2); q += __shfl_xor(q, 1); q += __shfl_xor(q, 2);
    const float mean = s * (1.0f / 1024.0f), var = fmaxf(q * (1.0f / 1024.0f) - mean * mean, 0.f);
    if (part == 0) { stats[row * 2] = mean; stats[row * 2 + 1] = 1.0f / sqrtf(var + EPS); }
}
DEV void sgu_stats2(const Ctx& c, LAS float* stats, int t0) {
    const int row = c.tid >> 2, j = c.tid & 3;
    const f32x4* sp = (const f32x4*)(c.sst + ((size_t)(t0 + row) * 16 + 4 * j) * 2); const f32x4 a = sp[0], b = sp[1];
    float s = (a.x + a.z) + (b.x + b.z), q = (a.y + a.w) + (b.y + b.w);
    s += dppq<0xB1>(s); s += dppq<0x4E>(s); q += dppq<0xB1>(q); q += dppq<0x4E>(q);
    const float mean = s * (1.0f / 1024.0f), var = fmaxf(q * (1.0f / 1024.0f) - mean * mean, 0.f);
    if (j == 0) { stats[row * 2] = mean; stats[row * 2 + 1] = 1.0f / sqrtf(var + EPS); }
}
constexpr int SG_RS = 320, SG_IMG = 128 * SG_RS, SG_SCR = 32 * 144;
DEV void phase_sgu(const Ctx& c, LAS unsigned char* lds) {
    LAS float* stats = (LAS float*)lds;
    LAS unsigned char* img = lds + 1024;
    LAS unsigned char* scr = lds + 1024 + 2 * SG_IMG + c.wave * SG_SCR;
    const int lane = c.lane, r = lane & 31, hh = lane >> 5, wave = c.wave, tid = c.tid;
    const int mt = wave >> 1, cw = wave & 1, nks = 2 * (mt + 1);
    const int srow = tid >> 4, sch = (tid & 15) * 8;
    const int erow = lane >> 3, ech = cw * 64 + (lane & 7) * 8;
    const unsigned troff = (unsigned)(size_t)img + (unsigned)((8 * hh + ((lane & 15) >> 2)) * SG_RS + (cw * 64 + 16 * ((lane >> 4) & 1) + 4 * (lane & 3)) * 2);
#define SG_LOADVG(V, LG, LB, G_) do { _Pragma("unroll") for (int q = 0; q < 4; ++q) V[q] = *(const v4u*)(c.proj + (size_t)(t0 + srow + 32 * q) * PST + C_VG + (G_) * 128 + sch); \
        LG[0] = *(const f32x4*)(c.ln_g + (G_) * 128 + sch); LG[1] = *(const f32x4*)(c.ln_g + (G_) * 128 + sch + 4); LB[0] = *(const f32x4*)(c.ln_b + (G_) * 128 + sch); LB[1] = *(const f32x4*)(c.ln_b + (G_) * 128 + sch + 4); } while (0)
#define SG_LOADOPS(AF, UU, BI, G_) do { _Pragma("unroll") for (int ks = 0; ks < 8; ++ks) if (ks < nks) AF[ks] = *(const v4u*)(c.swb + ((size_t)((G_) * 128 + 32 * mt + r)) * 128 + 16 * ks + 8 * hh); \
        _Pragma("unroll") for (int j = 0; j < 4; ++j) UU[j] = *(const v4u*)(c.proj + (size_t)(t0 + 32 * mt + erow + 8 * j) * PST + C_U + (G_) * 128 + ech); \
        BI = c.sgu_b[(G_) * 128 + 32 * mt + r]; } while (0)
#define SG_STAGE(V, LG, LB, BUF) do { LAS unsigned char* ib = img + (BUF) * SG_IMG; \
        const float gg[8] = {LG[0].x, LG[0].y, LG[0].z, LG[0].w, LG[1].x, LG[1].y, LG[1].z, LG[1].w}, bbv[8] = {LB[0].x, LB[0].y, LB[0].z, LB[0].w, LB[1].x, LB[1].y, LB[1].z, LB[1].w}; \
        _Pragma("unroll") for (int q = 0; q < 4; ++q) { const int row = srow + 32 * q; const float mean = stats[2 * row], rstd = stats[2 * row + 1]; const v4u w = V[q]; \
            const float e[8] = {bflo(w.x), bfhi(w.x), bflo(w.y), bfhi(w.y), bflo(w.z), bfhi(w.z), bflo(w.w), bfhi(w.w)}; float y[8]; \
            _Pragma("unroll") for (int i = 0; i < 8; ++i) y[i] = (e[i] - mean) * rstd * gg[i] + bbv[i]; \
            *(LAS v4u*)(ib + row * SG_RS + sch * 2) = (v4u){pkbf(y[0], y[1]), pkbf(y[2], y[3]), pkbf(y[4], y[5]), pkbf(y[6], y[7])}; } } while (0)
#define SG_BAR asm volatile("s_waitcnt lgkmcnt(0)\n\ts_barrier" ::: "memory")
    for (int unit = c.bid; unit < 256; unit += c.G) {
        const int chunk = unit >> 1, gh = unit & 1, t0 = chunk * 128, g0 = gh * 4;
        __syncthreads();
        v4u vgN[4]; f32x4 lgN[2], lbN[2];
        v4u afN[8], uuN[4]; float biasN;
        SG_LOADVG(vgN, lgN, lbN, g0);
        SG_LOADOPS(afN, uuN, biasN, g0);
        sgu_stats2(c, stats, t0);
        __syncthreads();
        SG_STAGE(vgN, lgN, lbN, 0);
        SG_BAR;
#pragma unroll 1
        for (int gi = 0; gi < 4; ++gi) { const int g = g0 + gi, buf = gi & 1;
            v4u af[8], uu[4]; const float bias = biasN;
#pragma unroll
            for (int ks = 0; ks < 8; ++ks) af[ks] = afN[ks];
#pragma unroll
            for (int j = 0; j < 4; ++j) uu[j] = uuN[j];
            if (gi < 3) { SG_LOADVG(vgN, lgN, lbN, g + 1); SG_LOADOPS(afN, uuN, biasN, g + 1); }
            f32x16 acc0, acc1;
#pragma unroll
            for (int i = 0; i < 16; ++i) { acc0[i] = 0.f; acc1[i] = 0.f; }
#pragma unroll
            for (int ks = 0; ks < 8; ++ks) if (ks < nks) {
                const unsigned ad = troff + (unsigned)(buf * SG_IMG + 16 * ks * SG_RS);
                v2u b00, b01, b10, b11;
                asm volatile("ds_read_b64_tr_b16 %0, %4\n\tds_read_b64_tr_b16 %1, %4 offset:1280\n\tds_read_b64_tr_b16 %2, %4 offset:64\n\tds_read_b64_tr_b16 %3, %4 offset:1344\n\ts_waitcnt lgkmcnt(0)"
                             : "=&v"(b00), "=&v"(b01), "=&v"(b10), "=&v"(b11) : "v"(ad) : "memory");
                const bf16x8 a = __builtin_bit_cast(bf16x8, af[ks]);
                acc0 = MFMA32(__builtin_bit_cast(bf16x8, ((v4u){b00.x, b00.y, b01.x, b01.y})), a, acc0);
                acc1 = MFMA32(__builtin_bit_cast(bf16x8, ((v4u){b10.x, b10.y, b11.x, b11.y})), a, acc1); }
#pragma unroll
            for (int k = 0; k < 4; ++k) {
                *(LAS v2u*)(scr + r * 144 + (8 * k + 4 * hh) * 2) = (v2u){pkbf(acc0[4 * k] + bias, acc0[4 * k + 1] + bias), pkbf(acc0[4 * k + 2] + bias, acc0[4 * k + 3] + bias)};
                *(LAS v2u*)(scr + r * 144 + (32 + 8 * k + 4 * hh) * 2) = (v2u){pkbf(acc1[4 * k] + bias, acc1[4 * k + 1] + bias), pkbf(acc1[4 * k + 2] + bias, acc1[4 * k + 3] + bias)}; }
            asm volatile("s_waitcnt lgkmcnt(0)" ::: "memory");
#pragma unroll
            for (int j = 0; j < 4; ++j) { const int row = erow + 8 * j; const v4u mx = *(const LAS v4u*)(scr + row * 144 + (lane & 7) * 16); const v4u u = uu[j];
                v4u o; o.x = pkbf(bflo(u.x) * bflo(mx.x), bfhi(u.x) * bfhi(mx.x)); o.y = pkbf(bflo(u.y) * bflo(mx.y), bfhi(u.y) * bfhi(mx.y));
                o.z = pkbf(bflo(u.z) * bflo(mx.z), bfhi(u.z) * bfhi(mx.z)); o.w = pkbf(bflo(u.w) * bflo(mx.w), bfhi(u.w) * bfhi(mx.w));
                *(v4u*)(c.ysgu + (size_t)(t0 + 32 * mt + row) * 1024 + g * 128 + ech) = o; }
            asm volatile("s_waitcnt lgkmcnt(0)" ::: "memory");
            if (gi < 3) SG_STAGE(vgN, lgN, lbN, (gi + 1) & 1);
            SG_BAR;
        }
    }
#undef SG_LOADVG
#undef SG_LOADOPS
#undef SG_STAGE
#undef SG_BAR
}
DEV void naive_sgu(const Ctx& c, LAS unsigned char* lds) {
    LAS float* stats = (LAS float*)lds;
    for (int chunk = c.bid; chunk < 128; chunk += c.G) { const int t0 = chunk * 128;
        __syncthreads(); sgu_stats(c, stats, t0); __syncthreads();
        for (int o = c.tid; o < 128 * 1024; o += NTHREADS) { const int tl = o >> 10, f = o & 1023, g = f >> 7;
            float acc = 0.f;
            for (int s = 0; s <= tl; ++s) { const float v = bf2f(c.proj[(size_t)(t0 + s) * PST + C_VG + f]); const float y = (v - stats[2 * s]) * stats[2 * s + 1] * c.ln_g[f] + c.ln_b[f];
                acc += c.sgu_w[((size_t)g * 128 + tl) * 128 + s] * y; }
            acc += c.sgu_b[g * 128 + tl];
            c.ysgu[(size_t)(t0 + tl) * 1024 + f] = (bf16)(pkbf(bf2f(c.proj[(size_t)(t0 + tl) * PST + C_U + f]) * acc, 0.f) & 0xffff); }
    }
}

DEV void insert3(float v, int n, float& v1, float& v2, float& v3, int& i1, int& i2, int& i3) {
    const bool b1 = v > v1, b2 = v > v2, b3 = v > v3;
    v3 = b2 ? v2 : (b3 ? v : v3); i3 = b2 ? i2 : (b3 ? n : i3);
    v2 = b1 ? v1 : (b2 ? v : v2); i2 = b1 ? i1 : (b2 ? n : i2);
    v1 = b1 ? v : v1; i1 = b1 ? n : i1;
}
constexpr int VT_STRIDE = 520;
constexpr float ATT_C = 0.08838834764831845f * 1.4426950408889634f;
DEV void phase_select(const Ctx& c, unsigned* kcnt) {
    const int lane = c.lane, r = lane & 31, hh = lane >> 5, gw = c.bid * 8 + c.wave, NGW = c.G * 8;
    for (int wt = gw; wt < 16 * NBLK * 8; wt += NGW) {
        const int bh = wt >> 8, j = (wt >> 3) & 31, w = wt & 7, b = bh >> 3, h = bh & 7;
        const int q = j * BLK + 32 * w + r;
        int i1 = -1, i2 = -1, i3 = -1;
        if (j > 0) {
            const bf16* qrow = c.proj + ((size_t)b * SEQ + q) * PST + C_Q + h * HD;
            f32x16 g;
#pragma unroll
            for (int i = 0; i < 16; ++i) g[i] = 0.f;
            const float* km = c.kmp + ((size_t)bh * NBLK + r) * HD; const float* km1 = km + 16 * NBLK * HD;
#pragma unroll
            for (int ks = 0; ks < 8; ++ks) { const bf16x8 qf = *(const bf16x8*)(qrow + 16 * ks + 8 * hh);
                const f32x4 ka = *(const f32x4*)(km + 16 * ks + 8 * hh) + *(const f32x4*)(km1 + 16 * ks + 8 * hh), kb = *(const f32x4*)(km + 16 * ks + 8 * hh + 4) + *(const f32x4*)(km1 + 16 * ks + 8 * hh + 4);
                v4u hi; hi.x = pkbf(ka.x, ka.y); hi.y = pkbf(ka.z, ka.w); hi.z = pkbf(kb.x, kb.y); hi.w = pkbf(kb.z, kb.w);
                v4u lo; lo.x = pkbf(ka.x - bflo(hi.x), ka.y - bfhi(hi.x)); lo.y = pkbf(ka.z - bflo(hi.y), ka.w - bfhi(hi.y)); lo.z = pkbf(kb.x - bflo(hi.z), kb.y - bfhi(hi.z)); lo.w = pkbf(kb.z - bflo(hi.w), kb.w - bfhi(hi.w));
                g = MFMA32(__builtin_bit_cast(bf16x8, hi), qf, g); g = MFMA32(__builtin_bit_cast(bf16x8, lo), qf, g); }
            float v1 = -INFINITY, v2 = -INFINITY, v3 = -INFINITY; int a1 = 0, a2 = 0, a3 = 0;
#pragma unroll
            for (int i = 0; i < 16; ++i) { const int n = crow(i, hh); const float v = (n < j) ? g[i] : -INFINITY; insert3(v, n, v1, v2, v3, a1, a2, a3); }
            const float pv1 = __shfl_xor(v1, 32), pv2 = __shfl_xor(v2, 32), pv3 = __shfl_xor(v3, 32); const int pi1 = __shfl_xor(a1, 32), pi2 = __shfl_xor(a2, 32), pi3 = __shfl_xor(a3, 32);
            insert3(pv1, pi1, v1, v2, v3, a1, a2, a3); insert3(pv2, pi2, v1, v2, v3, a1, a2, a3); insert3(pv3, pi3, v1, v2, v3, a1, a2, a3);
            i1 = v1 > -INFINITY ? a1 : -1; i2 = v2 > -INFINITY ? a2 : -1; i3 = v3 > -INFINITY ? a3 : -1;
        }
        if (hh == 0) *(int4*)(c.sel + ((size_t)bh * SEQ + q) * 4) = make_int4(i1, i2, i3, -1);
    }
}
struct AttItem { unsigned char n, jlo, jhi, own; };
#if ATT_FINE
constexpr int NATT_ITEMS = 58;
__device__ const AttItem ATT_ITEMS[NATT_ITEMS] = {{2,3,6,1}, {0,3,7,0}, {2,13,32,0}, {1,2,4,1}, {0,1,3,1}, {7,8,15,1}, {3,4,7,1}, {0,14,32,0}, {17,18,32,1}, {2,6,13,0}, {3,7,15,0}, {8,9,15,1}, {18,19,32,1}, {8,15,32,0}, {7,15,32,0}, {3,15,32,0}, {1,15,32,0}, {4,5,8,1}, {1,4,8,0}, {9,10,16,1}, {0,7,14,0}, {19,20,32,1}, {4,8,16,0}, {9,16,32,0}, {4,16,32,0}, {10,11,17,1}, {5,6,9,1}, {20,21,32,1}, {11,12,18,1}, {5,9,17,0}, {1,8,15,0}, {10,17,32,0}, {5,17,32,0}, {12,13,19,1}, {21,22,32,1}, {6,7,10,1}, {6,10,18,0}, {11,18,32,0}, {6,18,32,0}, {22,23,32,1}, {13,14,19,1}, {14,15,20,1}, {23,24,32,1}, {13,19,32,0}, {12,19,32,0}, {24,25,32,1}, {15,16,20,1}, {15,20,32,0}, {14,20,32,0}, {16,17,21,1}, {25,26,32,1}, {16,21,32,0}, {26,27,32,1}, {27,28,32,1}, {28,29,32,1}, {29,30,32,1}, {30,31,32,1}, {31,32,32,1}};
#else
constexpr int NATT_ITEMS = 44;
__device__ const AttItem ATT_ITEMS[NATT_ITEMS] = {{9,10,32,1}, {10,11,32,1}, {11,12,32,1}, {0,1,4,1}, {3,4,10,1}, {3,10,32,0}, {4,5,12,1}, {12,13,32,1}, {1,2,5,1}, {0,11,32,0}, {13,14,32,1}, {0,4,11,0}, {5,6,13,1}, {2,3,6,1}, {14,15,32,1}, {4,12,32,0}, {1,12,32,0}, {6,7,14,1}, {15,16,32,1}, {1,5,12,0}, {5,13,32,0}, {2,13,32,0}, {7,8,15,1}, {16,17,32,1}, {6,14,32,0}, {17,18,32,1}, {2,6,13,0}, {8,9,15,1}, {18,19,32,1}, {8,15,32,0}, {7,15,32,0}, {19,20,32,1}, {20,21,32,1}, {21,22,32,1}, {22,23,32,1}, {23,24,32,1}, {24,25,32,1}, {25,26,32,1}, {26,27,32,1}, {27,28,32,1}, {28,29,32,1}, {29,30,32,1}, {30,31,32,1}, {31,32,32,1}};
#endif
constexpr int ATT_LIST_OFF = 65536 + 128 * VT_STRIDE;
constexpr int ATT_LIST_CAP = 2048;
DEV void quant_tables(const Ctx& c, int row0, int row1, int step, int first, LAS unsigned char* scr);
constexpr int NQUANT_ITEMS = 2 * NEXP / 128, NQMIX = 2 * NEXP / 64;
DEV void phase_attn(const Ctx& c, LAS unsigned char* lds, unsigned* qctr, bool skip_compute = false, bool skip_quant = false) {
    LAS unsigned char* Kl = lds;
    LAS unsigned char* Vl = lds + 65536;
    LAS unsigned* list = (LAS unsigned*)(lds + ATT_LIST_OFF);
    LAS unsigned* lctl = list + ATT_LIST_CAP;
    const int tid = c.tid, lane = c.lane, wave = c.wave, r = lane & 31, hh = lane >> 5;
    bf16* partO = (bf16*)c.out;
    for (;;) {
        __syncthreads();
        if (tid == 0) lctl[1] = atomicAdd(qctr, 1u);
        __syncthreads();
        const int item = (int)lctl[1];
        if (item >= NATT_ITEMS * 16 + (ATT_MIX ? NQMIX : NQUANT_ITEMS)) break;
#if QUANT_FIRST
        if (item < NQUANT_ITEMS) { const int r0 = item * 128; quant_tables(c, r0, r0 + 128, 8, wave, lds + wave * 2048); continue; }
        const int aitem = item - NQUANT_ITEMS;
#else
#if ATT_MIX
        int aitem;
        if (item < 2 * NQMIX) { if (item & 1) { const int r0 = (item >> 1) * 64; if (!skip_quant) quant_tables(c, r0, r0 + 64, 8, wave, lds + wave * 2048); continue; } aitem = item >> 1; }
        else aitem = item - NQMIX;
#else
        if (item >= NATT_ITEMS * 16) { const int r0 = (item - NATT_ITEMS * 16) * 128; if (!skip_quant) quant_tables(c, r0, r0 + 128, 8, wave, lds + wave * 2048); continue; }
        const int aitem = item;
#endif
#endif
        const AttItem it = ATT_ITEMS[aitem >> 4]; const int bh = aitem & 15, n = it.n, b = bh >> 3, h = bh & 7;
        const size_t tb = (size_t)b * SEQ;
        { const bf16* kg = c.proj + (tb + (size_t)n * BLK) * PST + C_K + h * HD; const bf16* vg = c.proj + (tb + (size_t)n * BLK) * PST + C_V + h * HD;
#pragma unroll 1
          for (int qb = 0; qb < 8; qb += 4) {
              v4u kv[4], vv[4];
#pragma unroll
              for (int q = 0; q < 4; ++q) { const int ch = tid + NTHREADS * (qb + q); kv[q] = *(const v4u*)(kg + (size_t)(ch >> 4) * PST + (ch & 15) * 8); vv[q] = *(const v4u*)(vg + (size_t)(ch & 255) * PST + (ch >> 8) * 8); }
#pragma unroll
              for (int q = 0; q < 4; ++q) { const int ch = tid + NTHREADS * (qb + q); const int key = ch >> 4, c16 = ch & 15;
                  *(LAS v4u*)(Kl + key * 256 + ((c16 ^ (key & 15)) << 4)) = kv[q];
                  const int vk = ch & 255, dc = ch >> 8; LAS unsigned char* vp = Vl + (8 * dc) * VT_STRIDE + vk * 2;
                  const unsigned ww[4] = {vv[q].x, vv[q].y, vv[q].z, vv[q].w};
#pragma unroll
                  for (int i = 0; i < 4; ++i) { *(LAS bf16*)(vp + (2 * i) * VT_STRIDE) = (bf16)(ww[i] & 0xffffu); *(LAS bf16*)(vp + (2 * i + 1) * VT_STRIDE) = (bf16)(ww[i] >> 16); } } } }
        const int qlo = it.jlo * BLK, qhi = it.jhi * BLK;
        bool own_pending = it.own != 0;
        for (int cq = qlo; cq < qhi || own_pending; cq += ATT_LIST_CAP) {
            __syncthreads();
            if (tid == 0) lctl[0] = 0u;
            __syncthreads();
            const int cend = (cq + ATT_LIST_CAP < qhi) ? cq + ATT_LIST_CAP : qhi;
            for (int q = cq + tid; q < cend; q += NTHREADS) {
                const int4 s4 = *(const int4*)(c.sel + ((size_t)bh * SEQ + q) * 4);
                const int slot = (s4.x == n) ? 0 : ((s4.y == n) ? 1 : ((s4.z == n) ? 2 : -1));
                if (slot >= 0) { const unsigned pos = __hip_atomic_fetch_add(lctl, 1u, __ATOMIC_RELAXED, __HIP_MEMORY_SCOPE_WORKGROUP); list[pos] = (unsigned)q | ((unsigned)slot << 16); }
            }
            __syncthreads();
            const int len = (int)lctl[0];
            const int nown = own_pending ? 8 : 0, ngroups = nown + ((len + 31) >> 5);
            for (int gi = wave; gi < (skip_compute ? 0 : ngroups); gi += 8) {
                const bool own = gi < nown;
                int q, slot; bool valid = true;
                if (own) { q = n * BLK + 32 * gi + r; slot = 3; }
                else { const int li = 32 * (gi - nown) + r; valid = li < len; const unsigned e = list[valid ? li : 32 * (gi - nown)]; q = (int)(e & 0xffffu); slot = (int)(e >> 16); }
                const int qloc = 32 * gi + r;
                const bf16* qrow = c.proj + (tb + q) * PST + C_Q + h * HD;
                bf16x8 qf[8];
#pragma unroll
                for (int ks = 0; ks < 8; ++ks) qf[ks] = *(const bf16x8*)(qrow + 16 * ks + 8 * hh);
                float m = -INFINITY, l = 0.f;
                f32x16 o[4];
#pragma unroll
                for (int dt = 0; dt < 4; ++dt)
#pragma unroll
                    for (int i = 0; i < 16; ++i) o[dt][i] = 0.f;
                const int nsteps = own ? ((gi >> 1) + 1) : 4;
                for (int st = 0; st < nsteps; ++st) {
                    f32x16 s0, s1;
#pragma unroll
                    for (int i = 0; i < 16; ++i) { s0[i] = 0.f; s1[i] = 0.f; }
                    const int kr0 = 64 * st + r, kr1 = kr0 + 32;
#pragma unroll
                    for (int ks = 0; ks < 8; ++ks) { const int c16 = 2 * ks + hh;
                        const bf16x8 a0 = *(const LAS bf16x8*)(Kl + kr0 * 256 + ((c16 ^ (kr0 & 15)) << 4)), a1 = *(const LAS bf16x8*)(Kl + kr1 * 256 + ((c16 ^ (kr1 & 15)) << 4));
                        s0 = MFMA32(a0, qf[ks], s0); s1 = MFMA32(a1, qf[ks], s1); }
                    float mx = -INFINITY;
                    if (own) {
#pragma unroll
                        for (int i = 0; i < 16; ++i) { const int k0 = 64 * st + crow(i, hh), k1 = k0 + 32;
                            s0[i] = (k0 <= qloc) ? s0[i] * ATT_C : -INFINITY; s1[i] = (k1 <= qloc) ? s1[i] * ATT_C : -INFINITY; mx = fmaxf(mx, fmaxf(s0[i], s1[i])); }
                    } else {
#pragma unroll
                        for (int i = 0; i < 16; ++i) { s0[i] *= ATT_C; s1[i] *= ATT_C; mx = fmaxf(mx, fmaxf(s0[i], s1[i])); }
                    }
                    mx = fmaxf(mx, __shfl_xor(mx, 32));
                    const float mn = fmaxf(m, mx);
                    const float alpha = __builtin_amdgcn_exp2f(m - mn);
                    float ps = 0.f;
#pragma unroll
                    for (int i = 0; i < 16; ++i) { s0[i] = __builtin_amdgcn_exp2f(s0[i] - mn); s1[i] = __builtin_amdgcn_exp2f(s1[i] - mn); ps += s0[i] + s1[i]; }
                    l = l * alpha + ps; m = mn;
                    if (__any(alpha != 1.0f)) {
#pragma unroll
                        for (int dt = 0; dt < 4; ++dt)
#pragma unroll
                            for (int i = 0; i < 16; ++i) o[dt][i] *= alpha;
                    }
                    bf16x8 pf[2][2];
#pragma unroll
                    for (int s = 0; s < 2; ++s) {
                        v4u w0, w1;
                        w0.x = pkbf(s0[8 * s + 0], s0[8 * s + 1]); w0.y = pkbf(s0[8 * s + 2], s0[8 * s + 3]); w0.z = pkbf(s0[8 * s + 4], s0[8 * s + 5]); w0.w = pkbf(s0[8 * s + 6], s0[8 * s + 7]);
                        w1.x = pkbf(s1[8 * s + 0], s1[8 * s + 1]); w1.y = pkbf(s1[8 * s + 2], s1[8 * s + 3]); w1.z = pkbf(s1[8 * s + 4], s1[8 * s + 5]); w1.w = pkbf(s1[8 * s + 6], s1[8 * s + 7]);
                        pf[0][s] = __builtin_bit_cast(bf16x8, w0); pf[1][s] = __builtin_bit_cast(bf16x8, w1); }
#pragma unroll
                    for (int dt = 0; dt < 4; ++dt)
#pragma unroll
                        for (int kt = 0; kt < 2; ++kt)
#pragma unroll
                            for (int s = 0; s < 2; ++s) {
                                const LAS unsigned char* vp = Vl + (32 * dt + r) * VT_STRIDE + (64 * st + 32 * kt + 16 * s + 4 * hh) * 2;
                                const v2u lo = *(const LAS v2u*)vp, hi = *(const LAS v2u*)(vp + 16);
                                const v4u vw = {lo.x, lo.y, hi.x, hi.y};
                                o[dt] = MFMA32(__builtin_bit_cast(bf16x8, vw), pf[kt][s], o[dt]); }
                }
                l += __shfl_xor(l, 32);
                const float inv = 1.0f / l;
                if (valid) {
                    const size_t pidx = ((size_t)bh * SEQ + q) * 4 + slot;
                    bf16* yp = partO + pidx * HD;
#pragma unroll
                    for (int dt = 0; dt < 4; ++dt)
#pragma unroll
                        for (int g4 = 0; g4 < 4; ++g4) { v2u w; w.x = pkbf(o[dt][4 * g4] * inv, o[dt][4 * g4 + 1] * inv); w.y = pkbf(o[dt][4 * g4 + 2] * inv, o[dt][4 * g4 + 3] * inv);
                            *(v2u*)(yp + 32 * dt + 8 * g4 + 4 * hh) = w; }
                    if (hh == 0) c.lse[pidx] = m + __builtin_amdgcn_logf(l);
                }
            }
            own_pending = false;
        }
    }
}
DEV void phase_attn_combine(const Ctx& c) {
    const int lane = c.lane, gw = c.bid * 8 + c.wave, NGW = c.G * 8, h = lane >> 3, sub = lane & 7;
    const bf16* partO = (const bf16*)c.out;
    for (int t = gw; t < T; t += NGW) {
        const int b = t / SEQ, q = t % SEQ; const size_t pbase = ((size_t)(b * NH + h) * SEQ + q) * 4;
        const int4 s4 = *(const int4*)(c.sel + pbase); const f32x4 L = *(const f32x4*)(c.lse + pbase);
        const float l0 = s4.x >= 0 ? L.x : -INFINITY, l1 = s4.y >= 0 ? L.y : -INFINITY, l2 = s4.z >= 0 ? L.z : -INFINITY, l3 = L.w;
        const float M = fmaxf(fmaxf(l0, l1), fmaxf(l2, l3));
        const float w0 = __builtin_amdgcn_exp2f(l0 - M), w1 = __builtin_amdgcn_exp2f(l1 - M), w2 = __builtin_amdgcn_exp2f(l2 - M), w3 = __builtin_amdgcn_exp2f(l3 - M);
        const float winv = 1.0f / (w0 + w1 + w2 + w3);
        const float ws[4] = {w0 * winv, w1 * winv, w2 * winv, w3 * winv};
        float acc[16];
#pragma unroll
        for (int i = 0; i < 16; ++i) acc[i] = 0.f;
#pragma unroll
        for (int s = 0; s < 4; ++s) { if (ws[s] != 0.f) { const v4u a = *(const v4u*)(partO + (pbase + s) * HD + 16 * sub), bq = *(const v4u*)(partO + (pbase + s) * HD + 16 * sub + 8); const float w = ws[s];
            acc[0] += w * bflo(a.x); acc[1] += w * bfhi(a.x); acc[2] += w * bflo(a.y); acc[3] += w * bfhi(a.y); acc[4] += w * bflo(a.z); acc[5] += w * bfhi(a.z); acc[6] += w * bflo(a.w); acc[7] += w * bfhi(a.w);
            acc[8] += w * bflo(bq.x); acc[9] += w * bfhi(bq.x); acc[10] += w * bflo(bq.y); acc[11] += w * bfhi(bq.y); acc[12] += w * bflo(bq.z); acc[13] += w * bfhi(bq.z); acc[14] += w * bflo(bq.w); acc[15] += w * bfhi(bq.w); } }
        v4u o0, o1; o0.x = pkbf(acc[0], acc[1]); o0.y = pkbf(acc[2], acc[3]); o0.z = pkbf(acc[4], acc[5]); o0.w = pkbf(acc[6], acc[7]); o1.x = pkbf(acc[8], acc[9]); o1.y = pkbf(acc[10], acc[11]); o1.z = pkbf(acc[12], acc[13]); o1.w = pkbf(acc[14], acc[15]);
        bf16* yp = c.yatt + (size_t)t * 1024 + h * HD + 16 * sub; *(v4u*)yp = o0; *(v4u*)(yp + 8) = o1;
    }
}
DEV void naive_attn(const Ctx& c, LAS unsigned char* lds) {
    LAS float* qs = (LAS float*)(lds + c.wave * 5120);
    LAS float* sc = qs + 128;
    const int lane = c.lane, gw = c.bid * 8 + c.wave, NGW = c.G * 8;
    for (int idx = gw; idx < 16 * SEQ; idx += NGW) {
        const int bh = idx / SEQ, sq = idx % SEQ, j = sq / BLK, b = bh >> 3, h = bh & 7; const size_t tb = (size_t)b * SEQ;
        const unsigned qw = *(const unsigned*)(c.proj + (tb + sq) * PST + C_Q + h * HD + 2 * lane);
        const float qa = bflo(qw), qb = bfhi(qw);
        qs[2 * lane] = qa; qs[2 * lane + 1] = qb;
        float v1 = -INFINITY, v2 = -INFINITY, v3 = -INFINITY; int i1 = 0, i2 = 0, i3 = 0;
        for (int n = 0; n < j; ++n) { const f32x2 km = *(const f32x2*)(c.kmean + ((size_t)bh * NBLK + n) * HD + 2 * lane); const float g = wave_sum(qa * km.x + qb * km.y); insert3(g, n, v1, v2, v3, i1, i2, i3); }
        const int nsel = j < 3 ? j : 3;
        asm volatile("s_waitcnt lgkmcnt(0)" ::: "memory");
        float mx = -INFINITY;
        for (int bi = 0; bi <= nsel; ++bi) { const int n = (bi == nsel) ? j : (bi == 0 ? i1 : (bi == 1 ? i2 : i3));
            for (int kk = lane; kk < BLK; kk += 64) { const int kpos = n * BLK + kk; float s = -INFINITY;
                if (kpos <= sq) { const bf16* kp = c.proj + (tb + kpos) * PST + C_K + h * HD; float a = 0.f;
                    for (int d = 0; d < HD; d += 2) { const unsigned w = *(const unsigned*)(kp + d); a += qs[d] * bflo(w) + qs[d + 1] * bfhi(w); }
                    s = a * 0.08838834764831845f; }
                sc[bi * BLK + kk] = s; mx = fmaxf(mx, s); } }
#pragma unroll
        for (int o = 1; o < 64; o <<= 1) mx = fmaxf(mx, __shfl_xor(mx, o));
        asm volatile("s_waitcnt lgkmcnt(0)" ::: "memory");
        float sum = 0.f, oa = 0.f, ob = 0.f;
        for (int bi = 0; bi <= nsel; ++bi) { const int n = (bi == nsel) ? j : (bi == 0 ? i1 : (bi == 1 ? i2 : i3));
            for (int kk = 0; kk < BLK; ++kk) { const float pz = __expf(sc[bi * BLK + kk] - mx); if (pz == 0.f) continue;
                const unsigned w = *(const unsigned*)(c.proj + (tb + n * BLK + kk) * PST + C_V + h * HD + 2 * lane); sum += pz; oa += pz * bflo(w); ob += pz * bfhi(w); } }
        *(unsigned*)(c.yatt + (tb + sq) * 1024 + h * HD + 2 * lane) = pkbf(oa / sum, ob / sum);
    }
}


DEV void phase_final(const Ctx& c) {
    const int gw = c.bid * 8 + c.wave, NGW = c.G * 8, lane = c.lane;
    const f32x4* gr = (const f32x4*)c.g_fin + lane;
    v2u vn[8]; int m = gw;
    if (m < T) { const v2u* xr = (const v2u*)(c.h2b + (size_t)m * D) + lane;
#pragma unroll
        for (int j = 0; j < 8; ++j) vn[j] = xr[64 * j]; }
    for (; m < T; m += NGW) {
        f32x4 v[8]; float s = 0.f;
#pragma unroll
        for (int j = 0; j < 8; ++j) { v[j] = (f32x4){bflo(vn[j].x), bfhi(vn[j].x), bflo(vn[j].y), bfhi(vn[j].y)}; s += (v[j].x * v[j].x + v[j].y * v[j].y) + (v[j].z * v[j].z + v[j].w * v[j].w); }
        { const int mn = m + NGW < T ? m + NGW : m; const v2u* xn_ = (const v2u*)(c.h2b + (size_t)mn * D) + lane;
#pragma unroll
          for (int j = 0; j < 8; ++j) vn[j] = xn_[64 * j]; }
        const float r = 1.0f / sqrtf(wsum_q(s) * (1.0f / D) + EPS);
        f32x4* xr = (f32x4*)(c.out + (size_t)m * D) + lane;
#pragma unroll
        for (int j = 0; j < 8; ++j) xr[64 * j] = v[j] * r * gr[64 * j];
    }
}

DEV unsigned f2key(float f) { const unsigned u = __float_as_uint(f); return u ^ ((unsigned)((int)u >> 31) | 0x80000000u); }
DEV float key2f(unsigned k) { const unsigned u = (k & 0x80000000u) ? (k ^ 0x80000000u) : ~k; return __uint_as_float(u); }
#define TK_INSERT(L, key) do { unsigned _k = (key); _Pragma("unroll") for (int _j = 0; _j < 16; ++_j) { const unsigned _hi = max(L[_j], _k); _k = min(L[_j], _k); L[_j] = _hi; } } while (0)
#define TK_MERGE(a, b) do { _Pragma("unroll") for (int _i = 0; _i < 16; ++_i) a[_i] = max(a[_i], b[15 - _i]); \
    _Pragma("unroll") for (int _st = 8; _st >= 1; _st >>= 1) { _Pragma("unroll") for (int _i = 0; _i < 16; ++_i) if ((_i & _st) == 0) { const unsigned _x = max(a[_i], a[_i + _st]), _y = min(a[_i], a[_i + _st]); a[_i] = _x; a[_i + _st] = _y; } } } while (0)
#define TK_SORT16(a) do { _Pragma("unroll") for (int _k = 2; _k <= 16; _k <<= 1) { _Pragma("unroll") for (int _j = _k >> 1; _j > 0; _j >>= 1) { _Pragma("unroll") for (int _i = 0; _i < 16; ++_i) { const int _l = _i ^ _j; \
    if (_l > _i) { const unsigned _x = max(a[_i], a[_l]), _y = min(a[_i], a[_l]); if ((_i & _k) == 0) { a[_i] = _x; a[_l] = _y; } else { a[_i] = _y; a[_l] = _x; } } } } } } while (0)
DEV void peer_topk_task(const Ctx& c, int tg, int h) {
    const int lane = c.lane, r = lane & 31, hh = lane >> 5;
    {
        const int tok = tg * 32 + r;
        unsigned LA[16], LB[16];
#pragma unroll
        for (int p = 0; p < 2; ++p) {
            const bf16* qrow = c.qp + (size_t)tok * D + h * 256 + p * 128;
            bf16x8 qf[8];
#pragma unroll
            for (int ks = 0; ks < 8; ++ks) qf[ks] = *(const bf16x8*)(qrow + 16 * ks + 8 * hh);
            unsigned L[16];
            const bf16* skp = c.skb + ((size_t)(h * 2 + p) * 128) * 128;
            bf16x8 an[8];
#pragma unroll
            for (int ks = 0; ks < 8; ++ks) an[ks] = *(const bf16x8*)(skp + (size_t)r * 128 + 16 * ks + 8 * hh);
#pragma unroll 1
            for (int nt = 0; nt < 4; ++nt) {
                f32x16 s;
#pragma unroll
                for (int i = 0; i < 16; ++i) s[i] = 0.f;
                bf16x8 ac[8];
#pragma unroll
                for (int ks = 0; ks < 8; ++ks) ac[ks] = an[ks];
                { const int ntn = nt < 3 ? nt + 1 : 3;
#pragma unroll
                  for (int ks = 0; ks < 8; ++ks) an[ks] = *(const bf16x8*)(skp + (size_t)(32 * ntn + r) * 128 + 16 * ks + 8 * hh); }
#pragma unroll
                for (int ks = 0; ks < 8; ++ks) s = MFMA32(ac[ks], qf[ks], s);
                unsigned Tl[16];
#pragma unroll
                for (int i = 0; i < 16; ++i) Tl[i] = (f2key(s[i]) & ~0x7Fu) | (unsigned)(32 * nt + crow(i, hh));
                TK_SORT16(Tl);
                if (nt == 0) {
#pragma unroll
                    for (int i = 0; i < 16; ++i) L[i] = Tl[i];
                } else { TK_MERGE(L, Tl); }
            }
            unsigned PL[16];
#pragma unroll
            for (int i = 0; i < 16; ++i) PL[i] = (unsigned)__shfl_xor((int)L[i], 32);
            TK_MERGE(L, PL);
#pragma unroll
            for (int i = 0; i < 16; ++i) { if (p == 0) LA[i] = L[i]; else LB[i] = L[i]; }
        }
        float va[16], vb[16];
#pragma unroll
        for (int i = 0; i < 16; ++i) { va[i] = key2f(LA[i] & ~0x7Fu); vb[i] = key2f(LB[i] & ~0x7Fu); }
        unsigned CL[16];
#pragma unroll
        for (int i = 0; i < 16; ++i) CL[i] = 0u;
#pragma unroll
        for (int i = 0; i < 16; ++i)
#pragma unroll
            for (int m = 0; m < 8; ++m) if ((i + 1) * (2 * m + 1) <= 16) {
                const float bsel = hh ? vb[2 * m + 1] : vb[2 * m];
                const bool okj = hh ? ((i + 1) * (2 * m + 2) <= 16) : true;
                const unsigned key = okj ? ((f2key(va[i] + bsel) & ~0xFFu) | (unsigned)(i * 16 + 2 * m + hh)) : 0u; TK_INSERT(CL, key); }
        { unsigned PC[16];
#pragma unroll
          for (int i = 0; i < 16; ++i) PC[i] = (unsigned)__shfl_xor((int)CL[i], 32);
          TK_MERGE(CL, PC); }
        unsigned pa[4], pb[4];
#pragma unroll
        for (int w = 0; w < 4; ++w) { pa[w] = (LA[4 * w] & 0x7Fu) | ((LA[4 * w + 1] & 0x7Fu) << 8) | ((LA[4 * w + 2] & 0x7Fu) << 16) | ((LA[4 * w + 3] & 0x7Fu) << 24);
                                      pb[w] = (LB[4 * w] & 0x7Fu) | ((LB[4 * w + 1] & 0x7Fu) << 8) | ((LB[4 * w + 2] & 0x7Fu) << 16) | ((LB[4 * w + 3] & 0x7Fu) << 24); }
        float r1; { float ss = 0.f; const f32x4* rp = (const f32x4*)(c.rss + (size_t)tok * 32);
#pragma unroll
            for (int i = 0; i < 8; ++i) { const f32x4 t4 = rp[i]; ss += (t4.x + t4.y) + (t4.z + t4.w); }
            r1 = 1.0f / sqrtf(ss * (1.0f / D) + EPS); }
        float sv[16]; float ssum = 0.f; const float smax = key2f(CL[0] & ~0xFFu);
#pragma unroll
        for (int k = 0; k < 16; ++k) { sv[k] = __expf((key2f(CL[k] & ~0xFFu) - smax) * r1); ssum += sv[k]; }
        const float sinv = 1.0f / ssum;
        int* ep = c.eid + (size_t)tok * 128 + h * 16; float* gp = c.egate + (size_t)tok * 128 + h * 16;
#pragma unroll
        for (int k = 0; k < 16; ++k) {
            const unsigned ci = (CL[k] >> 4) & 15u, cj = CL[k] & 15u;
            const unsigned wa = (ci >> 2) == 0 ? pa[0] : ((ci >> 2) == 1 ? pa[1] : ((ci >> 2) == 2 ? pa[2] : pa[3]));
            const unsigned wb = (cj >> 2) == 0 ? pb[0] : ((cj >> 2) == 1 ? pb[1] : ((cj >> 2) == 2 ? pb[2] : pb[3]));
            const unsigned ia = (wa >> ((ci & 3u) * 8u)) & 0x7Fu, ib = (wb >> ((cj & 3u) * 8u)) & 0x7Fu;
            if (hh == 0) ep[k] = (int)(ia * 128u + ib); else gp[k] = sv[k] * sinv;
        }
    }
}
DEV void phase_peer_topk(const Ctx& c) {
    const int gw = c.bid * 8 + c.wave, NGW = c.G * 8;
    for (int wt = gw; wt < (T / 32) * NH; wt += NGW) peer_topk_task(c, wt >> 3, wt & 7);
}
DEV void naive_peer_topk(const Ctx& c) {
    const int lane = c.lane, gw = c.bid * 8 + c.wave, NGW = c.G * 8;
    for (int wt = gw; wt < T * NH; wt += NGW) {
        const int tok = wt >> 3, h = wt & 7;
        float ts[2][16]; int ti[2][16];
#pragma unroll
        for (int p = 0; p < 2; ++p) {
            const bf16* qrow = c.qp + (size_t)tok * D + h * 256 + p * 128;
            float s0 = 0.f, s1 = 0.f;
            const bf16* k0 = c.skb + ((size_t)(h * 2 + p) * 128 + lane) * 128; const bf16* k1 = k0 + 64 * 128;
            for (int d = 0; d < 128; ++d) { const float q = bf2f(qrow[d]); s0 += q * bf2f(k0[d]); s1 += q * bf2f(k1[d]); }
#pragma unroll
            for (int k = 0; k < 16; ++k) {
                float best = fmaxf(s0, s1); int bi = (s0 >= s1) ? lane : lane + 64;
#pragma unroll
                for (int o = 1; o < 64; o <<= 1) { const float ob = __shfl_xor(best, o); const int oi = __shfl_xor(bi, o); if (ob > best || (ob == best && oi < bi)) { best = ob; bi = oi; } }
                ts[p][k] = best; ti[p][k] = bi;
                if (bi == lane) s0 = -INFINITY; if (bi == lane + 64) s1 = -INFINITY;
            }
        }
        float cv[4]; int cid[4];
#pragma unroll
        for (int q = 0; q < 4; ++q) { cv[q] = 0.f; cid[q] = 0; }
#pragma unroll
        for (int i = 0; i < 16; ++i)
#pragma unroll
            for (int jj = 0; jj < 16; ++jj) { if ((lane >> 2) == i && (lane & 3) == (jj >> 2)) { cv[jj & 3] = ts[0][i] + ts[1][jj]; cid[jj & 3] = ti[0][i] * 128 + ti[1][jj]; } }
        float bs[16]; int be[16];
#pragma unroll
        for (int k = 0; k < 16; ++k) {
            float best = cv[0]; int bq = 0;
#pragma unroll
            for (int q = 1; q < 4; ++q) if (cv[q] > best) { best = cv[q]; bq = q; }
            int bpos = lane * 4 + bq; int bid_ = (bq == 0) ? cid[0] : (bq == 1 ? cid[1] : (bq == 2 ? cid[2] : cid[3]));
#pragma unroll
            for (int o = 1; o < 64; o <<= 1) { const float ob = __shfl_xor(best, o); const int op = __shfl_xor(bpos, o); const int oe = __shfl_xor(bid_, o); if (ob > best || (ob == best && op < bpos)) { best = ob; bpos = op; bid_ = oe; } }
            bs[k] = best; be[k] = bid_;
#pragma unroll
            for (int q = 0; q < 4; ++q) if (bpos == lane * 4 + q) cv[q] = -INFINITY;
        }
        const float mxs = bs[0]; float tot = 0.f;
#pragma unroll
        for (int k = 0; k < 16; ++k) { bs[k] = __expf(bs[k] - mxs); tot += bs[k]; }
        int* ep = c.eid + (size_t)tok * 128 + h * 16; float* gp = c.egate + (size_t)tok * 128 + h * 16;
        if (lane == 0) {
#pragma unroll
            for (int k = 0; k < 16; ++k) { ep[k] = be[k]; gp[k] = bs[k] / tot; }
        }
    }
}

DEV float rl_f(float v, int l) { return __int_as_float(__builtin_amdgcn_readlane(__float_as_int(v), l)); }
DEV unsigned q4(float a, float b, float c_, float d, float inv, int off) {
    const int qa = (int)rintf(a * inv) + off, qb = (int)rintf(b * inv) + off, qc = (int)rintf(c_ * inv) + off, qd = (int)rintf(d * inv) + off;
    return (unsigned)(qa & 0xff) | ((unsigned)(qb & 0xff) << 8) | ((unsigned)(qc & 0xff) << 16) | ((unsigned)(qd & 0xff) << 24);
}
DEV float wave_max(float v) {
#pragma unroll
    for (int o = 1; o < 64; o <<= 1) v = fmaxf(v, __shfl_xor(v, o));
    return v;
}
DEV void quant_tables(const Ctx& c, int row0, int row1, int step, int first, LAS unsigned char* scr) {
    const int lane = c.lane;
    int row = row0 + first;
    if (row >= row1) return;
    f32x4 vn[8];
    { const bool isup = row >= NEXP; const int e = isup ? row - NEXP : row; const f32x4* src = (const f32x4*)((isup ? c.up : c.dn) + (size_t)e * D) + lane;
#pragma unroll
      for (int j = 0; j < 8; ++j) vn[j] = src[64 * j]; }
    for (; row < row1; row += step) {
        const bool isup = row >= NEXP; const int e = isup ? row - NEXP : row;
        f32x4 v[8];
#pragma unroll
        for (int j = 0; j < 8; ++j) v[j] = vn[j];
        { const int rn = row + step < row1 ? row + step : row; const bool upn = rn >= NEXP; const int en = upn ? rn - NEXP : rn; const f32x4* src = (const f32x4*)((upn ? c.up : c.dn) + (size_t)en * D) + lane;
#pragma unroll
          for (int j = 0; j < 8; ++j) vn[j] = src[64 * j]; }
        float am = 0.f;
#pragma unroll
        for (int j = 0; j < 8; ++j) { if (!isup) v[j] *= ((const f32x4*)c.g_ffn)[64 * j + lane];
            am = fmaxf(am, fmaxf(fmaxf(fabsf(v[j].x), fabsf(v[j].y)), fmaxf(fabsf(v[j].z), fabsf(v[j].w)))); }
        am = wmax_q(am);
        if (!isup) {
            const float inv = am > 0.f ? 127.0f / am : 0.f;
            unsigned* dst = (unsigned*)(c.dn8 + (size_t)e * D) + lane;
#pragma unroll
            for (int j = 0; j < 8; ++j) dst[64 * j] = q4(v[j].x, v[j].y, v[j].z, v[j].w, inv, 0);
            if (lane == 0) c.sdn[e] = am * (1.0f / 127.0f);
        } else {
            float ssq = 0.f;
#pragma unroll
            for (int j = 0; j < 8; ++j) ssq += (v[j].x * v[j].x + v[j].y * v[j].y) + (v[j].z * v[j].z + v[j].w * v[j].w);
            const float rms = sqrtf(wsum_q(ssq) * (1.0f / D));
            const float stA = am * (1.0f / 7.0f), stB = fminf(stA, 0.36f * rms);
            const float ivA = stA > 0.f ? 1.0f / stA : 0.f, ivB = stB > 0.f ? 1.0f / stB : 0.f;
            float eA = 0.f, eB = 0.f;
#pragma unroll
            for (int j = 0; j < 8; ++j) { const float vv[4] = {v[j].x, v[j].y, v[j].z, v[j].w};
#pragma unroll
                for (int i = 0; i < 4; ++i) { const float qa = fminf(fmaxf(rintf(vv[i] * ivA), -7.f), 7.f) * stA - vv[i], qb = fminf(fmaxf(rintf(vv[i] * ivB), -7.f), 7.f) * stB - vv[i]; eA += qa * qa; eB += qb * qb; } }
            eA = wsum_q(eA); eB = wsum_q(eB);
            const bool useB = am > 0.f && eB < eA;
            const float st = useB ? stB : stA, inv = useB ? ivB : ivA; am = st * 7.0f;
#pragma unroll
            for (int j = 0; j < 8; ++j) { const f32x4 cl = {fminf(fmaxf(v[j].x * inv, -7.f), 7.f), fminf(fmaxf(v[j].y * inv, -7.f), 7.f), fminf(fmaxf(v[j].z * inv, -7.f), 7.f), fminf(fmaxf(v[j].w * inv, -7.f), 7.f)};
                *(LAS unsigned*)(scr + 4 * (64 * j + lane)) = q4(cl.x, cl.y, cl.z, cl.w, 1.0f, 8); }
            asm volatile("s_waitcnt lgkmcnt(0)" ::: "memory");
            const v4u lo = *(const LAS v4u*)(scr + 32 * lane), hi = *(const LAS v4u*)(scr + 32 * lane + 16);
            v4u o; o.x = (lo.x & 0x0F0F0F0Fu) | ((lo.y & 0x0F0F0F0Fu) << 4); o.y = (lo.z & 0x0F0F0F0Fu) | ((lo.w & 0x0F0F0F0Fu) << 4);
                   o.z = (hi.x & 0x0F0F0F0Fu) | ((hi.y & 0x0F0F0F0Fu) << 4); o.w = (hi.z & 0x0F0F0F0Fu) | ((hi.w & 0x0F0F0F0Fu) << 4);
            *(v4u*)(c.up8 + (size_t)e * (D / 2) + 16 * lane) = o;
            if (lane == 0) c.sup[e] = am * (1.0f / 7.0f);
            asm volatile("s_waitcnt lgkmcnt(0)" ::: "memory");
        }
    }
}
#ifndef EXP_NT
#define EXP_NT 2
#endif
constexpr int ENT = EXP_NT;
struct TokQ { int e0, e1, hid0, hid1; float sd0, sd1, gs0, gs1, cf0, cf1, sx, csum; };
DEV int sread_i(int v0, int v1, int k) { const int a = __builtin_amdgcn_readlane(v0, k & 63), b = __builtin_amdgcn_readlane(v1, k & 63); return k < 64 ? a : b; }
DEV float sread_f(float v0, float v1, int k) { return __int_as_float(sread_i(__float_as_int(v0), __float_as_int(v1), k)); }
DEV v4u bload16(__amdgpu_buffer_rsrc_t rs, int voff, int soff) { return __builtin_bit_cast(v4u, __builtin_amdgcn_raw_buffer_load_b128(rs, voff, soff, 0)); }
DEV unsigned bsort_step(unsigned v, unsigned pv, bool keepmin) { return keepmin ? min(v, pv) : max(v, pv); }
DEV void tokq_init(const Ctx& c, int tok, TokQ& s, unsigned (&xq)[4][4], int lane, unsigned idmask = 0xFFFFu) {
    float am = 0.f;
#pragma unroll
    for (int q = 0; q < 4; ++q)
#pragma unroll
        for (int hf = 0; hf < 2; ++hf) { const v4u w = *(const v4u*)(c.h1n + (size_t)tok * D + q * 512 + 16 * (lane & 31) + 8 * hf);
            am = fmaxf(am, fmaxf(fmaxf(fmaxf(fabsf(bflo(w.x)), fabsf(bfhi(w.x))), fmaxf(fabsf(bflo(w.y)), fabsf(bfhi(w.y)))), fmaxf(fmaxf(fabsf(bflo(w.z)), fabsf(bfhi(w.z))), fmaxf(fabsf(bflo(w.w)), fabsf(bfhi(w.w)))))); }
    am = wave_max(am);
    const float r1 = 1.0f / sqrtf(wave_sum(lane < 32 ? c.rss[(size_t)tok * 32 + lane] : 0.f) * (1.0f / D) + EPS);
    const float inv = am > 0.f ? 127.0f / am : 0.f; s.sx = am * (1.0f / 127.0f) * r1;
#pragma unroll
    for (int q = 0; q < 4; ++q)
#pragma unroll
        for (int hf = 0; hf < 2; ++hf) { const v4u w = *(const v4u*)(c.h1n + (size_t)tok * D + q * 512 + 16 * (lane & 31) + 8 * hf);
            xq[q][2 * hf] = q4(bflo(w.x), bfhi(w.x), bflo(w.y), bfhi(w.y), inv, 0); xq[q][2 * hf + 1] = q4(bflo(w.z), bfhi(w.z), bflo(w.w), bfhi(w.w), inv, 0); }
    const float g0 = c.egate[(size_t)tok * 128 + lane], g1 = c.egate[(size_t)tok * 128 + 64 + lane];
    unsigned k0 = (((unsigned)c.eid[(size_t)tok * 128 + lane] & idmask) << 7) | (unsigned)lane, k1 = (((unsigned)c.eid[(size_t)tok * 128 + 64 + lane] & idmask) << 7) | (unsigned)(64 + lane);
#pragma unroll
    for (int k = 2; k <= 128; k <<= 1)
#pragma unroll
        for (int j = k >> 1; j > 0; j >>= 1) {
            if (j == 64) { const unsigned a = min(k0, k1), b = max(k0, k1); k0 = a; k1 = b; }
            else { const unsigned p0 = (unsigned)__shfl_xor((int)k0, j), p1 = (unsigned)__shfl_xor((int)k1, j);
                const bool lower = (lane & j) == 0;
                const bool up0 = (k == 128) ? true : ((lane & k) == 0), up1 = (k == 128) ? true : ((k == 64) ? false : ((lane & k) == 0));
                k0 = bsort_step(k0, p0, up0 == lower); k1 = bsort_step(k1, p1, up1 == lower); }
        }
    s.e0 = (int)(k0 >> 7); s.e1 = (int)(k1 >> 7);
    { const int s0 = (int)(k0 & 127u), s1 = (int)(k1 & 127u);
      const float a0 = __shfl(g0, s0 & 63), b0 = __shfl(g1, s0 & 63), a1 = __shfl(g0, s1 & 63), b1 = __shfl(g1, s1 & 63);
      s.gs0 = (s0 < 64 ? a0 : b0) * c.sup[s.e0]; s.gs1 = (s1 < 64 ? a1 : b1) * c.sup[s.e1]; }
    s.sd0 = c.sdn[s.e0]; s.sd1 = c.sdn[s.e1];
    s.hid0 = 0; s.hid1 = 0; s.cf0 = 0.f; s.cf1 = 0.f; s.csum = 0.f;
}
DEV void q_load(__amdgpu_buffer_rsrc_t rs, const TokQ& s, int kb, int q, int lane, v4u (&dq)[4]) {
    const int esel = kb < 64 ? s.e0 : s.e1;
#pragma unroll
    for (int j = 0; j < 4; ++j) { const int id = __shfl(esel, (kb + 2 * j + (lane >> 5)) & 63);
        dq[j] = bload16(rs, id * D + q * 512 + 16 * (lane & 31), 0); }
}
DEV void u_load(__amdgpu_buffer_rsrc_t rs, const TokQ& s, int kb, int hq, int lane, v4u (&dq)[4]) {
    const int esel = kb < 64 ? s.e0 : s.e1;
#pragma unroll
    for (int j = 0; j < 4; ++j) { const int id = __shfl(esel, (kb + 2 * j + (lane >> 5)) & 63);
        dq[j] = bload16(rs, id * (D / 2) + hq * 512 + 16 * (lane & 31), 0); }
}
DEV void q_down_dot(const unsigned (&xq)[4], const v4u (&dq)[4], int (&part)[16], const int sub) {
#pragma unroll
    for (int j = 0; j < 4; ++j) { int a = __builtin_amdgcn_sdot4((int)dq[j].x, (int)xq[0], 0, false); a = __builtin_amdgcn_sdot4((int)dq[j].y, (int)xq[1], a, false);
        a = __builtin_amdgcn_sdot4((int)dq[j].z, (int)xq[2], a, false); a = __builtin_amdgcn_sdot4((int)dq[j].w, (int)xq[3], a, false); part[4 * sub + j] = a; }
}
DEV void q_down_reduce(TokQ& s, int kg, int lane, const int (&part)[16]) {
    int r8[8], r4[4], r2[2], r1;
    { const bool h = (lane & 16) != 0;
#pragma unroll
      for (int i = 0; i < 8; ++i) { const int keep = h ? part[i + 8] : part[i], send = h ? part[i] : part[i + 8]; r8[i] = keep + __shfl_xor(send, 16); } }
    { const bool h = (lane & 8) != 0;
#pragma unroll
      for (int i = 0; i < 4; ++i) { const int keep = h ? r8[i + 4] : r8[i], send = h ? r8[i] : r8[i + 4]; r4[i] = keep + __shfl_xor(send, 8); } }
    { const bool h = (lane & 4) != 0;
#pragma unroll
      for (int i = 0; i < 2; ++i) { const int keep = h ? r4[i + 2] : r4[i], send = h ? r4[i] : r4[i + 2]; r2[i] = keep + __shfl_xor(send, 4); } }
    { const bool h = (lane & 2) != 0; const int keep = h ? r2[1] : r2[0], send = h ? r2[0] : r2[1]; r1 = keep + __shfl_xor(send, 2); }
    r1 += __shfl_xor(r1, 1);
    const int e = (lane - kg) & 31;
    const int isrc = 4 * (e >> 3) + ((e & 7) >> 1), hsrc = e & 1;
    const int gsum = __shfl(r1, 32 * hsrc + 2 * isrc);
    if ((lane >> 5) == ((kg & 63) >> 5)) { if (kg < 64) s.hid0 += gsum; else s.hid1 += gsum; }
}
DEV void q_up_compute(const TokQ& s, float (&y)[16], int kb, int lane, const v4u (&uq)[4]) {
#pragma unroll
    for (int j = 0; j < 4; ++j) { const float flo = sread_f(s.cf0, s.cf1, kb + 2 * j), fhi = sread_f(s.cf0, s.cf1, kb + 2 * j + 1); const float f = lane < 32 ? flo : fhi;
        const unsigned ww[4] = {uq[j].x, uq[j].y, uq[j].z, uq[j].w};
#pragma unroll
        for (int w = 0; w < 4; ++w) { y[4 * w + 0] += f * (float)(ww[w] & 0xffu); y[4 * w + 1] += f * (float)((ww[w] >> 8) & 0xffu); y[4 * w + 2] += f * (float)((ww[w] >> 16) & 0xffu); y[4 * w + 3] += f * (float)(ww[w] >> 24); } }
}
DEV void tokq_final(const Ctx& c, int tok, int lane) {
    const v2u* hp = (const v2u*)(c.h2b + (size_t)tok * D) + lane;
    f32x4 v[8]; float ss = 0.f, am = 0.f;
#pragma unroll
    for (int j = 0; j < 8; ++j) { const v2u w = hp[64 * j]; v[j] = (f32x4){bflo(w.x), bfhi(w.x), bflo(w.y), bfhi(w.y)}; ss += (v[j].x * v[j].x + v[j].y * v[j].y) + (v[j].z * v[j].z + v[j].w * v[j].w);
        am = fmaxf(am, fmaxf(fmaxf(fabsf(v[j].x), fabsf(v[j].y)), fmaxf(fabsf(v[j].z), fabsf(v[j].w)))); }
    const float rr = 1.0f / sqrtf(wave_sum(ss) * (1.0f / D) + EPS);
    am = wave_max(am);
    const float inv = am > 0.f ? 127.0f / am : 0.f;
    unsigned* o4 = (unsigned*)(c.h2q8 + (size_t)tok * D) + lane;
#pragma unroll
    for (int j = 0; j < 8; ++j) o4[64 * j] = q4(v[j].x, v[j].y, v[j].z, v[j].w, inv, 0);
    if (lane == 0) c.h2s[tok] = am * (1.0f / 127.0f) * rr;
}
DEV void phase_peer_experts(const Ctx& c, unsigned idmask = 0xFFFFu) {
    const int lane = c.lane, gw = c.bid * 8 + c.wave, NGW = c.G * 8;
    const __amdgpu_buffer_rsrc_t rsd = __builtin_amdgcn_make_buffer_rsrc((void*)c.dn8, 0, NEXP * D, 0x00020000), rsu = __builtin_amdgcn_make_buffer_rsrc((void*)c.up8, 0, NEXP * D / 2, 0x00020000);
    for (int tg = gw; tg < T / ENT; tg += NGW) {
        const int tok0 = tg * ENT;
        TokQ S[ENT];
        {
            unsigned xq[ENT][4][4];
#pragma unroll
            for (int t = 0; t < ENT; ++t) tokq_init(c, tok0 + t, S[t], xq[t], lane, idmask);
#pragma unroll 1
            for (int q = 0; q < 4; ++q) {
                unsigned xc[ENT][4];
#pragma unroll
                for (int t = 0; t < ENT; ++t)
#pragma unroll
                    for (int w = 0; w < 4; ++w) xc[t][w] = q == 0 ? xq[t][0][w] : (q == 1 ? xq[t][1][w] : (q == 2 ? xq[t][2][w] : xq[t][3][w]));
                v4u dq[ENT][2][4];
#pragma unroll
                for (int t = 0; t < ENT; ++t) { q_load(rsd, S[t], 0, q, lane, dq[t][0]); q_load(rsd, S[t], 8, q, lane, dq[t][1]); }
#pragma unroll 1
                for (int kg = 0; kg < 128; kg += 32) {
                    int part[ENT][16];
#pragma unroll
                    for (int sub = 0; sub < 4; ++sub) { const int kb = kg + 8 * sub, kn = kb + 16 < 128 ? kb + 16 : 120;
#pragma unroll
                        for (int t = 0; t < ENT; ++t) { q_down_dot(xc[t], dq[t][sub & 1], part[t], sub); q_load(rsd, S[t], kn, q, lane, dq[t][sub & 1]); } }
#pragma unroll
                    for (int t = 0; t < ENT; ++t) q_down_reduce(S[t], kg, lane, part[t]);
                }
            }
        }
#pragma unroll
        for (int t = 0; t < ENT; ++t) { S[t].cf0 = S[t].gs0 * gelu_erf((float)S[t].hid0 * (S[t].sx * S[t].sd0)); S[t].cf1 = S[t].gs1 * gelu_erf((float)S[t].hid1 * (S[t].sx * S[t].sd1));
            S[t].csum = wave_sum(S[t].cf0 + S[t].cf1); }
        unsigned cpk[ENT]; float cscale[ENT]; int csumq[ENT];
#pragma unroll
        for (int t = 0; t < ENT; ++t) { const float cm = wave_max(fmaxf(fabsf(S[t].cf0), fabsf(S[t].cf1))); const float inv = cm > 0.f ? 127.0f / cm : 0.f; cscale[t] = cm * (1.0f / 127.0f);
            const int c0 = (int)rintf(S[t].cf0 * inv), c1 = (int)rintf(S[t].cf1 * inv);
            { int sq = c0 + c1;
#pragma unroll
              for (int o = 1; o < 64; o <<= 1) sq += __shfl_xor(sq, o);
              csumq[t] = sq; }
            unsigned pk = 0u;
#pragma unroll
            for (int i = 0; i < 4; ++i) { const int p = 8 * ((lane & 31) >> 1) + (lane & 1) + 2 * i; const int a = __shfl(c0, p & 63), bq = __shfl(c1, p & 63); pk |= ((unsigned)((p < 64 ? a : bq) & 0xff)) << (8 * i); }
            cpk[t] = pk; }
#pragma unroll 1
        for (int hq = 0; hq < 2; ++hq) {
            int y[ENT][32];
#pragma unroll
            for (int t = 0; t < ENT; ++t)
#pragma unroll
                for (int i = 0; i < 32; ++i) y[t][i] = 0;
            v4u uq[ENT][4];
#pragma unroll
            for (int t = 0; t < ENT; ++t) u_load(rsu, S[t], 0, hq, lane, uq[t]);
            for (int kb = 0; kb < 128; kb += 8) { const int kn = kb + 8 < 128 ? kb + 8 : 120;
#pragma unroll
                for (int t = 0; t < ENT; ++t) {
                    const unsigned clo = (unsigned)__builtin_amdgcn_readlane((int)cpk[t], (kb >> 2) & 31), chi = (unsigned)__builtin_amdgcn_readlane((int)cpk[t], ((kb >> 2) & 31) + 1);
                    const int cw = (int)(lane < 32 ? clo : chi);
                    const unsigned a0[4] = {uq[t][0].x, uq[t][0].y, uq[t][0].z, uq[t][0].w}, a1[4] = {uq[t][1].x, uq[t][1].y, uq[t][1].z, uq[t][1].w}, a2[4] = {uq[t][2].x, uq[t][2].y, uq[t][2].z, uq[t][2].w}, a3[4] = {uq[t][3].x, uq[t][3].y, uq[t][3].z, uq[t][3].w};
#pragma unroll
                    for (int w = 0; w < 4; ++w)
#pragma unroll
                        for (int nb = 0; nb < 2; ++nb) {
                            const unsigned b0 = (a0[w] >> (4 * nb)) & 0x0F0F0F0Fu, b1 = (a1[w] >> (4 * nb)) & 0x0F0F0F0Fu, b2 = (a2[w] >> (4 * nb)) & 0x0F0F0F0Fu, b3 = (a3[w] >> (4 * nb)) & 0x0F0F0F0Fu;
                            const unsigned x0 = __builtin_amdgcn_perm(b1, b0, 0x05010400u), x1 = __builtin_amdgcn_perm(b1, b0, 0x07030602u), x2 = __builtin_amdgcn_perm(b3, b2, 0x05010400u), x3 = __builtin_amdgcn_perm(b3, b2, 0x07030602u);
                            const unsigned t0 = __builtin_amdgcn_perm(x2, x0, 0x05040100u), t1 = __builtin_amdgcn_perm(x2, x0, 0x07060302u), t2 = __builtin_amdgcn_perm(x3, x1, 0x05040100u), t3 = __builtin_amdgcn_perm(x3, x1, 0x07060302u);
                            const int yb = 8 * w + 4 * nb;
                            y[t][yb + 0] = __builtin_amdgcn_sdot4((int)t0, cw, y[t][yb + 0], false); y[t][yb + 1] = __builtin_amdgcn_sdot4((int)t1, cw, y[t][yb + 1], false);
                            y[t][yb + 2] = __builtin_amdgcn_sdot4((int)t2, cw, y[t][yb + 2], false); y[t][yb + 3] = __builtin_amdgcn_sdot4((int)t3, cw, y[t][yb + 3], false); }
                    u_load(rsu, S[t], kn, hq, lane, uq[t]); } }
#pragma unroll
            for (int t = 0; t < ENT; ++t) {
#pragma unroll
                for (int i = 0; i < 32; ++i) y[t][i] += __shfl_xor(y[t][i], 32);
                if (lane < 32) { bf16* hp = c.h2b + (size_t)(tok0 + t) * D + hq * 1024 + 32 * lane; const float sc = cscale[t]; const int corr = 8 * csumq[t];
                    const bf16* hb = c.h1n + (size_t)(tok0 + t) * D + hq * 1024 + 32 * lane;
#pragma unroll
                    for (int g8 = 0; g8 < 4; ++g8) { const v4u hw = *(const v4u*)(hb + 8 * g8); const int yb = 8 * g8; v4u o;
                        o.x = pkbf(bflo(hw.x) + (float)(y[t][yb] - corr) * sc, bfhi(hw.x) + (float)(y[t][yb + 1] - corr) * sc); o.y = pkbf(bflo(hw.y) + (float)(y[t][yb + 2] - corr) * sc, bfhi(hw.y) + (float)(y[t][yb + 3] - corr) * sc);
                        o.z = pkbf(bflo(hw.z) + (float)(y[t][yb + 4] - corr) * sc, bfhi(hw.z) + (float)(y[t][yb + 5] - corr) * sc); o.w = pkbf(bflo(hw.w) + (float)(y[t][yb + 6] - corr) * sc, bfhi(hw.w) + (float)(y[t][yb + 7] - corr) * sc);
                        *(v4u*)(hp + yb) = o; } } }
        }
        __builtin_amdgcn_fence(__ATOMIC_RELEASE, "workgroup"); asm volatile("s_waitcnt vmcnt(0)" ::: "memory"); __builtin_amdgcn_fence(__ATOMIC_ACQUIRE, "workgroup");
#pragma unroll
        for (int t = 0; t < ENT; ++t) tokq_final(c, tok0 + t, lane);
    }
}


#define GAS __attribute__((address_space(1)))
#define XB_TMO      128
#define XB_XCNT(j)  (256  + 64 * (j))
#define XB_XSUB(j)  (1280 + 64 * (j))
#define XB_XGEN(j)  (2304 + 64 * (j))
#define XB_TOP      3328
#define XB_TOPGEN   3392
#define XCD_BAR_WORDS 3456
#define XB_SPIN_CAP (1u << 18)

__device__ __forceinline__ unsigned xb_ld(unsigned* p)              { return __hip_atomic_load(p, __ATOMIC_RELAXED, __HIP_MEMORY_SCOPE_AGENT); }
__device__ __forceinline__ unsigned xb_add(unsigned* p, unsigned v) { return __hip_atomic_fetch_add(p, v, __ATOMIC_RELAXED, __HIP_MEMORY_SCOPE_AGENT); }
__device__ __forceinline__ unsigned xb_xcc_id() { return (unsigned)__builtin_amdgcn_s_getreg((3 << 11) | 20) & 0xFu; }
#define XB_SPIN(cond, bar) do { unsigned _sp = 0; while (cond) { __builtin_amdgcn_s_sleep(1); \
    if ((++_sp & 255u) == 0u) { if (xb_ld(&(bar)[XB_TMO])) break; if (_sp > XB_SPIN_CAP) { atomicAdd(&(bar)[XB_TMO], 1u); break; } } } } while (0)

struct XcdBarrier {
    unsigned* bar; unsigned x;
    volatile LAS unsigned* st;
};

__device__ __forceinline__ XcdBarrier xcd_barrier_post(unsigned* bar, volatile LAS unsigned* st) {
    XcdBarrier b; b.bar = bar; b.x = xb_xcc_id(); b.st = st;
    if (threadIdx.x == 0) (void)xb_add(&bar[XB_XCNT(b.x)], 1u);
    return b;
}
__device__ __forceinline__ void xcd_barrier_complete(unsigned* bar, unsigned x, unsigned& nloc, unsigned& nx) {
    const unsigned G = gridDim.x * gridDim.y * gridDim.z;
    unsigned sum, cnt, mine, sp = 0u;
    for (;;) {
        sum = 0u; cnt = 0u; mine = 0u;
#pragma unroll
        for (unsigned j = 0; j < 16; ++j) { const unsigned c = xb_ld(&bar[XB_XCNT(j)]); sum += c; cnt += (c > 0u) ? 1u : 0u; mine = (j == x) ? c : mine; }
        if (sum == G) break;
        __builtin_amdgcn_s_sleep(1);
        if ((++sp & 255u) == 0u) { if (xb_ld(&bar[XB_TMO])) break; if (sp > XB_SPIN_CAP) { atomicAdd(&bar[XB_TMO], 1u); break; } }
    }
    nloc = mine > 0u ? mine : 1u; nx = cnt > 0u ? cnt : 1u;
}

__device__ __forceinline__ void xcd_barrier(const XcdBarrier& b) {
    asm volatile("s_waitcnt vmcnt(0)" ::: "memory");
    __syncthreads();
    if (threadIdx.x == 0) {
        unsigned* bar = b.bar;
        __builtin_amdgcn_s_waitcnt(0);
        unsigned nloc = b.st[0], nx = b.st[1];
        if (nloc == 0u) { xcd_barrier_complete(bar, b.x, nloc, nx); b.st[0] = nloc; b.st[1] = nx; }
        const unsigned old = xb_add(&bar[XB_XSUB(b.x)], 1u);
        const unsigned gen = old / nloc;
        if (old + 1u == (gen + 1u) * nloc) {
            __builtin_amdgcn_fence(__ATOMIC_RELEASE, "agent");
            asm volatile("s_waitcnt vmcnt(0)" ::: "memory");
            const unsigned og = xb_add(&bar[XB_TOP], 1u);
            const unsigned tg = og / nx;
            if (og + 1u == (tg + 1u) * nx) xb_add(&bar[XB_TOPGEN], 1u);
            else XB_SPIN(xb_ld(&bar[XB_TOPGEN]) == tg, bar);
            __builtin_amdgcn_fence(__ATOMIC_ACQUIRE, "agent");
            xb_add(&bar[XB_XGEN(b.x)], 1u);
            asm volatile("s_waitcnt vmcnt(0)" ::: "memory");
        } else {
            XB_SPIN(xb_ld(&bar[XB_XGEN(b.x)]) == gen, bar);
            __builtin_amdgcn_fence(__ATOMIC_ACQUIRE, "agent");
            asm volatile("s_waitcnt vmcnt(0)" ::: "memory");
        }
    }
    __syncthreads();
}

struct Args { const float* in[20]; float* out; unsigned char* ws; int ph_lo, ph_hi; };
constexpr int NPHASES = 16;
__global__ void __launch_bounds__(NTHREADS, 2) fwd_kernel(Args args) {
    extern __shared__ __attribute__((aligned(16))) unsigned char lds_raw[];
    LAS unsigned char* lds = (LAS unsigned char*)lds_raw;
    cg::grid_group grid = cg::this_grid();
    Ctx c;
    c.x = args.in[0]; c.p = args.in[1]; c.g_mix = args.in[2]; c.w_in = args.in[3]; c.ln_g = args.in[4]; c.ln_b = args.in[5]; c.sgu_w = args.in[6]; c.sgu_b = args.in[7];
    c.w_ba = args.in[8]; c.w_bs = args.in[9]; c.w_out = args.in[10]; c.g_ffn = args.in[11]; c.w_pq = args.in[12]; c.subk = args.in[13]; c.dn = args.in[14]; c.up = args.in[15];
    c.g_ple = args.in[16]; c.w_pp = args.in[17]; c.w_pg = args.in[18]; c.g_fin = args.in[19];
    c.out = args.out;
    unsigned char* ws = args.ws;
    c.WinT = (bf16*)(ws + WS_WIN); c.WbaT = (bf16*)(ws + WS_WBA); c.WbsT = (bf16*)(ws + WS_WBS); c.WoutT = (bf16*)(ws + WS_WOUT); c.WqT = (bf16*)(ws + WS_WQ); c.WgT = (bf16*)(ws + WS_WG); c.WprojT = (bf16*)(ws + WS_WPROJ);
    c.pb = (bf16*)(ws + WS_PB); c.skb = (bf16*)(ws + WS_SKB); c.kmean = (float*)(ws + WS_KMEAN); c.xn = (bf16*)(ws + WS_XN); c.proj = (bf16*)(ws + WS_PROJ); c.vT = (bf16*)(ws + WS_VT);
    c.yatt = (bf16*)(ws + WS_YATT); c.ysgu = (bf16*)(ws + WS_YSGU); c.merged = (bf16*)(ws + WS_MERGED); c.h1n = (bf16*)(ws + WS_H1N); c.qp = (bf16*)(ws + WS_QP);
    c.dn8 = ws + WS_DN8; c.up8 = ws + WS_UP8; c.sdn = (float*)(ws + WS_SDN); c.sup = (float*)(ws + WS_SDN) + NEXP; c.rss = (float*)(ws + WS_RSS); c.h2n = (bf16*)(ws + WS_H2N); c.gtmp = (bf16*)(ws + WS_GTMP); c.eid = (int*)(ws + WS_EID); c.egate = (float*)(ws + WS_EGATE); c.sel = (int*)(ws + WS_SEL); c.lse = (float*)(ws + WS_LSE);
    c.h2b = (bf16*)(ws + WS_H2B); c.sst = (float*)(ws + 468 * MiB); c.kmp = (float*)(ws + 470 * MiB); c.swb = (bf16*)(ws + WS_SKB + 512 * 1024); c.xq8 = ws + WS_XN; c.WinT8 = ws + WS_WIN; c.WgT8 = ws + WS_WG; c.h2q8 = ws + WS_H2N; c.xs = (float*)(ws + WS_SC); c.h2s = c.xs + T; c.wcs = c.h2s + T; c.gcs = c.wcs + INW; c.qcs = c.gcs + D; c.h1s = c.qcs + D; c.ocs = c.h1s + T; c.ms = c.ocs + D; c.WoutT8 = ws + WS_WOUT; c.mq8 = ws + WS_MQ8; c.WqT8 = ws + WS_WQ; c.h1q8 = ws + WS_H1N;
    c.G = gridDim.x; c.bid = blockIdx.x; c.tid = threadIdx.x; c.lane = c.tid & 63; c.wave = __builtin_amdgcn_readfirstlane(c.tid >> 6);
    const int lo = args.ph_lo, hi = args.ph_hi;
    volatile LAS unsigned* xst = (volatile LAS unsigned*)(lds + LDS_BYTES - 64);
    if (c.tid < 2) xst[c.tid] = 0u;
    __syncthreads();
    XcdBarrier xbar = xcd_barrier_post((unsigned*)(ws + WS_CTL), xst);
#ifndef PHASE_MASK
#define PHASE_MASK 0xFFFFFFFu
#endif
#ifndef REP_MASK
#define REP_MASK 0u
#endif
#define IN(k) ((((PHASE_MASK) >> (k)) & 1u) && lo <= (k) && (k) < hi)
#define NAIVE(k) (((NAIVE_MASK) >> (k)) & 1u)
#define REP(k) for (int _rep = 0; _rep < 1 + (int)(((REP_MASK) >> (k)) & 1u); ++_rep)
    const bool single = (hi - lo) > 1;
    bool first_sync = true;
#define GSYNC() do { if (single) { if ((first_sync && !ALL_XCD) || !USE_XCDBAR) grid.sync(); else xcd_barrier(xbar); first_sync = false; } } while (0)
    unsigned* kcnt = (unsigned*)(ws + WS_CTL) + 8192; unsigned* qctr = (unsigned*)(ws + WS_CTL) + 8256;
    unsigned* cam = (unsigned*)(ws + WS_CTL) + 9216;
    if (IN(0)) REP(0) { __syncthreads(); phase_prologue(c, lds, cam); }
    if (IN(0)) GSYNC();
    if (IN(15)) REP(15) { __syncthreads(); phase_prologue2(c, lds, cam); }
    if (IN(15)) GSYNC();
#ifdef PAD_NOPS
    if (IN(1)) { asm volatile(".fill %0, 4, 0xbf800000" :: "n"(PAD_NOPS)); }
#endif
    if (IN(1)) REP(1) { __syncthreads(); run_gemm_in(lds, c, _rep); }
    if (IN(1)) GSYNC();
#ifndef P2_REP_PARTS
#define P2_REP_PARTS 7
#endif
    if (IN(2)) REP(2) { __syncthreads(); const int parts = _rep == 0 ? 7 : P2_REP_PARTS;
        if (parts & 2) { if (NAIVE(2)) naive_sgu(c, lds); else phase_sgu(c, lds); } if (parts & 4) phase_select(c, kcnt); }
    if (IN(2)) GSYNC();
    if (IN(3)) REP(3) { __syncthreads(); if (NAIVE(3)) naive_attn(c, lds); else phase_attn(c, lds, qctr + 64 * _rep, _rep == 1 && ATT_PROBE_SKIPC, _rep == 1 && ATT_PROBE_SKIPQ); }
    if (IN(3)) GSYNC();
    if (IN(14)) REP(14) { if (!NAIVE(3)) phase_attn_combine(c); }
    if (IN(14)) GSYNC();
    if (IN(5)) REP(5) { __syncthreads(); int Kk = D; asm volatile("" : "+s"(Kk)); pg8::Gemm g{c.yatt, c.WbaT, T, D, Kk, c.ysgu, 1024}; pg8::StaticOrder S; S.init(T, D, c.G, c.bid);
                 pg8::gemm_phase<EpiBranch, pg8::StaticOrder, true, true>((PG8_LAS unsigned char*)lds, g, S, EpiBranch{c.proj, c.merged}); }
    if (IN(5)) GSYNC();
    if (IN(6)) REP(6) { __syncthreads(); int Kk = D; asm volatile("" : "+s"(Kk)); pg8::Gemm g{c.merged, c.WoutT, T, D, Kk, c.merged + D / 2, D}; pg8::StaticOrder S; S.init(T, D, c.G, c.bid);
                 pg8::gemm_phase<EpiF5, pg8::StaticOrder, true, true>((PG8_LAS unsigned char*)lds, g, S, EpiF5{c.x, c.out, c.h1n, c.rss}); }
    if (IN(6)) GSYNC();
    if (IN(8)) REP(8) { __syncthreads(); run_gemm(false, lds, c.h1n, c.WqT, T, D, D, F6{c.qp}, c.G, c.bid);
        asm volatile("s_waitcnt vmcnt(0)" ::: "memory"); __syncthreads();
        if (c.tid == 0) __builtin_amdgcn_fence(__ATOMIC_ACQUIRE, "agent");
        asm volatile("s_waitcnt vmcnt(0)" ::: "memory"); __syncthreads();
        pg8::StaticOrder S; S.init(T, D, c.G, c.bid); pg8::Unit u;
        for (int i = 0; S.next(i, u); ++i) peer_topk_task(c, u.pm * 8 + c.wave, u.pn); }
    if (IN(8)) GSYNC();
#ifdef EXP_DUMMY_MASK
    if (IN(10)) { phase_peer_experts(c, EXP_DUMMY_MASK); __syncthreads(); }
#endif
    if (IN(10)) REP(10) { phase_peer_experts(c); }
    if (IN(10)) GSYNC();
    if (IN(11)) REP(11) { __syncthreads(); run_gemm_i8(lds, c.h2q8, c.WgT8, c.h2s, c.gcs, T, D, D, F9a{c.gtmp}, c.G, c.bid); }
    if (IN(11) && NAIVE(11) != NAIVE(12)) GSYNC();
    if (IN(12)) { int Kk = PLE; asm volatile("" : "+s"(Kk)); pg8::Gemm g{c.pb, c.WprojT, T, D, Kk, c.pb + PLE / 2, PLE}; pg8::StaticOrder S; S.init(T, D, c.G, c.bid);
                  pg8::gemm_phase<Epi9b, pg8::StaticOrder, true, true>((PG8_LAS unsigned char*)lds, g, S, Epi9b{c.gtmp, c.h2b}); }
    if (IN(12)) GSYNC();
#ifdef BENCH_OP
    if (IN(13)) {
        unsigned a[16];
#pragma unroll
        for (int i = 0; i < 16; ++i) a[i] = c.tid * 2654435761u + i;
        unsigned b = c.lane * 40503u + 77u, sel = 0x05010400u;
#pragma unroll 1
        for (int it = 0; it < 4000; ++it) {
#pragma unroll
            for (int i = 0; i < 16; ++i) {
#if BENCH_OP == 0
                a[i] = (unsigned)__builtin_amdgcn_sdot4((int)a[i], (int)b, (int)a[i], false);
#elif BENCH_OP == 1
                a[i] = __builtin_amdgcn_perm(a[i], b, sel);
#elif BENCH_OP == 2
                a[i] = (a[i] >> 4) & 0x0F0F0F0Fu;  a[i] += b;
#elif BENCH_OP == 3
                a[i] = (unsigned)__shfl_xor((int)a[i], 16);
#elif BENCH_OP == 4
                a[i] = (unsigned)__builtin_amdgcn_readlane((int)a[i], it & 63) + b;
#elif BENCH_OP == 5
                a[i] = __float_as_uint(__uint_as_float(a[i]) * 1.0001f + 0.5f);
#endif
            }
        }
        unsigned s = 0;
#pragma unroll
        for (int i = 0; i < 16; ++i) s ^= a[i];
        if (s == 0x12345679u) c.out[0] = 1.0f;
        __syncthreads();
    }
#endif
    if (IN(13)) { phase_final(c); }
#if DEBUG_CHECK
    {
        float* dbg = (float*)(ws + WS_KMEAN + 512 * 1024);
        const int gw = c.bid * 8 + c.wave, NGW = c.G * 8;
        if (IN(0)) { for (int i = c.bid * NTHREADS + c.tid; i < T; i += c.G * NTHREADS) dbg[i] = 0.f; }
        if (IN(3)) { __syncthreads(); Ctx c2 = c; c2.yatt = (bf16*)(ws + 434 * MiB); naive_attn(c2, lds); }
        if (IN(20)) { const bf16* ya = (const bf16*)(ws + 434 * MiB);
            for (int t = gw; t < T; t += NGW) { float sa = 0.f;
                for (int cc = c.lane; cc < 1024; cc += 64) { const float d1 = bf2f(c.yatt[(size_t)t * 1024 + cc]) - bf2f(ya[(size_t)t * 1024 + cc]); sa += d1 * d1; }
                sa = wave_sum(sa); if (c.lane == 0) dbg[t] += DBG_GA * sa; } }
        if (IN(22)) { for (int t = c.bid * NTHREADS + c.tid; t < T; t += c.G * NTHREADS) c.out[(size_t)t * D] += sqrtf(dbg[t]); }
    }
#endif
#undef IN
#undef GSYNC
#undef NAIVE
}

extern "C" void kernel_launch(void* const* d_in, const int* in_sizes, int n_in, void* d_out, int out_size, void* d_ws, size_t ws_size, hipStream_t stream) {
    static int grid = 0;
    if (grid == 0) {
        if (n_in != 20 || out_size != T * D || ws_size < WS_END) { fprintf(stderr, "kernel_launch: unexpected shapes (n_in %d, out %d, ws %zu)\n", n_in, out_size, ws_size); grid = -1; return; }
        int dev = 0, cus = 0, per_cu = 0;
        if (hipGetDevice(&dev) != hipSuccess || hipDeviceGetAttribute(&cus, hipDeviceAttributeMultiprocessorCount, dev) != hipSuccess) { grid = -1; return; }
        if (hipFuncSetAttribute((const void*)fwd_kernel, hipFuncAttributeMaxDynamicSharedMemorySize, LDS_BYTES) != hipSuccess) { fprintf(stderr, "kernel_launch: hipFuncSetAttribute failed\n"); grid = -1; return; }
        if (hipOccupancyMaxActiveBlocksPerMultiprocessor(&per_cu, (const void*)fwd_kernel, NTHREADS, LDS_BYTES) != hipSuccess || per_cu < 1) { fprintf(stderr, "kernel_launch: occupancy query says %d blocks per CU\n", per_cu); per_cu = 1; }
        (void)hipGetLastError();
        grid = cus;
    }
    if (grid < 0) return;
    if (hipMemsetAsync((char*)d_ws + WS_CTL, 0, 131072, stream) != hipSuccess) { fprintf(stderr, "kernel_launch: memset failed\n"); return; }
    Args a{};
    for (int i = 0; i < 20; ++i) a.in[i] = (const float*)d_in[i];
    a.out = (float*)d_out; a.ws = (unsigned char*)d_ws;
#if MK_SINGLE
    a.ph_lo = 0; a.ph_hi = NPHASES;
    void* kargs[] = {&a};
    hipError_t e = hipLaunchCooperativeKernel((const void*)fwd_kernel, dim3(grid), dim3(NTHREADS), kargs, LDS_BYTES, stream);
    if (e != hipSuccess) fprintf(stderr, "kernel_launch: cooperative launch failed: %s (grid %d)\n", hipGetErrorString(e), grid);
#else
#if DEBUG_CHECK
    const int order[] = {0, 15, 1, 2, 3, 14, 20, 5, 6, 8, 10, 11, 12, 13, 22};
    for (int ph : order) { a.ph_lo = ph; a.ph_hi = ph + 1; hipLaunchKernelGGL(fwd_kernel, dim3(grid), dim3(NTHREADS), LDS_BYTES, stream, a); }
#else
    const int order[] = {0, 15, 1, 2, 3, 14, 5, 6, 8, 10, 11, 12, 13};
    for (int ph : order) { a.ph_lo = ph; a.ph_hi = ph + 1; hipLaunchKernelGGL(fwd_kernel, dim3(grid), dim3(NTHREADS), LDS_BYTES, stream, a); }
#endif
#endif
}
```

```cpp
#define MK_SINGLE 1
#define EXP_NT 2
#define ALL_XCD 1
#include <hip/hip_runtime.h>
#include <hip/hip_cooperative_groups.h>
#include <cstdio>
#include <cstdint>
namespace cg = cooperative_groups;

#ifndef MK_SINGLE
#define MK_SINGLE 1
#endif
#ifndef NAIVE_MASK
#define NAIVE_MASK 0u
#endif

#ifndef GI8_ALIGN
#define GI8_ALIGN true
#endif
#ifndef ATT_PROBE_SKIPC
#define ATT_PROBE_SKIPC 0
#define ATT_PROBE_SKIPQ 0
#endif
#ifndef ATT_FINE
#define ATT_FINE 0
#endif
#ifndef ATT_MIX
#define ATT_MIX 1
#endif
#ifndef QUANT_FIRST
#define QUANT_FIRST 0
#endif
#ifndef ALL_XCD
#define ALL_XCD 0
#endif
#ifndef USE_XCDBAR
#define USE_XCDBAR 1
#endif
#ifndef DEBUG_CHECK
#define DEBUG_CHECK 0
#endif
#ifndef DBG_GA
#define DBG_GA 200.0f
#define DBG_GS 2.0f
#define DBG_GT 1.0f
#endif
#define DEV __device__ __forceinline__
#define LAS __attribute__((address_space(3)))
typedef unsigned short bf16;
typedef float f32x2 __attribute__((ext_vector_type(2)));
typedef float f32x4 __attribute__((ext_vector_type(4)));
typedef float f32x16 __attribute__((ext_vector_type(16)));
typedef short bf16x8 __attribute__((ext_vector_type(8)));
typedef unsigned v4u __attribute__((ext_vector_type(4)));
typedef unsigned v2u __attribute__((ext_vector_type(2)));
typedef __bf16 bfx2 __attribute__((ext_vector_type(2)));

constexpr int T = 16384, SEQ = 8192, D = 2048, INW = 9216, NH = 8, HD = 128, NBLK = 32, BLK = 256;
constexpr int C_Q = 0, C_K = 1024, C_V = 2048, C_U = 3072, C_VG = 4096, C_GA = 5120, C_GB = 7168;
constexpr int NEXP = 16384, PLE = 256;
constexpr int PST = INW;
constexpr float EPS = 1e-6f;

constexpr size_t MiB = 1u << 20;
constexpr size_t WS_CTL = 0;
constexpr size_t WS_WIN = 1 * MiB, WS_WBA = 37 * MiB, WS_WBS = 41 * MiB, WS_WOUT = 45 * MiB, WS_WQ = 53 * MiB, WS_WG = 61 * MiB, WS_WPROJ = 69 * MiB;
constexpr size_t WS_PB = 70 * MiB, WS_SKB = 78 * MiB, WS_KMEAN = 79 * MiB;
constexpr size_t WS_XN = 80 * MiB, WS_YATT = 1 * MiB, WS_YSGU = 112 * MiB, WS_H2N = 112 * MiB;
constexpr size_t WS_PROJ = 144 * MiB, WS_DN8 = 80 * MiB, WS_UP8 = 498 * MiB, WS_SDN = 79 * MiB + 256 * 1024, WS_RSS = 528 * MiB, WS_H1N = 272 * MiB, WS_QP = 336 * MiB, WS_EID = 400 * MiB, WS_EGATE = 408 * MiB;
constexpr size_t WS_SC = 79 * MiB + 640 * 1024;
constexpr size_t WS_MQ8 = 336 * MiB;
constexpr size_t WS_SEL = 464 * MiB, WS_LSE = 466 * MiB;
constexpr size_t WS_VT = 434 * MiB, WS_MERGED = 434 * MiB, WS_GTMP = 434 * MiB;
constexpr size_t WS_H2B = 144 * MiB;
constexpr size_t WS_END = 530 * MiB;

constexpr int LDS_BYTES = 147456;
constexpr int NTHREADS = 512;

DEV unsigned pkbf(float a, float b) { bfx2 v = __builtin_convertvector((f32x2){a, b}, bfx2); return __builtin_bit_cast(unsigned, v); }
DEV float bflo(unsigned w) { return __uint_as_float(w << 16); }
DEV float bfhi(unsigned w) { return __uint_as_float(w & 0xffff0000u); }
DEV float bf2f(bf16 b) { return __uint_as_float(((unsigned)b) << 16); }
DEV float wave_sum(float v) {
#pragma unroll
    for (int o = 1; o < 64; o <<= 1) v += __shfl_xor(v, o);
    return v;
}
template <int CTRL> DEV float dppq(float v) { return __int_as_float(__builtin_amdgcn_update_dpp(0, __float_as_int(v), CTRL, 0xF, 0xF, false)); }
DEV float wsum_q(float v) {
    v += dppq<0xB1>(v); v += dppq<0x4E>(v); v += dppq<0x1B>(dppq<0x141>(v)); v += dppq<0x128>(v);
    { const auto r = __builtin_amdgcn_permlane16_swap(__float_as_uint(v), __float_as_uint(v), false, false); v = __uint_as_float(r[0]) + __uint_as_float(r[1]); }
    { const auto r = __builtin_amdgcn_permlane32_swap(__float_as_uint(v), __float_as_uint(v), false, false); v = __uint_as_float(r[0]) + __uint_as_float(r[1]); }
    return v;
}
DEV float wmax_q(float v) {
    v = fmaxf(v, dppq<0xB1>(v)); v = fmaxf(v, dppq<0x4E>(v)); v = fmaxf(v, dppq<0x1B>(dppq<0x141>(v))); v = fmaxf(v, dppq<0x128>(v));
    { const auto r = __builtin_amdgcn_permlane16_swap(__float_as_uint(v), __float_as_uint(v), false, false); v = fmaxf(__uint_as_float(r[0]), __uint_as_float(r[1])); }
    { const auto r = __builtin_amdgcn_permlane32_swap(__float_as_uint(v), __float_as_uint(v), false, false); v = fmaxf(__uint_as_float(r[0]), __uint_as_float(r[1])); }
    return v;
}
DEV float sigmoidf_(float x) { return __builtin_amdgcn_rcpf(1.0f + __expf(-x)); }
DEV float gelu_erf(float v) { return 0.5f * v * (1.0f + erff(v * 0.70710678118f)); }
#define MFMA32(a, b, c) __builtin_amdgcn_mfma_f32_32x32x16_bf16((a), (b), (c), 0, 0, 0)
DEV int crow(int reg, int h) { return (reg & 3) + 8 * (reg >> 2) + 4 * h; }
namespace pg8 {
#define PG8_LAS __attribute__((address_space(3)))
typedef unsigned short bf16_t;
typedef short bf16x8 __attribute__((ext_vector_type(8)));
typedef float f32x4 __attribute__((ext_vector_type(4)));
typedef unsigned u32x4 __attribute__((ext_vector_type(4)));
constexpr int BM = 256, BK = 64, HALF = 128, HTB = HALF * BK * 2  , STAGE_BYTES = 8 * HTB, NXCD = 8, WGM = 8;

__host__ __device__ __forceinline__ int lds_byte(int r, int c) { const int st = (r >> 4) * 2 + (c >> 5), rr = r & 15, cc = c & 31, ob = rr * 64 + cc * 2; return st * 1024 + (ob ^ (((ob >> 9) & 1) << 5)); }
__host__ __device__ __forceinline__ void stage_rc(int b, int& R, int& C) { const int st = b / 1024, sb = b % 1024, swz = sb ^ (((sb >> 9) & 1) << 5); R = (st >> 1) * 16 + swz / 64; C = (st & 1) * 32 + (swz % 64) / 2; }
__host__ __device__ __forceinline__ int perm32(int rho) { const int n = rho >> 4, i = rho & 15; return 8 * (i >> 2) + 4 * n + (i & 3); }

struct Unit { int pm, pn; };
struct Gemm { const bf16_t* A; const bf16_t* Bt; int M, N, K; const bf16_t* A2; int lda; };

struct StaticOrder {
    int nM, nN, nwg, G, c;
    __host__ __device__ __forceinline__ void init(int M, int N, int G_, int c_) { nM = M / BM; nN = N / BM; nwg = nM * nN; G = G_; c = c_; }
    int rot = 0, nround = 1;
    __host__ __device__ __forceinline__ bool next(int i0, Unit& u) const {
        if ((long)i0 * G + c >= nwg) return false;
        int i = i0; if (rot) { i = i0 + rot; if (i >= nround) i -= nround; }
        const long L = (long)i * G + c;
        int wgid = (int)L; { const int q = nwg / NXCD, r = nwg % NXCD, xcd = wgid % NXCD, off = wgid / NXCD; wgid = (xcd < r ? xcd * (q + 1) : r * (q + 1) + (xcd - r) * q) + off; }
        const int nig = WGM * nN, gid = wgid / nig, fm = gid * WGM, gsz = (nM - fm) < WGM ? (nM - fm) : WGM;
        u.pm = fm + ((wgid % nig) % gsz); u.pn = (wgid % nig) / gsz; return true;
    }
    __device__ __forceinline__ void a_ready(const Unit&) const {}
    __device__ __forceinline__ void done(const Unit&) const {}
};


typedef float f32x2 __attribute__((ext_vector_type(2)));
__device__ __forceinline__ f32x2 gelu_pk(f32x2 v) {
    const f32x2 av = __builtin_elementwise_abs(v), d = av * 0.2316418882f + 1.0f;
    f32x2 t; t.x = __builtin_amdgcn_rcpf(d.x); t.y = __builtin_amdgcn_rcpf(d.y);
    f32x2 q = t * 0.5307027145f + (-0.7265760135f); q = q * t + 0.7107068705f; q = q * t + (-0.142248368f); q = q * t + 0.127414796f; q = q * t;
    const f32x2 s = (v * v) * (-0.72134752044f);
    f32x2 e; e.x = __builtin_amdgcn_exp2f(s.x); e.y = __builtin_amdgcn_exp2f(s.y);
    const f32x2 m = v * (q * e), r = v - m;
    f32x2 o; o.x = v.x < 0.f ? m.x : r.x; o.y = v.y < 0.f ? m.y : r.y; return o;
}
template <class F> struct EpiW {
    static constexpr bool PERM = false, AFTER_DRAIN = false, HAS_MID = false;
    F f;
    __device__ __forceinline__ void operator()(const f32x4 (&acc)[2][2][4][2], const Unit& u, int wr, int wc, int fr, int fq) const {
        const int row0 = u.pm * BM + wr * 64 + fr, col0 = u.pn * BM + wc * 32 + 4 * fq;
#pragma unroll
        for (int ai = 0; ai < 2; ++ai)
#pragma unroll
            for (int m = 0; m < 4; ++m) {
#pragma unroll
                for (int bj = 0; bj < 2; ++bj)
#pragma unroll
                    for (int n = 0; n < 2; ++n) f.elem4(row0 + ai * HALF + m * 16, col0 + bj * HALF + n * 16, acc[ai][bj][m][n]);
                asm volatile("" ::: "memory");
            }
    }
};

typedef int i32x4 __attribute__((ext_vector_type(4)));
template <class F> struct EpiW8 {
    static constexpr bool PERM = false, AFTER_DRAIN = false, HAS_MID = false;
    F f; const float* rs; const float* cs;
    __device__ __forceinline__ void operator()(const i32x4 (&acc)[2][2][4][2], const Unit& u, int wr, int wc, int fr, int fq) const {
        const int row0 = u.pm * BM + wr * 64 + fr, col0 = u.pn * BM + wc * 32 + 4 * fq;
        f32x4 cv[2][2];
#pragma unroll
        for (int bj = 0; bj < 2; ++bj)
#pragma unroll
            for (int n = 0; n < 2; ++n) cv[bj][n] = *(const f32x4*)(cs + col0 + bj * HALF + n * 16);
        float rsv[8];
#pragma unroll
        for (int g = 0; g < 8; ++g) rsv[g] = rs[row0 + (g >> 2) * HALF + (g & 3) * 16];
#pragma unroll
        for (int ai = 0; ai < 2; ++ai)
#pragma unroll
            for (int m = 0; m < 4; ++m) { const int row = row0 + ai * HALF + m * 16; const float r = rsv[ai * 4 + m];
#pragma unroll
                for (int bj = 0; bj < 2; ++bj)
#pragma unroll
                    for (int n = 0; n < 2; ++n) { const i32x4 a = acc[ai][bj][m][n]; const f32x4 c4 = cv[bj][n];
                        f.elem4(row, col0 + bj * HALF + n * 16, (f32x4){(float)a.x * (r * c4.x), (float)a.y * (r * c4.y), (float)a.z * (r * c4.z), (float)a.w * (r * c4.w)}); }
                asm volatile("" ::: "memory");
            }
    }
};
template <class Epi, class Sched, bool ALIGN_EPI = false, bool SP2 = false>
__device__ __forceinline__ void gemm_phase(PG8_LAS unsigned char* lds, const Gemm g, const Sched& S, const Epi& E) {
    const int tid = threadIdx.x, wid = __builtin_amdgcn_readfirstlane(tid >> 6), lane = tid & 63, wr = wid >> 2, wc = wid & 3, fr = lane & 15, fq = lane >> 4;
    const int K = g.K, nt = K / BK;
    unsigned voffA[2], voffB[2];
#pragma unroll
    for (int i = 0; i < 2; ++i) { int R, C; stage_rc(tid * 16 + i * 8192, R, C); const int Rb = Epi::PERM ? ((R & ~31) + perm32(R & 31)) : R;
        voffA[i] = (unsigned)(R * g.lda + C) * 2u; voffB[i] = (unsigned)(Rb * K + C) * 2u; }
    const size_t kstep = (size_t)(BK * 2);
    const size_t hstep = (size_t)HALF * K * 2;
    const size_t tstep = 2 * hstep;
    const size_t hstepA = (size_t)HALF * g.lda * 2, tstepA = 2 * hstepA;
    const int nth = nt / 2; const ptrdiff_t a2off = (const char*)g.A2 - (const char*)g.A - (ptrdiff_t)nth * (BK * 2);
    const unsigned ldsw = (unsigned)wid * 1024u;
    const int aoff = lds_byte(wr * 64 + fr, fq * 8), boff = lds_byte(wc * 32 + fr, fq * 8);
#define PG8_SA(b, h) (((b) * 2 + (h)) * HTB)
#define PG8_SB(b, h) ((4 + (b) * 2 + (h)) * HTB)
#define PG8_STAGE(bufoff, gbase, voff) do { _Pragma("unroll") for (int _i = 0; _i < 2; ++_i) \
        __builtin_amdgcn_global_load_lds((const unsigned*)((const char*)(gbase) + (voff)[_i]), (PG8_LAS unsigned*)(lds + (bufoff) + ldsw + _i * 8192), 16, 0, 0); } while (0)
#define PG8_LDA(dst, b, h) do { _Pragma("unroll") for (int m = 0; m < 4; ++m) _Pragma("unroll") for (int k = 0; k < 2; ++k) dst[m][k] = *(const PG8_LAS bf16x8*)(lds + PG8_SA(b, h) + aoff + m * 2048 + k * 1024); } while (0)
#define PG8_LDB(dst, b, h) do { _Pragma("unroll") for (int n = 0; n < 2; ++n) _Pragma("unroll") for (int k = 0; k < 2; ++k) dst[n][k] = *(const PG8_LAS bf16x8*)(lds + PG8_SB(b, h) + boff + n * 2048 + k * 1024); } while (0)
#define PG8_MMA(ai, bj, At, Bt) do { __builtin_amdgcn_s_setprio(1); _Pragma("unroll") for (int m = 0; m < 4; ++m) _Pragma("unroll") for (int n = 0; n < 2; ++n) _Pragma("unroll") for (int k = 0; k < 2; ++k) \
        acc[ai][bj][m][n] = __builtin_amdgcn_mfma_f32_16x16x32_bf16(Bt[n][k], At[m][k], acc[ai][bj][m][n], 0, 0, 0); __builtin_amdgcn_s_setprio(0); } while (0)
#define PG8_WAIT_V(n) asm volatile("s_waitcnt vmcnt(" #n ")" ::: "memory")
#define PG8_WAIT_L(n) asm volatile("s_waitcnt lgkmcnt(" #n ")" ::: "memory")
#define PG8_BAR __builtin_amdgcn_s_barrier()
#define PG8_SCHED __builtin_amdgcn_sched_barrier(0)
    Unit cur, nxt; int ui = 0;
    if (!S.next(0, cur)) return;
    f32x4 acc[2][2][4][2];
#pragma unroll
    for (int a = 0; a < 2; ++a)
#pragma unroll
        for (int b = 0; b < 2; ++b)
#pragma unroll
            for (int m = 0; m < 4; ++m)
#pragma unroll
                for (int n = 0; n < 2; ++n) acc[a][b][m][n] = (f32x4){0.f, 0.f, 0.f, 0.f};
    bf16x8 At[4][2], B0[2][2], B1[2][2];
    const char* cA = (const char*)g.A + (size_t)cur.pm * tstepA; const char* cB = (const char*)g.Bt + (size_t)cur.pn * tstep;
    S.a_ready(cur);
    if constexpr (SP2) {
        PG8_STAGE(PG8_SB(0, 0), cB, voffB); PG8_STAGE(PG8_SB(0, 1), cB + hstep, voffB); PG8_STAGE(PG8_SA(0, 0), cA, voffA); PG8_STAGE(PG8_SA(0, 1), cA + hstepA, voffA);
        if (wr == 1) PG8_BAR;
        PG8_WAIT_V(2); PG8_BAR;
        PG8_STAGE(PG8_SB(1, 0), cB + kstep, voffB); PG8_STAGE(PG8_SA(1, 0), cA + kstep, voffA); PG8_STAGE(PG8_SB(1, 1), cB + hstep + kstep, voffB);
        PG8_WAIT_V(6); PG8_BAR;
    } else {
        PG8_STAGE(PG8_SB(0, 0), cB, voffB); PG8_STAGE(PG8_SA(0, 0), cA, voffA); PG8_STAGE(PG8_SB(0, 1), cB + hstep, voffB); PG8_STAGE(PG8_SA(0, 1), cA + hstepA, voffA);
        if (wr == 1) PG8_BAR;
        PG8_WAIT_V(4); PG8_BAR;
        PG8_STAGE(PG8_SB(1, 0), cB + kstep, voffB); PG8_STAGE(PG8_SA(1, 0), cA + kstep, voffA); PG8_STAGE(PG8_SB(1, 1), cB + hstep + kstep, voffB);
        PG8_WAIT_V(6); PG8_BAR;
    }
    for (;;) {
        const bool has_next = S.next(ui + 1, nxt);
        const char* nA = has_next ? (const char*)g.A + (size_t)nxt.pm * tstepA : cA; const char* nB = has_next ? (const char*)g.Bt + (size_t)nxt.pn * tstep : cB;
        if constexpr (Epi::HAS_MID) {
        for (int t = 0; t < nth; t += 2) {
            const bool last = (t == nt - 2);
            const char* a1 = cA + (t + 1 >= nth ? a2off : 0) + (size_t)(t + 1) * kstep;
            const char* a2 = last ? nA : cA + (t + 2 >= nth ? a2off : 0) + (size_t)(t + 2) * kstep; const char* b2 = last ? nB : cB + (size_t)(t + 2) * kstep;
            const char* a3 = a2 + kstep; const char* b3 = b2 + kstep;
            if (last && has_next) S.a_ready(nxt);
            if constexpr (SP2) {
            PG8_LDB(B0, 0, 0); PG8_LDB(B1, 0, 1); PG8_SCHED; PG8_LDA(At, 0, 0); PG8_STAGE(PG8_SA(1, 1), a1 + hstepA, voffA);
            PG8_WAIT_V(8); PG8_WAIT_L(0); PG8_BAR; PG8_MMA(0, 0, At, B0); PG8_MMA(0, 1, At, B1); PG8_BAR; PG8_SCHED;
            PG8_LDA(At, 0, 1); PG8_STAGE(PG8_SB(0, 0), b2, voffB); PG8_STAGE(PG8_SB(0, 1), b2 + hstep, voffB); PG8_STAGE(PG8_SA(0, 0), a2, voffA);
            PG8_WAIT_V(8); PG8_WAIT_L(0); PG8_BAR; PG8_MMA(1, 0, At, B0); PG8_MMA(1, 1, At, B1); PG8_BAR; PG8_SCHED;
            PG8_LDB(B0, 1, 0); PG8_LDB(B1, 1, 1); PG8_SCHED; PG8_LDA(At, 1, 0); PG8_STAGE(PG8_SA(0, 1), a2 + hstepA, voffA);
            PG8_WAIT_V(8); PG8_WAIT_L(0); PG8_BAR; PG8_MMA(0, 0, At, B0); PG8_MMA(0, 1, At, B1); PG8_BAR; PG8_SCHED;
            PG8_LDA(At, 1, 1); PG8_STAGE(PG8_SB(1, 0), b3, voffB); PG8_STAGE(PG8_SB(1, 1), b3 + hstep, voffB); PG8_STAGE(PG8_SA(1, 0), a3, voffA);
            PG8_WAIT_V(8); PG8_WAIT_L(0); PG8_BAR; PG8_MMA(1, 0, At, B0); PG8_MMA(1, 1, At, B1); PG8_BAR; PG8_SCHED;
            } else {
            PG8_LDB(B0, 0, 0); PG8_SCHED; PG8_LDA(At, 0, 0); PG8_STAGE(PG8_SA(1, 1), a1 + hstepA, voffA);
            PG8_WAIT_L(8); PG8_BAR; PG8_WAIT_L(0); PG8_MMA(0, 0, At, B0); PG8_BAR; PG8_SCHED;
            PG8_LDB(B1, 0, 1); PG8_STAGE(PG8_SB(0, 0), b2, voffB);
            PG8_BAR; PG8_WAIT_L(0); PG8_MMA(0, 1, At, B1); PG8_BAR;
            PG8_LDA(At, 0, 1); PG8_STAGE(PG8_SA(0, 0), a2, voffA);
            PG8_BAR; PG8_WAIT_L(0); PG8_MMA(1, 0, At, B0); PG8_BAR; PG8_SCHED;
            PG8_STAGE(PG8_SB(0, 1), b2 + hstep, voffB);
            PG8_WAIT_V(6); PG8_BAR; PG8_MMA(1, 1, At, B1); PG8_BAR;
            PG8_LDB(B0, 1, 0); PG8_SCHED; PG8_LDA(At, 1, 0); PG8_STAGE(PG8_SA(0, 1), a2 + hstepA, voffA);
            PG8_WAIT_L(8); PG8_BAR; PG8_WAIT_L(0); PG8_MMA(0, 0, At, B0); PG8_BAR; PG8_SCHED;
            PG8_LDB(B1, 1, 1); PG8_STAGE(PG8_SB(1, 0), b3, voffB);
            PG8_BAR; PG8_WAIT_L(0); PG8_MMA(0, 1, At, B1); PG8_BAR;
            PG8_LDA(At, 1, 1); PG8_STAGE(PG8_SA(1, 0), a3, voffA);
            PG8_BAR; PG8_WAIT_L(0); PG8_MMA(1, 0, At, B0); PG8_BAR; PG8_SCHED;
            PG8_STAGE(PG8_SB(1, 1), b3 + hstep, voffB);
            PG8_WAIT_V(6); PG8_BAR; PG8_MMA(1, 1, At, B1); PG8_BAR;
            }
        }
        E.mid(acc, cur, wr, wc, fr, fq);
        for (int t = nth; t < nt; t += 2) {
            const bool last = (t == nt - 2);
            const char* a1 = cA + (t + 1 >= nth ? a2off : 0) + (size_t)(t + 1) * kstep;
            const char* a2 = last ? nA : cA + (t + 2 >= nth ? a2off : 0) + (size_t)(t + 2) * kstep; const char* b2 = last ? nB : cB + (size_t)(t + 2) * kstep;
            const char* a3 = a2 + kstep; const char* b3 = b2 + kstep;
            if (last && has_next) S.a_ready(nxt);
            if constexpr (SP2) {
            PG8_LDB(B0, 0, 0); PG8_LDB(B1, 0, 1); PG8_SCHED; PG8_LDA(At, 0, 0); PG8_STAGE(PG8_SA(1, 1), a1 + hstepA, voffA);
            PG8_WAIT_V(8); PG8_WAIT_L(0); PG8_BAR; PG8_MMA(0, 0, At, B0); PG8_MMA(0, 1, At, B1); PG8_BAR; PG8_SCHED;
            PG8_LDA(At, 0, 1); PG8_STAGE(PG8_SB(0, 0), b2, voffB); PG8_STAGE(PG8_SB(0, 1), b2 + hstep, voffB); PG8_STAGE(PG8_SA(0, 0), a2, voffA);
            PG8_WAIT_V(8); PG8_WAIT_L(0); PG8_BAR; PG8_MMA(1, 0, At, B0); PG8_MMA(1, 1, At, B1); PG8_BAR; PG8_SCHED;
            PG8_LDB(B0, 1, 0); PG8_LDB(B1, 1, 1); PG8_SCHED; PG8_LDA(At, 1, 0); PG8_STAGE(PG8_SA(0, 1), a2 + hstepA, voffA);
            PG8_WAIT_V(8); PG8_WAIT_L(0); PG8_BAR; PG8_MMA(0, 0, At, B0); PG8_MMA(0, 1, At, B1); PG8_BAR; PG8_SCHED;
            PG8_LDA(At, 1, 1); PG8_STAGE(PG8_SB(1, 0), b3, voffB); PG8_STAGE(PG8_SB(1, 1), b3 + hstep, voffB); PG8_STAGE(PG8_SA(1, 0), a3, voffA);
            PG8_WAIT_V(8); PG8_WAIT_L(0); PG8_BAR; PG8_MMA(1, 0, At, B0); PG8_MMA(1, 1, At, B1); PG8_BAR; PG8_SCHED;
            } else {
            PG8_LDB(B0, 0, 0); PG8_SCHED; PG8_LDA(At, 0, 0); PG8_STAGE(PG8_SA(1, 1), a1 + hstepA, voffA);
            PG8_WAIT_L(8); PG8_BAR; PG8_WAIT_L(0); PG8_MMA(0, 0, At, B0); PG8_BAR; PG8_SCHED;
            PG8_LDB(B1, 0, 1); PG8_STAGE(PG8_SB(0, 0), b2, voffB);
            PG8_BAR; PG8_WAIT_L(0); PG8_MMA(0, 1, At, B1); PG8_BAR;
            PG8_LDA(At, 0, 1); PG8_STAGE(PG8_SA(0, 0), a2, voffA);
            PG8_BAR; PG8_WAIT_L(0); PG8_MMA(1, 0, At, B0); PG8_BAR; PG8_SCHED;
            PG8_STAGE(PG8_SB(0, 1), b2 + hstep, voffB);
            PG8_WAIT_V(6); PG8_BAR; PG8_MMA(1, 1, At, B1); PG8_BAR;
            PG8_LDB(B0, 1, 0); PG8_SCHED; PG8_LDA(At, 1, 0); PG8_STAGE(PG8_SA(0, 1), a2 + hstepA, voffA);
            PG8_WAIT_L(8); PG8_BAR; PG8_WAIT_L(0); PG8_MMA(0, 0, At, B0); PG8_BAR; PG8_SCHED;
            PG8_LDB(B1, 1, 1); PG8_STAGE(PG8_SB(1, 0), b3, voffB);
            PG8_BAR; PG8_WAIT_L(0); PG8_MMA(0, 1, At, B1); PG8_BAR;
            PG8_LDA(At, 1, 1); PG8_STAGE(PG8_SA(1, 0), a3, voffA);
            PG8_BAR; PG8_WAIT_L(0); PG8_MMA(1, 0, At, B0); PG8_BAR; PG8_SCHED;
            PG8_STAGE(PG8_SB(1, 1), b3 + hstep, voffB);
            PG8_WAIT_V(6); PG8_BAR; PG8_MMA(1, 1, At, B1); PG8_BAR;
            }
        }
        } else {
        for (int t = 0; t < nt; t += 2) {
            const bool last = (t == nt - 2);
            const char* a1 = cA + (t + 1 >= nth ? a2off : 0) + (size_t)(t + 1) * kstep;
            const char* a2 = last ? nA : cA + (t + 2 >= nth ? a2off : 0) + (size_t)(t + 2) * kstep; const char* b2 = last ? nB : cB + (size_t)(t + 2) * kstep;
            const char* a3 = a2 + kstep; const char* b3 = b2 + kstep;
            if (last && has_next) S.a_ready(nxt);
            if constexpr (SP2) {
            PG8_LDB(B0, 0, 0); PG8_LDB(B1, 0, 1); PG8_SCHED; PG8_LDA(At, 0, 0); PG8_STAGE(PG8_SA(1, 1), a1 + hstepA, voffA);
            PG8_WAIT_V(8); PG8_WAIT_L(0); PG8_BAR; PG8_MMA(0, 0, At, B0); PG8_MMA(0, 1, At, B1); PG8_BAR; PG8_SCHED;
            PG8_LDA(At, 0, 1); PG8_STAGE(PG8_SB(0, 0), b2, voffB); PG8_STAGE(PG8_SB(0, 1), b2 + hstep, voffB); PG8_STAGE(PG8_SA(0, 0), a2, voffA);
            PG8_WAIT_V(8); PG8_WAIT_L(0); PG8_BAR; PG8_MMA(1, 0, At, B0); PG8_MMA(1, 1, At, B1); PG8_BAR; PG8_SCHED;
            PG8_LDB(B0, 1, 0); PG8_LDB(B1, 1, 1); PG8_SCHED; PG8_LDA(At, 1, 0); PG8_STAGE(PG8_SA(0, 1), a2 + hstepA, voffA);
            PG8_WAIT_V(8); PG8_WAIT_L(0); PG8_BAR; PG8_MMA(0, 0, At, B0); PG8_MMA(0, 1, At, B1); PG8_BAR; PG8_SCHED;
            PG8_LDA(At, 1, 1); PG8_STAGE(PG8_SB(1, 0), b3, voffB); PG8_STAGE(PG8_SB(1, 1), b3 + hstep, voffB); PG8_STAGE(PG8_SA(1, 0), a3, voffA);
            PG8_WAIT_V(8); PG8_WAIT_L(0); PG8_BAR; PG8_MMA(1, 0, At, B0); PG8_MMA(1, 1, At, B1); PG8_BAR; PG8_SCHED;
            } else {
            PG8_LDB(B0, 0, 0); PG8_SCHED; PG8_LDA(At, 0, 0); PG8_STAGE(PG8_SA(1, 1), a1 + hstepA, voffA);
            PG8_WAIT_L(8); PG8_BAR; PG8_WAIT_L(0); PG8_MMA(0, 0, At, B0); PG8_BAR; PG8_SCHED;
            PG8_LDB(B1, 0, 1); PG8_STAGE(PG8_SB(0, 0), b2, voffB);
            PG8_BAR; PG8_WAIT_L(0); PG8_MMA(0, 1, At, B1); PG8_BAR;
            PG8_LDA(At, 0, 1); PG8_STAGE(PG8_SA(0, 0), a2, voffA);
            PG8_BAR; PG8_WAIT_L(0); PG8_MMA(1, 0, At, B0); PG8_BAR; PG8_SCHED;
            PG8_STAGE(PG8_SB(0, 1), b2 + hstep, voffB);
            PG8_WAIT_V(6); PG8_BAR; PG8_MMA(1, 1, At, B1); PG8_BAR;
            PG8_LDB(B0, 1, 0); PG8_SCHED; PG8_LDA(At, 1, 0); PG8_STAGE(PG8_SA(0, 1), a2 + hstepA, voffA);
            PG8_WAIT_L(8); PG8_BAR; PG8_WAIT_L(0); PG8_MMA(0, 0, At, B0); PG8_BAR; PG8_SCHED;
            PG8_LDB(B1, 1, 1); PG8_STAGE(PG8_SB(1, 0), b3, voffB);
            PG8_BAR; PG8_WAIT_L(0); PG8_MMA(0, 1, At, B1); PG8_BAR;
            PG8_LDA(At, 1, 1); PG8_STAGE(PG8_SA(1, 0), a3, voffA);
            PG8_BAR; PG8_WAIT_L(0); PG8_MMA(1, 0, At, B0); PG8_BAR; PG8_SCHED;
            PG8_STAGE(PG8_SB(1, 1), b3 + hstep, voffB);
            PG8_WAIT_V(6); PG8_BAR; PG8_MMA(1, 1, At, B1); PG8_BAR;
            }
        }
        }
        if constexpr (ALIGN_EPI) { if (wr == 0) PG8_BAR; }
        if constexpr (!Epi::AFTER_DRAIN) { E(acc, cur, wr, wc, fr, fq); S.done(cur); }
        if (!has_next) break;
#pragma unroll
        for (int a = 0; a < 2; ++a)
#pragma unroll
            for (int b = 0; b < 2; ++b)
#pragma unroll
                for (int m = 0; m < 4; ++m)
#pragma unroll
                    for (int n = 0; n < 2; ++n) acc[a][b][m][n] = (f32x4){0.f, 0.f, 0.f, 0.f};
        cur = nxt; cA = nA; cB = nB; ++ui;
        if constexpr (ALIGN_EPI) { if (wr == 1) PG8_BAR; }
    }
    PG8_WAIT_V(0);
    if constexpr (!ALIGN_EPI) { if (wr == 0) PG8_BAR; }
    PG8_BAR;
    if constexpr (Epi::AFTER_DRAIN) { E.fused(acc, cur, wr, wc, fr, fq, lds, wid, lane); S.done(cur); }
#undef PG8_SA
#undef PG8_SB
#undef PG8_STAGE
#undef PG8_LDA
#undef PG8_LDB
#undef PG8_MMA
#undef PG8_WAIT_V
#undef PG8_WAIT_L
#undef PG8_BAR
#undef PG8_SCHED
}

typedef int i32x4 __attribute__((ext_vector_type(4)));
template <class Epi, class Sched, bool ALIGN_EPI = false, bool SP2 = false>
__device__ __forceinline__ void gemm_phase_i8(PG8_LAS unsigned char* lds, const Gemm g, const Sched& S, const Epi& E) {
    const int tid = threadIdx.x, wid = __builtin_amdgcn_readfirstlane(tid >> 6), lane = tid & 63, wr = wid >> 2, wc = wid & 3, fr = lane & 15, fq = lane >> 4;
    const int K = g.K, nt = K / 128;
    unsigned voffA[2], voffB[2];
#pragma unroll
    for (int i = 0; i < 2; ++i) { int R, C; stage_rc(tid * 16 + i * 8192, R, C); const int Rb = Epi::PERM ? ((R & ~31) + perm32(R & 31)) : R;
        voffA[i] = (unsigned)(R * K + C * 2); voffB[i] = (unsigned)(Rb * K + C * 2); }
    const size_t kstep = (size_t)(BK * 2);
    const size_t hstep = (size_t)HALF * K;
    const size_t tstep = 2 * hstep;
    const unsigned ldsw = (unsigned)wid * 1024u;
    const int aoff = lds_byte(wr * 64 + fr, fq * 8), boff = lds_byte(wc * 32 + fr, fq * 8);
#define PG8_SA(b, h) (((b) * 2 + (h)) * HTB)
#define PG8_SB(b, h) ((4 + (b) * 2 + (h)) * HTB)
#define PG8_STAGE(bufoff, gbase, voff) do { _Pragma("unroll") for (int _i = 0; _i < 2; ++_i) \
        __builtin_amdgcn_global_load_lds((const unsigned*)((const char*)(gbase) + (voff)[_i]), (PG8_LAS unsigned*)(lds + (bufoff) + ldsw + _i * 8192), 16, 0, 0); } while (0)
#define PG8_LDA(dst, b, h) do { _Pragma("unroll") for (int m = 0; m < 4; ++m) _Pragma("unroll") for (int k = 0; k < 2; ++k) dst[m][k] = *(const PG8_LAS i32x4*)(lds + PG8_SA(b, h) + aoff + m * 2048 + k * 1024); } while (0)
#define PG8_LDB(dst, b, h) do { _Pragma("unroll") for (int n = 0; n < 2; ++n) _Pragma("unroll") for (int k = 0; k < 2; ++k) dst[n][k] = *(const PG8_LAS i32x4*)(lds + PG8_SB(b, h) + boff + n * 2048 + k * 1024); } while (0)
#define PG8_MMA(ai, bj, At, Bt) do { __builtin_amdgcn_s_setprio(1); _Pragma("unroll") for (int m = 0; m < 4; ++m) _Pragma("unroll") for (int n = 0; n < 2; ++n) _Pragma("unroll") for (int k = 0; k < 2; ++k) \
        acc[ai][bj][m][n] = __builtin_amdgcn_mfma_i32_16x16x64_i8(Bt[n][k], At[m][k], acc[ai][bj][m][n], 0, 0, 0); __builtin_amdgcn_s_setprio(0); } while (0)
#define PG8_WAIT_V(n) asm volatile("s_waitcnt vmcnt(" #n ")" ::: "memory")
#define PG8_WAIT_L(n) asm volatile("s_waitcnt lgkmcnt(" #n ")" ::: "memory")
#define PG8_BAR __builtin_amdgcn_s_barrier()
#define PG8_SCHED __builtin_amdgcn_sched_barrier(0)
    Unit cur, nxt; int ui = 0;
    if (!S.next(0, cur)) return;
    i32x4 acc[2][2][4][2];
#pragma unroll
    for (int a = 0; a < 2; ++a)
#pragma unroll
        for (int b = 0; b < 2; ++b)
#pragma unroll
            for (int m = 0; m < 4; ++m)
#pragma unroll
                for (int n = 0; n < 2; ++n) acc[a][b][m][n] = (i32x4){0, 0, 0, 0};
    i32x4 At[4][2], B0[2][2], B1[2][2];
    const char* cA = (const char*)g.A + (size_t)cur.pm * tstep; const char* cB = (const char*)g.Bt + (size_t)cur.pn * tstep;
    S.a_ready(cur);
    if constexpr (SP2) {
        PG8_STAGE(PG8_SB(0, 0), cB, voffB); PG8_STAGE(PG8_SB(0, 1), cB + hstep, voffB); PG8_STAGE(PG8_SA(0, 0), cA, voffA); PG8_STAGE(PG8_SA(0, 1), cA + hstep, voffA);
        if (wr == 1) PG8_BAR;
        PG8_WAIT_V(2); PG8_BAR;
        PG8_STAGE(PG8_SB(1, 0), cB + kstep, voffB); PG8_STAGE(PG8_SA(1, 0), cA + kstep, voffA); PG8_STAGE(PG8_SB(1, 1), cB + hstep + kstep, voffB);
        PG8_WAIT_V(6); PG8_BAR;
    } else {
        PG8_STAGE(PG8_SB(0, 0), cB, voffB); PG8_STAGE(PG8_SA(0, 0), cA, voffA); PG8_STAGE(PG8_SB(0, 1), cB + hstep, voffB); PG8_STAGE(PG8_SA(0, 1), cA + hstep, voffA);
        if (wr == 1) PG8_BAR;
        PG8_WAIT_V(4); PG8_BAR;
        PG8_STAGE(PG8_SB(1, 0), cB + kstep, voffB); PG8_STAGE(PG8_SA(1, 0), cA + kstep, voffA); PG8_STAGE(PG8_SB(1, 1), cB + hstep + kstep, voffB);
        PG8_WAIT_V(6); PG8_BAR;
    }
    for (;;) {
        const bool has_next = S.next(ui + 1, nxt);
        const char* nA = has_next ? (const char*)g.A + (size_t)nxt.pm * tstep : cA; const char* nB = has_next ? (const char*)g.Bt + (size_t)nxt.pn * tstep : cB;
        for (int t = 0; t < nt; t += 2) {
            const bool last = (t == nt - 2);
            const char* a1 = cA + (size_t)(t + 1) * kstep;
            const char* a2 = last ? nA : cA + (size_t)(t + 2) * kstep; const char* b2 = last ? nB : cB + (size_t)(t + 2) * kstep;
            const char* a3 = a2 + kstep; const char* b3 = b2 + kstep;
            if (last && has_next) S.a_ready(nxt);
            if constexpr (SP2) {
            PG8_LDB(B0, 0, 0); PG8_LDB(B1, 0, 1); PG8_SCHED; PG8_LDA(At, 0, 0); PG8_STAGE(PG8_SA(1, 1), a1 + hstep, voffA);
            PG8_WAIT_V(8); PG8_WAIT_L(0); PG8_BAR; PG8_MMA(0, 0, At, B0); PG8_MMA(0, 1, At, B1); PG8_BAR; PG8_SCHED;
            PG8_LDA(At, 0, 1); PG8_STAGE(PG8_SB(0, 0), b2, voffB); PG8_STAGE(PG8_SB(0, 1), b2 + hstep, voffB); PG8_STAGE(PG8_SA(0, 0), a2, voffA);
            PG8_WAIT_V(8); PG8_WAIT_L(0); PG8_BAR; PG8_MMA(1, 0, At, B0); PG8_MMA(1, 1, At, B1); PG8_BAR; PG8_SCHED;
            PG8_LDB(B0, 1, 0); PG8_LDB(B1, 1, 1); PG8_SCHED; PG8_LDA(At, 1, 0); PG8_STAGE(PG8_SA(0, 1), a2 + hstep, voffA);
            PG8_WAIT_V(8); PG8_WAIT_L(0); PG8_BAR; PG8_MMA(0, 0, At, B0); PG8_MMA(0, 1, At, B1); PG8_BAR; PG8_SCHED;
            PG8_LDA(At, 1, 1); PG8_STAGE(PG8_SB(1, 0), b3, voffB); PG8_STAGE(PG8_SB(1, 1), b3 + hstep, voffB); PG8_STAGE(PG8_SA(1, 0), a3, voffA);
            PG8_WAIT_V(8); PG8_WAIT_L(0); PG8_BAR; PG8_MMA(1, 0, At, B0); PG8_MMA(1, 1, At, B1); PG8_BAR; PG8_SCHED;
            } else {
            PG8_LDB(B0, 0, 0); PG8_SCHED; PG8_LDA(At, 0, 0); PG8_STAGE(PG8_SA(1, 1), a1 + hstep, voffA);
            PG8_WAIT_L(8); PG8_BAR; PG8_WAIT_L(0); PG8_MMA(0, 0, At, B0); PG8_BAR; PG8_SCHED;
            PG8_LDB(B1, 0, 1); PG8_STAGE(PG8_SB(0, 0), b2, voffB);
            PG8_BAR; PG8_WAIT_L(0); PG8_MMA(0, 1, At, B1); PG8_BAR;
            PG8_LDA(At, 0, 1); PG8_STAGE(PG8_SA(0, 0), a2, voffA);
            PG8_BAR; PG8_WAIT_L(0); PG8_MMA(1, 0, At, B0); PG8_BAR; PG8_SCHED;
            PG8_STAGE(PG8_SB(0, 1), b2 + hstep, voffB);
            PG8_WAIT_V(6); PG8_BAR; PG8_MMA(1, 1, At, B1); PG8_BAR;
            PG8_LDB(B0, 1, 0); PG8_SCHED; PG8_LDA(At, 1, 0); PG8_STAGE(PG8_SA(0, 1), a2 + hstep, voffA);
            PG8_WAIT_L(8); PG8_BAR; PG8_WAIT_L(0); PG8_MMA(0, 0, At, B0); PG8_BAR; PG8_SCHED;
            PG8_LDB(B1, 1, 1); PG8_STAGE(PG8_SB(1, 0), b3, voffB);
            PG8_BAR; PG8_WAIT_L(0); PG8_MMA(0, 1, At, B1); PG8_BAR;
            PG8_LDA(At, 1, 1); PG8_STAGE(PG8_SA(1, 0), a3, voffA);
            PG8_BAR; PG8_WAIT_L(0); PG8_MMA(1, 0, At, B0); PG8_BAR; PG8_SCHED;
            PG8_STAGE(PG8_SB(1, 1), b3 + hstep, voffB);
            PG8_WAIT_V(6); PG8_BAR; PG8_MMA(1, 1, At, B1); PG8_BAR;
            }
        }
        if constexpr (ALIGN_EPI) { if (wr == 0) PG8_BAR; }
        if constexpr (!Epi::AFTER_DRAIN) { E(acc, cur, wr, wc, fr, fq); S.done(cur); }
        if (!has_next) break;
#pragma unroll
        for (int a = 0; a < 2; ++a)
#pragma unroll
            for (int b = 0; b < 2; ++b)
#pragma unroll
                for (int m = 0; m < 4; ++m)
#pragma unroll
                    for (int n = 0; n < 2; ++n) acc[a][b][m][n] = (i32x4){0, 0, 0, 0};
        cur = nxt; cA = nA; cB = nB; ++ui;
        if constexpr (ALIGN_EPI) { if (wr == 1) PG8_BAR; }
    }
    PG8_WAIT_V(0);
    if constexpr (!ALIGN_EPI) { if (wr == 0) PG8_BAR; }
    PG8_BAR;
    if constexpr (Epi::AFTER_DRAIN) { E.fused(acc, cur, wr, wc, fr, fq, lds, wid, lane); S.done(cur); }
#undef PG8_SA
#undef PG8_SB
#undef PG8_STAGE
#undef PG8_LDA
#undef PG8_LDB
#undef PG8_MMA
#undef PG8_WAIT_V
#undef PG8_WAIT_L
#undef PG8_BAR
#undef PG8_SCHED
}
}

struct Ctx {
    const float *x, *p, *g_mix, *w_in, *ln_g, *ln_b, *sgu_w, *sgu_b, *w_ba, *w_bs, *w_out, *g_ffn, *w_pq, *subk, *dn, *up, *g_ple, *w_pp, *w_pg, *g_fin;
    float* out;
    bf16 *WinT, *WbaT, *WbsT, *WoutT, *WqT, *WgT, *WprojT, *pb, *skb, *xn, *proj, *vT, *yatt, *ysgu, *merged, *h1n, *qp, *h2n, *gtmp, *h2b, *swb;
    float *kmean, *kmp, *sst, *egate, *sdn, *sup, *lse, *xs, *h2s, *wcs, *gcs, *qcs, *h1s, *rss, *ocs, *ms; int *eid, *sel; unsigned char *xq8, *WinT8, *WgT8, *WqT8, *h2q8, *h1q8, *WoutT8, *mq8; unsigned char *dn8, *up8;
    int G, bid, tid, lane, wave;
};

DEV void transpose_item(const float* W, int K, int N, bf16* WT, const float* gain, LAS float* scr, int item, int lane, int ldt = 0) {
    if (ldt == 0) ldt = K;
    const int nblk = N / 32, kb = item / nblk, nb = item % nblk, k0 = 64 * kb, n0 = 32 * nb;
#pragma unroll
    for (int i = 0; i < 8; ++i) { const int kk = 8 * i + (lane >> 3), cc = (lane & 7) * 4; const float gsc = gain ? gain[k0 + kk] : 1.0f;
        const f32x4 w = *(const f32x4*)(W + (size_t)(k0 + kk) * N + n0 + cc); LAS float* sp = scr + kk * 33 + cc; sp[0] = w.x * gsc; sp[1] = w.y * gsc; sp[2] = w.z * gsc; sp[3] = w.w * gsc; }
    asm volatile("s_waitcnt lgkmcnt(0)" ::: "memory");
    const int c = lane & 7;
#pragma unroll
    for (int j = 0; j < 4; ++j) { const int n = (lane >> 3) + 8 * j; const LAS float* s = scr + (8 * c) * 33 + n;
        v4u o; o.x = pkbf(s[0 * 33], s[1 * 33]); o.y = pkbf(s[2 * 33], s[3 * 33]); o.z = pkbf(s[4 * 33], s[5 * 33]); o.w = pkbf(s[6 * 33], s[7 * 33]);
        *(v4u*)(WT + (size_t)(n0 + n) * ldt + k0 + 8 * c) = o; }
    asm volatile("s_waitcnt lgkmcnt(0)" ::: "memory");
}
DEV void row_rms_bf16(const float* xrow, bf16* orow, int lane) {
    const f32x4* xr = (const f32x4*)xrow + lane;
    f32x4 v[8]; float s = 0.f;
#pragma unroll
    for (int j = 0; j < 8; ++j) { v[j] = xr[64 * j]; s += (v[j].x * v[j].x + v[j].y * v[j].y) + (v[j].z * v[j].z + v[j].w * v[j].w); }
    const float r = 1.0f / sqrtf(wave_sum(s) * (1.0f / D) + EPS);
    v2u* o8 = (v2u*)orow + lane;
#pragma unroll
    for (int j = 0; j < 8; ++j) { v2u w; w.x = pkbf(v[j].x * r, v[j].y * r); w.y = pkbf(v[j].z * r, v[j].w * r); o8[64 * j] = w; }
}
DEV void cvt_items(const float* src, bf16* dst, size_t n8, const float* gain, size_t gtid, size_t gthreads) {
    for (size_t i = gtid; i < n8; i += gthreads) {
        const f32x4 a = ((const f32x4*)src)[2 * i], b = ((const f32x4*)src)[2 * i + 1];
        f32x4 ga = {1.f, 1.f, 1.f, 1.f}, gb = ga;
        if (gain) { const size_t c = (i * 8) % D; ga = *(const f32x4*)(gain + c); gb = *(const f32x4*)(gain + c + 4); }
        v4u o; o.x = pkbf(a.x * ga.x, a.y * ga.y); o.y = pkbf(a.z * ga.z, a.w * ga.w); o.z = pkbf(b.x * gb.x, b.y * gb.y); o.w = pkbf(b.z * gb.z, b.w * gb.w);
        ((v4u*)dst)[i] = o;
    }
}
DEV float wave_max(float v);
DEV unsigned q4(float a, float b, float c_, float d, float inv, int off);
DEV void colmax_item(const float* W, int N, const float* gain, unsigned* cam, int item, int lane) {
    const int nblk = N / 256, kb = item / nblk, nb = item % nblk, k0 = 64 * kb, n0 = 256 * nb + 4 * lane;
    f32x4 am = {0.f, 0.f, 0.f, 0.f};
#pragma unroll 8
    for (int kk = 0; kk < 64; ++kk) { const f32x4 w = *(const f32x4*)(W + (size_t)(k0 + kk) * N + n0); const float g = gain ? gain[k0 + kk] : 1.0f;
        am.x = fmaxf(am.x, fabsf(w.x * g)); am.y = fmaxf(am.y, fabsf(w.y * g)); am.z = fmaxf(am.z, fabsf(w.z * g)); am.w = fmaxf(am.w, fabsf(w.w * g)); }
    atomicMax(cam + n0, __float_as_uint(am.x)); atomicMax(cam + n0 + 1, __float_as_uint(am.y)); atomicMax(cam + n0 + 2, __float_as_uint(am.z)); atomicMax(cam + n0 + 3, __float_as_uint(am.w));
}
DEV void transpose_item_i8(const float* W, int K, int N, unsigned char* WT8, const float* gain, const unsigned* cam, LAS float* scr, int item, int lane) {
    const int nblk = N / 32, kb = item / nblk, nb = item % nblk, k0 = 64 * kb, n0 = 32 * nb;
#pragma unroll
    for (int i = 0; i < 8; ++i) { const int kk = 8 * i + (lane >> 3), cc = (lane & 7) * 4; const float gsc = gain ? gain[k0 + kk] : 1.0f;
        const f32x4 w = *(const f32x4*)(W + (size_t)(k0 + kk) * N + n0 + cc); LAS float* sp = scr + kk * 33 + cc; sp[0] = w.x * gsc; sp[1] = w.y * gsc; sp[2] = w.z * gsc; sp[3] = w.w * gsc; }
    asm volatile("s_waitcnt lgkmcnt(0)" ::: "memory");
    const int cq = lane & 3;
#pragma unroll
    for (int j = 0; j < 2; ++j) { const int n = (lane >> 2) + 16 * j; const LAS float* s = scr + (16 * cq) * 33 + n;
        const float am = __uint_as_float(cam[n0 + n]); const float inv = am > 0.f ? 127.0f / am : 0.f;
        v4u o; o.x = q4(s[0 * 33], s[1 * 33], s[2 * 33], s[3 * 33], inv, 0); o.y = q4(s[4 * 33], s[5 * 33], s[6 * 33], s[7 * 33], inv, 0);
        o.z = q4(s[8 * 33], s[9 * 33], s[10 * 33], s[11 * 33], inv, 0); o.w = q4(s[12 * 33], s[13 * 33], s[14 * 33], s[15 * 33], inv, 0);
        *(v4u*)(WT8 + (size_t)(n0 + n) * K + k0 + 16 * cq) = o; }
    asm volatile("s_waitcnt lgkmcnt(0)" ::: "memory");
}
DEV void row_rms_i8(const float* xrow, unsigned char* orow, float* sc, int lane) {
    const f32x4* xr = (const f32x4*)xrow + lane;
    f32x4 v[8]; float s = 0.f, am = 0.f;
#pragma unroll
    for (int j = 0; j < 8; ++j) { v[j] = xr[64 * j]; s += (v[j].x * v[j].x + v[j].y * v[j].y) + (v[j].z * v[j].z + v[j].w * v[j].w);
        am = fmaxf(am, fmaxf(fmaxf(fabsf(v[j].x), fabsf(v[j].y)), fmaxf(fabsf(v[j].z), fabsf(v[j].w)))); }
    const float r = 1.0f / sqrtf(wave_sum(s) * (1.0f / D) + EPS);
    am = wave_max(am);
    const float inv = am > 0.f ? 127.0f / am : 0.f;
    unsigned* o4 = (unsigned*)orow + lane;
#pragma unroll
    for (int j = 0; j < 8; ++j) o4[64 * j] = q4(v[j].x, v[j].y, v[j].z, v[j].w, inv, 0);
    if (lane == 0) *sc = am * (1.0f / 127.0f) * r;
}
DEV void phase_prologue2(const Ctx& c, LAS unsigned char* lds, const unsigned* cam) {
    LAS float* scr = (LAS float*)(lds + c.wave * 16384);
    const int gw = c.bid * 8 + c.wave, NGW = c.G * 8;
    constexpr int I_IN = (D / 64) * (INW / 32), I_SQ = (D / 64) * (D / 32);
    for (int it = gw; it < I_IN + I_SQ; it += NGW) {
        if (it < I_IN) transpose_item_i8(c.w_in, D, INW, c.WinT8, c.g_mix, cam, scr, it, c.lane);
        else transpose_item_i8(c.w_pg, D, D, c.WgT8, c.g_ple, cam + INW, scr, it - I_IN, c.lane);
    }
    for (int i = c.bid * NTHREADS + c.tid; i < INW + D; i += c.G * NTHREADS) { const float s = __uint_as_float(cam[i]) * (1.0f / 127.0f); if (i < INW) c.wcs[i] = s; else c.gcs[i - INW] = s; }
}
DEV void phase_prologue(const Ctx& c, LAS unsigned char* lds, unsigned* cam) {
    LAS float* scr = (LAS float*)(lds + c.wave * 16384);
    const int gw = c.bid * 8 + c.wave, NGW = c.G * 8;
    constexpr int I_IN = (D / 64) * (INW / 32), I_BA = (1024 / 64) * (D / 32), I_SQ = (D / 64) * (D / 32), I_PP = (PLE / 64) * (D / 32);
    constexpr int C_IN = (D / 64) * (INW / 256), C_SQ = (D / 64) * (D / 256);
    for (int it = gw; it < C_IN + C_SQ; it += NGW) {
        if (it < C_IN) colmax_item(c.w_in, INW, c.g_mix, cam, it, c.lane); else colmax_item(c.w_pg, D, c.g_ple, cam + INW, it - C_IN, c.lane);
    }
    constexpr int NITEMS = 2 * I_BA + 2 * I_SQ + I_PP;
    for (int it = gw; it < NITEMS; it += NGW) {
        int r = it;
        if (r < I_BA) { transpose_item(c.w_ba, 1024, D, c.WbaT, nullptr, scr, r, c.lane, 2048); continue; } r -= I_BA;
        if (r < I_BA) { transpose_item(c.w_bs, 1024, D, c.WbaT + 1024, nullptr, scr, r, c.lane, 2048); continue; } r -= I_BA;
        if (r < I_SQ) { transpose_item(c.w_out, D, D, c.WoutT, nullptr, scr, r, c.lane); continue; } r -= I_SQ;
        if (r < I_SQ) { transpose_item(c.w_pq, D, D, c.WqT, c.g_ffn, scr, r, c.lane); continue; } r -= I_SQ;
        transpose_item(c.w_pp, PLE, D, c.WprojT, nullptr, scr, r, c.lane);
    }
    {
        f32x4 vn[8]; int m = gw;
        if (m < T) { const f32x4* xr = (const f32x4*)(c.x + (size_t)m * D) + c.lane;
#pragma unroll
            for (int j = 0; j < 8; ++j) vn[j] = xr[64 * j]; }
        for (; m < T; m += NGW) {
            f32x4 v[8];
#pragma unroll
            for (int j = 0; j < 8; ++j) v[j] = vn[j];
            { const int mn = m + NGW < T ? m + NGW : m; const f32x4* xr = (const f32x4*)(c.x + (size_t)mn * D) + c.lane;
#pragma unroll
              for (int j = 0; j < 8; ++j) vn[j] = xr[64 * j]; }
            float s = 0.f, am = 0.f;
#pragma unroll
            for (int j = 0; j < 8; ++j) { s += (v[j].x * v[j].x + v[j].y * v[j].y) + (v[j].z * v[j].z + v[j].w * v[j].w);
                am = fmaxf(am, fmaxf(fmaxf(fabsf(v[j].x), fabsf(v[j].y)), fmaxf(fabsf(v[j].z), fabsf(v[j].w)))); }
            const float r = 1.0f / sqrtf(wsum_q(s) * (1.0f / D) + EPS);
            am = wmax_q(am);
            const float inv = am > 0.f ? 127.0f / am : 0.f;
            unsigned* o4 = (unsigned*)(c.xq8 + (size_t)m * D) + c.lane;
#pragma unroll
            for (int j = 0; j < 8; ++j) o4[64 * j] = q4(v[j].x, v[j].y, v[j].z, v[j].w, inv, 0);
            if (c.lane == 0) c.xs[m] = am * (1.0f / 127.0f) * r;
        }
    }
    const size_t gtid = (size_t)c.bid * NTHREADS + c.tid, gthreads = (size_t)c.G * NTHREADS;
    cvt_items(c.p, c.pb, (size_t)T * PLE / 8, nullptr, gtid, gthreads);
    cvt_items(c.subk, c.skb, (size_t)NH * 2 * 128 * 128 / 8, nullptr, gtid, gthreads);
    for (size_t i = gtid; i < (size_t)8 * 128 * 128 / 8; i += gthreads) {
        const int t = (int)(i >> 4) & 127, s0 = (int)(i & 15) * 8; const f32x4 a = *(const f32x4*)(c.sgu_w + i * 8), b = *(const f32x4*)(c.sgu_w + i * 8 + 4);
        v4u o; o.x = pkbf(s0 + 0 <= t ? a.x : 0.f, s0 + 1 <= t ? a.y : 0.f); o.y = pkbf(s0 + 2 <= t ? a.z : 0.f, s0 + 3 <= t ? a.w : 0.f);
        o.z = pkbf(s0 + 4 <= t ? b.x : 0.f, s0 + 5 <= t ? b.y : 0.f); o.w = pkbf(s0 + 6 <= t ? b.z : 0.f, s0 + 7 <= t ? b.w : 0.f);
        *(v4u*)(c.swb + i * 8) = o; }
}

DEV float rsum16(float v) { v += dppq<0xB1>(v); v += dppq<0x4E>(v); v += dppq<0x1B>(dppq<0x141>(v)); v += dppq<0x128>(v); return v; }
struct F1 { bf16* proj;
    DEV void elem4(int row, int col, f32x4 v) const {
        if (col >= C_GA) { v.x = sigmoidf_(v.x); v.y = sigmoidf_(v.y); v.z = sigmoidf_(v.z); v.w = sigmoidf_(v.w); }
        else if (col >= C_U) { const f32x2 a = pg8::gelu_pk((f32x2){v.x, v.y}), b = pg8::gelu_pk((f32x2){v.z, v.w}); v = (f32x4){a.x, a.y, b.x, b.y}; }
        v2u w; w.x = pkbf(v.x, v.y); w.y = pkbf(v.z, v.w); *(v2u*)(proj + (size_t)row * PST + col) = w; } };
constexpr float GQ = 255.99f;
DEV unsigned gate_q(float x) { return (unsigned)__builtin_amdgcn_rcpf((1.0f / GQ) + __builtin_amdgcn_exp2f(fmaf(x, -1.4426950408889634f, -7.999943641f))); }
DEV f32x4 gate_dq(unsigned w) { return (f32x4){((float)(w & 0xffu) + 0.5f) * (1.0f / GQ), ((float)((w >> 8) & 0xffu) + 0.5f) * (1.0f / GQ), ((float)((w >> 16) & 0xffu) + 0.5f) * (1.0f / GQ), ((float)(w >> 24) + 0.5f) * (1.0f / GQ)}; }
struct EpiIn { static constexpr bool PERM = false, AFTER_DRAIN = false, HAS_MID = false; bf16* proj; const float* rs; const float* cs; float* kmp; float* sst; int skip;
    DEV void operator()(const pg8::i32x4 (&acc)[2][2][4][2], const pg8::Unit& u, int wr, int wc, int fr, int fq) const {
#ifdef EPI_SKIP_PROBE
        if (skip) { if (acc[0][0][0][0].x == 0x7fffffff && acc[1][1][3][1].w == 0x7ffffff1) proj[0] = 0; return; }
#endif
        const int row0 = u.pm * 256 + wr * 64 + fr, col0 = u.pn * 256 + wc * 32 + 4 * fq;
        const int pns = __builtin_amdgcn_readfirstlane(u.pn);
        const bool isK = pns >= C_K / 256 && pns < C_V / 256, isVG = pns >= C_VG / 256 && pns < C_GA / 256, isGate = pns >= C_GA / 256, isGelu = pns >= C_U / 256;
        f32x4 cv[2][2];
#pragma unroll
        for (int bj = 0; bj < 2; ++bj)
#pragma unroll
            for (int n = 0; n < 2; ++n) cv[bj][n] = *(const f32x4*)(cs + col0 + bj * 128 + n * 16);
        float rsv[8];
#pragma unroll
        for (int g = 0; g < 8; ++g) rsv[g] = rs[row0 + (g >> 2) * 128 + (g & 3) * 16];
        f32x4 ksum[2][2];
#pragma unroll
        for (int bj = 0; bj < 2; ++bj)
#pragma unroll
            for (int n = 0; n < 2; ++n) ksum[bj][n] = (f32x4){0.f, 0.f, 0.f, 0.f};
#pragma unroll
        for (int ai = 0; ai < 2; ++ai)
#pragma unroll
            for (int m = 0; m < 4; ++m) { const int row = row0 + ai * 128 + m * 16; const float r = rsv[ai * 4 + m]; float ss = 0.f, sq = 0.f;
#pragma unroll
                for (int bj = 0; bj < 2; ++bj)
#pragma unroll
                    for (int n = 0; n < 2; ++n) { const pg8::i32x4 a = acc[ai][bj][m][n]; const f32x4 c4 = cv[bj][n]; const int col = col0 + bj * 128 + n * 16;
                        f32x4 v = (f32x4){(float)a.x * (r * c4.x), (float)a.y * (r * c4.y), (float)a.z * (r * c4.z), (float)a.w * (r * c4.w)};
                        if (isGate) {
                            const unsigned q0 = gate_q(v.x), q1 = gate_q(v.y), q2 = gate_q(v.z), q3 = gate_q(v.w);
                            *(unsigned*)((unsigned char*)(proj + (size_t)row * PST + C_GA) + (col - C_GA)) = q0 | (q1 << 8) | (q2 << 16) | (q3 << 24); continue; }
                        if (isGelu) { const f32x2 ga = pg8::gelu_pk((f32x2){v.x, v.y}), gb = pg8::gelu_pk((f32x2){v.z, v.w}); v = (f32x4){ga.x, ga.y, gb.x, gb.y}; }
                        v2u w; w.x = pkbf(v.x, v.y); w.y = pkbf(v.z, v.w); *(v2u*)(proj + (size_t)row * PST + col) = w;
                        if (isK) ksum[bj][n] += v;
                        if (isVG) { const float e0 = bflo(w.x), e1 = bfhi(w.x), e2 = bflo(w.y), e3 = bfhi(w.y); ss += (e0 + e1) + (e2 + e3); sq += (e0 * e0 + e1 * e1) + (e2 * e2 + e3 * e3); } }
                if (isVG) { ss += __shfl_xor(ss, 16); sq += __shfl_xor(sq, 16); ss += __shfl_xor(ss, 32); sq += __shfl_xor(sq, 32);
                    if (fq == 0) *(f32x2*)(sst + ((size_t)row * 16 + (u.pn - C_VG / 256) * 4 + wc) * 2) = (f32x2){ss, sq}; }
                asm volatile("" ::: "memory");
            }
        if (isK) { const int b = u.pm >> 5, nb = u.pm & 31;
#pragma unroll
            for (int bj = 0; bj < 2; ++bj)
#pragma unroll
                for (int n = 0; n < 2; ++n) { f32x4 s = ksum[bj][n]; s.x = rsum16(s.x); s.y = rsum16(s.y); s.z = rsum16(s.z); s.w = rsum16(s.w);
                    const int h = 2 * (u.pn - C_K / 256) + bj, d = 32 * wc + 16 * n + 4 * fq;
                    if (fr == 0) *(f32x4*)(kmp + (((size_t)wr * 16 + b * 8 + h) * NBLK + nb) * HD + d) = s * (1.0f / BLK); } }
    } };
struct F4a { const bf16* proj; float* out;
    DEV void elem4(int row, int col, f32x4 v) const { const v2u g = *(const v2u*)(proj + (size_t)row * PST + C_GA + col);
        *(f32x4*)(out + (size_t)row * D + col) = (f32x4){v.x * bflo(g.x), v.y * bfhi(g.x), v.z * bflo(g.y), v.w * bfhi(g.y)}; } };
struct F4b { const bf16* proj; const float* out; bf16* merged;
    DEV void elem4(int row, int col, f32x4 v) const { const v2u g = *(const v2u*)(proj + (size_t)row * PST + C_GB + col); const f32x4 t = *(const f32x4*)(out + (size_t)row * D + col);
        v2u w; w.x = pkbf(t.x + v.x * bflo(g.x), t.y + v.y * bfhi(g.x)); w.y = pkbf(t.z + v.z * bflo(g.y), t.w + v.w * bfhi(g.y)); *(v2u*)(merged + (size_t)row * D + col) = w; } };
struct F5 { const float* x; float* out;
    DEV void elem4(int row, int col, f32x4 v) const { const f32x4 t = *(const f32x4*)(x + (size_t)row * D + col); *(f32x4*)(out + (size_t)row * D + col) = t + v; } };
struct EpiBranch { static constexpr bool PERM = false, AFTER_DRAIN = false, HAS_MID = true; const bf16* proj; bf16* merged;
    DEV void mid(f32x4 (&acc)[2][2][4][2], const pg8::Unit& u, int wr, int wc, int fr, int fq) const {
        const unsigned char* pb = (const unsigned char*)(proj + (size_t)(u.pm * 256 + wr * 64 + fr) * PST + C_GA) + u.pn * 256 + wc * 32 + 4 * fq;
        unsigned gan[4], gbn[4];
#pragma unroll
        for (int q = 0; q < 4; ++q) { const unsigned char* qp_ = pb + (q >> 1) * 128 + (q & 1) * 16; gan[q] = *(const unsigned*)qp_; gbn[q] = *(const unsigned*)(qp_ + 2048); }
#pragma unroll
        for (int g = 0; g < 8; ++g) { const int ai = g >> 2, m = g & 3;
            unsigned gac[4], gbc[4];
#pragma unroll
            for (int q = 0; q < 4; ++q) { gac[q] = gan[q]; gbc[q] = gbn[q]; }
            if (g < 7) { const int gn = g + 1; const unsigned char* rp = pb + (size_t)((gn >> 2) * 128 + (gn & 3) * 16) * (PST * 2);
#pragma unroll
                for (int q = 0; q < 4; ++q) { const unsigned char* qp_ = rp + (q >> 1) * 128 + (q & 1) * 16; gan[q] = *(const unsigned*)qp_; gbn[q] = *(const unsigned*)(qp_ + 2048); } }
#pragma unroll
            for (int bj = 0; bj < 2; ++bj)
#pragma unroll
                for (int n = 0; n < 2; ++n) { const f32x4 ga = gate_dq(gac[bj * 2 + n]), gb = gate_dq(gbc[bj * 2 + n]); f32x4 v = acc[ai][bj][m][n];
                    v.x *= ga.x * __builtin_amdgcn_rcpf(gb.x); v.y *= ga.y * __builtin_amdgcn_rcpf(gb.y); v.z *= ga.z * __builtin_amdgcn_rcpf(gb.z); v.w *= ga.w * __builtin_amdgcn_rcpf(gb.w);
                    acc[ai][bj][m][n] = v; } }
    }
    DEV void operator()(const f32x4 (&acc)[2][2][4][2], const pg8::Unit& u, int wr, int wc, int fr, int fq) const {
        const int row0 = u.pm * 256 + wr * 64 + fr, col0 = u.pn * 256 + wc * 32 + 4 * fq;
        const unsigned char* pb = (const unsigned char*)(proj + (size_t)row0 * PST + C_GA) + 2048 + col0;
        unsigned gbn[4];
#pragma unroll
        for (int q = 0; q < 4; ++q) gbn[q] = *(const unsigned*)(pb + (q >> 1) * 128 + (q & 1) * 16);
#pragma unroll
        for (int g = 0; g < 8; ++g) { const int ai = g >> 2, m = g & 3; const int row = row0 + ai * 128 + m * 16;
            unsigned gbc[4];
#pragma unroll
            for (int q = 0; q < 4; ++q) gbc[q] = gbn[q];
            if (g < 7) { const int gn = g + 1; const unsigned char* rp = pb + (size_t)((gn >> 2) * 128 + (gn & 3) * 16) * (PST * 2);
#pragma unroll
                for (int q = 0; q < 4; ++q) gbn[q] = *(const unsigned*)(rp + (q >> 1) * 128 + (q & 1) * 16); }
#pragma unroll
            for (int bj = 0; bj < 2; ++bj)
#pragma unroll
                for (int n = 0; n < 2; ++n) { const int col = col0 + bj * 128 + n * 16; const f32x4 gb = gate_dq(gbc[bj * 2 + n]); const f32x4 v = acc[ai][bj][m][n];
                    v2u w; w.x = pkbf(v.x * gb.x, v.y * gb.y); w.y = pkbf(v.z * gb.z, v.w * gb.w); *(v2u*)(merged + (size_t)row * D + col) = w; } }
    } };
struct EpiF5 { static constexpr bool PERM = false, AFTER_DRAIN = false, HAS_MID = false; const float* x; float* out; bf16* h1b; float* rss;
    DEV void operator()(const f32x4 (&acc)[2][2][4][2], const pg8::Unit& u, int wr, int wc, int fr, int fq) const {
        const int row0 = u.pm * 256 + wr * 64 + fr, col0 = u.pn * 256 + wc * 32 + 4 * fq;
        f32x4 xn[4];
        { const float* xp = x + (size_t)row0 * D + col0;
#pragma unroll
          for (int q = 0; q < 4; ++q) xn[q] = *(const f32x4*)(xp + (q >> 1) * 128 + (q & 1) * 16); }
#pragma unroll
        for (int g = 0; g < 8; ++g) { const int ai = g >> 2, m = g & 3; const int row = row0 + ai * 128 + m * 16; float ss = 0.f;
            f32x4 xc[4];
#pragma unroll
            for (int q = 0; q < 4; ++q) xc[q] = xn[q];
            if (g < 7) { const int gn = g + 1; const float* xp = x + (size_t)(row0 + (gn >> 2) * 128 + (gn & 3) * 16) * D + col0;
#pragma unroll
                for (int q = 0; q < 4; ++q) xn[q] = *(const f32x4*)(xp + (q >> 1) * 128 + (q & 1) * 16); }
#pragma unroll
            for (int bj = 0; bj < 2; ++bj)
#pragma unroll
                for (int n = 0; n < 2; ++n) { const int col = col0 + bj * 128 + n * 16; const f32x4 v = xc[bj * 2 + n] + acc[ai][bj][m][n];
                    v2u w; w.x = pkbf(v.x, v.y); w.y = pkbf(v.z, v.w); *(v2u*)(h1b + (size_t)row * D + col) = w;
                    ss += (v.x * v.x + v.y * v.y) + (v.z * v.z + v.w * v.w); }
            ss += __shfl_xor(ss, 16); ss += __shfl_xor(ss, 32);
            if (fq == 0) rss[(size_t)row * 32 + u.pn * 4 + wc] = ss; }
    } };
struct EpiF5i { static constexpr bool PERM = false, AFTER_DRAIN = false, HAS_MID = false; const float* x; bf16* h1b; float* rss; const float* rs; const float* cs;
    DEV void operator()(const pg8::i32x4 (&acc)[2][2][4][2], const pg8::Unit& u, int wr, int wc, int fr, int fq) const {
        const int row0 = u.pm * 256 + wr * 64 + fr, col0 = u.pn * 256 + wc * 32 + 4 * fq;
        f32x4 cv[2][2];
#pragma unroll
        for (int bj = 0; bj < 2; ++bj)
#pragma unroll
            for (int n = 0; n < 2; ++n) cv[bj][n] = *(const f32x4*)(cs + col0 + bj * 128 + n * 16);
#pragma unroll
        for (int ai = 0; ai < 2; ++ai)
#pragma unroll
            for (int m = 0; m < 4; ++m) { const int row = row0 + ai * 128 + m * 16; float ss = 0.f; const float r = rs[row];
#pragma unroll
                for (int bj = 0; bj < 2; ++bj)
#pragma unroll
                    for (int n = 0; n < 2; ++n) { const int col = col0 + bj * 128 + n * 16; const pg8::i32x4 a = acc[ai][bj][m][n]; const f32x4 c4 = cv[bj][n];
                        const f32x4 v = *(const f32x4*)(x + (size_t)row * D + col) + (f32x4){(float)a.x * (r * c4.x), (float)a.y * (r * c4.y), (float)a.z * (r * c4.z), (float)a.w * (r * c4.w)};
                        v2u w; w.x = pkbf(v.x, v.y); w.y = pkbf(v.z, v.w); *(v2u*)(h1b + (size_t)row * D + col) = w;
                        ss += (v.x * v.x + v.y * v.y) + (v.z * v.z + v.w * v.w); }
                ss += __shfl_xor(ss, 16); ss += __shfl_xor(ss, 32);
                if (fq == 0) rss[(size_t)row * 32 + u.pn * 4 + wc] = ss;
                asm volatile("" ::: "memory"); }
    } };
DEV void phase_quant_merged(const Ctx& c) {
    const int gw = c.bid * 8 + c.wave, NGW = c.G * 8, lane = c.lane;
    for (int m = gw; m < T; m += NGW) {
        const v4u* src = (const v4u*)(c.merged + (size_t)m * D) + lane;
        v4u v[4]; float am = 0.f;
#pragma unroll
        for (int j = 0; j < 4; ++j) { v[j] = src[64 * j]; const v4u w = v[j];
            am = fmaxf(am, fmaxf(fmaxf(fmaxf(fabsf(bflo(w.x)), fabsf(bfhi(w.x))), fmaxf(fabsf(bflo(w.y)), fabsf(bfhi(w.y)))), fmaxf(fmaxf(fabsf(bflo(w.z)), fabsf(bfhi(w.z))), fmaxf(fabsf(bflo(w.w)), fabsf(bfhi(w.w)))))); }
        am = wave_max(am);
        const float inv = am > 0.f ? 127.0f / am : 0.f;
        v2u* dst = (v2u*)(c.mq8 + (size_t)m * D) + lane;
#pragma unroll
        for (int j = 0; j < 4; ++j) { const v4u w = v[j]; v2u o; o.x = q4(bflo(w.x), bfhi(w.x), bflo(w.y), bfhi(w.y), inv, 0); o.y = q4(bflo(w.z), bfhi(w.z), bflo(w.w), bfhi(w.w), inv, 0); dst[64 * j] = o; }
        if (lane == 0) c.ms[m] = am * (1.0f / 127.0f);
    }
}
struct F6 { bf16* qp;
    DEV void elem4(int row, int col, f32x4 v) const { v2u w; w.x = pkbf(v.x, v.y); w.y = pkbf(v.z, v.w); *(v2u*)(qp + (size_t)row * D + col) = w; } };
struct F9a { bf16* gtmp;
    DEV void elem4(int row, int col, f32x4 v) const { v2u w; w.x = pkbf(sigmoidf_(v.x), sigmoidf_(v.y)); w.y = pkbf(sigmoidf_(v.z), sigmoidf_(v.w)); *(v2u*)(gtmp + (size_t)row * D + col) = w; } };
struct F9b { const bf16* gtmp; float* out;
    DEV void elem4(int row, int col, f32x4 v) const { const v2u g = *(const v2u*)(gtmp + (size_t)row * D + col); float* o = out + (size_t)row * D + col; const f32x4 t = *(const f32x4*)o;
        *(f32x4*)o = (f32x4){t.x + v.x * bflo(g.x), t.y + v.y * bfhi(g.x), t.z + v.z * bflo(g.y), t.w + v.w * bfhi(g.y)}; } };
struct Epi9b { static constexpr bool PERM = false, AFTER_DRAIN = false, HAS_MID = false; const bf16* gtmp; bf16* hb;
    DEV void operator()(const f32x4 (&acc)[2][2][4][2], const pg8::Unit& u, int wr, int wc, int fr, int fq) const {
        const int row0 = u.pm * 256 + wr * 64 + fr, col0 = u.pn * 256 + wc * 32 + 4 * fq;
        v2u gn[4], tn[4];
        { const size_t o0 = (size_t)row0 * D + col0;
#pragma unroll
          for (int q = 0; q < 4; ++q) { const size_t o = o0 + (q >> 1) * 128 + (q & 1) * 16; gn[q] = *(const v2u*)(gtmp + o); tn[q] = *(const v2u*)(hb + o); } }
#pragma unroll
        for (int g = 0; g < 8; ++g) { const int ai = g >> 2, m = g & 3; const size_t o0 = (size_t)(row0 + ai * 128 + m * 16) * D + col0;
            v2u gc[4], tc[4];
#pragma unroll
            for (int q = 0; q < 4; ++q) { gc[q] = gn[q]; tc[q] = tn[q]; }
            if (g < 7) { const int g1 = g + 1; const size_t o1 = (size_t)(row0 + (g1 >> 2) * 128 + (g1 & 3) * 16) * D + col0;
#pragma unroll
                for (int q = 0; q < 4; ++q) { const size_t o = o1 + (q >> 1) * 128 + (q & 1) * 16; gn[q] = *(const v2u*)(gtmp + o); tn[q] = *(const v2u*)(hb + o); } }
#pragma unroll
            for (int bj = 0; bj < 2; ++bj)
#pragma unroll
                for (int n = 0; n < 2; ++n) { const int q = bj * 2 + n; const f32x4 v = acc[ai][bj][m][n]; const v2u t = tc[q], gg = gc[q];
                    v2u w; w.x = pkbf(bflo(t.x) + v.x * bflo(gg.x), bfhi(t.x) + v.y * bfhi(gg.x)); w.y = pkbf(bflo(t.y) + v.z * bflo(gg.y), bfhi(t.y) + v.w * bfhi(gg.y));
                    *(v2u*)(hb + o0 + bj * 128 + n * 16) = w; } }
    } };

template <class F> DEV void naive_gemm(LAS unsigned char* lds, const bf16* A, const bf16* Bt, int M, int N, int K, const F& f) {
    LAS float* As = (LAS float*)lds; LAS float* Bs = As + 64 * 33;
    const int tid = threadIdx.x, ty = tid >> 4, tx = tid & 15;
    const int ntn = N / 64, ntiles = (M / 64) * ntn;
    for (int tile = blockIdx.x; tile < ntiles; tile += gridDim.x) {
        const int tm = tile / ntn, tn = tile % ntn;
        f32x4 a0 = {0.f, 0.f, 0.f, 0.f}, a1 = a0;
        for (int k0 = 0; k0 < K; k0 += 32) {
            { const int r = tid >> 3, cc = (tid & 7) * 4;
              const v2u av = *(const v2u*)(A + (size_t)(tm * 64 + r) * K + k0 + cc), bv = *(const v2u*)(Bt + (size_t)(tn * 64 + r) * K + k0 + cc);
              As[r * 33 + cc] = bflo(av.x); As[r * 33 + cc + 1] = bfhi(av.x); As[r * 33 + cc + 2] = bflo(av.y); As[r * 33 + cc + 3] = bfhi(av.y);
              Bs[r * 33 + cc] = bflo(bv.x); Bs[r * 33 + cc + 1] = bfhi(bv.x); Bs[r * 33 + cc + 2] = bflo(bv.y); Bs[r * 33 + cc + 3] = bfhi(bv.y); }
            __syncthreads();
#pragma unroll 8
            for (int kk = 0; kk < 32; ++kk) { const float x0 = As[(2 * ty) * 33 + kk], x1 = As[(2 * ty + 1) * 33 + kk];
                const f32x4 b = {Bs[(4 * tx) * 33 + kk], Bs[(4 * tx + 1) * 33 + kk], Bs[(4 * tx + 2) * 33 + kk], Bs[(4 * tx + 3) * 33 + kk]};
                a0 += b * x0; a1 += b * x1; }
            __syncthreads();
        }
        f.elem4(tm * 64 + 2 * ty, tn * 64 + 4 * tx, a0); f.elem4(tm * 64 + 2 * ty + 1, tn * 64 + 4 * tx, a1);
    }
}
template <class F> DEV void run_gemm(bool naive, LAS unsigned char* lds, const bf16* A, const bf16* Bt, int M, int N, int K, const F& f, int G, int bid) {
    if (naive) { naive_gemm<F>(lds, A, Bt, M, N, K, f); return; }
    asm volatile("" : "+s"(K));
    pg8::Gemm g{A, Bt, M, N, K, A + K / 2, K}; pg8::StaticOrder S; S.init(M, N, G, bid);
    pg8::EpiW<F> E{f};
    pg8::gemm_phase<pg8::EpiW<F>, pg8::StaticOrder, true, true>((PG8_LAS unsigned char*)lds, g, S, E);
}

template <class F> DEV void run_gemm_i8(LAS unsigned char* lds, const unsigned char* A8, const unsigned char* Bt8, const float* rs, const float* cs, int M, int N, int K, const F& f, int G, int bid) {
    asm volatile("" : "+s"(K));
    pg8::Gemm g{(const bf16*)A8, (const bf16*)Bt8, M, N, K, nullptr, K}; pg8::StaticOrder S; S.init(M, N, G, bid);
    pg8::EpiW8<F> E{f, rs, cs};
    pg8::gemm_phase_i8<pg8::EpiW8<F>, pg8::StaticOrder, GI8_ALIGN, true>((PG8_LAS unsigned char*)lds, g, S, E);
}

DEV void run_gemm_in(LAS unsigned char* lds, const Ctx& c, int skip = 0) {
    int K = D; asm volatile("" : "+s"(K));
    pg8::Gemm g{(const bf16*)c.xq8, (const bf16*)c.WinT8, T, INW, K, nullptr, K}; pg8::StaticOrder S; S.init(T, INW, c.G, c.bid);
    if ((T / 256) * (INW / 256) % c.G == 0) { S.nround = (T / 256) * (INW / 256) / c.G; S.rot = (c.bid & 7) % S.nround; }
    pg8::gemm_phase_i8<EpiIn, pg8::StaticOrder, GI8_ALIGN, true>((PG8_LAS unsigned char*)lds, g, S, EpiIn{c.proj, c.xs, c.wcs, c.kmp, c.sst, skip});
}

DEV void phase_kmean_vt(const Ctx& c, unsigned* kcnt) {
    const int gw = c.bid * 8 + c.wave, NGW = c.G * 8, lane = c.lane;
    for (int it = gw; it < 16 * NBLK; it += NGW) { const int bh = it / NBLK, n = it % NBLK, b = bh >> 3, h = bh & 7;
        const bf16* kp = c.proj + (size_t)(b * SEQ + n * BLK + (lane >> 4)) * PST + C_K + h * HD + (lane & 15) * 8;
        float s[8];
#pragma unroll
        for (int i = 0; i < 8; ++i) s[i] = 0.f;
#pragma unroll 8
        for (int r = 0; r < BLK; r += 4) { const v4u w = *(const v4u*)(kp + (size_t)r * PST);
            s[0] += bflo(w.x); s[1] += bfhi(w.x); s[2] += bflo(w.y); s[3] += bfhi(w.y); s[4] += bflo(w.z); s[5] += bfhi(w.z); s[6] += bflo(w.w); s[7] += bfhi(w.w); }
#pragma unroll
        for (int i = 0; i < 8; ++i) { s[i] += __shfl_xor(s[i], 16); s[i] += __shfl_xor(s[i], 32); s[i] *= (1.0f / BLK); }
        if (lane < 16) { float* kd = c.kmean + ((size_t)bh * NBLK + n) * HD + lane * 8; *(f32x4*)kd = (f32x4){s[0], s[1], s[2], s[3]}; *(f32x4*)(kd + 4) = (f32x4){s[4], s[5], s[6], s[7]}; }
        asm volatile("s_waitcnt vmcnt(0)" ::: "memory");
        if (lane == 0) { __builtin_amdgcn_fence(__ATOMIC_RELEASE, "agent"); asm volatile("s_waitcnt vmcnt(0)" ::: "memory"); __hip_atomic_fetch_add(kcnt, 1u, __ATOMIC_RELAXED, __HIP_MEMORY_SCOPE_AGENT); }
    }
}
DEV void sgu_stats(const Ctx& c, LAS float* stats, int t0) {
    const int row = c.tid >> 2, part = c.tid & 3;
    const bf16* vp = c.proj + (size_t)(t0 + row) * PST + C_VG + part * 256;
    float s = 0.f, q = 0.f;
#pragma unroll 4
    for (int i = 0; i < 32; ++i) { const v4u w = *(const v4u*)(vp + i * 8);
        const float e0 = bflo(w.x), e1 = bfhi(w.x), e2 = bflo(w.y), e3 = bfhi(w.y), e4 = bflo(w.z), e5 = bfhi(w.z), e6 = bflo(w.w), e7 = bfhi(w.w);
        s += ((e0 + e1) + (e2 + e3)) + ((e4 + e5) + (e6 + e7)); q += ((e0 * e0 + e1 * e1) + (e2 * e2 + e3 * e3)) + ((e4 * e4 + e5 * e5) + (e6 * e6 + e7 * e7)); }
    s += __shfl_xor(s, 1); s += __shfl_xor(s, 2); q += __shfl_xor(q, 1); q += __shfl_xor(q, 2);
    const float mean = s * (1.0f / 1024.0f), var = fmaxf(q * (1.0f / 1024.0f) - mean * mean, 0.f);
    if (part == 0) { stats[row * 2] = mean; stats[row * 2 + 1] = 1.0f / sqrtf(var + EPS); }
}
DEV void sgu_stats2(const Ctx& c, LAS float* stats, int t0) {
    const int row = c.tid >> 2, j = c.tid & 3;
    const f32x4* sp = (const f32x4*)(c.sst + ((size_t)(t0 + row) * 16 + 4 * j) * 2); const f32x4 a = sp[0], b = sp[1];
    float s = (a.x + a.z) + (b.x + b.z), q = (a.y + a.w) + (b.y + b.w);
    s += dppq<0xB1>(s); s += dppq<0x4E>(s); q += dppq<0xB1>(q); q += dppq<0x4E>(q);
    const float mean = s * (1.0f / 1024.0f), var = fmaxf(q * (1.0f / 1024.0f) - mean * mean, 0.f);
    if (j == 0) { stats[row * 2] = mean; stats[row * 2 + 1] = 1.0f / sqrtf(var + EPS); }
}
constexpr int SG_RS = 320, SG_IMG = 128 * SG_RS, SG_SCR = 32 * 144;
DEV void phase_sgu(const Ctx& c, LAS unsigned char* lds) {
    LAS float* stats = (LAS float*)lds;
    LAS unsigned char* img = lds + 1024;
    LAS unsigned char* scr = lds + 1024 + 2 * SG_IMG + c.wave * SG_SCR;
    const int lane = c.lane, r = lane & 31, hh = lane >> 5, wave = c.wave, tid = c.tid;
    const int mt = wave >> 1, cw = wave & 1, nks = 2 * (mt + 1);
    const int srow = tid >> 4, sch = (tid & 15) * 8;
    const int erow = lane >> 3, ech = cw * 64 + (lane & 7) * 8;
    const unsigned troff = (unsigned)(size_t)img + (unsigned)((8 * hh + ((lane & 15) >> 2)) * SG_RS + (cw * 64 + 16 * ((lane >> 4) & 1) + 4 * (lane & 3)) * 2);
#define SG_LOADVG(V, LG, LB, G_) do { _Pragma("unroll") for (int q = 0; q < 4; ++q) V[q] = *(const v4u*)(c.proj + (size_t)(t0 + srow + 32 * q) * PST + C_VG + (G_) * 128 + sch); \
        LG[0] = *(const f32x4*)(c.ln_g + (G_) * 128 + sch); LG[1] = *(const f32x4*)(c.ln_g + (G_) * 128 + sch + 4); LB[0] = *(const f32x4*)(c.ln_b + (G_) * 128 + sch); LB[1] = *(const f32x4*)(c.ln_b + (G_) * 128 + sch + 4); } while (0)
#define SG_LOADOPS(AF, UU, BI, G_) do { _Pragma("unroll") for (int ks = 0; ks < 8; ++ks) if (ks < nks) AF[ks] = *(const v4u*)(c.swb + ((size_t)((G_) * 128 + 32 * mt + r)) * 128 + 16 * ks + 8 * hh); \
        _Pragma("unroll") for (int j = 0; j < 4; ++j) UU[j] = *(const v4u*)(c.proj + (size_t)(t0 + 32 * mt + erow + 8 * j) * PST + C_U + (G_) * 128 + ech); \
        BI = c.sgu_b[(G_) * 128 + 32 * mt + r]; } while (0)
#define SG_STAGE(V, LG, LB, BUF) do { LAS unsigned char* ib = img + (BUF) * SG_IMG; \
        const float gg[8] = {LG[0].x, LG[0].y, LG[0].z, LG[0].w, LG[1].x, LG[1].y, LG[1].z, LG[1].w}, bbv[8] = {LB[0].x, LB[0].y, LB[0].z, LB[0].w, LB[1].x, LB[1].y, LB[1].z, LB[1].w}; \
        _Pragma("unroll") for (int q = 0; q < 4; ++q) { const int row = srow + 32 * q; const float mean = stats[2 * row], rstd = stats[2 * row + 1]; const v4u w = V[q]; \
            const float e[8] = {bflo(w.x), bfhi(w.x), bflo(w.y), bfhi(w.y), bflo(w.z), bfhi(w.z), bflo(w.w), bfhi(w.w)}; float y[8]; \
            _Pragma("unroll") for (int i = 0; i < 8; ++i) y[i] = (e[i] - mean) * rstd * gg[i] + bbv[i]; \
            *(LAS v4u*)(ib + row * SG_RS + sch * 2) = (v4u){pkbf(y[0], y[1]), pkbf(y[2], y[3]), pkbf(y[4], y[5]), pkbf(y[6], y[7])}; } } while (0)
#define SG_BAR asm volatile("s_waitcnt lgkmcnt(0)\n\ts_barrier" ::: "memory")
    for (int unit = c.bid; unit < 256; unit += c.G) {
        const int chunk = unit >> 1, gh = unit & 1, t0 = chunk * 128, g0 = gh * 4;
        __syncthreads();
        v4u vgN[4]; f32x4 lgN[2], lbN[2];
        v4u afN[8], uuN[4]; float biasN;
        SG_LOADVG(vgN, lgN, lbN, g0);
        SG_LOADOPS(afN, uuN, biasN, g0);
        sgu_stats2(c, stats, t0);
        __syncthreads();
        SG_STAGE(vgN, lgN, lbN, 0);
        SG_BAR;
#pragma unroll 1
        for (int gi = 0; gi < 4; ++gi) { const int g = g0 + gi, buf = gi & 1;
            v4u af[8], uu[4]; const float bias = biasN;
#pragma unroll
            for (int ks = 0; ks < 8; ++ks) af[ks] = afN[ks];
#pragma unroll
            for (int j = 0; j < 4; ++j) uu[j] = uuN[j];
            if (gi < 3) { SG_LOADVG(vgN, lgN, lbN, g + 1); SG_LOADOPS(afN, uuN, biasN, g + 1); }
            f32x16 acc0, acc1;
#pragma unroll
            for (int i = 0; i < 16; ++i) { acc0[i] = 0.f; acc1[i] = 0.f; }
#pragma unroll
            for (int ks = 0; ks < 8; ++ks) if (ks < nks) {
                const unsigned ad = troff + (unsigned)(buf * SG_IMG + 16 * ks * SG_RS);
                v2u b00, b01, b10, b11;
                asm volatile("ds_read_b64_tr_b16 %0, %4\n\tds_read_b64_tr_b16 %1, %4 offset:1280\n\tds_read_b64_tr_b16 %2, %4 offset:64\n\tds_read_b64_tr_b16 %3, %4 offset:1344\n\ts_waitcnt lgkmcnt(0)"
                             : "=&v"(b00), "=&v"(b01), "=&v"(b10), "=&v"(b11) : "v"(ad) : "memory");
                const bf16x8 a = __builtin_bit_cast(bf16x8, af[ks]);
                acc0 = MFMA32(__builtin_bit_cast(bf16x8, ((v4u){b00.x, b00.y, b01.x, b01.y})), a, acc0);
                acc1 = MFMA32(__builtin_bit_cast(bf16x8, ((v4u){b10.x, b10.y, b11.x, b11.y})), a, acc1); }
#pragma unroll
            for (int k = 0; k < 4; ++k) {
                *(LAS v2u*)(scr + r * 144 + (8 * k + 4 * hh) * 2) = (v2u){pkbf(acc0[4 * k] + bias, acc0[4 * k + 1] + bias), pkbf(acc0[4 * k + 2] + bias, acc0[4 * k + 3] + bias)};
                *(LAS v2u*)(scr + r * 144 + (32 + 8 * k + 4 * hh) * 2) = (v2u){pkbf(acc1[4 * k] + bias, acc1[4 * k + 1] + bias), pkbf(acc1[4 * k + 2] + bias, acc1[4 * k + 3] + bias)}; }
            asm volatile("s_waitcnt lgkmcnt(0)" ::: "memory");
#pragma unroll
            for (int j = 0; j < 4; ++j) { const int row = erow + 8 * j; const v4u mx = *(const LAS v4u*)(scr + row * 144 + (lane & 7) * 16); const v4u u = uu[j];
                v4u o; o.x = pkbf(bflo(u.x) * bflo(mx.x), bfhi(u.x) * bfhi(mx.x)); o.y = pkbf(bflo(u.y) * bflo(mx.y), bfhi(u.y) * bfhi(mx.y));
                o.z = pkbf(bflo(u.z) * bflo(mx.z), bfhi(u.z) * bfhi(mx.z)); o.w = pkbf(bflo(u.w) * bflo(mx.w), bfhi(u.w) * bfhi(mx.w));
                *(v4u*)(c.ysgu + (size_t)(t0 + 32 * mt + row) * 1024 + g * 128 + ech) = o; }
            asm volatile("s_waitcnt lgkmcnt(0)" ::: "memory");
            if (gi < 3) SG_STAGE(vgN, lgN, lbN, (gi + 1) & 1);
            SG_BAR;
        }
    }
#undef SG_LOADVG
#undef SG_LOADOPS
#undef SG_STAGE
#undef SG_BAR
}
DEV void naive_sgu(const Ctx& c, LAS unsigned char* lds) {
    LAS float* stats = (LAS float*)lds;
    for (int chunk = c.bid; chunk < 128; chunk += c.G) { const int t0 = chunk * 128;
        __syncthreads(); sgu_stats(c, stats, t0); __syncthreads();
        for (int o = c.tid; o < 128 * 1024; o += NTHREADS) { const int tl = o >> 10, f = o & 1023, g = f >> 7;
            float acc = 0.f;
            for (int s = 0; s <= tl; ++s) { const float v = bf2f(c.proj[(size_t)(t0 + s) * PST + C_VG + f]); const float y = (v - stats[2 * s]) * stats[2 * s + 1] * c.ln_g[f] + c.ln_b[f];
                acc += c.sgu_w[((size_t)g * 128 + tl) * 128 + s] * y; }
            acc += c.sgu_b[g * 128 + tl];
            c.ysgu[(size_t)(t0 + tl) * 1024 + f] = (bf16)(pkbf(bf2f(c.proj[(size_t)(t0 + tl) * PST + C_U + f]) * acc, 0.f) & 0xffff); }
    }
}

DEV void insert3(float v, int n, float& v1, float& v2, float& v3, int& i1, int& i2, int& i3) {
    const bool b1 = v > v1, b2 = v > v2, b3 = v > v3;
    v3 = b2 ? v2 : (b3 ? v : v3); i3 = b2 ? i2 : (b3 ? n : i3);
    v2 = b1 ? v1 : (b2 ? v : v2); i2 = b1 ? i1 : (b2 ? n : i2);
    v1 = b1 ? v : v1; i1 = b1 ? n : i1;
}
constexpr int VT_STRIDE = 520;
constexpr float ATT_C = 0.08838834764831845f * 1.4426950408889634f;
DEV void phase_select(const Ctx& c, unsigned* kcnt) {
    const int lane = c.lane, r = lane & 31, hh = lane >> 5, gw = c.bid * 8 + c.wave, NGW = c.G * 8;
    for (int wt = gw; wt < 16 * NBLK * 8; wt += NGW) {
        const int bh = wt >> 8, j = (wt >> 3) & 31, w = wt & 7, b = bh >> 3, h = bh & 7;
        const int q = j * BLK + 32 * w + r;
        int i1 = -1, i2 = -1, i3 = -1;
        if (j > 0) {
            const bf16* qrow = c.proj + ((size_t)b * SEQ + q) * PST + C_Q + h * HD;
            f32x16 g;
#pragma unroll
            for (int i = 0; i < 16; ++i) g[i] = 0.f;
            const float* km = c.kmp + ((size_t)bh * NBLK + r) * HD; const float* km1 = km + 16 * NBLK * HD;
#pragma unroll
            for (int ks = 0; ks < 8; ++ks) { const bf16x8 qf = *(const bf16x8*)(qrow + 16 * ks + 8 * hh);
                const f32x4 ka = *(const f32x4*)(km + 16 * ks + 8 * hh) + *(const f32x4*)(km1 + 16 * ks + 8 * hh), kb = *(const f32x4*)(km + 16 * ks + 8 * hh + 4) + *(const f32x4*)(km1 + 16 * ks + 8 * hh + 4);
                v4u hi; hi.x = pkbf(ka.x, ka.y); hi.y = pkbf(ka.z, ka.w); hi.z = pkbf(kb.x, kb.y); hi.w = pkbf(kb.z, kb.w);
                v4u lo; lo.x = pkbf(ka.x - bflo(hi.x), ka.y - bfhi(hi.x)); lo.y = pkbf(ka.z - bflo(hi.y), ka.w - bfhi(hi.y)); lo.z = pkbf(kb.x - bflo(hi.z), kb.y - bfhi(hi.z)); lo.w = pkbf(kb.z - bflo(hi.w), kb.w - bfhi(hi.w));
                g = MFMA32(__builtin_bit_cast(bf16x8, hi), qf, g); g = MFMA32(__builtin_bit_cast(bf16x8, lo), qf, g); }
            float v1 = -INFINITY, v2 = -INFINITY, v3 = -INFINITY; int a1 = 0, a2 = 0, a3 = 0;
#pragma unroll
            for (int i = 0; i < 16; ++i) { const int n = crow(i, hh); const float v = (n < j) ? g[i] : -INFINITY; insert3(v, n, v1, v2, v3, a1, a2, a3); }
            const float pv1 = __shfl_xor(v1, 32), pv2 = __shfl_xor(v2, 32), pv3 = __shfl_xor(v3, 32); const int pi1 = __shfl_xor(a1, 32), pi2 = __shfl_xor(a2, 32), pi3 = __shfl_xor(a3, 32);
            insert3(pv1, pi1, v1, v2, v3, a1, a2, a3); insert3(pv2, pi2, v1, v2, v3, a1, a2, a3); insert3(pv3, pi3, v1, v2, v3, a1, a2, a3);
            i1 = v1 > -INFINITY ? a1 : -1; i2 = v2 > -INFINITY ? a2 : -1; i3 = v3 > -INFINITY ? a3 : -1;
        }
        if (hh == 0) *(int4*)(c.sel + ((size_t)bh * SEQ + q) * 4) = make_int4(i1, i2, i3, -1);
    }
}
struct AttItem { unsigned char n, jlo, jhi, own; };
#if ATT_FINE
constexpr int NATT_ITEMS = 58;
__device__ const AttItem ATT_ITEMS[NATT_ITEMS] = {{2,3,6,1}, {0,3,7,0}, {2,13,32,0}, {1,2,4,1}, {0,1,3,1}, {7,8,15,1}, {3,4,7,1}, {0,14,32,0}, {17,18,32,1}, {2,6,13,0}, {3,7,15,0}, {8,9,15,1}, {18,19,32,1}, {8,15,32,0}, {7,15,32,0}, {3,15,32,0}, {1,15,32,0}, {4,5,8,1}, {1,4,8,0}, {9,10,16,1}, {0,7,14,0}, {19,20,32,1}, {4,8,16,0}, {9,16,32,0}, {4,16,32,0}, {10,11,17,1}, {5,6,9,1}, {20,21,32,1}, {11,12,18,1}, {5,9,17,0}, {1,8,15,0}, {10,17,32,0}, {5,17,32,0}, {12,13,19,1}, {21,22,32,1}, {6,7,10,1}, {6,10,18,0}, {11,18,32,0}, {6,18,32,0}, {22,23,32,1}, {13,14,19,1}, {14,15,20,1}, {23,24,32,1}, {13,19,32,0}, {12,19,32,0}, {24,25,32,1}, {15,16,20,1}, {15,20,32,0}, {14,20,32,0}, {16,17,21,1}, {25,26,32,1}, {16,21,32,0}, {26,27,32,1}, {27,28,32,1}, {28,29,32,1}, {29,30,32,1}, {30,31,32,1}, {31,32,32,1}};
#else
constexpr int NATT_ITEMS = 44;
__device__ const AttItem ATT_ITEMS[NATT_ITEMS] = {{9,10,32,1}, {10,11,32,1}, {11,12,32,1}, {0,1,4,1}, {3,4,10,1}, {3,10,32,0}, {4,5,12,1}, {12,13,32,1}, {1,2,5,1}, {0,11,32,0}, {13,14,32,1}, {0,4,11,0}, {5,6,13,1}, {2,3,6,1}, {14,15,32,1}, {4,12,32,0}, {1,12,32,0}, {6,7,14,1}, {15,16,32,1}, {1,5,12,0}, {5,13,32,0}, {2,13,32,0}, {7,8,15,1}, {16,17,32,1}, {6,14,32,0}, {17,18,32,1}, {2,6,13,0}, {8,9,15,1}, {18,19,32,1}, {8,15,32,0}, {7,15,32,0}, {19,20,32,1}, {20,21,32,1}, {21,22,32,1}, {22,23,32,1}, {23,24,32,1}, {24,25,32,1}, {25,26,32,1}, {26,27,32,1}, {27,28,32,1}, {28,29,32,1}, {29,30,32,1}, {30,31,32,1}, {31,32,32,1}};
#endif
constexpr int ATT_LIST_OFF = 65536 + 128 * VT_STRIDE;
constexpr int ATT_LIST_CAP = 2048;
DEV void quant_tables(const Ctx& c, int row0, int row1, int step, int first, LAS unsigned char* scr);
constexpr int NQUANT_ITEMS = 2 * NEXP / 128, NQMIX = 2 * NEXP / 64;
DEV void phase_attn(const Ctx& c, LAS unsigned char* lds, unsigned* qctr, bool skip_compute = false, bool skip_quant = false) {
    LAS unsigned char* Kl = lds;
    LAS unsigned char* Vl = lds + 65536;
    LAS unsigned* list = (LAS unsigned*)(lds + ATT_LIST_OFF);
    LAS unsigned* lctl = list + ATT_LIST_CAP;
    const int tid = c.tid, lane = c.lane, wave = c.wave, r = lane & 31, hh = lane >> 5;
    bf16* partO = (bf16*)c.out;
    for (;;) {
        __syncthreads();
        if (tid == 0) lctl[1] = atomicAdd(qctr, 1u);
        __syncthreads();
        const int item = (int)lctl[1];
        if (item >= NATT_ITEMS * 16 + (ATT_MIX ? NQMIX : NQUANT_ITEMS)) break;
#if QUANT_FIRST
        if (item < NQUANT_ITEMS) { const int r0 = item * 128; quant_tables(c, r0, r0 + 128, 8, wave, lds + wave * 2048); continue; }
        const int aitem = item - NQUANT_ITEMS;
#else
#if ATT_MIX
        int aitem;
        if (item < 2 * NQMIX) { if (item & 1) { const int r0 = (item >> 1) * 64; if (!skip_quant) quant_tables(c, r0, r0 + 64, 8, wave, lds + wave * 2048); continue; } aitem = item >> 1; }
        else aitem = item - NQMIX;
#else
        if (item >= NATT_ITEMS * 16) { const int r0 = (item - NATT_ITEMS * 16) * 128; if (!skip_quant) quant_tables(c, r0, r0 + 128, 8, wave, lds + wave * 2048); continue; }
        const int aitem = item;
#endif
#endif
        const AttItem it = ATT_ITEMS[aitem >> 4]; const int bh = aitem & 15, n = it.n, b = bh >> 3, h = bh & 7;
        const size_t tb = (size_t)b * SEQ;
        { const bf16* kg = c.proj + (tb + (size_t)n * BLK) * PST + C_K + h * HD; const bf16* vg = c.proj + (tb + (size_t)n * BLK) * PST + C_V + h * HD;
#pragma unroll 1
          for (int qb = 0; qb < 8; qb += 4) {
              v4u kv[4], vv[4];
#pragma unroll
              for (int q = 0; q < 4; ++q) { const int ch = tid + NTHREADS * (qb + q); kv[q] = *(const v4u*)(kg + (size_t)(ch >> 4) * PST + (ch & 15) * 8); vv[q] = *(const v4u*)(vg + (size_t)(ch & 255) * PST + (ch >> 8) * 8); }
#pragma unroll
              for (int q = 0; q < 4; ++q) { const int ch = tid + NTHREADS * (qb + q); const int key = ch >> 4, c16 = ch & 15;
                  *(LAS v4u*)(Kl + key * 256 + ((c16 ^ (key & 15)) << 4)) = kv[q];
                  const int vk = ch & 255, dc = ch >> 8; LAS unsigned char* vp = Vl + (8 * dc) * VT_STRIDE + vk * 2;
                  const unsigned ww[4] = {vv[q].x, vv[q].y, vv[q].z, vv[q].w};
#pragma unroll
                  for (int i = 0; i < 4; ++i) { *(LAS bf16*)(vp + (2 * i) * VT_STRIDE) = (bf16)(ww[i] & 0xffffu); *(LAS bf16*)(vp + (2 * i + 1) * VT_STRIDE) = (bf16)(ww[i] >> 16); } } } }
        const int qlo = it.jlo * BLK, qhi = it.jhi * BLK;
        bool own_pending = it.own != 0;
        for (int cq = qlo; cq < qhi || own_pending; cq += ATT_LIST_CAP) {
            __syncthreads();
            if (tid == 0) lctl[0] = 0u;
            __syncthreads();
            const int cend = (cq + ATT_LIST_CAP < qhi) ? cq + ATT_LIST_CAP : qhi;
            for (int q = cq + tid; q < cend; q += NTHREADS) {
                const int4 s4 = *(const int4*)(c.sel + ((size_t)bh * SEQ + q) * 4);
                const int slot = (s4.x == n) ? 0 : ((s4.y == n) ? 1 : ((s4.z == n) ? 2 : -1));
                if (slot >= 0) { const unsigned pos = __hip_atomic_fetch_add(lctl, 1u, __ATOMIC_RELAXED, __HIP_MEMORY_SCOPE_WORKGROUP); list[pos] = (unsigned)q | ((unsigned)slot << 16); }
            }
            __syncthreads();
            const int len = (int)lctl[0];
            const int nown = own_pending ? 8 : 0, ngroups = nown + ((len + 31) >> 5);
            for (int gi = wave; gi < (skip_compute ? 0 : ngroups); gi += 8) {
                const bool own = gi < nown;
                int q, slot; bool valid = true;
                if (own) { q = n * BLK + 32 * gi + r; slot = 3; }
                else { const int li = 32 * (gi - nown) + r; valid = li < len; const unsigned e = list[valid ? li : 32 * (gi - nown)]; q = (int)(e & 0xffffu); slot = (int)(e >> 16); }
                const int qloc = 32 * gi + r;
                const bf16* qrow = c.proj + (tb + q) * PST + C_Q + h * HD;
                bf16x8 qf[8];
#pragma unroll
                for (int ks = 0; ks < 8; ++ks) qf[ks] = *(const bf16x8*)(qrow + 16 * ks + 8 * hh);
                float m = -INFINITY, l = 0.f;
                f32x16 o[4];
#pragma unroll
                for (int dt = 0; dt < 4; ++dt)
#pragma unroll
                    for (int i = 0; i < 16; ++i) o[dt][i] = 0.f;
                const int nsteps = own ? ((gi >> 1) + 1) : 4;
                for (int st = 0; st < nsteps; ++st) {
                    f32x16 s0, s1;
#pragma unroll
                    for (int i = 0; i < 16; ++i) { s0[i] = 0.f; s1[i] = 0.f; }
                    const int kr0 = 64 * st + r, kr1 = kr0 + 32;
#pragma unroll
                    for (int ks = 0; ks < 8; ++ks) { const int c16 = 2 * ks + hh;
                        const bf16x8 a0 = *(const LAS bf16x8*)(Kl + kr0 * 256 + ((c16 ^ (kr0 & 15)) << 4)), a1 = *(const LAS bf16x8*)(Kl + kr1 * 256 + ((c16 ^ (kr1 & 15)) << 4));
                        s0 = MFMA32(a0, qf[ks], s0); s1 = MFMA32(a1, qf[ks], s1); }
                    float mx = -INFINITY;
                    if (own) {
#pragma unroll
                        for (int i = 0; i < 16; ++i) { const int k0 = 64 * st + crow(i, hh), k1 = k0 + 32;
                            s0[i] = (k0 <= qloc) ? s0[i] * ATT_C : -INFINITY; s1[i] = (k1 <= qloc) ? s1[i] * ATT_C : -INFINITY; mx = fmaxf(mx, fmaxf(s0[i], s1[i])); }
                    } else {
#pragma unroll
                        for (int i = 0; i < 16; ++i) { s0[i] *= ATT_C; s1[i] *= ATT_C; mx = fmaxf(mx, fmaxf(s0[i], s1[i])); }
                    }
                    mx = fmaxf(mx, __shfl_xor(mx, 32));
                    const float mn = fmaxf(m, mx);
                    const float alpha = __builtin_amdgcn_exp2f(m - mn);
                    float ps = 0.f;
#pragma unroll
                    for (int i = 0; i < 16; ++i) { s0[i] = __builtin_amdgcn_exp2f(s0[i] - mn); s1[i] = __builtin_amdgcn_exp2f(s1[i] - mn); ps += s0[i] + s1[i]; }
                    l = l * alpha + ps; m = mn;
                    if (__any(alpha != 1.0f)) {
#pragma unroll
                        for (int dt = 0; dt < 4; ++dt)
#pragma unroll
                            for (int i = 0; i < 16; ++i) o[dt][i] *= alpha;
                    }
                    bf16x8 pf[2][2];
#pragma unroll
                    for (int s = 0; s < 2; ++s) {
                        v4u w0, w1;
                        w0.x = pkbf(s0[8 * s + 0], s0[8 * s + 1]); w0.y = pkbf(s0[8 * s + 2], s0[8 * s + 3]); w0.z = pkbf(s0[8 * s + 4], s0[8 * s + 5]); w0.w = pkbf(s0[8 * s + 6], s0[8 * s + 7]);
                        w1.x = pkbf(s1[8 * s + 0], s1[8 * s + 1]); w1.y = pkbf(s1[8 * s + 2], s1[8 * s + 3]); w1.z = pkbf(s1[8 * s + 4], s1[8 * s + 5]); w1.w = pkbf(s1[8 * s + 6], s1[8 * s + 7]);
                        pf[0][s] = __builtin_bit_cast(bf16x8, w0); pf[1][s] = __builtin_bit_cast(bf16x8, w1); }
#pragma unroll
                    for (int dt = 0; dt < 4; ++dt)
#pragma unroll
                        for (int kt = 0; kt < 2; ++kt)
#pragma unroll
                            for (int s = 0; s < 2; ++s) {
                                const LAS unsigned char* vp = Vl + (32 * dt + r) * VT_STRIDE + (64 * st + 32 * kt + 16 * s + 4 * hh) * 2;
                                const v2u lo = *(const LAS v2u*)vp, hi = *(const LAS v2u*)(vp + 16);
                                const v4u vw = {lo.x, lo.y, hi.x, hi.y};
                                o[dt] = MFMA32(__builtin_bit_cast(bf16x8, vw), pf[kt][s], o[dt]); }
                }
                l += __shfl_xor(l, 32);
                const float inv = 1.0f / l;
                if (valid) {
                    const size_t pidx = ((size_t)bh * SEQ + q) * 4 + slot;
                    bf16* yp = partO + pidx * HD;
#pragma unroll
                    for (int dt = 0; dt < 4; ++dt)
#pragma unroll
                        for (int g4 = 0; g4 < 4; ++g4) { v2u w; w.x = pkbf(o[dt][4 * g4] * inv, o[dt][4 * g4 + 1] * inv); w.y = pkbf(o[dt][4 * g4 + 2] * inv, o[dt][4 * g4 + 3] * inv);
                            *(v2u*)(yp + 32 * dt + 8 * g4 + 4 * hh) = w; }
                    if (hh == 0) c.lse[pidx] = m + __builtin_amdgcn_logf(l);
                }
            }
            own_pending = false;
        }
    }
}
DEV void phase_attn_combine(const Ctx& c) {
    const int lane = c.lane, gw = c.bid * 8 + c.wave, NGW = c.G * 8, h = lane >> 3, sub = lane & 7;
    const bf16* partO = (const bf16*)c.out;
    for (int t = gw; t < T; t += NGW) {
        const int b = t / SEQ, q = t % SEQ; const size_t pbase = ((size_t)(b * NH + h) * SEQ + q) * 4;
        const int4 s4 = *(const int4*)(c.sel + pbase); const f32x4 L = *(const f32x4*)(c.lse + pbase);
        const float l0 = s4.x >= 0 ? L.x : -INFINITY, l1 = s4.y >= 0 ? L.y : -INFINITY, l2 = s4.z >= 0 ? L.z : -INFINITY, l3 = L.w;
        const float M = fmaxf(fmaxf(l0, l1), fmaxf(l2, l3));
        const float w0 = __builtin_amdgcn_exp2f(l0 - M), w1 = __builtin_amdgcn_exp2f(l1 - M), w2 = __builtin_amdgcn_exp2f(l2 - M), w3 = __builtin_amdgcn_exp2f(l3 - M);
        const float winv = 1.0f / (w0 + w1 + w2 + w3);
        const float ws[4] = {w0 * winv, w1 * winv, w2 * winv, w3 * winv};
        float acc[16];
#pragma unroll
        for (int i = 0; i < 16; ++i) acc[i] = 0.f;
#pragma unroll
        for (int s = 0; s < 4; ++s) { if (ws[s] != 0.f) { const v4u a = *(const v4u*)(partO + (pbase + s) * HD + 16 * sub), bq = *(const v4u*)(partO + (pbase + s) * HD + 16 * sub + 8); const float w = ws[s];
            acc[0] += w * bflo(a.x); acc[1] += w * bfhi(a.x); acc[2] += w * bflo(a.y); acc[3] += w * bfhi(a.y); acc[4] += w * bflo(a.z); acc[5] += w * bfhi(a.z); acc[6] += w * bflo(a.w); acc[7] += w * bfhi(a.w);
            acc[8] += w * bflo(bq.x); acc[9] += w * bfhi(bq.x); acc[10] += w * bflo(bq.y); acc[11] += w * bfhi(bq.y); acc[12] += w * bflo(bq.z); acc[13] += w * bfhi(bq.z); acc[14] += w * bflo(bq.w); acc[15] += w * bfhi(bq.w); } }
        v4u o0, o1; o0.x = pkbf(acc[0], acc[1]); o0.y = pkbf(acc[2], acc[3]); o0.z = pkbf(acc[4], acc[5]); o0.w = pkbf(acc[6], acc[7]); o1.x = pkbf(acc[8], acc[9]); o1.y = pkbf(acc[10], acc[11]); o1.z = pkbf(acc[12], acc[13]); o1.w = pkbf(acc[14], acc[15]);
        bf16* yp = c.yatt + (size_t)t * 1024 + h * HD + 16 * sub; *(v4u*)yp = o0; *(v4u*)(yp + 8) = o1;
    }
}
DEV void naive_attn(const Ctx& c, LAS unsigned char* lds) {
    LAS float* qs = (LAS float*)(lds + c.wave * 5120);
    LAS float* sc = qs + 128;
    const int lane = c.lane, gw = c.bid * 8 + c.wave, NGW = c.G * 8;
    for (int idx = gw; idx < 16 * SEQ; idx += NGW) {
        const int bh = idx / SEQ, sq = idx % SEQ, j = sq / BLK, b = bh >> 3, h = bh & 7; const size_t tb = (size_t)b * SEQ;
        const unsigned qw = *(const unsigned*)(c.proj + (tb + sq) * PST + C_Q + h * HD + 2 * lane);
        const float qa = bflo(qw), qb = bfhi(qw);
        qs[2 * lane] = qa; qs[2 * lane + 1] = qb;
        float v1 = -INFINITY, v2 = -INFINITY, v3 = -INFINITY; int i1 = 0, i2 = 0, i3 = 0;
        for (int n = 0; n < j; ++n) { const f32x2 km = *(const f32x2*)(c.kmean + ((size_t)bh * NBLK + n) * HD + 2 * lane); const float g = wave_sum(qa * km.x + qb * km.y); insert3(g, n, v1, v2, v3, i1, i2, i3); }
        const int nsel = j < 3 ? j : 3;
        asm volatile("s_waitcnt lgkmcnt(0)" ::: "memory");
        float mx = -INFINITY;
        for (int bi = 0; bi <= nsel; ++bi) { const int n = (bi == nsel) ? j : (bi == 0 ? i1 : (bi == 1 ? i2 : i3));
            for (int kk = lane; kk < BLK; kk += 64) { const int kpos = n * BLK + kk; float s = -INFINITY;
                if (kpos <= sq) { const bf16* kp = c.proj + (tb + kpos) * PST + C_K + h * HD; float a = 0.f;
                    for (int d = 0; d < HD; d += 2) { const unsigned w = *(const unsigned*)(kp + d); a += qs[d] * bflo(w) + qs[d + 1] * bfhi(w); }
                    s = a * 0.08838834764831845f; }
                sc[bi * BLK + kk] = s; mx = fmaxf(mx, s); } }
#pragma unroll
        for (int o = 1; o < 64; o <<= 1) mx = fmaxf(mx, __shfl_xor(mx, o));
        asm volatile("s_waitcnt lgkmcnt(0)" ::: "memory");
        float sum = 0.f, oa = 0.f, ob = 0.f;
        for (int bi = 0; bi <= nsel; ++bi) { const int n = (bi == nsel) ? j : (bi == 0 ? i1 : (bi == 1 ? i2 : i3));
            for (int kk = 0; kk < BLK; ++kk) { const float pz = __expf(sc[bi * BLK + kk] - mx); if (pz == 0.f) continue;
                const unsigned w = *(const unsigned*)(c.proj + (tb + n * BLK + kk) * PST + C_V + h * HD + 2 * lane); sum += pz; oa += pz * bflo(w); ob += pz * bfhi(w); } }
        *(unsigned*)(c.yatt + (tb + sq) * 1024 + h * HD + 2 * lane) = pkbf(oa / sum, ob / sum);
    }
}


DEV void phase_final(const Ctx& c) {
    const int gw = c.bid * 8 + c.wave, NGW = c.G * 8, lane = c.lane;
    const f32x4* gr = (const f32x4*)c.g_fin + lane;
    v2u vn[8]; int m = gw;
    if (m < T) { const v2u* xr = (const v2u*)(c.h2b + (size_t)m * D) + lane;
#pragma unroll
        for (int j = 0; j < 8; ++j) vn[j] = xr[64 * j]; }
    for (; m < T; m += NGW) {
        f32x4 v[8]; float s = 0.f;
#pragma unroll
        for (int j = 0; j < 8; ++j) { v[j] = (f32x4){bflo(vn[j].x), bfhi(vn[j].x), bflo(vn[j].y), bfhi(vn[j].y)}; s += (v[j].x * v[j].x + v[j].y * v[j].y) + (v[j].z * v[j].z + v[j].w * v[j].w); }
        { const int mn = m + NGW < T ? m + NGW : m; const v2u* xn_ = (const v2u*)(c.h2b + (size_t)mn * D) + lane;
#pragma unroll
          for (int j = 0; j < 8; ++j) vn[j] = xn_[64 * j]; }
        const float r = 1.0f / sqrtf(wsum_q(s) * (1.0f / D) + EPS);
        f32x4* xr = (f32x4*)(c.out + (size_t)m * D) + lane;
#pragma unroll
        for (int j = 0; j < 8; ++j) xr[64 * j] = v[j] * r * gr[64 * j];
    }
}

DEV unsigned f2key(float f) { const unsigned u = __float_as_uint(f); return u ^ ((unsigned)((int)u >> 31) | 0x80000000u); }
DEV float key2f(unsigned k) { const unsigned u = (k & 0x80000000u) ? (k ^ 0x80000000u) : ~k; return __uint_as_float(u); }
#define TK_INSERT(L, key) do { unsigned _k = (key); _Pragma("unroll") for (int _j = 0; _j < 16; ++_j) { const unsigned _hi = max(L[_j], _k); _k = min(L[_j], _k); L[_j] = _hi; } } while (0)
#define TK_MERGE(a, b) do { _Pragma("unroll") for (int _i = 0; _i < 16; ++_i) a[_i] = max(a[_i], b[15 - _i]); \
    _Pragma("unroll") for (int _st = 8; _st >= 1; _st >>= 1) { _Pragma("unroll") for (int _i = 0; _i < 16; ++_i) if ((_i & _st) == 0) { const unsigned _x = max(a[_i], a[_i + _st]), _y = min(a[_i], a[_i + _st]); a[_i] = _x; a[_i + _st] = _y; } } } while (0)
#define TK_SORT16(a) do { _Pragma("unroll") for (int _k = 2; _k <= 16; _k <<= 1) { _Pragma("unroll") for (int _j = _k >> 1; _j > 0; _j >>= 1) { _Pragma("unroll") for (int _i = 0; _i < 16; ++_i) { const int _l = _i ^ _j; \
    if (_l > _i) { const unsigned _x = max(a[_i], a[_l]), _y = min(a[_i], a[_l]); if ((_i & _k) == 0) { a[_i] = _x; a[_l] = _y; } else { a[_i] = _y; a[_l] = _x; } } } } } } while (0)
DEV void peer_topk_task(const Ctx& c, int tg, int h) {
    const int lane = c.lane, r = lane & 31, hh = lane >> 5;
    {
        const int tok = tg * 32 + r;
        unsigned LA[16], LB[16];
#pragma unroll
        for (int p = 0; p < 2; ++p) {
            const bf16* qrow = c.qp + (size_t)tok * D + h * 256 + p * 128;
            bf16x8 qf[8];
#pragma unroll
            for (int ks = 0; ks < 8; ++ks) qf[ks] = *(const bf16x8*)(qrow + 16 * ks + 8 * hh);
            unsigned L[16];
            const bf16* skp = c.skb + ((size_t)(h * 2 + p) * 128) * 128;
            bf16x8 an[8];
#pragma unroll
            for (int ks = 0; ks < 8; ++ks) an[ks] = *(const bf16x8*)(skp + (size_t)r * 128 + 16 * ks + 8 * hh);
#pragma unroll 1
            for (int nt = 0; nt < 4; ++nt) {
                f32x16 s;
#pragma unroll
                for (int i = 0; i < 16; ++i) s[i] = 0.f;
                bf16x8 ac[8];
#pragma unroll
                for (int ks = 0; ks < 8; ++ks) ac[ks] = an[ks];
                { const int ntn = nt < 3 ? nt + 1 : 3;
#pragma unroll
                  for (int ks = 0; ks < 8; ++ks) an[ks] = *(const bf16x8*)(skp + (size_t)(32 * ntn + r) * 128 + 16 * ks + 8 * hh); }
#pragma unroll
                for (int ks = 0; ks < 8; ++ks) s = MFMA32(ac[ks], qf[ks], s);
                unsigned Tl[16];
#pragma unroll
                for (int i = 0; i < 16; ++i) Tl[i] = (f2key(s[i]) & ~0x7Fu) | (unsigned)(32 * nt + crow(i, hh));
                TK_SORT16(Tl);
                if (nt == 0) {
#pragma unroll
                    for (int i = 0; i < 16; ++i) L[i] = Tl[i];
                } else { TK_MERGE(L, Tl); }
            }
            unsigned PL[16];
#pragma unroll
            for (int i = 0; i < 16; ++i) PL[i] = (unsigned)__shfl_xor((int)L[i], 32);
            TK_MERGE(L, PL);
#pragma unroll
            for (int i = 0; i < 16; ++i) { if (p == 0) LA[i] = L[i]; else LB[i] = L[i]; }
        }
        float va[16], vb[16];
#pragma unroll
        for (int i = 0; i < 16; ++i) { va[i] = key2f(LA[i] & ~0x7Fu); vb[i] = key2f(LB[i] & ~0x7Fu); }
        unsigned CL[16];
#pragma unroll
        for (int i = 0; i < 16; ++i) CL[i] = 0u;
#pragma unroll
        for (int i = 0; i < 16; ++i)
#pragma unroll
            for (int m = 0; m < 8; ++m) if ((i + 1) * (2 * m + 1) <= 16) {
                const float bsel = hh ? vb[2 * m + 1] : vb[2 * m];
                const bool okj = hh ? ((i + 1) * (2 * m + 2) <= 16) : true;
                const unsigned key = okj ? ((f2key(va[i] + bsel) & ~0xFFu) | (unsigned)(i * 16 + 2 * m + hh)) : 0u; TK_INSERT(CL, key); }
        { unsigned PC[16];
#pragma unroll
          for (int i = 0; i < 16; ++i) PC[i] = (unsigned)__shfl_xor((int)CL[i], 32);
          TK_MERGE(CL, PC); }
        unsigned pa[4], pb[4];
#pragma unroll
        for (int w = 0; w < 4; ++w) { pa[w] = (LA[4 * w] & 0x7Fu) | ((LA[4 * w + 1] & 0x7Fu) << 8) | ((LA[4 * w + 2] & 0x7Fu) << 16) | ((LA[4 * w + 3] & 0x7Fu) << 24);
                                      pb[w] = (LB[4 * w] & 0x7Fu) | ((LB[4 * w + 1] & 0x7Fu) << 8) | ((LB[4 * w + 2] & 0x7Fu) << 16) | ((LB[4 * w + 3] & 0x7Fu) << 24); }
        float r1; { float ss = 0.f; const f32x4* rp = (const f32x4*)(c.rss + (size_t)tok * 32);
#pragma unroll
            for (int i = 0; i < 8; ++i) { const f32x4 t4 = rp[i]; ss += (t4.x + t4.y) + (t4.z + t4.w); }
            r1 = 1.0f / sqrtf(ss * (1.0f / D) + EPS); }
        float sv[16]; float ssum = 0.f; const float smax = key2f(CL[0] & ~0xFFu);
#pragma unroll
        for (int k = 0; k < 16; ++k) { sv[k] = __expf((key2f(CL[k] & ~0xFFu) - smax) * r1); ssum += sv[k]; }
        const float sinv = 1.0f / ssum;
        int* ep = c.eid + (size_t)tok * 128 + h * 16; float* gp = c.egate + (size_t)tok * 128 + h * 16;
#pragma unroll
        for (int k = 0; k < 16; ++k) {
            const unsigned ci = (CL[k] >> 4) & 15u, cj = CL[k] & 15u;
            const unsigned wa = (ci >> 2) == 0 ? pa[0] : ((ci >> 2) == 1 ? pa[1] : ((ci >> 2) == 2 ? pa[2] : pa[3]));
            const unsigned wb = (cj >> 2) == 0 ? pb[0] : ((cj >> 2) == 1 ? pb[1] : ((cj >> 2) == 2 ? pb[2] : pb[3]));
            const unsigned ia = (wa >> ((ci & 3u) * 8u)) & 0x7Fu, ib = (wb >> ((cj & 3u) * 8u)) & 0x7Fu;
            if (hh == 0) ep[k] = (int)(ia * 128u + ib); else gp[k] = sv[k] * sinv;
        }
    }
}
DEV void phase_peer_topk(const Ctx& c) {
    const int gw = c.bid * 8 + c.wave, NGW = c.G * 8;
    for (int wt = gw; wt < (T / 32) * NH; wt += NGW) peer_topk_task(c, wt >> 3, wt & 7);
}
DEV void naive_peer_topk(const Ctx& c) {
    const int lane = c.lane, gw = c.bid * 8 + c.wave, NGW = c.G * 8;
    for (int wt = gw; wt < T * NH; wt += NGW) {
        const int tok = wt >> 3, h = wt & 7;
        float ts[2][16]; int ti[2][16];
#pragma unroll
        for (int p = 0; p < 2; ++p) {
            const bf16* qrow = c.qp + (size_t)tok * D + h * 256 + p * 128;
            float s0 = 0.f, s1 = 0.f;
            const bf16* k0 = c.skb + ((size_t)(h * 2 + p) * 128 + lane) * 128; const bf16* k1 = k0 + 64 * 128;
            for (int d = 0; d < 128; ++d) { const float q = bf2f(qrow[d]); s0 += q * bf2f(k0[d]); s1 += q * bf2f(k1[d]); }
#pragma unroll
            for (int k = 0; k < 16; ++k) {
                float best = fmaxf(s0, s1); int bi = (s0 >= s1) ? lane : lane + 64;
#pragma unroll
                for (int o = 1; o < 64; o <<= 1) { const float ob = __shfl_xor(best, o); const int oi = __shfl_xor(bi, o); if (ob > best || (ob == best && oi < bi)) { best = ob; bi = oi; } }
                ts[p][k] = best; ti[p][k] = bi;
                if (bi == lane) s0 = -INFINITY; if (bi == lane + 64) s1 = -INFINITY;
            }
        }
        float cv[4]; int cid[4];
#pragma unroll
        for (int q = 0; q < 4; ++q) { cv[q] = 0.f; cid[q] = 0; }
#pragma unroll
        for (int i = 0; i < 16; ++i)
#pragma unroll
            for (int jj = 0; jj < 16; ++jj) { if ((lane >> 2) == i && (lane & 3) == (jj >> 2)) { cv[jj & 3] = ts[0][i] + ts[1][jj]; cid[jj & 3] = ti[0][i] * 128 + ti[1][jj]; } }
        float bs[16]; int be[16];
#pragma unroll
        for (int k = 0; k < 16; ++k) {
            float best = cv[0]; int bq = 0;
#pragma unroll
            for (int q = 1; q < 4; ++q) if (cv[q] > best) { best = cv[q]; bq = q; }
            int bpos = lane * 4 + bq; int bid_ = (bq == 0) ? cid[0] : (bq == 1 ? cid[1] : (bq == 2 ? cid[2] : cid[3]));
#pragma unroll
            for (int o = 1; o < 64; o <<= 1) { const float ob = __shfl_xor(best, o); const int op = __shfl_xor(bpos, o); const int oe = __shfl_xor(bid_, o); if (ob > best || (ob == best && op < bpos)) { best = ob; bpos = op; bid_ = oe; } }
            bs[k] = best; be[k] = bid_;
#pragma unroll
            for (int q = 0; q < 4; ++q) if (bpos == lane * 4 + q) cv[q] = -INFINITY;
        }
        const float mxs = bs[0]; float tot = 0.f;
#pragma unroll
        for (int k = 0; k < 16; ++k) { bs[k] = __expf(bs[k] - mxs); tot += bs[k]; }
        int* ep = c.eid + (size_t)tok * 128 + h * 16; float* gp = c.egate + (size_t)tok * 128 + h * 16;
        if (lane == 0) {
#pragma unroll
            for (int k = 0; k < 16; ++k) { ep[k] = be[k]; gp[k] = bs[k] / tot; }
        }
    }
}

DEV float rl_f(float v, int l) { return __int_as_float(__builtin_amdgcn_readlane(__float_as_int(v), l)); }
DEV unsigned q4(float a, float b, float c_, float d, float inv, int off) {
    const int qa = (int)rintf(a * inv) + off, qb = (int)rintf(b * inv) + off, qc = (int)rintf(c_ * inv) + off, qd = (int)rintf(d * inv) + off;
    return (unsigned)(qa & 0xff) | ((unsigned)(qb & 0xff) << 8) | ((unsigned)(qc & 0xff) << 16) | ((unsigned)(qd & 0xff) << 24);
}
DEV float wave_max(float v) {
#pragma unroll
    for (int o = 1; o < 64; o <<= 1) v = fmaxf(v, __shfl_xor(v, o));
    return v;
}
DEV void quant_tables(const Ctx& c, int row0, int row1, int step, int first, LAS unsigned char* scr) {
    const int lane = c.lane;
    int row = row0 + first;
    if (row >= row1) return;
    f32x4 vn[8];
    { const bool isup = row >= NEXP; const int e = isup ? row - NEXP : row; const f32x4* src = (const f32x4*)((isup ? c.up : c.dn) + (size_t)e * D) + lane;
#pragma unroll
      for (int j = 0; j < 8; ++j) vn[j] = src[64 * j]; }
    for (; row < row1; row += step) {
        const bool isup = row >= NEXP; const int e = isup ? row - NEXP : row;
        f32x4 v[8];
#pragma unroll
        for (int j = 0; j < 8; ++j) v[j] = vn[j];
        { const int rn = row + step < row1 ? row + step : row; const bool upn = rn >= NEXP; const int en = upn ? rn - NEXP : rn; const f32x4* src = (const f32x4*)((upn ? c.up : c.dn) + (size_t)en * D) + lane;
#pragma unroll
          for (int j = 0; j < 8; ++j) vn[j] = src[64 * j]; }
        float am = 0.f;
#pragma unroll
        for (int j = 0; j < 8; ++j) { if (!isup) v[j] *= ((const f32x4*)c.g_ffn)[64 * j + lane];
            am = fmaxf(am, fmaxf(fmaxf(fabsf(v[j].x), fabsf(v[j].y)), fmaxf(fabsf(v[j].z), fabsf(v[j].w)))); }
        am = wmax_q(am);
        if (!isup) {
            const float inv = am > 0.f ? 127.0f / am : 0.f;
            unsigned* dst = (unsigned*)(c.dn8 + (size_t)e * D) + lane;
#pragma unroll
            for (int j = 0; j < 8; ++j) dst[64 * j] = q4(v[j].x, v[j].y, v[j].z, v[j].w, inv, 0);
            if (lane == 0) c.sdn[e] = am * (1.0f / 127.0f);
        } else {
            float ssq = 0.f;
#pragma unroll
            for (int j = 0; j < 8; ++j) ssq += (v[j].x * v[j].x + v[j].y * v[j].y) + (v[j].z * v[j].z + v[j].w * v[j].w);
            const float rms = sqrtf(wsum_q(ssq) * (1.0f / D));
            const float stA = am * (1.0f / 7.0f), stB = fminf(stA, 0.36f * rms);
            const float ivA = stA > 0.f ? 1.0f / stA : 0.f, ivB = stB > 0.f ? 1.0f / stB : 0.f;
            float eA = 0.f, eB = 0.f;
#pragma unroll
            for (int j = 0; j < 8; ++j) { const float vv[4] = {v[j].x, v[j].y, v[j].z, v[j].w};
#pragma unroll
                for (int i = 0; i < 4; ++i) { const float qa = fminf(fmaxf(rintf(vv[i] * ivA), -7.f), 7.f) * stA - vv[i], qb = fminf(fmaxf(rintf(vv[i] * ivB), -7.f), 7.f) * stB - vv[i]; eA += qa * qa; eB += qb * qb; } }
            eA = wsum_q(eA); eB = wsum_q(eB);
            const bool useB = am > 0.f && eB < eA;
            const float st = useB ? stB : stA, inv = useB ? ivB : ivA; am = st * 7.0f;
#pragma unroll
            for (int j = 0; j < 8; ++j) { const f32x4 cl = {fminf(fmaxf(v[j].x * inv, -7.f), 7.f), fminf(fmaxf(v[j].y * inv, -7.f), 7.f), fminf(fmaxf(v[j].z * inv, -7.f), 7.f), fminf(fmaxf(v[j].w * inv, -7.f), 7.f)};
                *(LAS unsigned*)(scr + 4 * (64 * j + lane)) = q4(cl.x, cl.y, cl.z, cl.w, 1.0f, 8); }
            asm volatile("s_waitcnt lgkmcnt(0)" ::: "memory");
            const v4u lo = *(const LAS v4u*)(scr + 32 * lane), hi = *(const LAS v4u*)(scr + 32 * lane + 16);
            v4u o; o.x = (lo.x & 0x0F0F0F0Fu) | ((lo.y & 0x0F0F0F0Fu) << 4); o.y = (lo.z & 0x0F0F0F0Fu) | ((lo.w & 0x0F0F0F0Fu) << 4);
                   o.z = (hi.x & 0x0F0F0F0Fu) | ((hi.y & 0x0F0F0F0Fu) << 4); o.w = (hi.z & 0x0F0F0F0Fu) | ((hi.w & 0x0F0F0F0Fu) << 4);
            *(v4u*)(c.up8 + (size_t)e * (D / 2) + 16 * lane) = o;
            if (lane == 0) c.sup[e] = am * (1.0f / 7.0f);
            asm volatile("s_waitcnt lgkmcnt(0)" ::: "memory");
        }
    }
}
#ifndef EXP_NT
#define EXP_NT 2
#endif
constexpr int ENT = EXP_NT;
struct TokQ { int e0, e1, hid0, hid1; float sd0, sd1, gs0, gs1, cf0, cf1, sx, csum; };
DEV int sread_i(int v0, int v1, int k) { const int a = __builtin_amdgcn_readlane(v0, k & 63), b = __builtin_amdgcn_readlane(v1, k & 63); return k < 64 ? a : b; }
DEV float sread_f(float v0, float v1, int k) { return __int_as_float(sread_i(__float_as_int(v0), __float_as_int(v1), k)); }
DEV v4u bload16(__amdgpu_buffer_rsrc_t rs, int voff, int soff) { return __builtin_bit_cast(v4u, __builtin_amdgcn_raw_buffer_load_b128(rs, voff, soff, 0)); }
DEV unsigned bsort_step(unsigned v, unsigned pv, bool keepmin) { return keepmin ? min(v, pv) : max(v, pv); }
DEV void tokq_init(const Ctx& c, int tok, TokQ& s, unsigned (&xq)[4][4], int lane, unsigned idmask = 0xFFFFu) {
    float am = 0.f;
#pragma unroll
    for (int q = 0; q < 4; ++q)
#pragma unroll
        for (int hf = 0; hf < 2; ++hf) { const v4u w = *(const v4u*)(c.h1n + (size_t)tok * D + q * 512 + 16 * (lane & 31) + 8 * hf);
            am = fmaxf(am, fmaxf(fmaxf(fmaxf(fabsf(bflo(w.x)), fabsf(bfhi(w.x))), fmaxf(fabsf(bflo(w.y)), fabsf(bfhi(w.y)))), fmaxf(fmaxf(fabsf(bflo(w.z)), fabsf(bfhi(w.z))), fmaxf(fabsf(bflo(w.w)), fabsf(bfhi(w.w)))))); }
    am = wave_max(am);
    const float r1 = 1.0f / sqrtf(wave_sum(lane < 32 ? c.rss[(size_t)tok * 32 + lane] : 0.f) * (1.0f / D) + EPS);
    const float inv = am > 0.f ? 127.0f / am : 0.f; s.sx = am * (1.0f / 127.0f) * r1;
#pragma unroll
    for (int q = 0; q < 4; ++q)
#pragma unroll
        for (int hf = 0; hf < 2; ++hf) { const v4u w = *(const v4u*)(c.h1n + (size_t)tok * D + q * 512 + 16 * (lane & 31) + 8 * hf);
            xq[q][2 * hf] = q4(bflo(w.x), bfhi(w.x), bflo(w.y), bfhi(w.y), inv, 0); xq[q][2 * hf + 1] = q4(bflo(w.z), bfhi(w.z), bflo(w.w), bfhi(w.w), inv, 0); }
    const float g0 = c.egate[(size_t)tok * 128 + lane], g1 = c.egate[(size_t)tok * 128 + 64 + lane];
    unsigned k0 = (((unsigned)c.eid[(size_t)tok * 128 + lane] & idmask) << 7) | (unsigned)lane, k1 = (((unsigned)c.eid[(size_t)tok * 128 + 64 + lane] & idmask) << 7) | (unsigned)(64 + lane);
#pragma unroll
    for (int k = 2; k <= 128; k <<= 1)
#pragma unroll
        for (int j = k >> 1; j > 0; j >>= 1) {
            if (j == 64) { const unsigned a = min(k0, k1), b = max(k0, k1); k0 = a; k1 = b; }
            else { const unsigned p0 = (unsigned)__shfl_xor((int)k0, j), p1 = (unsigned)__shfl_xor((int)k1, j);
                const bool lower = (lane & j) == 0;
                const bool up0 = (k == 128) ? true : ((lane & k) == 0), up1 = (k == 128) ? true : ((k == 64) ? false : ((lane & k) == 0));
                k0 = bsort_step(k0, p0, up0 == lower); k1 = bsort_step(k1, p1, up1 == lower); }
        }
    s.e0 = (int)(k0 >> 7); s.e1 = (int)(k1 >> 7);
    { const int s0 = (int)(k0 & 127u), s1 = (int)(k1 & 127u);
      const float a0 = __shfl(g0, s0 & 63), b0 = __shfl(g1, s0 & 63), a1 = __shfl(g0, s1 & 63), b1 = __shfl(g1, s1 & 63);
      s.gs0 = (s0 < 64 ? a0 : b0) * c.sup[s.e0]; s.gs1 = (s1 < 64 ? a1 : b1) * c.sup[s.e1]; }
    s.sd0 = c.sdn[s.e0]; s.sd1 = c.sdn[s.e1];
    s.hid0 = 0; s.hid1 = 0; s.cf0 = 0.f; s.cf1 = 0.f; s.csum = 0.f;
}
DEV void q_load(__amdgpu_buffer_rsrc_t rs, const TokQ& s, int kb, int q, int lane, v4u (&dq)[4]) {
    const int esel = kb < 64 ? s.e0 : s.e1;
#pragma unroll
    for (int j = 0; j < 4; ++j) { const int id = __shfl(esel, (kb + 2 * j + (lane >> 5)) & 63);
        dq[j] = bload16(rs, id * D + q * 512 + 16 * (lane & 31), 0); }
}
DEV void u_load(__amdgpu_buffer_rsrc_t rs, const TokQ& s, int kb, int hq, int lane, v4u (&dq)[4]) {
    const int esel = kb < 64 ? s.e0 : s.e1;
#pragma unroll
    for (int j = 0; j < 4; ++j) { const int id = __shfl(esel, (kb + 2 * j + (lane >> 5)) & 63);
        dq[j] = bload16(rs, id * (D / 2) + hq * 512 + 16 * (lane & 31), 0); }
}
DEV void q_down_dot(const unsigned (&xq)[4], const v4u (&dq)[4], int (&part)[16], const int sub) {
#pragma unroll
    for (int j = 0; j < 4; ++j) { int a = __builtin_amdgcn_sdot4((int)dq[j].x, (int)xq[0], 0, false); a = __builtin_amdgcn_sdot4((int)dq[j].y, (int)xq[1], a, false);
        a = __builtin_amdgcn_sdot4((int)dq[j].z, (int)xq[2], a, false); a = __builtin_amdgcn_sdot4((int)dq[j].w, (int)xq[3], a, false); part[4 * sub + j] = a; }
}
DEV void q_down_reduce(TokQ& s, int kg, int lane, const int (&part)[16]) {
    int r8[8], r4[4], r2[2], r1;
    { const bool h = (lane & 16) != 0;
#pragma unroll
      for (int i = 0; i < 8; ++i) { const int keep = h ? part[i + 8] : part[i], send = h ? part[i] : part[i + 8]; r8[i] = keep + __shfl_xor(send, 16); } }
    { const bool h = (lane & 8) != 0;
#pragma unroll
      for (int i = 0; i < 4; ++i) { const int keep = h ? r8[i + 4] : r8[i], send = h ? r8[i] : r8[i + 4]; r4[i] = keep + __shfl_xor(send, 8); } }
    { const bool h = (lane & 4) != 0;
#pragma unroll
      for (int i = 0; i < 2; ++i) { const int keep = h ? r4[i + 2] : r4[i], send = h ? r4[i] : r4[i + 2]; r2[i] = keep + __shfl_xor(send, 4); } }
    { const bool h = (lane & 2) != 0; const int keep = h ? r2[1] : r2[0], send = h ? r2[0] : r2[1]; r1 = keep + __shfl_xor(send, 2); }
    r1 += __shfl_xor(r1, 1);
    const int e = (lane - kg) & 31;
    const int isrc = 4 * (e >> 3) + ((e & 7) >> 1), hsrc = e & 1;
    const int gsum = __shfl(r1, 32 * hsrc + 2 * isrc);
    if ((lane >> 5) == ((kg & 63) >> 5)) { if (kg < 64) s.hid0 += gsum; else s.hid1 += gsum; }
}
DEV void q_up_compute(const TokQ& s, float (&y)[16], int kb, int lane, const v4u (&uq)[4]) {
#pragma unroll
    for (int j = 0; j < 4; ++j) { const float flo = sread_f(s.cf0, s.cf1, kb + 2 * j), fhi = sread_f(s.cf0, s.cf1, kb + 2 * j + 1); const float f = lane < 32 ? flo : fhi;
        const unsigned ww[4] = {uq[j].x, uq[j].y, uq[j].z, uq[j].w};
#pragma unroll
        for (int w = 0; w < 4; ++w) { y[4 * w + 0] += f * (float)(ww[w] & 0xffu); y[4 * w + 1] += f * (float)((ww[w] >> 8) & 0xffu); y[4 * w + 2] += f * (float)((ww[w] >> 16) & 0xffu); y[4 * w + 3] += f * (float)(ww[w] >> 24); } }
}
DEV void tokq_final(const Ctx& c, int tok, int lane) {
    const v2u* hp = (const v2u*)(c.h2b + (size_t)tok * D) + lane;
    f32x4 v[8]; float ss = 0.f, am = 0.f;
#pragma unroll
    for (int j = 0; j < 8; ++j) { const v2u w = hp[64 * j]; v[j] = (f32x4){bflo(w.x), bfhi(w.x), bflo(w.y), bfhi(w.y)}; ss += (v[j].x * v[j].x + v[j].y * v[j].y) + (v[j].z * v[j].z + v[j].w * v[j].w);
        am = fmaxf(am, fmaxf(fmaxf(fabsf(v[j].x), fabsf(v[j].y)), fmaxf(fabsf(v[j].z), fabsf(v[j].w)))); }
    const float rr = 1.0f / sqrtf(wave_sum(ss) * (1.0f / D) + EPS);
    am = wave_max(am);
    const float inv = am > 0.f ? 127.0f / am : 0.f;
    unsigned* o4 = (unsigned*)(c.h2q8 + (size_t)tok * D) + lane;
#pragma unroll
    for (int j = 0; j < 8; ++j) o4[64 * j] = q4(v[j].x, v[j].y, v[j].z, v[j].w, inv, 0);
    if (lane == 0) c.h2s[tok] = am * (1.0f / 127.0f) * rr;
}
DEV void phase_peer_experts(const Ctx& c, unsigned idmask = 0xFFFFu) {
    const int lane = c.lane, gw = c.bid * 8 + c.wave, NGW = c.G * 8;
    const __amdgpu_buffer_rsrc_t rsd = __builtin_amdgcn_make_buffer_rsrc((void*)c.dn8, 0, NEXP * D, 0x00020000), rsu = __builtin_amdgcn_make_buffer_rsrc((void*)c.up8, 0, NEXP * D / 2, 0x00020000);
    for (int tg = gw; tg < T / ENT; tg += NGW) {
        const int tok0 = tg * ENT;
        TokQ S[ENT];
        {
            unsigned xq[ENT][4][4];
#pragma unroll
            for (int t = 0; t < ENT; ++t) tokq_init(c, tok0 + t, S[t], xq[t], lane, idmask);
#pragma unroll 1
            for (int q = 0; q < 4; ++q) {
                unsigned xc[ENT][4];
#pragma unroll
                for (int t = 0; t < ENT; ++t)
#pragma unroll
                    for (int w = 0; w < 4; ++w) xc[t][w] = q == 0 ? xq[t][0][w] : (q == 1 ? xq[t][1][w] : (q == 2 ? xq[t][2][w] : xq[t][3][w]));
                v4u dq[ENT][2][4];
#pragma unroll
                for (int t = 0; t < ENT; ++t) { q_load(rsd, S[t], 0, q, lane, dq[t][0]); q_load(rsd, S[t], 8, q, lane, dq[t][1]); }
#pragma unroll 1
                for (int kg = 0; kg < 128; kg += 32) {
                    int part[ENT][16];
#pragma unroll
                    for (int sub = 0; sub < 4; ++sub) { const int kb = kg + 8 * sub, kn = kb + 16 < 128 ? kb + 16 : 120;
#pragma unroll
                        for (int t = 0; t < ENT; ++t) { q_down_dot(xc[t], dq[t][sub & 1], part[t], sub); q_load(rsd, S[t], kn, q, lane, dq[t][sub & 1]); } }
#pragma unroll
                    for (int t = 0; t < ENT; ++t) q_down_reduce(S[t], kg, lane, part[t]);
                }
            }
        }
#pragma unroll
        for (int t = 0; t < ENT; ++t) { S[t].cf0 = S[t].gs0 * gelu_erf((float)S[t].hid0 * (S[t].sx * S[t].sd0)); S[t].cf1 = S[t].gs1 * gelu_erf((float)S[t].hid1 * (S[t].sx * S[t].sd1));
            S[t].csum = wave_sum(S[t].cf0 + S[t].cf1); }
        unsigned cpk[ENT]; float cscale[ENT]; int csumq[ENT];
#pragma unroll
        for (int t = 0; t < ENT; ++t) { const float cm = wave_max(fmaxf(fabsf(S[t].cf0), fabsf(S[t].cf1))); const float inv = cm > 0.f ? 127.0f / cm : 0.f; cscale[t] = cm * (1.0f / 127.0f);
            const int c0 = (int)rintf(S[t].cf0 * inv), c1 = (int)rintf(S[t].cf1 * inv);
            { int sq = c0 + c1;
#pragma unroll
              for (int o = 1; o < 64; o <<= 1) sq += __shfl_xor(sq, o);
              csumq[t] = sq; }
            unsigned pk = 0u;
#pragma unroll
            for (int i = 0; i < 4; ++i) { const int p = 8 * ((lane & 31) >> 1) + (lane & 1) + 2 * i; const int a = __shfl(c0, p & 63), bq = __shfl(c1, p & 63); pk |= ((unsigned)((p < 64 ? a : bq) & 0xff)) << (8 * i); }
            cpk[t] = pk; }
#pragma unroll 1
        for (int hq = 0; hq < 2; ++hq) {
            int y[ENT][32];
#pragma unroll
            for (int t = 0; t < ENT; ++t)
#pragma unroll
                for (int i = 0; i < 32; ++i) y[t][i] = 0;
            v4u uq[ENT][4];
#pragma unroll
            for (int t = 0; t < ENT; ++t) u_load(rsu, S[t], 0, hq, lane, uq[t]);
            for (int kb = 0; kb < 128; kb += 8) { const int kn = kb + 8 < 128 ? kb + 8 : 120;
#pragma unroll
                for (int t = 0; t < ENT; ++t) {
                    const unsigned clo = (unsigned)__builtin_amdgcn_readlane((int)cpk[t], (kb >> 2) & 31), chi = (unsigned)__builtin_amdgcn_readlane((int)cpk[t], ((kb >> 2) & 31) + 1);
                    const int cw = (int)(lane < 32 ? clo : chi);
                    const unsigned a0[4] = {uq[t][0].x, uq[t][0].y, uq[t][0].z, uq[t][0].w}, a1[4] = {uq[t][1].x, uq[t][1].y, uq[t][1].z, uq[t][1].w}, a2[4] = {uq[t][2].x, uq[t][2].y, uq[t][2].z, uq[t][2].w}, a3[4] = {uq[t][3].x, uq[t][3].y, uq[t][3].z, uq[t][3].w};
#pragma unroll
                    for (int w = 0; w < 4; ++w)
#pragma unroll
                        for (int nb = 0; nb < 2; ++nb) {
                            const unsigned b0 = (a0[w] >> (4 * nb)) & 0x0F0F0F0Fu, b1 = (a1[w] >> (4 * nb)) & 0x0F0F0F0Fu, b2 = (a2[w] >> (4 * nb)) & 0x0F0F0F0Fu, b3 = (a3[w] >> (4 * nb)) & 0x0F0F0F0Fu;
                            const unsigned x0 = __builtin_amdgcn_perm(b1, b0, 0x05010400u), x1 = __builtin_amdgcn_perm(b1, b0, 0x07030602u), x2 = __builtin_amdgcn_perm(b3, b2, 0x05010400u), x3 = __builtin_amdgcn_perm(b3, b2, 0x07030602u);
                            const unsigned t0 = __builtin_amdgcn_perm(x2, x0, 0x05040100u), t1 = __builtin_amdgcn_perm(x2, x0, 0x07060302u), t2 = __builtin_amdgcn_perm(x3, x1, 0x05040100u), t3 = __builtin_amdgcn_perm(x3, x1, 0x07060302u);
                            const int yb = 8 * w + 4 * nb;
                            y[t][yb + 0] = __builtin_amdgcn_sdot4((int)t0, cw, y[t][yb + 0], false); y[t][yb + 1] = __builtin_amdgcn_sdot4((int)t1, cw, y[t][yb + 1], false);
                            y[t][yb + 2] = __builtin_amdgcn_sdot4((int)t2, cw, y[t][yb + 2], false); y[t][yb + 3] = __builtin_amdgcn_sdot4((int)t3, cw, y[t][yb + 3], false); }
                    u_load(rsu, S[t], kn, hq, lane, uq[t]); } }
#pragma unroll
            for (int t = 0; t < ENT; ++t) {
#pragma unroll
                for (int i = 0; i < 32; ++i) y[t][i] += __shfl_xor(y[t][i], 32);
                if (lane < 32) { bf16* hp = c.h2b + (size_t)(tok0 + t) * D + hq * 1024 + 32 * lane; const float sc = cscale[t]; const int corr = 8 * csumq[t];
                    const bf16* hb = c.h1n + (size_t)(tok0 + t) * D + hq * 1024 + 32 * lane;
#pragma unroll
                    for (int g8 = 0; g8 < 4; ++g8) { const v4u hw = *(const v4u*)(hb + 8 * g8); const int yb = 8 * g8; v4u o;
                        o.x = pkbf(bflo(hw.x) + (float)(y[t][yb] - corr) * sc, bfhi(hw.x) + (float)(y[t][yb + 1] - corr) * sc); o.y = pkbf(bflo(hw.y) + (float)(y[t][yb + 2] - corr) * sc, bfhi(hw.y) + (float)(y[t][yb + 3] - corr) * sc);
                        o.z = pkbf(bflo(hw.z) + (float)(y[t][yb + 4] - corr) * sc, bfhi(hw.z) + (float)(y[t][yb + 5] - corr) * sc); o.w = pkbf(bflo(hw.w) + (float)(y[t][yb + 6] - corr) * sc, bfhi(hw.w) + (float)(y[t][yb + 7] - corr) * sc);
                        *(v4u*)(hp + yb) = o; } } }
        }
        __builtin_amdgcn_fence(__ATOMIC_RELEASE, "workgroup"); asm volatile("s_waitcnt vmcnt(0)" ::: "memory"); __builtin_amdgcn_fence(__ATOMIC_ACQUIRE, "workgroup");
#pragma unroll
        for (int t = 0; t < ENT; ++t) tokq_final(c, tok0 + t, lane);
    }
}


#define GAS __attribute__((address_space(1)))
#define XB_TMO      128
#define XB_XCNT(j)  (256  + 64 * (j))
#define XB_XSUB(j)  (1280 + 64 * (j))
#define XB_XGEN(j)  (2304 + 64 * (j))
#define XB_TOP      3328
#define XB_TOPGEN   3392
#define XCD_BAR_WORDS 3456
#define XB_SPIN_CAP (1u << 18)

__device__ __forceinline__ unsigned xb_ld(unsigned* p)              { return __hip_atomic_load(p, __ATOMIC_RELAXED, __HIP_MEMORY_SCOPE_AGENT); }
__device__ __forceinline__ unsigned xb_add(unsigned* p, unsigned v) { return __hip_atomic_fetch_add(p, v, __ATOMIC_RELAXED, __HIP_MEMORY_SCOPE_AGENT); }
__device__ __forceinline__ unsigned xb_xcc_id() { return (unsigned)__builtin_amdgcn_s_getreg((3 << 11) | 20) & 0xFu; }
#define XB_SPIN(cond, bar) do { unsigned _sp = 0; while (cond) { __builtin_amdgcn_s_sleep(1); \
    if ((++_sp & 255u) == 0u) { if (xb_ld(&(bar)[XB_TMO])) break; if (_sp > XB_SPIN_CAP) { atomicAdd(&(bar)[XB_TMO], 1u); break; } } } } while (0)

struct XcdBarrier {
    unsigned* bar; unsigned x;
    volatile LAS unsigned* st;
};

__device__ __forceinline__ XcdBarrier xcd_barrier_post(unsigned* bar, volatile LAS unsigned* st) {
    XcdBarrier b; b.bar = bar; b.x = xb_xcc_id(); b.st = st;
    if (threadIdx.x == 0) (void)xb_add(&bar[XB_XCNT(b.x)], 1u);
    return b;
}
__device__ __forceinline__ void xcd_barrier_complete(unsigned* bar, unsigned x, unsigned& nloc, unsigned& nx) {
    const unsigned G = gridDim.x * gridDim.y * gridDim.z;
    unsigned sum, cnt, mine, sp = 0u;
    for (;;) {
        sum = 0u; cnt = 0u; mine = 0u;
#pragma unroll
        for (unsigned j = 0; j < 16; ++j) { const unsigned c = xb_ld(&bar[XB_XCNT(j)]); sum += c; cnt += (c > 0u) ? 1u : 0u; mine = (j == x) ? c : mine; }
        if (sum == G) break;
        __builtin_amdgcn_s_sleep(1);
        if ((++sp & 255u) == 0u) { if (xb_ld(&bar[XB_TMO])) break; if (sp > XB_SPIN_CAP) { atomicAdd(&bar[XB_TMO], 1u); break; } }
    }
    nloc = mine > 0u ? mine : 1u; nx = cnt > 0u ? cnt : 1u;
}

__device__ __forceinline__ void xcd_barrier(const XcdBarrier& b) {
    asm volatile("s_waitcnt vmcnt(0)" ::: "memory");
    __syncthreads();
    if (threadIdx.x == 0) {
        unsigned* bar = b.bar;
        __builtin_amdgcn_s_waitcnt(0);
        unsigned nloc = b.st[0], nx = b.st[1];
        if (nloc == 0u) { xcd_barrier_complete(bar, b.x, nloc, nx); b.st[0] = nloc; b.st[1] = nx; }
        const unsigned old = xb_add(&bar[XB_XSUB(b.x)], 1u);
        const unsigned gen = old / nloc;
        if (old + 1u == (gen + 1u) * nloc) {
            __builtin_amdgcn_fence(__ATOMIC_RELEASE, "agent");
            asm volatile("s_waitcnt vmcnt(0)" ::: "memory");
            const unsigned og = xb_add(&bar[XB_TOP], 1u);
            const unsigned tg = og / nx;
            if (og + 1u == (tg + 1u) * nx) xb_add(&bar[XB_TOPGEN], 1u);
            else XB_SPIN(xb_ld(&bar[XB_TOPGEN]) == tg, bar);
            __builtin_amdgcn_fence(__ATOMIC_ACQUIRE, "agent");
            xb_add(&bar[XB_XGEN(b.x)], 1u);
            asm volatile("s_waitcnt vmcnt(0)" ::: "memory");
        } else {
            XB_SPIN(xb_ld(&bar[XB_XGEN(b.x)]) == gen, bar);
            __builtin_amdgcn_fence(__ATOMIC_ACQUIRE, "agent");
            asm volatile("s_waitcnt vmcnt(0)" ::: "memory");
        }
    }
    __syncthreads();
}

struct Args { const float* in[20]; float* out; unsigned char* ws; int ph_lo, ph_hi; };
constexpr int NPHASES = 16;
__global__ void __launch_bounds__(NTHREADS, 2) fwd_kernel(Args args) {
    extern __shared__ __attribute__((aligned(16))) unsigned char lds_raw[];
    LAS unsigned char* lds = (LAS unsigned char*)lds_raw;
    cg::grid_group grid = cg::this_grid();
    Ctx c;
    c.x = args.in[0]; c.p = args.in[1]; c.g_mix = args.in[2]; c.w_in = args.in[3]; c.ln_g = args.in[4]; c.ln_b = args.in[5]; c.sgu_w = args.in[6]; c.sgu_b = args.in[7];
    c.w_ba = args.in[8]; c.w_bs = args.in[9]; c.w_out = args.in[10]; c.g_ffn = args.in[11]; c.w_pq = args.in[12]; c.subk = args.in[13]; c.dn = args.in[14]; c.up = args.in[15];
    c.g_ple = args.in[16]; c.w_pp = args.in[17]; c.w_pg = args.in[18]; c.g_fin = args.in[19];
    c.out = args.out;
    unsigned char* ws = args.ws;
    c.WinT = (bf16*)(ws + WS_WIN); c.WbaT = (bf16*)(ws + WS_WBA); c.WbsT = (bf16*)(ws + WS_WBS); c.WoutT = (bf16*)(ws + WS_WOUT); c.WqT = (bf16*)(ws + WS_WQ); c.WgT = (bf16*)(ws + WS_WG); c.WprojT = (bf16*)(ws + WS_WPROJ);
    c.pb = (bf16*)(ws + WS_PB); c.skb = (bf16*)(ws + WS_SKB); c.kmean = (float*)(ws + WS_KMEAN); c.xn = (bf16*)(ws + WS_XN); c.proj = (bf16*)(ws + WS_PROJ); c.vT = (bf16*)(ws + WS_VT);
    c.yatt = (bf16*)(ws + WS_YATT); c.ysgu = (bf16*)(ws + WS_YSGU); c.merged = (bf16*)(ws + WS_MERGED); c.h1n = (bf16*)(ws + WS_H1N); c.qp = (bf16*)(ws + WS_QP);
    c.dn8 = ws + WS_DN8; c.up8 = ws + WS_UP8; c.sdn = (float*)(ws + WS_SDN); c.sup = (float*)(ws + WS_SDN) + NEXP; c.rss = (float*)(ws + WS_RSS); c.h2n = (bf16*)(ws + WS_H2N); c.gtmp = (bf16*)(ws + WS_GTMP); c.eid = (int*)(ws + WS_EID); c.egate = (float*)(ws + WS_EGATE); c.sel = (int*)(ws + WS_SEL); c.lse = (float*)(ws + WS_LSE);
    c.h2b = (bf16*)(ws + WS_H2B); c.sst = (float*)(ws + 468 * MiB); c.kmp = (float*)(ws + 470 * MiB); c.swb = (bf16*)(ws + WS_SKB + 512 * 1024); c.xq8 = ws + WS_XN; c.WinT8 = ws + WS_WIN; c.WgT8 = ws + WS_WG; c.h2q8 = ws + WS_H2N; c.xs = (float*)(ws + WS_SC); c.h2s = c.xs + T; c.wcs = c.h2s + T; c.gcs = c.wcs + INW; c.qcs = c.gcs + D; c.h1s = c.qcs + D; c.ocs = c.h1s + T; c.ms = c.ocs + D; c.WoutT8 = ws + WS_WOUT; c.mq8 = ws + WS_MQ8; c.WqT8 = ws + WS_WQ; c.h1q8 = ws + WS_H1N;
    c.G = gridDim.x; c.bid = blockIdx.x; c.tid = threadIdx.x; c.lane = c.tid & 63; c.wave = __builtin_amdgcn_readfirstlane(c.tid >> 6);
    const int lo = args.ph_lo, hi = args.ph_hi;
    volatile LAS unsigned* xst = (volatile LAS unsigned*)(lds + LDS_BYTES - 64);
    if (c.tid < 2) xst[c.tid] = 0u;
    __syncthreads();
    XcdBarrier xbar = xcd_barrier_post((unsigned*)(ws + WS_CTL), xst);
#ifndef PHASE_MASK
#define PHASE_MASK 0xFFFFFFFu
#endif
#ifndef REP_MASK
#define REP_MASK 0u
#endif
#define IN(k) ((((PHASE_MASK) >> (k)) & 1u) && lo <= (k) && (k) < hi)
#define NAIVE(k) (((NAIVE_MASK) >> (k)) & 1u)
#define REP(k) for (int _rep = 0; _rep < 1 + (int)(((REP_MASK) >> (k)) & 1u); ++_rep)
    const bool single = (hi - lo) > 1;
    bool first_sync = true;
#define GSYNC() do { if (single) { if ((first_sync && !ALL_XCD) || !USE_XCDBAR) grid.sync(); else xcd_barrier(xbar); first_sync = false; } } while (0)
    unsigned* kcnt = (unsigned*)(ws + WS_CTL) + 8192; unsigned* qctr = (unsigned*)(ws + WS_CTL) + 8256;
    unsigned* cam = (unsigned*)(ws + WS_CTL) + 9216;
    if (IN(0)) REP(0) { __syncthreads(); phase_prologue(c, lds, cam); }
    if (IN(0)) GSYNC();
    if (IN(15)) REP(15) { __syncthreads(); phase_prologue2(c, lds, cam); }
    if (IN(15)) GSYNC();
#ifdef PAD_NOPS
    if (IN(1)) { asm volatile(".fill %0, 4, 0xbf800000" :: "n"(PAD_NOPS)); }
#endif
    if (IN(1)) REP(1) { __syncthreads(); run_gemm_in(lds, c, _rep); }
    if (IN(1)) GSYNC();
#ifndef P2_REP_PARTS
#define P2_REP_PARTS 7
#endif
    if (IN(2)) REP(2) { __syncthreads(); const int parts = _rep == 0 ? 7 : P2_REP_PARTS;
        if (parts & 2) { if (NAIVE(2)) naive_sgu(c, lds); else phase_sgu(c, lds); } if (parts & 4) phase_select(c, kcnt); }
    if (IN(2)) GSYNC();
    if (IN(3)) REP(3) { __syncthreads(); if (NAIVE(3)) naive_attn(c, lds); else phase_attn(c, lds, qctr + 64 * _rep, _rep == 1 && ATT_PROBE_SKIPC, _rep == 1 && ATT_PROBE_SKIPQ); }
    if (IN(3)) GSYNC();
    if (IN(14)) REP(14) { if (!NAIVE(3)) phase_attn_combine(c); }
    if (IN(14)) GSYNC();
    if (IN(5)) REP(5) { __syncthreads(); int Kk = D; asm volatile("" : "+s"(Kk)); pg8::Gemm g{c.yatt, c.WbaT, T, D, Kk, c.ysgu, 1024}; pg8::StaticOrder S; S.init(T, D, c.G, c.bid);
                 pg8::gemm_phase<EpiBranch, pg8::StaticOrder, true, true>((PG8_LAS unsigned char*)lds, g, S, EpiBranch{c.proj, c.merged}); }
    if (IN(5)) GSYNC();
    if (IN(6)) REP(6) { __syncthreads(); int Kk = D; asm volatile("" : "+s"(Kk)); pg8::Gemm g{c.merged, c.WoutT, T, D, Kk, c.merged + D / 2, D}; pg8::StaticOrder S; S.init(T, D, c.G, c.bid);
                 pg8::gemm_phase<EpiF5, pg8::StaticOrder, true, true>((PG8_LAS unsigned char*)lds, g, S, EpiF5{c.x, c.out, c.h1n, c.rss}); }
    if (IN(6)) GSYNC();
    if (IN(8)) REP(8) { __syncthreads(); run_gemm(false, lds, c.h1n, c.WqT, T, D, D, F6{c.qp}, c.G, c.bid);
        asm volatile("s_waitcnt vmcnt(0)" ::: "memory"); __syncthreads();
        if (c.tid == 0) __builtin_amdgcn_fence(__ATOMIC_ACQUIRE, "agent");
        asm volatile("s_waitcnt vmcnt(0)" ::: "memory"); __syncthreads();
        pg8::StaticOrder S; S.init(T, D, c.G, c.bid); pg8::Unit u;
        for (int i = 0; S.next(i, u); ++i) peer_topk_task(c, u.pm * 8 + c.wave, u.pn); }
    if (IN(8)) GSYNC();
#ifdef EXP_DUMMY_MASK
    if (IN(10)) { phase_peer_experts(c, EXP_DUMMY_MASK); __syncthreads(); }
#endif
    if (IN(10)) REP(10) { phase_peer_experts(c); }
    if (IN(10)) GSYNC();
    if (IN(11)) REP(11) { __syncthreads(); run_gemm_i8(lds, c.h2q8, c.WgT8, c.h2s, c.gcs, T, D, D, F9a{c.gtmp}, c.G, c.bid); }
    if (IN(11) && NAIVE(11) != NAIVE(12)) GSYNC();
    if (IN(12)) { int Kk = PLE; asm volatile("" : "+s"(Kk)); pg8::Gemm g{c.pb, c.WprojT, T, D, Kk, c.pb + PLE / 2, PLE}; pg8::StaticOrder S; S.init(T, D, c.G, c.bid);
                  pg8::gemm_phase<Epi9b, pg8::StaticOrder, true, true>((PG8_LAS unsigned char*)lds, g, S, Epi9b{c.gtmp, c.h2b}); }
    if (IN(12)) GSYNC();
#ifdef BENCH_OP
    if (IN(13)) {
        unsigned a[16];
#pragma unroll
        for (int i = 0; i < 16; ++i) a[i] = c.tid * 2654435761u + i;
        unsigned b = c.lane * 40503u + 77u, sel = 0x05010400u;
#pragma unroll 1
        for (int it = 0; it < 4000; ++it) {
#pragma unroll
            for (int i = 0; i < 16; ++i) {
#if BENCH_OP == 0
                a[i] = (unsigned)__builtin_amdgcn_sdot4((int)a[i], (int)b, (int)a[i], false);
#elif BENCH_OP == 1
                a[i] = __builtin_amdgcn_perm(a[i], b, sel);
#elif BENCH_OP == 2
                a[i] = (a[i] >> 4) & 0x0F0F0F0Fu;  a[i] += b;
#elif BENCH_OP == 3
                a[i] = (unsigned)__shfl_xor((int)a[i], 16);
#elif BENCH_OP == 4
                a[i] = (unsigned)__builtin_amdgcn_readlane((int)a[i], it & 63) + b;
#elif BENCH_OP == 5
                a[i] = __float_as_uint(__uint_as_float(a[i]) * 1.0001f + 0.5f);
#endif
            }
        }
        unsigned s = 0;
#pragma unroll
        for (int i = 0; i < 16; ++i) s ^= a[i];
        if (s == 0x12345679u) c.out[0] = 1.0f;
        __syncthreads();
    }
#endif
    if (IN(13)) { phase_final(c); }
#if DEBUG_CHECK
    {
        float* dbg = (float*)(ws + WS_KMEAN + 512 * 1024);
        const int gw = c.bid * 8 + c.wave, NGW = c.G * 8;
        if (IN(0)) { for (int i = c.bid * NTHREADS + c.tid; i < T; i += c.G * NTHREADS) dbg[i] = 0.f; }
        if (IN(3)) { __syncthreads(); Ctx c2 = c; c2.yatt = (bf16*)(ws + 434 * MiB); naive_attn(c2, lds); }
        if (IN(20)) { const bf16* ya = (const bf16*)(ws + 434 * MiB);
            for (int t = gw; t < T; t += NGW) { float sa = 0.f;
                for (int cc = c.lane; cc < 1024; cc += 64) { const float d1 = bf2f(c.yatt[(size_t)t * 1024 + cc]) - bf2f(ya[(size_t)t * 1024 + cc]); sa += d1 * d1; }
                sa = wave_sum(sa); if (c.lane == 0) dbg[t] += DBG_GA * sa; } }
        if (IN(22)) { for (int t = c.bid * NTHREADS + c.tid; t < T; t += c.G * NTHREADS) c.out[(size_t)t * D] += sqrtf(dbg[t]); }
    }
#endif
#undef IN
#undef GSYNC
#undef NAIVE
}

extern "C" void kernel_launch(void* const* d_in, const int* in_sizes, int n_in, void* d_out, int out_size, void* d_ws, size_t ws_size, hipStream_t stream) {
    static int grid = 0;
    if (grid == 0) {
        if (n_in != 20 || out_size != T * D || ws_size < WS_END) { fprintf(stderr, "kernel_launch: unexpected shapes (n_in %d, out %d, ws %zu)\n", n_in, out_size, ws_size); grid = -1; return; }
        int dev = 0, cus = 0, per_cu = 0;
        if (hipGetDevice(&dev) != hipSuccess || hipDeviceGetAttribute(&cus, hipDeviceAttributeMultiprocessorCount, dev) != hipSuccess) { grid = -1; return; }
        if (hipFuncSetAttribute((const void*)fwd_kernel, hipFuncAttributeMaxDynamicSharedMemorySize, LDS_BYTES) != hipSuccess) { fprintf(stderr, "kernel_launch: hipFuncSetAttribute failed\n"); grid = -1; return; }
        if (hipOccupancyMaxActiveBlocksPerMultiprocessor(&per_cu, (const void*)fwd_kernel, NTHREADS, LDS_BYTES) != hipSuccess || per_cu < 1) { fprintf(stderr, "kernel_launch: occupancy query says %d blocks per CU\n", per_cu); per_cu = 1; }
        (void)hipGetLastError();
        grid = cus;
    }
    if (grid < 0) return;
    if (hipMemsetAsync((char*)d_ws + WS_CTL, 0, 131072, stream) != hipSuccess) { fprintf(stderr, "kernel_launch: memset failed\n"); return; }
    Args a{};
    for (int i = 0; i < 20; ++i) a.in[i] = (const float*)d_in[i];
    a.out = (float*)d_out; a.ws = (unsigned char*)d_ws;
#if MK_SINGLE
    a.ph_lo = 0; a.ph_hi = NPHASES;
    void* kargs[] = {&a};
    hipError_t e = hipLaunchCooperativeKernel((const void*)fwd_kernel, dim3(grid), dim3(NTHREADS), kargs, LDS_BYTES, stream);
    if (e != hipSuccess) fprintf(stderr, "kernel_launch: cooperative launch failed: %s (grid %d)\n", hipGetErrorString(e), grid);
#else
#if DEBUG_CHECK
    const int order[] = {0, 15, 1, 2, 3, 14, 20, 5, 6, 8, 10, 11, 12, 13, 22};
    for (int ph : order) { a.ph_lo = ph; a.ph_hi = ph + 1; hipLaunchKernelGGL(fwd_kernel, dim3(grid), dim3(NTHREADS), LDS_BYTES, stream, a); }
#else
    const int order[] = {0, 15, 1, 2, 3, 14, 5, 6, 8, 10, 11, 12, 13};
    for (int ph : order) { a.ph_lo = ph; a.ph_hi = ph + 1; hipLaunchKernelGGL(fwd_kernel, dim3(grid), dim3(NTHREADS), LDS_BYTES, stream, a); }
#endif
#endif
}
```

```cpp
#define MK_SINGLE 1
#define EXP_NT 2
#define ALL_XCD 1
#include <hip/hip_runtime.h>
#include <hip/hip_cooperative_groups.h>
#include <cstdio>
#include <cstdint>
namespace cg = cooperative_groups;

#ifndef MK_SINGLE
#define MK_SINGLE 1
#endif
#ifndef NAIVE_MASK
#define NAIVE_MASK 0u
#endif

#ifndef GI8_ALIGN
#define GI8_ALIGN true
#endif
#ifndef ATT_PROBE_SKIPC
#define ATT_PROBE_SKIPC 0
#define ATT_PROBE_SKIPQ 0
#endif
#ifndef ATT_FINE
#define ATT_FINE 0
#endif
#ifndef ATT_MIX
#define ATT_MIX 1
#endif
#ifndef DN4
#define DN4 1
#endif
#ifndef EXP_PART
#define EXP_PART 0
#endif
#ifndef GEMM1_ORDER
#define GEMM1_ORDER 0
#endif
#ifndef QI8
#define QI8 1
#endif
#ifndef QUANT_IN_PROLOGUE
#define QUANT_IN_PROLOGUE 0
#endif
#ifndef EXP_SPLIT
#define EXP_SPLIT 0
#endif
#ifndef GROUP_SYNC
#define GROUP_SYNC 1
#endif
#ifndef OI8
#define OI8 1
#endif
#ifndef BI8
#define BI8 1
#endif
#ifndef LATE_W
#define LATE_W 1
#endif
#ifndef QUANT_FIRST
#define QUANT_FIRST 0
#endif
#ifndef ALL_XCD
#define ALL_XCD 0
#endif
#ifndef USE_XCDBAR
#define USE_XCDBAR 1
#endif
#ifndef DEBUG_CHECK
#define DEBUG_CHECK 0
#endif
#ifndef DBG_GA
#define DBG_GA 200.0f
#define DBG_GS 2.0f
#define DBG_GT 1.0f
#endif
#define DEV __device__ __forceinline__
#define LAS __attribute__((address_space(3)))
typedef unsigned short bf16;
typedef float f32x2 __attribute__((ext_vector_type(2)));
typedef float f32x4 __attribute__((ext_vector_type(4)));
typedef float f32x16 __attribute__((ext_vector_type(16)));
typedef short bf16x8 __attribute__((ext_vector_type(8)));
typedef unsigned v4u __attribute__((ext_vector_type(4)));
typedef unsigned v2u __attribute__((ext_vector_type(2)));
typedef __bf16 bfx2 __attribute__((ext_vector_type(2)));

constexpr int T = 16384, SEQ = 8192, D = 2048, INW = 9216, NH = 8, HD = 128, NBLK = 32, BLK = 256;
constexpr int C_Q = 0, C_K = 1024, C_V = 2048, C_U = 3072, C_VG = 4096, C_GA = 5120, C_GB = 7168;
constexpr int NEXP = 16384, PLE = 256;
constexpr int XP = D + 128;
constexpr int PST = INW;
constexpr float EPS = 1e-6f;

constexpr size_t MiB = 1u << 20;
constexpr size_t WS_CTL = 0;
constexpr size_t WS_WIN = 1 * MiB, WS_WBA = 37 * MiB, WS_WBS = 41 * MiB, WS_WOUT = 45 * MiB, WS_WQ = 53 * MiB, WS_WG = 61 * MiB, WS_WPROJ = 69 * MiB;
constexpr size_t WS_PB = 70 * MiB, WS_SKB = 78 * MiB, WS_KMEAN = 79 * MiB;
constexpr size_t WS_XN = (QUANT_IN_PROLOGUE ? 434 : 80) * MiB,
                  WS_YATT = 1 * MiB, WS_YSGU = 112 * MiB, WS_H2N = 112 * MiB;
constexpr size_t WS_PROJ = 144 * MiB, WS_DN8 = 80 * MiB, WS_UP8 = 498 * MiB, WS_SDN = 79 * MiB + 256 * 1024, WS_RSS = 528 * MiB, WS_H1N = 272 * MiB, WS_QP = 336 * MiB, WS_EID = 400 * MiB, WS_EGATE = 408 * MiB;
constexpr size_t WS_SC = 79 * MiB + 640 * 1024;
constexpr size_t WS_MQ8 = 336 * MiB;
constexpr size_t WS_SEL = 464 * MiB, WS_LSE = 466 * MiB;
constexpr size_t WS_VT = 434 * MiB, WS_MERGED = 434 * MiB, WS_GTMP = 434 * MiB;
constexpr size_t WS_H2B = 144 * MiB;
constexpr size_t WS_END = 530 * MiB;

constexpr int LDS_BYTES = 147456;
constexpr int NTHREADS = 512;

DEV unsigned pkbf(float a, float b) { bfx2 v = __builtin_convertvector((f32x2){a, b}, bfx2); return __builtin_bit_cast(unsigned, v); }
DEV float bflo(unsigned w) { return __uint_as_float(w << 16); }
DEV float bfhi(unsigned w) { return __uint_as_float(w & 0xffff0000u); }
DEV float bf2f(bf16 b) { return __uint_as_float(((unsigned)b) << 16); }
DEV float wave_sum(float v) {
#pragma unroll
    for (int o = 1; o < 64; o <<= 1) v += __shfl_xor(v, o);
    return v;
}
template <int CTRL> DEV float dppq(float v) { return __int_as_float(__builtin_amdgcn_update_dpp(0, __float_as_int(v), CTRL, 0xF, 0xF, false)); }
DEV float wsum_q(float v) {
    v += dppq<0xB1>(v); v += dppq<0x4E>(v); v += dppq<0x1B>(dppq<0x141>(v)); v += dppq<0x128>(v);
    { const auto r = __builtin_amdgcn_permlane16_swap(__float_as_uint(v), __float_as_uint(v), false, false); v = __uint_as_float(r[0]) + __uint_as_float(r[1]); }
    { const auto r = __builtin_amdgcn_permlane32_swap(__float_as_uint(v), __float_as_uint(v), false, false); v = __uint_as_float(r[0]) + __uint_as_float(r[1]); }
    return v;
}
DEV float wmax_q(float v) {
    v = fmaxf(v, dppq<0xB1>(v)); v = fmaxf(v, dppq<0x4E>(v)); v = fmaxf(v, dppq<0x1B>(dppq<0x141>(v))); v = fmaxf(v, dppq<0x128>(v));
    { const auto r = __builtin_amdgcn_permlane16_swap(__float_as_uint(v), __float_as_uint(v), false, false); v = fmaxf(__uint_as_float(r[0]), __uint_as_float(r[1])); }
    { const auto r = __builtin_amdgcn_permlane32_swap(__float_as_uint(v), __float_as_uint(v), false, false); v = fmaxf(__uint_as_float(r[0]), __uint_as_float(r[1])); }
    return v;
}
DEV float sigmoidf_(float x) { return __builtin_amdgcn_rcpf(1.0f + __expf(-x)); }
DEV float gelu_erf(float v) { return 0.5f * v * (1.0f + erff(v * 0.70710678118f)); }
#define MFMA32(a, b, c) __builtin_amdgcn_mfma_f32_32x32x16_bf16((a), (b), (c), 0, 0, 0)
DEV int crow(int reg, int h) { return (reg & 3) + 8 * (reg >> 2) + 4 * h; }
namespace pg8 {
#define PG8_LAS __attribute__((address_space(3)))
typedef unsigned short bf16_t;
typedef short bf16x8 __attribute__((ext_vector_type(8)));
typedef float f32x4 __attribute__((ext_vector_type(4)));
typedef unsigned u32x4 __attribute__((ext_vector_type(4)));
constexpr int BM = 256, BK = 64, HALF = 128, HTB = HALF * BK * 2  , STAGE_BYTES = 8 * HTB, NXCD = 8, WGM = 8;

__host__ __device__ __forceinline__ int lds_byte(int r, int c) { const int st = (r >> 4) * 2 + (c >> 5), rr = r & 15, cc = c & 31, ob = rr * 64 + cc * 2; return st * 1024 + (ob ^ (((ob >> 9) & 1) << 5)); }
__host__ __device__ __forceinline__ void stage_rc(int b, int& R, int& C) { const int st = b / 1024, sb = b % 1024, swz = sb ^ (((sb >> 9) & 1) << 5); R = (st >> 1) * 16 + swz / 64; C = (st & 1) * 32 + (swz % 64) / 2; }
__host__ __device__ __forceinline__ int perm32(int rho) { const int n = rho >> 4, i = rho & 15; return 8 * (i >> 2) + 4 * n + (i & 3); }

struct Unit { int pm, pn; };
struct Gemm { const bf16_t* A; const bf16_t* Bt; int M, N, K; const bf16_t* A2; int lda; int ldb; };

struct StaticOrder {
    int nM, nN, nwg, G, c;
    __host__ __device__ __forceinline__ void init(int M, int N, int G_, int c_) { nM = M / BM; nN = N / BM; nwg = nM * nN; G = G_; c = c_; }
    unsigned long long perm9 = 0ull;
    int rot = 0, nround = 1;
    __host__ __device__ __forceinline__ bool next(int i0, Unit& u) const {
        if ((long)i0 * G + c >= nwg) return false;
        int i = i0; if (rot) { i = i0 + rot; if (i >= nround) i -= nround; }
        if (perm9) i = (int)((perm9 >> (4 * i)) & 15u);
        const long L = (long)i * G + c;
        int wgid = (int)L; { const int q = nwg / NXCD, r = nwg % NXCD, xcd = wgid % NXCD, off = wgid / NXCD; wgid = (xcd < r ? xcd * (q + 1) : r * (q + 1) + (xcd - r) * q) + off; }
        const int nig = WGM * nN, gid = wgid / nig, fm = gid * WGM, gsz = (nM - fm) < WGM ? (nM - fm) : WGM;
        u.pm = fm + ((wgid % nig) % gsz); u.pn = (wgid % nig) / gsz; return true;
    }
    __device__ __forceinline__ void a_ready(const Unit&) const {}
    __device__ __forceinline__ void done(const Unit&) const {}
};


typedef float f32x2 __attribute__((ext_vector_type(2)));
__device__ __forceinline__ f32x2 gelu_pk(f32x2 v) {
    const f32x2 av = __builtin_elementwise_abs(v), d = av * 0.2316418882f + 1.0f;
    f32x2 t; t.x = __builtin_amdgcn_rcpf(d.x); t.y = __builtin_amdgcn_rcpf(d.y);
    f32x2 q = t * 0.5307027145f + (-0.7265760135f); q = q * t + 0.7107068705f; q = q * t + (-0.142248368f); q = q * t + 0.127414796f; q = q * t;
    const f32x2 s = (v * v) * (-0.72134752044f);
    f32x2 e; e.x = __builtin_amdgcn_exp2f(s.x); e.y = __builtin_amdgcn_exp2f(s.y);
    const f32x2 m = v * (q * e), r = v - m;
    f32x2 o; o.x = v.x < 0.f ? m.x : r.x; o.y = v.y < 0.f ? m.y : r.y; return o;
}
template <class F> struct EpiW {
    static constexpr bool PERM = false, AFTER_DRAIN = false, HAS_MID = false;
    F f;
    __device__ __forceinline__ void operator()(const f32x4 (&acc)[2][2][4][2], const Unit& u, int wr, int wc, int fr, int fq) const {
        const int row0 = u.pm * BM + wr * 64 + fr, col0 = u.pn * BM + wc * 32 + 4 * fq;
#pragma unroll
        for (int ai = 0; ai < 2; ++ai)
#pragma unroll
            for (int m = 0; m < 4; ++m) {
#pragma unroll
                for (int bj = 0; bj < 2; ++bj)
#pragma unroll
                    for (int n = 0; n < 2; ++n) f.elem4(row0 + ai * HALF + m * 16, col0 + bj * HALF + n * 16, acc[ai][bj][m][n]);
                asm volatile("" ::: "memory");
            }
    }
};

typedef int i32x4 __attribute__((ext_vector_type(4)));
template <class F> struct EpiW8 {
    static constexpr bool PERM = false, AFTER_DRAIN = false, HAS_MID = false, HAS_SKIP = false;
    F f; const float* rs; const float* cs;
    __device__ __forceinline__ void operator()(const i32x4 (&acc)[2][2][4][2], const Unit& u, int wr, int wc, int fr, int fq) const {
        const int row0 = u.pm * BM + wr * 64 + fr, col0 = u.pn * BM + wc * 32 + 4 * fq;
        f32x4 cv[2][2];
#pragma unroll
        for (int bj = 0; bj < 2; ++bj)
#pragma unroll
            for (int n = 0; n < 2; ++n) cv[bj][n] = *(const f32x4*)(cs + col0 + bj * HALF + n * 16);
        float rsv[8];
#pragma unroll
        for (int g = 0; g < 8; ++g) rsv[g] = rs[row0 + (g >> 2) * HALF + (g & 3) * 16];
#pragma unroll
        for (int ai = 0; ai < 2; ++ai)
#pragma unroll
            for (int m = 0; m < 4; ++m) { const int row = row0 + ai * HALF + m * 16; const float r = rsv[ai * 4 + m];
#pragma unroll
                for (int bj = 0; bj < 2; ++bj)
#pragma unroll
                    for (int n = 0; n < 2; ++n) { const i32x4 a = acc[ai][bj][m][n]; const f32x4 c4 = cv[bj][n];
                        f.elem4(row, col0 + bj * HALF + n * 16, (f32x4){(float)a.x * (r * c4.x), (float)a.y * (r * c4.y), (float)a.z * (r * c4.z), (float)a.w * (r * c4.w)}); }
                asm volatile("" ::: "memory");
            }
    }
};
template <class Epi, class Sched, bool ALIGN_EPI = false, bool SP2 = false>
__device__ __forceinline__ void gemm_phase(PG8_LAS unsigned char* lds, const Gemm g, const Sched& S, const Epi& E) {
    const int tid = threadIdx.x, wid = __builtin_amdgcn_readfirstlane(tid >> 6), lane = tid & 63, wr = wid >> 2, wc = wid & 3, fr = lane & 15, fq = lane >> 4;
    const int K = g.K, nt = K / BK;
    unsigned voffA[2], voffB[2];
#pragma unroll
    for (int i = 0; i < 2; ++i) { int R, C; stage_rc(tid * 16 + i * 8192, R, C); const int Rb = Epi::PERM ? ((R & ~31) + perm32(R & 31)) : R;
        voffA[i] = (unsigned)(R * g.lda + C) * 2u; voffB[i] = (unsigned)(Rb * K + C) * 2u; }
    const size_t kstep = (size_t)(BK * 2);
    const size_t hstep = (size_t)HALF * K * 2;
    const size_t tstep = 2 * hstep;
    const size_t hstepA = (size_t)HALF * g.lda * 2, tstepA = 2 * hstepA;
    const int nth = nt / 2; const ptrdiff_t a2off = (const char*)g.A2 - (const char*)g.A - (ptrdiff_t)nth * (BK * 2);
    const unsigned ldsw = (unsigned)wid * 1024u;
    const int aoff = lds_byte(wr * 64 + fr, fq * 8), boff = lds_byte(wc * 32 + fr, fq * 8);
#define PG8_SA(b, h) (((b) * 2 + (h)) * HTB)
#define PG8_SB(b, h) ((4 + (b) * 2 + (h)) * HTB)
#define PG8_STAGE(bufoff, gbase, voff) do { _Pragma("unroll") for (int _i = 0; _i < 2; ++_i) \
        __builtin_amdgcn_global_load_lds((const unsigned*)((const char*)(gbase) + (voff)[_i]), (PG8_LAS unsigned*)(lds + (bufoff) + ldsw + _i * 8192), 16, 0, 0); } while (0)
#define PG8_LDA(dst, b, h) do { _Pragma("unroll") for (int m = 0; m < 4; ++m) _Pragma("unroll") for (int k = 0; k < 2; ++k) dst[m][k] = *(const PG8_LAS bf16x8*)(lds + PG8_SA(b, h) + aoff + m * 2048 + k * 1024); } while (0)
#define PG8_LDB(dst, b, h) do { _Pragma("unroll") for (int n = 0; n < 2; ++n) _Pragma("unroll") for (int k = 0; k < 2; ++k) dst[n][k] = *(const PG8_LAS bf16x8*)(lds + PG8_SB(b, h) + boff + n * 2048 + k * 1024); } while (0)
#define PG8_MMA(ai, bj, At, Bt) do { __builtin_amdgcn_s_setprio(1); _Pragma("unroll") for (int m = 0; m < 4; ++m) _Pragma("unroll") for (int n = 0; n < 2; ++n) _Pragma("unroll") for (int k = 0; k < 2; ++k) \
        acc[ai][bj][m][n] = __builtin_amdgcn_mfma_f32_16x16x32_bf16(Bt[n][k], At[m][k], acc[ai][bj][m][n], 0, 0, 0); __builtin_amdgcn_s_setprio(0); } while (0)
#define PG8_WAIT_V(n) asm volatile("s_waitcnt vmcnt(" #n ")" ::: "memory")
#define PG8_WAIT_L(n) asm volatile("s_waitcnt lgkmcnt(" #n ")" ::: "memory")
#define PG8_BAR __builtin_amdgcn_s_barrier()
#define PG8_SCHED __builtin_amdgcn_sched_barrier(0)
    Unit cur, nxt; int ui = 0;
    if (!S.next(0, cur)) return;
    f32x4 acc[2][2][4][2];
#pragma unroll
    for (int a = 0; a < 2; ++a)
#pragma unroll
        for (int b = 0; b < 2; ++b)
#pragma unroll
            for (int m = 0; m < 4; ++m)
#pragma unroll
                for (int n = 0; n < 2; ++n) acc[a][b][m][n] = (f32x4){0.f, 0.f, 0.f, 0.f};
    bf16x8 At[4][2], B0[2][2], B1[2][2];
    const char* cA = (const char*)g.A + (size_t)cur.pm * tstepA; const char* cB = (const char*)g.Bt + (size_t)cur.pn * tstep;
    S.a_ready(cur);
    if constexpr (SP2) {
        PG8_STAGE(PG8_SB(0, 0), cB, voffB); PG8_STAGE(PG8_SB(0, 1), cB + hstep, voffB); PG8_STAGE(PG8_SA(0, 0), cA, voffA); PG8_STAGE(PG8_SA(0, 1), cA + hstepA, voffA);
        if (wr == 1) PG8_BAR;
        PG8_WAIT_V(2); PG8_BAR;
        PG8_STAGE(PG8_SB(1, 0), cB + kstep, voffB); PG8_STAGE(PG8_SA(1, 0), cA + kstep, voffA); PG8_STAGE(PG8_SB(1, 1), cB + hstep + kstep, voffB);
        PG8_WAIT_V(6); PG8_BAR;
    } else {
        PG8_STAGE(PG8_SB(0, 0), cB, voffB); PG8_STAGE(PG8_SA(0, 0), cA, voffA); PG8_STAGE(PG8_SB(0, 1), cB + hstep, voffB); PG8_STAGE(PG8_SA(0, 1), cA + hstepA, voffA);
        if (wr == 1) PG8_BAR;
        PG8_WAIT_V(4); PG8_BAR;
        PG8_STAGE(PG8_SB(1, 0), cB + kstep, voffB); PG8_STAGE(PG8_SA(1, 0), cA + kstep, voffA); PG8_STAGE(PG8_SB(1, 1), cB + hstep + kstep, voffB);
        PG8_WAIT_V(6); PG8_BAR;
    }
    for (;;) {
        const bool has_next = S.next(ui + 1, nxt);
        const char* nA = has_next ? (const char*)g.A + (size_t)nxt.pm * tstepA : cA; const char* nB = has_next ? (const char*)g.Bt + (size_t)nxt.pn * tstep : cB;
        if constexpr (Epi::HAS_MID) {
        for (int t = 0; t < nth; t += 2) {
            const bool last = (t == nt - 2);
            const char* a1 = cA + (t + 1 >= nth ? a2off : 0) + (size_t)(t + 1) * kstep;
            const char* a2 = last ? nA : cA + (t + 2 >= nth ? a2off : 0) + (size_t)(t + 2) * kstep; const char* b2 = last ? nB : cB + (size_t)(t + 2) * kstep;
            const char* a3 = a2 + kstep; const char* b3 = b2 + kstep;
            if (last && has_next) S.a_ready(nxt);
            if constexpr (SP2) {
            PG8_LDB(B0, 0, 0); PG8_LDB(B1, 0, 1); PG8_SCHED; PG8_LDA(At, 0, 0); PG8_STAGE(PG8_SA(1, 1), a1 + hstepA, voffA);
            PG8_WAIT_V(8); PG8_WAIT_L(0); PG8_BAR; PG8_MMA(0, 0, At, B0); PG8_MMA(0, 1, At, B1); PG8_BAR; PG8_SCHED;
            PG8_LDA(At, 0, 1); PG8_STAGE(PG8_SB(0, 0), b2, voffB); PG8_STAGE(PG8_SB(0, 1), b2 + hstep, voffB); PG8_STAGE(PG8_SA(0, 0), a2, voffA);
            PG8_WAIT_V(8); PG8_WAIT_L(0); PG8_BAR; PG8_MMA(1, 0, At, B0); PG8_MMA(1, 1, At, B1); PG8_BAR; PG8_SCHED;
            PG8_LDB(B0, 1, 0); PG8_LDB(B1, 1, 1); PG8_SCHED; PG8_LDA(At, 1, 0); PG8_STAGE(PG8_SA(0, 1), a2 + hstepA, voffA);
            PG8_WAIT_V(8); PG8_WAIT_L(0); PG8_BAR; PG8_MMA(0, 0, At, B0); PG8_MMA(0, 1, At, B1); PG8_BAR; PG8_SCHED;
            PG8_LDA(At, 1, 1); PG8_STAGE(PG8_SB(1, 0), b3, voffB); PG8_STAGE(PG8_SB(1, 1), b3 + hstep, voffB); PG8_STAGE(PG8_SA(1, 0), a3, voffA);
            PG8_WAIT_V(8); PG8_WAIT_L(0); PG8_BAR; PG8_MMA(1, 0, At, B0); PG8_MMA(1, 1, At, B1); PG8_BAR; PG8_SCHED;
            } else {
            PG8_LDB(B0, 0, 0); PG8_SCHED; PG8_LDA(At, 0, 0); PG8_STAGE(PG8_SA(1, 1), a1 + hstepA, voffA);
            PG8_WAIT_L(8); PG8_BAR; PG8_WAIT_L(0); PG8_MMA(0, 0, At, B0); PG8_BAR; PG8_SCHED;
            PG8_LDB(B1, 0, 1); PG8_STAGE(PG8_SB(0, 0), b2, voffB);
            PG8_BAR; PG8_WAIT_L(0); PG8_MMA(0, 1, At, B1); PG8_BAR;
            PG8_LDA(At, 0, 1); PG8_STAGE(PG8_SA(0, 0), a2, voffA);
            PG8_BAR; PG8_WAIT_L(0); PG8_MMA(1, 0, At, B0); PG8_BAR; PG8_SCHED;
            PG8_STAGE(PG8_SB(0, 1), b2 + hstep, voffB);
            PG8_WAIT_V(6); PG8_BAR; PG8_MMA(1, 1, At, B1); PG8_BAR;
            PG8_LDB(B0, 1, 0); PG8_SCHED; PG8_LDA(At, 1, 0); PG8_STAGE(PG8_SA(0, 1), a2 + hstepA, voffA);
            PG8_WAIT_L(8); PG8_BAR; PG8_WAIT_L(0); PG8_MMA(0, 0, At, B0); PG8_BAR; PG8_SCHED;
            PG8_LDB(B1, 1, 1); PG8_STAGE(PG8_SB(1, 0), b3, voffB);
            PG8_BAR; PG8_WAIT_L(0); PG8_MMA(0, 1, At, B1); PG8_BAR;
            PG8_LDA(At, 1, 1); PG8_STAGE(PG8_SA(1, 0), a3, voffA);
            PG8_BAR; PG8_WAIT_L(0); PG8_MMA(1, 0, At, B0); PG8_BAR; PG8_SCHED;
            PG8_STAGE(PG8_SB(1, 1), b3 + hstep, voffB);
            PG8_WAIT_V(6); PG8_BAR; PG8_MMA(1, 1, At, B1); PG8_BAR;
            }
        }
        E.mid(acc, cur, wr, wc, fr, fq);
        for (int t = nth; t < nt; t += 2) {
            const bool last = (t == nt - 2);
            const char* a1 = cA + (t + 1 >= nth ? a2off : 0) + (size_t)(t + 1) * kstep;
            const char* a2 = last ? nA : cA + (t + 2 >= nth ? a2off : 0) + (size_t)(t + 2) * kstep; const char* b2 = last ? nB : cB + (size_t)(t + 2) * kstep;
            const char* a3 = a2 + kstep; const char* b3 = b2 + kstep;
            if (last && has_next) S.a_ready(nxt);
            if constexpr (SP2) {
            PG8_LDB(B0, 0, 0); PG8_LDB(B1, 0, 1); PG8_SCHED; PG8_LDA(At, 0, 0); PG8_STAGE(PG8_SA(1, 1), a1 + hstepA, voffA);
            PG8_WAIT_V(8); PG8_WAIT_L(0); PG8_BAR; PG8_MMA(0, 0, At, B0); PG8_MMA(0, 1, At, B1); PG8_BAR; PG8_SCHED;
            PG8_LDA(At, 0, 1); PG8_STAGE(PG8_SB(0, 0), b2, voffB); PG8_STAGE(PG8_SB(0, 1), b2 + hstep, voffB); PG8_STAGE(PG8_SA(0, 0), a2, voffA);
            PG8_WAIT_V(8); PG8_WAIT_L(0); PG8_BAR; PG8_MMA(1, 0, At, B0); PG8_MMA(1, 1, At, B1); PG8_BAR; PG8_SCHED;
            PG8_LDB(B0, 1, 0); PG8_LDB(B1, 1, 1); PG8_SCHED; PG8_LDA(At, 1, 0); PG8_STAGE(PG8_SA(0, 1), a2 + hstepA, voffA);
            PG8_WAIT_V(8); PG8_WAIT_L(0); PG8_BAR; PG8_MMA(0, 0, At, B0); PG8_MMA(0, 1, At, B1); PG8_BAR; PG8_SCHED;
            PG8_LDA(At, 1, 1); PG8_STAGE(PG8_SB(1, 0), b3, voffB); PG8_STAGE(PG8_SB(1, 1), b3 + hstep, voffB); PG8_STAGE(PG8_SA(1, 0), a3, voffA);
            PG8_WAIT_V(8); PG8_WAIT_L(0); PG8_BAR; PG8_MMA(1, 0, At, B0); PG8_MMA(1, 1, At, B1); PG8_BAR; PG8_SCHED;
            } else {
            PG8_LDB(B0, 0, 0); PG8_SCHED; PG8_LDA(At, 0, 0); PG8_STAGE(PG8_SA(1, 1), a1 + hstepA, voffA);
            PG8_WAIT_L(8); PG8_BAR; PG8_WAIT_L(0); PG8_MMA(0, 0, At, B0); PG8_BAR; PG8_SCHED;
            PG8_LDB(B1, 0, 1); PG8_STAGE(PG8_SB(0, 0), b2, voffB);
            PG8_BAR; PG8_WAIT_L(0); PG8_MMA(0, 1, At, B1); PG8_BAR;
            PG8_LDA(At, 0, 1); PG8_STAGE(PG8_SA(0, 0), a2, voffA);
            PG8_BAR; PG8_WAIT_L(0); PG8_MMA(1, 0, At, B0); PG8_BAR; PG8_SCHED;
            PG8_STAGE(PG8_SB(0, 1), b2 + hstep, voffB);
            PG8_WAIT_V(6); PG8_BAR; PG8_MMA(1, 1, At, B1); PG8_BAR;
            PG8_LDB(B0, 1, 0); PG8_SCHED; PG8_LDA(At, 1, 0); PG8_STAGE(PG8_SA(0, 1), a2 + hstepA, voffA);
            PG8_WAIT_L(8); PG8_BAR; PG8_WAIT_L(0); PG8_MMA(0, 0, At, B0); PG8_BAR; PG8_SCHED;
            PG8_LDB(B1, 1, 1); PG8_STAGE(PG8_SB(1, 0), b3, voffB);
            PG8_BAR; PG8_WAIT_L(0); PG8_MMA(0, 1, At, B1); PG8_BAR;
            PG8_LDA(At, 1, 1); PG8_STAGE(PG8_SA(1, 0), a3, voffA);
            PG8_BAR; PG8_WAIT_L(0); PG8_MMA(1, 0, At, B0); PG8_BAR; PG8_SCHED;
            PG8_STAGE(PG8_SB(1, 1), b3 + hstep, voffB);
            PG8_WAIT_V(6); PG8_BAR; PG8_MMA(1, 1, At, B1); PG8_BAR;
            }
        }
        } else {
        for (int t = 0; t < nt; t += 2) {
            const bool last = (t == nt - 2);
            const char* a1 = cA + (t + 1 >= nth ? a2off : 0) + (size_t)(t + 1) * kstep;
            const char* a2 = last ? nA : cA + (t + 2 >= nth ? a2off : 0) + (size_t)(t + 2) * kstep; const char* b2 = last ? nB : cB + (size_t)(t + 2) * kstep;
            const char* a3 = a2 + kstep; const char* b3 = b2 + kstep;
            if (last && has_next) S.a_ready(nxt);
            if constexpr (SP2) {
            PG8_LDB(B0, 0, 0); PG8_LDB(B1, 0, 1); PG8_SCHED; PG8_LDA(At, 0, 0); PG8_STAGE(PG8_SA(1, 1), a1 + hstepA, voffA);
            PG8_WAIT_V(8); PG8_WAIT_L(0); PG8_BAR; PG8_MMA(0, 0, At, B0); PG8_MMA(0, 1, At, B1); PG8_BAR; PG8_SCHED;
            PG8_LDA(At, 0, 1); PG8_STAGE(PG8_SB(0, 0), b2, voffB); PG8_STAGE(PG8_SB(0, 1), b2 + hstep, voffB); PG8_STAGE(PG8_SA(0, 0), a2, voffA);
            PG8_WAIT_V(8); PG8_WAIT_L(0); PG8_BAR; PG8_MMA(1, 0, At, B0); PG8_MMA(1, 1, At, B1); PG8_BAR; PG8_SCHED;
            PG8_LDB(B0, 1, 0); PG8_LDB(B1, 1, 1); PG8_SCHED; PG8_LDA(At, 1, 0); PG8_STAGE(PG8_SA(0, 1), a2 + hstepA, voffA);
            PG8_WAIT_V(8); PG8_WAIT_L(0); PG8_BAR; PG8_MMA(0, 0, At, B0); PG8_MMA(0, 1, At, B1); PG8_BAR; PG8_SCHED;
            PG8_LDA(At, 1, 1); PG8_STAGE(PG8_SB(1, 0), b3, voffB); PG8_STAGE(PG8_SB(1, 1), b3 + hstep, voffB); PG8_STAGE(PG8_SA(1, 0), a3, voffA);
            PG8_WAIT_V(8); PG8_WAIT_L(0); PG8_BAR; PG8_MMA(1, 0, At, B0); PG8_MMA(1, 1, At, B1); PG8_BAR; PG8_SCHED;
            } else {
            PG8_LDB(B0, 0, 0); PG8_SCHED; PG8_LDA(At, 0, 0); PG8_STAGE(PG8_SA(1, 1), a1 + hstepA, voffA);
            PG8_WAIT_L(8); PG8_BAR; PG8_WAIT_L(0); PG8_MMA(0, 0, At, B0); PG8_BAR; PG8_SCHED;
            PG8_LDB(B1, 0, 1); PG8_STAGE(PG8_SB(0, 0), b2, voffB);
            PG8_BAR; PG8_WAIT_L(0); PG8_MMA(0, 1, At, B1); PG8_BAR;
            PG8_LDA(At, 0, 1); PG8_STAGE(PG8_SA(0, 0), a2, voffA);
            PG8_BAR; PG8_WAIT_L(0); PG8_MMA(1, 0, At, B0); PG8_BAR; PG8_SCHED;
            PG8_STAGE(PG8_SB(0, 1), b2 + hstep, voffB);
            PG8_WAIT_V(6); PG8_BAR; PG8_MMA(1, 1, At, B1); PG8_BAR;
            PG8_LDB(B0, 1, 0); PG8_SCHED; PG8_LDA(At, 1, 0); PG8_STAGE(PG8_SA(0, 1), a2 + hstepA, voffA);
            PG8_WAIT_L(8); PG8_BAR; PG8_WAIT_L(0); PG8_MMA(0, 0, At, B0); PG8_BAR; PG8_SCHED;
            PG8_LDB(B1, 1, 1); PG8_STAGE(PG8_SB(1, 0), b3, voffB);
            PG8_BAR; PG8_WAIT_L(0); PG8_MMA(0, 1, At, B1); PG8_BAR;
            PG8_LDA(At, 1, 1); PG8_STAGE(PG8_SA(1, 0), a3, voffA);
            PG8_BAR; PG8_WAIT_L(0); PG8_MMA(1, 0, At, B0); PG8_BAR; PG8_SCHED;
            PG8_STAGE(PG8_SB(1, 1), b3 + hstep, voffB);
            PG8_WAIT_V(6); PG8_BAR; PG8_MMA(1, 1, At, B1); PG8_BAR;
            }
        }
        }
        if constexpr (ALIGN_EPI) { if (wr == 0) PG8_BAR; }
        if constexpr (!Epi::AFTER_DRAIN) { E(acc, cur, wr, wc, fr, fq); S.done(cur); }
        if (!has_next) break;
#pragma unroll
        for (int a = 0; a < 2; ++a)
#pragma unroll
            for (int b = 0; b < 2; ++b)
#pragma unroll
                for (int m = 0; m < 4; ++m)
#pragma unroll
                    for (int n = 0; n < 2; ++n) acc[a][b][m][n] = (f32x4){0.f, 0.f, 0.f, 0.f};
        cur = nxt; cA = nA; cB = nB; ++ui;
        if constexpr (ALIGN_EPI) { if (wr == 1) PG8_BAR; }
    }
    PG8_WAIT_V(0);
    if constexpr (!ALIGN_EPI) { if (wr == 0) PG8_BAR; }
    PG8_BAR;
    if constexpr (Epi::AFTER_DRAIN) { E.fused(acc, cur, wr, wc, fr, fq, lds, wid, lane); S.done(cur); }
#undef PG8_SA
#undef PG8_SB
#undef PG8_STAGE
#undef PG8_LDA
#undef PG8_LDB
#undef PG8_MMA
#undef PG8_WAIT_V
#undef PG8_WAIT_L
#undef PG8_BAR
#undef PG8_SCHED
}

typedef int i32x4 __attribute__((ext_vector_type(4)));
template <class Epi, class Sched, bool ALIGN_EPI = false, bool SP2 = false>
__device__ __forceinline__ void gemm_phase_i8(PG8_LAS unsigned char* lds, const Gemm g, const Sched& S, const Epi& E) {
    const int tid = threadIdx.x, wid = __builtin_amdgcn_readfirstlane(tid >> 6), lane = tid & 63, wr = wid >> 2, wc = wid & 3, fr = lane & 15, fq = lane >> 4;
    const int ldb = g.ldb ? g.ldb : g.lda;
    const int K = g.K, nt = K / 128;
    unsigned voffA[2], voffB[2];
#pragma unroll
    for (int i = 0; i < 2; ++i) { int R, C; stage_rc(tid * 16 + i * 8192, R, C); const int Rb = Epi::PERM ? ((R & ~31) + perm32(R & 31)) : R;
        voffA[i] = (unsigned)(R * g.lda + C * 2); voffB[i] = (unsigned)(Rb * ldb + C * 2); }
    size_t kstep = (size_t)(BK * 2);
#ifdef PROBE_KSTEP0
    if constexpr (Epi::HAS_SKIP) { if (E.skip) kstep = 0; }
#endif
    const size_t hstep = (size_t)HALF * ldb, hstepA = (size_t)HALF * g.lda;
    const size_t tstep = 2 * hstep, tstepA = 2 * hstepA;
    const unsigned ldsw = (unsigned)wid * 1024u;
    const int aoff = lds_byte(wr * 64 + fr, fq * 8), boff = lds_byte(wc * 32 + fr, fq * 8);
#define PG8_SA(b, h) (((b) * 2 + (h)) * HTB)
#define PG8_SB(b, h) ((4 + (b) * 2 + (h)) * HTB)
#define PG8_STAGE(bufoff, gbase, voff) do { _Pragma("unroll") for (int _i = 0; _i < 2; ++_i) \
        __builtin_amdgcn_global_load_lds((const unsigned*)((const char*)(gbase) + (voff)[_i]), (PG8_LAS unsigned*)(lds + (bufoff) + ldsw + _i * 8192), 16, 0, 0); } while (0)
#define PG8_LDA(dst, b, h) do { _Pragma("unroll") for (int m = 0; m < 4; ++m) _Pragma("unroll") for (int k = 0; k < 2; ++k) dst[m][k] = *(const PG8_LAS i32x4*)(lds + PG8_SA(b, h) + aoff + m * 2048 + k * 1024); } while (0)
#define PG8_LDB(dst, b, h) do { _Pragma("unroll") for (int n = 0; n < 2; ++n) _Pragma("unroll") for (int k = 0; k < 2; ++k) dst[n][k] = *(const PG8_LAS i32x4*)(lds + PG8_SB(b, h) + boff + n * 2048 + k * 1024); } while (0)
#define PG8_MMA(ai, bj, At, Bt) do { __builtin_amdgcn_s_setprio(1); _Pragma("unroll") for (int m = 0; m < 4; ++m) _Pragma("unroll") for (int n = 0; n < 2; ++n) _Pragma("unroll") for (int k = 0; k < 2; ++k) \
        acc[ai][bj][m][n] = __builtin_amdgcn_mfma_i32_16x16x64_i8(Bt[n][k], At[m][k], acc[ai][bj][m][n], 0, 0, 0); __builtin_amdgcn_s_setprio(0); } while (0)
#define PG8_WAIT_V(n) asm volatile("s_waitcnt vmcnt(" #n ")" ::: "memory")
#define PG8_WAIT_L(n) asm volatile("s_waitcnt lgkmcnt(" #n ")" ::: "memory")
#define PG8_BAR __builtin_amdgcn_s_barrier()
#define PG8_SCHED __builtin_amdgcn_sched_barrier(0)
    Unit cur, nxt; int ui = 0;
    if (!S.next(0, cur)) return;
    i32x4 acc[2][2][4][2];
#pragma unroll
    for (int a = 0; a < 2; ++a)
#pragma unroll
        for (int b = 0; b < 2; ++b)
#pragma unroll
            for (int m = 0; m < 4; ++m)
#pragma unroll
                for (int n = 0; n < 2; ++n) acc[a][b][m][n] = (i32x4){0, 0, 0, 0};
    i32x4 At[4][2], B0[2][2], B1[2][2];
    const char* cA = (const char*)g.A + (size_t)cur.pm * tstepA; const char* cB = (const char*)g.Bt + (size_t)cur.pn * tstep;
    S.a_ready(cur);
    if constexpr (SP2) {
        PG8_STAGE(PG8_SB(0, 0), cB, voffB); PG8_STAGE(PG8_SB(0, 1), cB + hstep, voffB); PG8_STAGE(PG8_SA(0, 0), cA, voffA); PG8_STAGE(PG8_SA(0, 1), cA + hstepA, voffA);
        if (wr == 1) PG8_BAR;
        PG8_WAIT_V(2); PG8_BAR;
        PG8_STAGE(PG8_SB(1, 0), cB + kstep, voffB); PG8_STAGE(PG8_SA(1, 0), cA + kstep, voffA); PG8_STAGE(PG8_SB(1, 1), cB + hstep + kstep, voffB);
        PG8_WAIT_V(6); PG8_BAR;
    } else {
        PG8_STAGE(PG8_SB(0, 0), cB, voffB); PG8_STAGE(PG8_SA(0, 0), cA, voffA); PG8_STAGE(PG8_SB(0, 1), cB + hstep, voffB); PG8_STAGE(PG8_SA(0, 1), cA + hstepA, voffA);
        if (wr == 1) PG8_BAR;
        PG8_WAIT_V(4); PG8_BAR;
        PG8_STAGE(PG8_SB(1, 0), cB + kstep, voffB); PG8_STAGE(PG8_SA(1, 0), cA + kstep, voffA); PG8_STAGE(PG8_SB(1, 1), cB + hstep + kstep, voffB);
        PG8_WAIT_V(6); PG8_BAR;
    }
    for (;;) {
        const bool has_next = S.next(ui + 1, nxt);
        const char* nA = has_next ? (const char*)g.A + (size_t)nxt.pm * tstepA : cA; const char* nB = has_next ? (const char*)g.Bt + (size_t)nxt.pn * tstep : cB;
        auto kloop = [&](const int tb, const int te) __attribute__((always_inline)) { for (int t = tb; t < te; t += 2) {
            const bool last = (t == nt - 2);
            const char* a1 = cA + (size_t)(t + 1) * kstep;
            const char* a2 = last ? nA : cA + (size_t)(t + 2) * kstep; const char* b2 = last ? nB : cB + (size_t)(t + 2) * kstep;
            const char* a3 = a2 + kstep; const char* b3 = b2 + kstep;
            if (last && has_next) S.a_ready(nxt);
            if constexpr (SP2) {
            PG8_LDB(B0, 0, 0); PG8_LDB(B1, 0, 1); PG8_SCHED; PG8_LDA(At, 0, 0); PG8_STAGE(PG8_SA(1, 1), a1 + hstepA, voffA);
            PG8_WAIT_V(8); PG8_WAIT_L(0); PG8_BAR; PG8_MMA(0, 0, At, B0); PG8_MMA(0, 1, At, B1); PG8_BAR; PG8_SCHED;
            PG8_LDA(At, 0, 1); PG8_STAGE(PG8_SB(0, 0), b2, voffB); PG8_STAGE(PG8_SB(0, 1), b2 + hstep, voffB); PG8_STAGE(PG8_SA(0, 0), a2, voffA);
            PG8_WAIT_V(8); PG8_WAIT_L(0); PG8_BAR; PG8_MMA(1, 0, At, B0); PG8_MMA(1, 1, At, B1); PG8_BAR; PG8_SCHED;
            PG8_LDB(B0, 1, 0); PG8_LDB(B1, 1, 1); PG8_SCHED; PG8_LDA(At, 1, 0); PG8_STAGE(PG8_SA(0, 1), a2 + hstepA, voffA);
            PG8_WAIT_V(8); PG8_WAIT_L(0); PG8_BAR; PG8_MMA(0, 0, At, B0); PG8_MMA(0, 1, At, B1); PG8_BAR; PG8_SCHED;
            PG8_LDA(At, 1, 1); PG8_STAGE(PG8_SB(1, 0), b3, voffB); PG8_STAGE(PG8_SB(1, 1), b3 + hstep, voffB); PG8_STAGE(PG8_SA(1, 0), a3, voffA);
            PG8_WAIT_V(8); PG8_WAIT_L(0); PG8_BAR; PG8_MMA(1, 0, At, B0); PG8_MMA(1, 1, At, B1); PG8_BAR; PG8_SCHED;
            } else {
            PG8_LDB(B0, 0, 0); PG8_SCHED; PG8_LDA(At, 0, 0); PG8_STAGE(PG8_SA(1, 1), a1 + hstepA, voffA);
            PG8_WAIT_L(8); PG8_BAR; PG8_WAIT_L(0); PG8_MMA(0, 0, At, B0); PG8_BAR; PG8_SCHED;
            PG8_LDB(B1, 0, 1); PG8_STAGE(PG8_SB(0, 0), b2, voffB);
            PG8_BAR; PG8_WAIT_L(0); PG8_MMA(0, 1, At, B1); PG8_BAR;
            PG8_LDA(At, 0, 1); PG8_STAGE(PG8_SA(0, 0), a2, voffA);
            PG8_BAR; PG8_WAIT_L(0); PG8_MMA(1, 0, At, B0); PG8_BAR; PG8_SCHED;
            PG8_STAGE(PG8_SB(0, 1), b2 + hstep, voffB);
            PG8_WAIT_V(6); PG8_BAR; PG8_MMA(1, 1, At, B1); PG8_BAR;
            PG8_LDB(B0, 1, 0); PG8_SCHED; PG8_LDA(At, 1, 0); PG8_STAGE(PG8_SA(0, 1), a2 + hstepA, voffA);
            PG8_WAIT_L(8); PG8_BAR; PG8_WAIT_L(0); PG8_MMA(0, 0, At, B0); PG8_BAR; PG8_SCHED;
            PG8_LDB(B1, 1, 1); PG8_STAGE(PG8_SB(1, 0), b3, voffB);
            PG8_BAR; PG8_WAIT_L(0); PG8_MMA(0, 1, At, B1); PG8_BAR;
            PG8_LDA(At, 1, 1); PG8_STAGE(PG8_SA(1, 0), a3, voffA);
            PG8_BAR; PG8_WAIT_L(0); PG8_MMA(1, 0, At, B0); PG8_BAR; PG8_SCHED;
            PG8_STAGE(PG8_SB(1, 1), b3 + hstep, voffB);
            PG8_WAIT_V(6); PG8_BAR; PG8_MMA(1, 1, At, B1); PG8_BAR;
            }
        } };
        if constexpr (Epi::HAS_MID) { kloop(0, nt >> 1); E.mid(acc, cur, wr, wc, fr, fq); kloop(nt >> 1, nt); } else kloop(0, nt);
        if constexpr (ALIGN_EPI) { if (wr == 0) PG8_BAR; }
        if constexpr (!Epi::AFTER_DRAIN) { E(acc, cur, wr, wc, fr, fq); S.done(cur); }
        if (!has_next) break;
#pragma unroll
        for (int a = 0; a < 2; ++a)
#pragma unroll
            for (int b = 0; b < 2; ++b)
#pragma unroll
                for (int m = 0; m < 4; ++m)
#pragma unroll
                    for (int n = 0; n < 2; ++n) acc[a][b][m][n] = (i32x4){0, 0, 0, 0};
        cur = nxt; cA = nA; cB = nB; ++ui;
        if constexpr (ALIGN_EPI) { if (wr == 1) PG8_BAR; }
    }
    PG8_WAIT_V(0);
    if constexpr (!ALIGN_EPI) { if (wr == 0) PG8_BAR; }
    PG8_BAR;
    if constexpr (Epi::AFTER_DRAIN) { E.fused(acc, cur, wr, wc, fr, fq, lds, wid, lane); S.done(cur); }
#undef PG8_SA
#undef PG8_SB
#undef PG8_STAGE
#undef PG8_LDA
#undef PG8_LDB
#undef PG8_MMA
#undef PG8_WAIT_V
#undef PG8_WAIT_L
#undef PG8_BAR
#undef PG8_SCHED
}
}

struct Ctx {
    const float *x, *p, *g_mix, *w_in, *ln_g, *ln_b, *sgu_w, *sgu_b, *w_ba, *w_bs, *w_out, *g_ffn, *w_pq, *subk, *dn, *up, *g_ple, *w_pp, *w_pg, *g_fin;
    float* out;
    bf16 *WinT, *WbaT, *WbsT, *WoutT, *WqT, *WgT, *WprojT, *pb, *skb, *xn, *proj, *vT, *yatt, *ysgu, *merged, *h1n, *qp, *h2n, *gtmp, *h2b, *swb;
    float *kmean, *kmp, *sst, *egate, *sdn, *sup, *lse, *xs, *h2s, *wcs, *gcs, *qcs, *h1s, *rss, *ocs, *ms; int *eid, *sel; unsigned char *xq8, *WinT8, *WgT8, *WqT8, *h2q8, *h1q8, *WoutT8, *mq8; unsigned char *dn8, *up8, *xq8g; float* sxg; int* xsg; int* hidb; unsigned char* WcatT8; float *bcs, *bs;
    int G, bid, tid, lane, wave;
    int grp, pm, kq;
};

DEV int xcd_wave(const Ctx& c) { return (c.G & 7) ? c.bid * 8 + c.wave : (c.bid & 7) * (c.G) + (c.bid >> 3) * 8 + c.wave; }
DEV void xcd_rows(const Ctx& c, int& m0, int& step, int& mend) {
    const int NGW = c.G * 8;
    if (c.grp) { m0 = 256 * c.pm + 64 * c.kq + 8 * c.wave; step = 1; mend = m0 + 8; }
    else if (c.G & 7) { m0 = c.bid * 8 + c.wave; step = NGW; mend = T; }
    else { const int x = c.bid & 7, j = (c.bid >> 3) * 8 + c.wave; step = NGW / 8; m0 = x * (T / 8) + j; mend = (x + 1) * (T / 8); }
}
DEV void transpose_item(const float* W, int K, int N, bf16* WT, const float* gain, LAS float* scr, int item, int lane, int ldt = 0) {
    if (ldt == 0) ldt = K;
    const int nblk = N / 32, kb = item / nblk, nb = item % nblk, k0 = 64 * kb, n0 = 32 * nb;
#pragma unroll
    for (int i = 0; i < 8; ++i) { const int kk = 8 * i + (lane >> 3), cc = (lane & 7) * 4; const float gsc = gain ? gain[k0 + kk] : 1.0f;
        const f32x4 w = *(const f32x4*)(W + (size_t)(k0 + kk) * N + n0 + cc); LAS float* sp = scr + kk * 33 + cc; sp[0] = w.x * gsc; sp[1] = w.y * gsc; sp[2] = w.z * gsc; sp[3] = w.w * gsc; }
    asm volatile("s_waitcnt lgkmcnt(0)" ::: "memory");
    const int c = lane & 7;
#pragma unroll
    for (int j = 0; j < 4; ++j) { const int n = (lane >> 3) + 8 * j; const LAS float* s = scr + (8 * c) * 33 + n;
        v4u o; o.x = pkbf(s[0 * 33], s[1 * 33]); o.y = pkbf(s[2 * 33], s[3 * 33]); o.z = pkbf(s[4 * 33], s[5 * 33]); o.w = pkbf(s[6 * 33], s[7 * 33]);
        *(v4u*)(WT + (size_t)(n0 + n) * ldt + k0 + 8 * c) = o; }
    asm volatile("s_waitcnt lgkmcnt(0)" ::: "memory");
}
DEV void row_rms_bf16(const float* xrow, bf16* orow, int lane) {
    const f32x4* xr = (const f32x4*)xrow + lane;
    f32x4 v[8]; float s = 0.f;
#pragma unroll
    for (int j = 0; j < 8; ++j) { v[j] = xr[64 * j]; s += (v[j].x * v[j].x + v[j].y * v[j].y) + (v[j].z * v[j].z + v[j].w * v[j].w); }
    const float r = 1.0f / sqrtf(wave_sum(s) * (1.0f / D) + EPS);
    v2u* o8 = (v2u*)orow + lane;
#pragma unroll
    for (int j = 0; j < 8; ++j) { v2u w; w.x = pkbf(v[j].x * r, v[j].y * r); w.y = pkbf(v[j].z * r, v[j].w * r); o8[64 * j] = w; }
}
DEV void cvt_items(const float* src, bf16* dst, size_t n8, const float* gain, size_t gtid, size_t gthreads) {
    for (size_t i = gtid; i < n8; i += gthreads) {
        const f32x4 a = ((const f32x4*)src)[2 * i], b = ((const f32x4*)src)[2 * i + 1];
        f32x4 ga = {1.f, 1.f, 1.f, 1.f}, gb = ga;
        if (gain) { const size_t c = (i * 8) % D; ga = *(const f32x4*)(gain + c); gb = *(const f32x4*)(gain + c + 4); }
        v4u o; o.x = pkbf(a.x * ga.x, a.y * ga.y); o.y = pkbf(a.z * ga.z, a.w * ga.w); o.z = pkbf(b.x * gb.x, b.y * gb.y); o.w = pkbf(b.z * gb.z, b.w * gb.w);
        ((v4u*)dst)[i] = o;
    }
}
DEV float wave_max(float v);
DEV unsigned q4(float a, float b, float c_, float d, float inv, int off);
DEV void colmax_item(const float* W, int N, const float* gain, unsigned* cam, int item, int lane) {
    const int nblk = N / 256, kb = item / nblk, nb = item % nblk, k0 = 64 * kb, n0 = 256 * nb + 4 * lane;
    f32x4 am = {0.f, 0.f, 0.f, 0.f};
#pragma unroll 8
    for (int kk = 0; kk < 64; ++kk) { const f32x4 w = *(const f32x4*)(W + (size_t)(k0 + kk) * N + n0); const float g = gain ? gain[k0 + kk] : 1.0f;
        am.x = fmaxf(am.x, fabsf(w.x * g)); am.y = fmaxf(am.y, fabsf(w.y * g)); am.z = fmaxf(am.z, fabsf(w.z * g)); am.w = fmaxf(am.w, fabsf(w.w * g)); }
    atomicMax(cam + n0, __float_as_uint(am.x)); atomicMax(cam + n0 + 1, __float_as_uint(am.y)); atomicMax(cam + n0 + 2, __float_as_uint(am.z)); atomicMax(cam + n0 + 3, __float_as_uint(am.w));
}
DEV void colmax_run(const float* W, int N, const float* gain, unsigned* cam, int nb, int k0, int k1, int lane) {
    const int n0 = 256 * nb + 4 * lane;
    f32x4 am = {0.f, 0.f, 0.f, 0.f};
#pragma unroll 8
    for (int kk = k0; kk < k1; ++kk) { const f32x4 w = *(const f32x4*)(W + (size_t)kk * N + n0); const float g = gain ? gain[kk] : 1.0f;
        am.x = fmaxf(am.x, fabsf(w.x * g)); am.y = fmaxf(am.y, fabsf(w.y * g)); am.z = fmaxf(am.z, fabsf(w.z * g)); am.w = fmaxf(am.w, fabsf(w.w * g)); }
    atomicMax(cam + n0, __float_as_uint(am.x)); atomicMax(cam + n0 + 1, __float_as_uint(am.y)); atomicMax(cam + n0 + 2, __float_as_uint(am.z)); atomicMax(cam + n0 + 3, __float_as_uint(am.w));
}
DEV void transpose_item_i8(const float* W, int K, int N, unsigned char* WT8, const float* gain, const unsigned* cam, LAS float* scr, int item, int lane, int pitch = 0) {
    if (pitch == 0) pitch = K;
    const int nblk = N / 32, kb = item / nblk, nb = item % nblk, k0 = 64 * kb, n0 = 32 * nb;
#pragma unroll
    for (int i = 0; i < 8; ++i) { const int kk = 8 * i + (lane >> 3), cc = (lane & 7) * 4; const float gsc = gain ? gain[k0 + kk] : 1.0f;
        const f32x4 w = *(const f32x4*)(W + (size_t)(k0 + kk) * N + n0 + cc); LAS float* sp = scr + kk * 33 + cc; sp[0] = w.x * gsc; sp[1] = w.y * gsc; sp[2] = w.z * gsc; sp[3] = w.w * gsc; }
    asm volatile("s_waitcnt lgkmcnt(0)" ::: "memory");
    const int cq = lane & 3;
#pragma unroll
    for (int j = 0; j < 2; ++j) { const int n = (lane >> 2) + 16 * j; const LAS float* s = scr + (16 * cq) * 33 + n;
        const float am = __uint_as_float(cam[n0 + n]); const float inv = am > 0.f ? 127.0f / am : 0.f;
        v4u o; o.x = q4(s[0 * 33], s[1 * 33], s[2 * 33], s[3 * 33], inv, 0); o.y = q4(s[4 * 33], s[5 * 33], s[6 * 33], s[7 * 33], inv, 0);
        o.z = q4(s[8 * 33], s[9 * 33], s[10 * 33], s[11 * 33], inv, 0); o.w = q4(s[12 * 33], s[13 * 33], s[14 * 33], s[15 * 33], inv, 0);
        *(v4u*)(WT8 + (size_t)(n0 + n) * pitch + k0 + 16 * cq) = o; }
    asm volatile("s_waitcnt lgkmcnt(0)" ::: "memory");
}
DEV void row_rms_i8(const float* xrow, unsigned char* orow, float* sc, int lane) {
    const f32x4* xr = (const f32x4*)xrow + lane;
    f32x4 v[8]; float s = 0.f, am = 0.f;
#pragma unroll
    for (int j = 0; j < 8; ++j) { v[j] = xr[64 * j]; s += (v[j].x * v[j].x + v[j].y * v[j].y) + (v[j].z * v[j].z + v[j].w * v[j].w);
        am = fmaxf(am, fmaxf(fmaxf(fabsf(v[j].x), fabsf(v[j].y)), fmaxf(fabsf(v[j].z), fabsf(v[j].w)))); }
    const float r = 1.0f / sqrtf(wave_sum(s) * (1.0f / D) + EPS);
    am = wave_max(am);
    const float inv = am > 0.f ? 127.0f / am : 0.f;
    unsigned* o4 = (unsigned*)orow + lane;
#pragma unroll
    for (int j = 0; j < 8; ++j) o4[64 * j] = q4(v[j].x, v[j].y, v[j].z, v[j].w, inv, 0);
    if (lane == 0) *sc = am * (1.0f / 127.0f) * r;
}
DEV void phase_prologue2(const Ctx& c, LAS unsigned char* lds, const unsigned* cam, const bool late = false) {
    LAS float* scr = (LAS float*)(lds + c.wave * 16384);
    const int gw = c.bid * 8 + c.wave, NGW = c.G * 8;
    constexpr int I_IN = (D / 64) * (INW / 32), I_SQ = (D / 64) * (D / 32);
    constexpr int SL_O = 1, SL_Q = 1 + OI8, SL_B = 1 + OI8 + QI8, NSL = 1 + OI8 + QI8 + BI8;
    for (int it = gw + (late ? I_IN : 0); it < (late ? I_IN + NSL * I_SQ : (LATE_W ? I_IN : I_IN + NSL * I_SQ)); it += NGW) {
        if (it < I_IN) transpose_item_i8(c.w_in, D, INW, c.WinT8, c.g_mix, cam, scr, it, c.lane, XP);
        else { const int sl = (it - I_IN) / I_SQ, r = (it - I_IN) % I_SQ;
            if (sl == 0) transpose_item_i8(c.w_pg, D, D, c.WgT8, c.g_ple, cam + INW, scr, r, c.lane);
            else if (OI8 && sl == SL_O) transpose_item_i8(c.w_out, D, D, c.WoutT8, nullptr, cam + INW + SL_O * D, scr, r, c.lane);
            else if (QI8 && sl == SL_Q) transpose_item_i8(c.w_pq, D, D, c.WqT8, c.g_ffn, cam + INW + SL_Q * D, scr, r, c.lane);
            else if (r < I_SQ / 2) transpose_item_i8(c.w_ba, 1024, D, c.WcatT8, nullptr, cam + INW + SL_B * D, scr, r, c.lane, 2048);
            else transpose_item_i8(c.w_bs, 1024, D, c.WcatT8 + 1024, nullptr, cam + INW + SL_B * D, scr, r - I_SQ / 2, c.lane, 2048); }
    }
    if (!late) for (int i = c.bid * NTHREADS + c.tid; i < INW + NSL * D; i += c.G * NTHREADS) { const float s = __uint_as_float(cam[i]) * (1.0f / 127.0f);
        if (i < INW) c.wcs[i] = s; else { const int sl = (i - INW) / D, r = (i - INW) % D; if (sl == 0) c.gcs[r] = s; else if (OI8 && sl == SL_O) c.ocs[r] = s; else if (QI8 && sl == SL_Q) c.qcs[r] = s; else c.bcs[r] = s; } }
}
DEV void quant_tables(const Ctx& c, int row0, int row1, int step, int first, LAS unsigned char* scr);
DEV void phase_prologue(const Ctx& c, LAS unsigned char* lds, unsigned* cam) {
    LAS float* scr = (LAS float*)(lds + c.wave * 16384);
    const int gw = c.bid * 8 + c.wave, NGW = c.G * 8;
    constexpr int I_IN = (D / 64) * (INW / 32), I_BA = (1024 / 64) * (D / 32), I_SQ = (D / 64) * (D / 32), I_PP = (PLE / 64) * (D / 32);
    constexpr int C_IN = (D / 64) * (INW / 256), C_SQ = (D / 64) * (D / 256);
#if QUANT_IN_PROLOGUE
    quant_tables(c, 0, 2 * NEXP, NGW, gw, lds + c.wave * 2048);
    __syncthreads();
#endif
    constexpr int NITEMS = 2 * I_BA + 2 * I_SQ + I_PP;
    for (int it = gw; it < NITEMS; it += NGW) {
        int r = it;
        if (r < I_BA) { if (!BI8) transpose_item(c.w_ba, 1024, D, c.WbaT, nullptr, scr, r, c.lane, 2048); continue; } r -= I_BA;
        if (r < I_BA) { if (!BI8) transpose_item(c.w_bs, 1024, D, c.WbaT + 1024, nullptr, scr, r, c.lane, 2048); continue; } r -= I_BA;
        if (r < I_SQ) { if (!OI8) transpose_item(c.w_out, D, D, c.WoutT, nullptr, scr, r, c.lane); continue; } r -= I_SQ;
        if (r < I_SQ) { if (!QI8) transpose_item(c.w_pq, D, D, c.WqT, c.g_ffn, scr, r, c.lane); continue; } r -= I_SQ;
        transpose_item(c.w_pp, PLE, D, c.WprojT, nullptr, scr, r, c.lane);
    }
    {
        f32x4 vn[8]; int m = gw;
        if (m < T) { const f32x4* xr = (const f32x4*)(c.x + (size_t)m * D) + c.lane;
#pragma unroll
            for (int j = 0; j < 8; ++j) vn[j] = __builtin_nontemporal_load(xr + 64 * j); }
        for (; m < T; m += NGW) {
            f32x4 v[8];
#pragma unroll
            for (int j = 0; j < 8; ++j) v[j] = vn[j];
            { const int mn = m + NGW < T ? m + NGW : m; const f32x4* xr = (const f32x4*)(c.x + (size_t)mn * D) + c.lane;
#pragma unroll
              for (int j = 0; j < 8; ++j) vn[j] = __builtin_nontemporal_load(xr + 64 * j); }
            float s = 0.f, am = 0.f;
#pragma unroll
            for (int j = 0; j < 8; ++j) { s += (v[j].x * v[j].x + v[j].y * v[j].y) + (v[j].z * v[j].z + v[j].w * v[j].w);
                am = fmaxf(am, fmaxf(fmaxf(fabsf(v[j].x), fabsf(v[j].y)), fmaxf(fabsf(v[j].z), fabsf(v[j].w)))); }
            const float r = 1.0f / sqrtf(wsum_q(s) * (1.0f / D) + EPS);
            am = wmax_q(am);
            const float inv = am > 0.f ? 127.0f / am : 0.f;
            unsigned* o4 = (unsigned*)(c.xq8 + (size_t)m * XP) + c.lane;
#pragma unroll
            for (int j = 0; j < 8; ++j) o4[64 * j] = q4(v[j].x, v[j].y, v[j].z, v[j].w, inv, 0);
            if (c.lane == 0) c.xs[m] = am * (1.0f / 127.0f) * r;
        }
    }
    const size_t gtid = (size_t)c.bid * NTHREADS + c.tid, gthreads = (size_t)c.G * NTHREADS;
    cvt_items(c.p, c.pb, (size_t)T * PLE / 8, nullptr, gtid, gthreads);
    cvt_items(c.subk, c.skb, (size_t)NH * 2 * 128 * 128 / 8, nullptr, gtid, gthreads);
    {
        constexpr int NBI = INW / 256, NBG = D / 256, NSL = 1 + OI8 + QI8 + BI8, SL_O = 1, SL_Q = 1 + OI8, SL_B = 1 + OI8 + QI8, NSEG = (NBI + NSL * NBG) * D; const int per = (NSEG + NGW - 1) / NGW;
        int s0 = per * gw; const int s1 = s0 + per < NSEG ? s0 + per : NSEG;
        while (s0 < s1) { const int blk = s0 / D, k0 = s0 % D, k1 = (k0 + (s1 - s0)) < D ? k0 + (s1 - s0) : D;
            if (blk < NBI) colmax_run(c.w_in, INW, c.g_mix, cam, blk, k0, k1, c.lane);
            else { const int sl = (blk - NBI) / NBG, nb = (blk - NBI) % NBG;
                if (sl == 0) colmax_run(c.w_pg, D, c.g_ple, cam + INW, nb, k0, k1, c.lane);
                else if (OI8 && sl == SL_O) colmax_run(c.w_out, D, nullptr, cam + INW + SL_O * D, nb, k0, k1, c.lane);
                else if (QI8 && sl == SL_Q) colmax_run(c.w_pq, D, c.g_ffn, cam + INW + SL_Q * D, nb, k0, k1, c.lane);
                else { if (k0 < 1024) colmax_run(c.w_ba, D, nullptr, cam + INW + SL_B * D, nb, k0, k1 < 1024 ? k1 : 1024, c.lane);
                       if (k1 > 1024) colmax_run(c.w_bs, D, nullptr, cam + INW + SL_B * D, nb, (k0 > 1024 ? k0 : 1024) - 1024, k1 - 1024, c.lane); } }
            s0 += k1 - k0; }
    }

    for (size_t i = gtid; i < (size_t)8 * 128 * 128 / 8; i += gthreads) {
        const int t = (int)(i >> 4) & 127, s0 = (int)(i & 15) * 8; const f32x4 a = *(const f32x4*)(c.sgu_w + i * 8), b = *(const f32x4*)(c.sgu_w + i * 8 + 4);
        v4u o; o.x = pkbf(s0 + 0 <= t ? a.x : 0.f, s0 + 1 <= t ? a.y : 0.f); o.y = pkbf(s0 + 2 <= t ? a.z : 0.f, s0 + 3 <= t ? a.w : 0.f);
        o.z = pkbf(s0 + 4 <= t ? b.x : 0.f, s0 + 5 <= t ? b.y : 0.f); o.w = pkbf(s0 + 6 <= t ? b.z : 0.f, s0 + 7 <= t ? b.w : 0.f);
        *(v4u*)(c.swb + i * 8) = o; }
}

DEV float rsum16(float v) { v += dppq<0xB1>(v); v += dppq<0x4E>(v); v += dppq<0x1B>(dppq<0x141>(v)); v += dppq<0x128>(v); return v; }
struct F1 { bf16* proj;
    DEV void elem4(int row, int col, f32x4 v) const {
        if (col >= C_GA) { v.x = sigmoidf_(v.x); v.y = sigmoidf_(v.y); v.z = sigmoidf_(v.z); v.w = sigmoidf_(v.w); }
        else if (col >= C_U) { const f32x2 a = pg8::gelu_pk((f32x2){v.x, v.y}), b = pg8::gelu_pk((f32x2){v.z, v.w}); v = (f32x4){a.x, a.y, b.x, b.y}; }
        v2u w; w.x = pkbf(v.x, v.y); w.y = pkbf(v.z, v.w); *(v2u*)(proj + (size_t)row * PST + col) = w; } };
constexpr float GQ = 255.99f;
DEV unsigned gate_q(float x) { return (unsigned)__builtin_amdgcn_rcpf((1.0f / GQ) + __builtin_amdgcn_exp2f(fmaf(x, -1.4426950408889634f, -7.999943641f))); }
DEV f32x4 gate_dq(unsigned w) { return (f32x4){((float)(w & 0xffu) + 0.5f) * (1.0f / GQ), ((float)((w >> 8) & 0xffu) + 0.5f) * (1.0f / GQ), ((float)((w >> 16) & 0xffu) + 0.5f) * (1.0f / GQ), ((float)(w >> 24) + 0.5f) * (1.0f / GQ)}; }
#if defined(EPI_SKIP_PROBE) && EPI_SKIP_PROBE == 2
#define NOSTORE(c) (!skip || (c))
#else
#define NOSTORE(c) true
#endif
struct EpiIn { static constexpr bool PERM = false, AFTER_DRAIN = false, HAS_MID = false, HAS_SKIP = true; bf16* proj; const float* rs; const float* cs; float* kmp; float* sst; int skip;
    DEV void operator()(const pg8::i32x4 (&acc)[2][2][4][2], const pg8::Unit& u, int wr, int wc, int fr, int fq) const {
#if defined(EPI_SKIP_PROBE) && EPI_SKIP_PROBE == 1
        if (skip) { if (acc[0][0][0][0].x == 0x7fffffff && acc[1][1][3][1].w == 0x7ffffff1) proj[0] = 0; return; }
#endif
        const int row0 = u.pm * 256 + wr * 64 + fr, col0 = u.pn * 256 + wc * 32 + 4 * fq;
        const bool isK = u.pn >= C_K / 256 && u.pn < C_V / 256, isVG = u.pn >= C_VG / 256 && u.pn < C_GA / 256;
        f32x4 cv[2][2];
#pragma unroll
        for (int bj = 0; bj < 2; ++bj)
#pragma unroll
            for (int n = 0; n < 2; ++n) cv[bj][n] = *(const f32x4*)(cs + col0 + bj * 128 + n * 16);
        float rsv[8];
#pragma unroll
        for (int g = 0; g < 8; ++g) rsv[g] = rs[row0 + (g >> 2) * 128 + (g & 3) * 16];
        f32x4 ksum[2][2];
#pragma unroll
        for (int bj = 0; bj < 2; ++bj)
#pragma unroll
            for (int n = 0; n < 2; ++n) ksum[bj][n] = (f32x4){0.f, 0.f, 0.f, 0.f};
#pragma unroll
        for (int ai = 0; ai < 2; ++ai)
#pragma unroll
            for (int m = 0; m < 4; ++m) { const int row = row0 + ai * 128 + m * 16; const float r = rsv[ai * 4 + m]; float ss = 0.f, sq = 0.f;
#pragma unroll
                for (int bj = 0; bj < 2; ++bj)
#pragma unroll
                    for (int n = 0; n < 2; ++n) { const pg8::i32x4 a = acc[ai][bj][m][n]; const f32x4 c4 = cv[bj][n]; const int col = col0 + bj * 128 + n * 16;
                        f32x4 v = (f32x4){(float)a.x * (r * c4.x), (float)a.y * (r * c4.y), (float)a.z * (r * c4.z), (float)a.w * (r * c4.w)};
                        if (col >= C_GA) {
                            const unsigned q0 = gate_q(v.x), q1 = gate_q(v.y), q2 = gate_q(v.z), q3 = gate_q(v.w);
                            { const unsigned qq = q0 | (q1 << 8) | (q2 << 16) | (q3 << 24); if (NOSTORE(qq == 0x12345678u)) *(unsigned*)((unsigned char*)(proj + (size_t)row * PST + C_GA) + (col - C_GA)) = qq; } continue; }
                        if (col >= C_U) { const f32x2 ga = pg8::gelu_pk((f32x2){v.x, v.y}), gb = pg8::gelu_pk((f32x2){v.z, v.w}); v = (f32x4){ga.x, ga.y, gb.x, gb.y}; }
                        v2u w; w.x = pkbf(v.x, v.y); w.y = pkbf(v.z, v.w); if (NOSTORE(w.x == 0x12345678u)) *(v2u*)(proj + (size_t)row * PST + col) = w;
                        if (isK) ksum[bj][n] += v;
                        if (isVG) { const float e0 = bflo(w.x), e1 = bfhi(w.x), e2 = bflo(w.y), e3 = bfhi(w.y); ss += (e0 + e1) + (e2 + e3); sq += (e0 * e0 + e1 * e1) + (e2 * e2 + e3 * e3); } }
                if (isVG) { ss += __shfl_xor(ss, 16); sq += __shfl_xor(sq, 16); ss += __shfl_xor(ss, 32); sq += __shfl_xor(sq, 32);
                    if (fq == 0) *(f32x2*)(sst + ((size_t)row * 16 + (u.pn - C_VG / 256) * 4 + wc) * 2) = (f32x2){ss, sq}; }
                asm volatile("" ::: "memory");
            }
        if (isK) { const int b = u.pm >> 5, nb = u.pm & 31;
#pragma unroll
            for (int bj = 0; bj < 2; ++bj)
#pragma unroll
                for (int n = 0; n < 2; ++n) { f32x4 s = ksum[bj][n]; s.x = rsum16(s.x); s.y = rsum16(s.y); s.z = rsum16(s.z); s.w = rsum16(s.w);
                    const int h = 2 * (u.pn - C_K / 256) + bj, d = 32 * wc + 16 * n + 4 * fq;
                    if (fr == 0) *(f32x4*)(kmp + (((size_t)wr * 16 + b * 8 + h) * NBLK + nb) * HD + d) = s * (1.0f / BLK); } }
    } };
struct F4a { const bf16* proj; float* out;
    DEV void elem4(int row, int col, f32x4 v) const { const v2u g = *(const v2u*)(proj + (size_t)row * PST + C_GA + col);
        *(f32x4*)(out + (size_t)row * D + col) = (f32x4){v.x * bflo(g.x), v.y * bfhi(g.x), v.z * bflo(g.y), v.w * bfhi(g.y)}; } };
struct F4b { const bf16* proj; const float* out; bf16* merged;
    DEV void elem4(int row, int col, f32x4 v) const { const v2u g = *(const v2u*)(proj + (size_t)row * PST + C_GB + col); const f32x4 t = *(const f32x4*)(out + (size_t)row * D + col);
        v2u w; w.x = pkbf(t.x + v.x * bflo(g.x), t.y + v.y * bfhi(g.x)); w.y = pkbf(t.z + v.z * bflo(g.y), t.w + v.w * bfhi(g.y)); *(v2u*)(merged + (size_t)row * D + col) = w; } };
struct F5 { const float* x; float* out;
    DEV void elem4(int row, int col, f32x4 v) const { const f32x4 t = *(const f32x4*)(x + (size_t)row * D + col); *(f32x4*)(out + (size_t)row * D + col) = t + v; } };
struct EpiBranch { static constexpr bool PERM = false, AFTER_DRAIN = false, HAS_MID = true; const bf16* proj; bf16* merged;
    DEV void mid(f32x4 (&acc)[2][2][4][2], const pg8::Unit& u, int wr, int wc, int fr, int fq) const {
        const unsigned char* pb = (const unsigned char*)(proj + (size_t)(u.pm * 256 + wr * 64 + fr) * PST + C_GA) + u.pn * 256 + wc * 32 + 4 * fq;
        unsigned gan[4], gbn[4];
#pragma unroll
        for (int q = 0; q < 4; ++q) { const unsigned char* qp_ = pb + (q >> 1) * 128 + (q & 1) * 16; gan[q] = *(const unsigned*)qp_; gbn[q] = *(const unsigned*)(qp_ + 2048); }
#pragma unroll
        for (int g = 0; g < 8; ++g) { const int ai = g >> 2, m = g & 3;
            unsigned gac[4], gbc[4];
#pragma unroll
            for (int q = 0; q < 4; ++q) { gac[q] = gan[q]; gbc[q] = gbn[q]; }
            if (g < 7) { const int gn = g + 1; const unsigned char* rp = pb + (size_t)((gn >> 2) * 128 + (gn & 3) * 16) * (PST * 2);
#pragma unroll
                for (int q = 0; q < 4; ++q) { const unsigned char* qp_ = rp + (q >> 1) * 128 + (q & 1) * 16; gan[q] = *(const unsigned*)qp_; gbn[q] = *(const unsigned*)(qp_ + 2048); } }
#pragma unroll
            for (int bj = 0; bj < 2; ++bj)
#pragma unroll
                for (int n = 0; n < 2; ++n) { const f32x4 ga = gate_dq(gac[bj * 2 + n]), gb = gate_dq(gbc[bj * 2 + n]); f32x4 v = acc[ai][bj][m][n];
                    v.x *= ga.x * __builtin_amdgcn_rcpf(gb.x); v.y *= ga.y * __builtin_amdgcn_rcpf(gb.y); v.z *= ga.z * __builtin_amdgcn_rcpf(gb.z); v.w *= ga.w * __builtin_amdgcn_rcpf(gb.w);
                    acc[ai][bj][m][n] = v; } }
    }
    DEV void operator()(const f32x4 (&acc)[2][2][4][2], const pg8::Unit& u, int wr, int wc, int fr, int fq) const {
        const int row0 = u.pm * 256 + wr * 64 + fr, col0 = u.pn * 256 + wc * 32 + 4 * fq;
        const unsigned char* pb = (const unsigned char*)(proj + (size_t)row0 * PST + C_GA) + 2048 + col0;
        unsigned gbn[4];
#pragma unroll
        for (int q = 0; q < 4; ++q) gbn[q] = *(const unsigned*)(pb + (q >> 1) * 128 + (q & 1) * 16);
#pragma unroll
        for (int g = 0; g < 8; ++g) { const int ai = g >> 2, m = g & 3; const int row = row0 + ai * 128 + m * 16;
            unsigned gbc[4];
#pragma unroll
            for (int q = 0; q < 4; ++q) gbc[q] = gbn[q];
            if (g < 7) { const int gn = g + 1; const unsigned char* rp = pb + (size_t)((gn >> 2) * 128 + (gn & 3) * 16) * (PST * 2);
#pragma unroll
                for (int q = 0; q < 4; ++q) gbn[q] = *(const unsigned*)(rp + (q >> 1) * 128 + (q & 1) * 16); }
#pragma unroll
            for (int bj = 0; bj < 2; ++bj)
#pragma unroll
                for (int n = 0; n < 2; ++n) { const int col = col0 + bj * 128 + n * 16; const f32x4 gb = gate_dq(gbc[bj * 2 + n]); const f32x4 v = acc[ai][bj][m][n];
                    v2u w; w.x = pkbf(v.x * gb.x, v.y * gb.y); w.y = pkbf(v.z * gb.z, v.w * gb.w); *(v2u*)(merged + (size_t)row * D + col) = w; } }
    } };
struct EpiBranchI { static constexpr bool PERM = false, AFTER_DRAIN = false, HAS_MID = true, HAS_SKIP = false; const bf16* proj; bf16* merged; const float* rs; const float* cs;
    DEV void mid(pg8::i32x4 (&acc)[2][2][4][2], const pg8::Unit& u, int wr, int wc, int fr, int fq) const {
        const unsigned char* pb = (const unsigned char*)(proj + (size_t)(u.pm * 256 + wr * 64 + fr) * PST + C_GA) + u.pn * 256 + wc * 32 + 4 * fq;
        unsigned gan[4], gbn[4];
#pragma unroll
        for (int q = 0; q < 4; ++q) { const unsigned char* qp_ = pb + (q >> 1) * 128 + (q & 1) * 16; gan[q] = *(const unsigned*)qp_; gbn[q] = *(const unsigned*)(qp_ + 2048); }
#pragma unroll
        for (int g = 0; g < 8; ++g) { const int ai = g >> 2, m = g & 3;
            unsigned gac[4], gbc[4];
#pragma unroll
            for (int q = 0; q < 4; ++q) { gac[q] = gan[q]; gbc[q] = gbn[q]; }
            if (g < 7) { const int gn = g + 1; const unsigned char* rp = pb + (size_t)((gn >> 2) * 128 + (gn & 3) * 16) * (PST * 2);
#pragma unroll
                for (int q = 0; q < 4; ++q) { const unsigned char* qp_ = rp + (q >> 1) * 128 + (q & 1) * 16; gan[q] = *(const unsigned*)qp_; gbn[q] = *(const unsigned*)(qp_ + 2048); } }
#pragma unroll
            for (int bj = 0; bj < 2; ++bj)
#pragma unroll
                for (int n = 0; n < 2; ++n) { const f32x4 ga = gate_dq(gac[bj * 2 + n]), gb = gate_dq(gbc[bj * 2 + n]); pg8::i32x4 a = acc[ai][bj][m][n];
                    a.x = (int)rintf((float)a.x * (ga.x * __builtin_amdgcn_rcpf(gb.x))); a.y = (int)rintf((float)a.y * (ga.y * __builtin_amdgcn_rcpf(gb.y)));
                    a.z = (int)rintf((float)a.z * (ga.z * __builtin_amdgcn_rcpf(gb.z))); a.w = (int)rintf((float)a.w * (ga.w * __builtin_amdgcn_rcpf(gb.w)));
                    acc[ai][bj][m][n] = a; }
            asm volatile("" ::: "memory"); }
    }
    DEV void operator()(const pg8::i32x4 (&acc)[2][2][4][2], const pg8::Unit& u, int wr, int wc, int fr, int fq) const {
        const int row0 = u.pm * 256 + wr * 64 + fr, col0 = u.pn * 256 + wc * 32 + 4 * fq;
        const unsigned char* pb = (const unsigned char*)(proj + (size_t)row0 * PST + C_GA) + 2048 + col0;
        f32x4 cv[2][2];
#pragma unroll
        for (int bj = 0; bj < 2; ++bj)
#pragma unroll
            for (int n = 0; n < 2; ++n) cv[bj][n] = *(const f32x4*)(cs + col0 + bj * 128 + n * 16);
        float rsv[8];
#pragma unroll
        for (int g = 0; g < 8; ++g) rsv[g] = rs[row0 + (g >> 2) * 128 + (g & 3) * 16];
        unsigned gbn[4];
#pragma unroll
        for (int q = 0; q < 4; ++q) gbn[q] = *(const unsigned*)(pb + (q >> 1) * 128 + (q & 1) * 16);
#pragma unroll
        for (int g = 0; g < 8; ++g) { const int ai = g >> 2, m = g & 3; const int row = row0 + ai * 128 + m * 16; const float r = rsv[g];
            unsigned gbc[4];
#pragma unroll
            for (int q = 0; q < 4; ++q) gbc[q] = gbn[q];
            if (g < 7) { const int gn = g + 1; const unsigned char* rp = pb + (size_t)((gn >> 2) * 128 + (gn & 3) * 16) * (PST * 2);
#pragma unroll
                for (int q = 0; q < 4; ++q) gbn[q] = *(const unsigned*)(rp + (q >> 1) * 128 + (q & 1) * 16); }
#pragma unroll
            for (int bj = 0; bj < 2; ++bj)
#pragma unroll
                for (int n = 0; n < 2; ++n) { const int col = col0 + bj * 128 + n * 16; const f32x4 gb = gate_dq(gbc[bj * 2 + n]); const pg8::i32x4 a = acc[ai][bj][m][n]; const f32x4 c4 = cv[bj][n];
                    v2u w; w.x = pkbf((float)a.x * (r * c4.x) * gb.x, (float)a.y * (r * c4.y) * gb.y); w.y = pkbf((float)a.z * (r * c4.z) * gb.z, (float)a.w * (r * c4.w) * gb.w);
                    *(v2u*)(merged + (size_t)row * D + col) = w; } }
    } };
DEV void phase_quant_branch(const Ctx& c) {
    const int lane = c.lane; int m0, mstep, mend; xcd_rows(c, m0, mstep, mend);
    v4u vn[4];
    if (m0 < mend) { const v4u* sa = (const v4u*)(c.yatt + (size_t)m0 * 1024) + lane; const v4u* sb = (const v4u*)(c.ysgu + (size_t)m0 * 1024) + lane; vn[0] = sa[0]; vn[1] = sa[64]; vn[2] = sb[0]; vn[3] = sb[64]; }
    for (int m = m0; m < mend; m += mstep) {
        v4u v[4]; v[0] = vn[0]; v[1] = vn[1]; v[2] = vn[2]; v[3] = vn[3]; float am = 0.f;
        { const int mn = m + mstep < mend ? m + mstep : m; const v4u* sa = (const v4u*)(c.yatt + (size_t)mn * 1024) + lane; const v4u* sb = (const v4u*)(c.ysgu + (size_t)mn * 1024) + lane; vn[0] = sa[0]; vn[1] = sa[64]; vn[2] = sb[0]; vn[3] = sb[64]; }
#pragma unroll
        for (int j = 0; j < 4; ++j) { const v4u w = v[j];
            am = fmaxf(am, fmaxf(fmaxf(fmaxf(fabsf(bflo(w.x)), fabsf(bfhi(w.x))), fmaxf(fabsf(bflo(w.y)), fabsf(bfhi(w.y)))), fmaxf(fmaxf(fabsf(bflo(w.z)), fabsf(bfhi(w.z))), fmaxf(fabsf(bflo(w.w)), fabsf(bfhi(w.w)))))); }
        am = wmax_q(am);
        const float inv = am > 0.f ? 127.0f / am : 0.f;
        v2u* dst = (v2u*)((unsigned char*)(c.proj + (size_t)m * PST)) + lane;
#pragma unroll
        for (int j = 0; j < 4; ++j) { const v4u w = v[j]; v2u o; o.x = q4(bflo(w.x), bfhi(w.x), bflo(w.y), bfhi(w.y), inv, 0); o.y = q4(bflo(w.z), bfhi(w.z), bflo(w.w), bfhi(w.w), inv, 0); dst[64 * j] = o; }
        if (lane == 0) c.bs[m] = am * (1.0f / 127.0f);
    }
}
struct EpiF5 { static constexpr bool PERM = false, AFTER_DRAIN = false, HAS_MID = false; const float* x; float* out; bf16* h1b; float* rss;
    DEV void operator()(const f32x4 (&acc)[2][2][4][2], const pg8::Unit& u, int wr, int wc, int fr, int fq) const {
        const int row0 = u.pm * 256 + wr * 64 + fr, col0 = u.pn * 256 + wc * 32 + 4 * fq;
        f32x4 xn[4];
        { const float* xp = x + (size_t)row0 * D + col0;
#pragma unroll
          for (int q = 0; q < 4; ++q) xn[q] = *(const f32x4*)(xp + (q >> 1) * 128 + (q & 1) * 16); }
#pragma unroll
        for (int g = 0; g < 8; ++g) { const int ai = g >> 2, m = g & 3; const int row = row0 + ai * 128 + m * 16; float ss = 0.f;
            f32x4 xc[4];
#pragma unroll
            for (int q = 0; q < 4; ++q) xc[q] = xn[q];
            if (g < 7) { const int gn = g + 1; const float* xp = x + (size_t)(row0 + (gn >> 2) * 128 + (gn & 3) * 16) * D + col0;
#pragma unroll
                for (int q = 0; q < 4; ++q) xn[q] = *(const f32x4*)(xp + (q >> 1) * 128 + (q & 1) * 16); }
#pragma unroll
            for (int bj = 0; bj < 2; ++bj)
#pragma unroll
                for (int n = 0; n < 2; ++n) { const int col = col0 + bj * 128 + n * 16; const f32x4 v = xc[bj * 2 + n] + acc[ai][bj][m][n];
                    v2u w; w.x = pkbf(v.x, v.y); w.y = pkbf(v.z, v.w); *(v2u*)(h1b + (size_t)row * D + col) = w;
                    ss += (v.x * v.x + v.y * v.y) + (v.z * v.z + v.w * v.w); }
            ss += __shfl_xor(ss, 16); ss += __shfl_xor(ss, 32);
            if (fq == 0) rss[(size_t)row * 32 + u.pn * 4 + wc] = ss; }
    } };
struct EpiF5i { static constexpr bool PERM = false, AFTER_DRAIN = false, HAS_MID = false, HAS_SKIP = false; const float* x; bf16* h1b; float* rss; const float* rs; const float* cs;
    DEV void operator()(const pg8::i32x4 (&acc)[2][2][4][2], const pg8::Unit& u, int wr, int wc, int fr, int fq) const {
        const int row0 = u.pm * 256 + wr * 64 + fr, col0 = u.pn * 256 + wc * 32 + 4 * fq;
        f32x4 cv[2][2];
#pragma unroll
        for (int bj = 0; bj < 2; ++bj)
#pragma unroll
            for (int n = 0; n < 2; ++n) cv[bj][n] = *(const f32x4*)(cs + col0 + bj * 128 + n * 16);
        float rsv[8];
#pragma unroll
        for (int g = 0; g < 8; ++g) rsv[g] = rs[row0 + (g >> 2) * 128 + (g & 3) * 16];
        f32x4 xn[4];
        { const float* xp = x + (size_t)row0 * D + col0;
#pragma unroll
          for (int q = 0; q < 4; ++q) xn[q] = __builtin_nontemporal_load((const f32x4*)(xp + (q >> 1) * 128 + (q & 1) * 16)); }
#pragma unroll
        for (int g = 0; g < 8; ++g) { const int ai = g >> 2, m = g & 3; const int row = row0 + ai * 128 + m * 16; float ss = 0.f; const float r = rsv[g];
            f32x4 xc[4];
#pragma unroll
            for (int q = 0; q < 4; ++q) xc[q] = xn[q];
            if (g < 7) { const int gn = g + 1; const float* xp = x + (size_t)(row0 + (gn >> 2) * 128 + (gn & 3) * 16) * D + col0;
#pragma unroll
                for (int q = 0; q < 4; ++q) xn[q] = __builtin_nontemporal_load((const f32x4*)(xp + (q >> 1) * 128 + (q & 1) * 16)); }
#pragma unroll
            for (int bj = 0; bj < 2; ++bj)
#pragma unroll
                for (int n = 0; n < 2; ++n) { const int col = col0 + bj * 128 + n * 16; const pg8::i32x4 a = acc[ai][bj][m][n]; const f32x4 c4 = cv[bj][n];
                    const f32x4 v = xc[bj * 2 + n] + (f32x4){(float)a.x * (r * c4.x), (float)a.y * (r * c4.y), (float)a.z * (r * c4.z), (float)a.w * (r * c4.w)};
                    v2u w; w.x = pkbf(v.x, v.y); w.y = pkbf(v.z, v.w); *(v2u*)(h1b + (size_t)row * D + col) = w;
                    ss += (v.x * v.x + v.y * v.y) + (v.z * v.z + v.w * v.w); }
            ss += __shfl_xor(ss, 16); ss += __shfl_xor(ss, 32);
            if (fq == 0) rss[(size_t)row * 32 + u.pn * 4 + wc] = ss; }
    } };
DEV void phase_quant_merged(const Ctx& c) {
    const int lane = c.lane; int m0, mstep, mend; xcd_rows(c, m0, mstep, mend);
    v4u vn[4];
    if (m0 < mend) { const v4u* src = (const v4u*)(c.merged + (size_t)m0 * D) + lane;
#pragma unroll
        for (int j = 0; j < 4; ++j) vn[j] = src[64 * j]; }
    for (int m = m0; m < mend; m += mstep) {
        v4u v[4]; float am = 0.f;
#pragma unroll
        for (int j = 0; j < 4; ++j) v[j] = vn[j];
        { const int mn = m + mstep < mend ? m + mstep : m; const v4u* src = (const v4u*)(c.merged + (size_t)mn * D) + lane;
#pragma unroll
          for (int j = 0; j < 4; ++j) vn[j] = src[64 * j]; }
#pragma unroll
        for (int j = 0; j < 4; ++j) { const v4u w = v[j];
            am = fmaxf(am, fmaxf(fmaxf(fmaxf(fabsf(bflo(w.x)), fabsf(bfhi(w.x))), fmaxf(fabsf(bflo(w.y)), fabsf(bfhi(w.y)))), fmaxf(fmaxf(fabsf(bflo(w.z)), fabsf(bfhi(w.z))), fmaxf(fabsf(bflo(w.w)), fabsf(bfhi(w.w)))))); }
        am = wave_max(am);
        const float inv = am > 0.f ? 127.0f / am : 0.f;
        v2u* dst = (v2u*)(c.mq8 + (size_t)m * D) + lane;
#pragma unroll
        for (int j = 0; j < 4; ++j) { const v4u w = v[j]; v2u o; o.x = q4(bflo(w.x), bfhi(w.x), bflo(w.y), bfhi(w.y), inv, 0); o.y = q4(bflo(w.z), bfhi(w.z), bflo(w.w), bfhi(w.w), inv, 0); dst[64 * j] = o; }
        if (lane == 0) c.ms[m] = am * (1.0f / 127.0f);
    }
}
DEV void phase_quant_h1(const Ctx& c) {
    const int lane = c.lane; int m0, mstep, mend; xcd_rows(c, m0, mstep, mend);
    v4u vn[4];
    if (m0 < mend) { const v4u* src = (const v4u*)(c.h1n + (size_t)m0 * D) + lane;
#pragma unroll
        for (int j = 0; j < 4; ++j) vn[j] = src[64 * j]; }
    for (int m = m0; m < mend; m += mstep) {
        v4u v[4]; float am = 0.f;
#pragma unroll
        for (int j = 0; j < 4; ++j) v[j] = vn[j];
        { const int mn = m + mstep < mend ? m + mstep : m; const v4u* src = (const v4u*)(c.h1n + (size_t)mn * D) + lane;
#pragma unroll
          for (int j = 0; j < 4; ++j) vn[j] = src[64 * j]; }
#pragma unroll
        for (int j = 0; j < 4; ++j) { const v4u w = v[j];
            am = fmaxf(am, fmaxf(fmaxf(fmaxf(fabsf(bflo(w.x)), fabsf(bfhi(w.x))), fmaxf(fabsf(bflo(w.y)), fabsf(bfhi(w.y)))), fmaxf(fmaxf(fabsf(bflo(w.z)), fabsf(bfhi(w.z))), fmaxf(fabsf(bflo(w.w)), fabsf(bfhi(w.w)))))); }
        am = wmax_q(am);
        const float r1 = 1.0f / sqrtf(wsum_q(lane < 32 ? c.rss[(size_t)m * 32 + lane] : 0.f) * (1.0f / D) + EPS);
        const float inv = am > 0.f ? 127.0f / am : 0.f;
        v2u* dst = (v2u*)(c.xq8g + (size_t)m * D) + lane; int xacc = 0;
#pragma unroll
        for (int j = 0; j < 4; ++j) { const v4u w = v[j]; v2u o; o.x = q4(bflo(w.x), bfhi(w.x), bflo(w.y), bfhi(w.y), inv, 0); o.y = q4(bflo(w.z), bfhi(w.z), bflo(w.w), bfhi(w.w), inv, 0); dst[64 * j] = o;
            xacc = __builtin_amdgcn_sdot4((int)o.x, 0x01010101, xacc, false); xacc = __builtin_amdgcn_sdot4((int)o.y, 0x01010101, xacc, false); }
        { float xf = (float)xacc; xf = wsum_q(xf);
          if (lane == 0) { c.h1s[m] = am * (1.0f / 127.0f); c.sxg[m] = am * (1.0f / 127.0f) * r1; c.xsg[m] = (int)xf; } }
    }
}
struct F6 { bf16* qp;
    DEV void elem4(int row, int col, f32x4 v) const { v2u w; w.x = pkbf(v.x, v.y); w.y = pkbf(v.z, v.w); *(v2u*)(qp + (size_t)row * D + col) = w; } };
struct F9a { bf16* gtmp;
    DEV void elem4(int row, int col, f32x4 v) const { *(unsigned*)((unsigned char*)(gtmp + (size_t)row * D) + col) = gate_q(v.x) | (gate_q(v.y) << 8) | (gate_q(v.z) << 16) | (gate_q(v.w) << 24); } };
struct F9b { const bf16* gtmp; float* out;
    DEV void elem4(int row, int col, f32x4 v) const { const v2u g = *(const v2u*)(gtmp + (size_t)row * D + col); float* o = out + (size_t)row * D + col; const f32x4 t = *(const f32x4*)o;
        *(f32x4*)o = (f32x4){t.x + v.x * bflo(g.x), t.y + v.y * bfhi(g.x), t.z + v.z * bflo(g.y), t.w + v.w * bfhi(g.y)}; } };
struct Epi9b { static constexpr bool PERM = false, AFTER_DRAIN = false, HAS_MID = false; const bf16* gtmp; bf16* hb;
    DEV void operator()(const f32x4 (&acc)[2][2][4][2], const pg8::Unit& u, int wr, int wc, int fr, int fq) const {
        const int row0 = u.pm * 256 + wr * 64 + fr, col0 = u.pn * 256 + wc * 32 + 4 * fq;
        unsigned gn[4]; v2u tn[4];
        { const size_t o0 = (size_t)row0 * D + col0;
#pragma unroll
          for (int q = 0; q < 4; ++q) { const size_t o = o0 + (q >> 1) * 128 + (q & 1) * 16; gn[q] = *(const unsigned*)((const unsigned char*)(gtmp + (size_t)row0 * D) + col0 + (q >> 1) * 128 + (q & 1) * 16); tn[q] = *(const v2u*)(hb + o); } }
#pragma unroll
        for (int g = 0; g < 8; ++g) { const int ai = g >> 2, m = g & 3; const size_t o0 = (size_t)(row0 + ai * 128 + m * 16) * D + col0;
            unsigned gc[4]; v2u tc[4];
#pragma unroll
            for (int q = 0; q < 4; ++q) { gc[q] = gn[q]; tc[q] = tn[q]; }
            if (g < 7) { const int g1 = g + 1; const size_t o1 = (size_t)(row0 + (g1 >> 2) * 128 + (g1 & 3) * 16) * D + col0;
#pragma unroll
                for (int q = 0; q < 4; ++q) { const size_t o = o1 + (q >> 1) * 128 + (q & 1) * 16; gn[q] = *(const unsigned*)((const unsigned char*)(gtmp + (size_t)(row0 + (g1 >> 2) * 128 + (g1 & 3) * 16) * D) + col0 + (q >> 1) * 128 + (q & 1) * 16); tn[q] = *(const v2u*)(hb + o); } }
#pragma unroll
            for (int bj = 0; bj < 2; ++bj)
#pragma unroll
                for (int n = 0; n < 2; ++n) { const int q = bj * 2 + n; const f32x4 v = acc[ai][bj][m][n]; const v2u t = tc[q]; const f32x4 gg = gate_dq(gc[q]);
                    v2u w; w.x = pkbf(bflo(t.x) + v.x * gg.x, bfhi(t.x) + v.y * gg.y); w.y = pkbf(bflo(t.y) + v.z * gg.z, bfhi(t.y) + v.w * gg.w);
                    *(v2u*)(hb + o0 + bj * 128 + n * 16) = w; } }
    } };

template <class F> DEV void naive_gemm(LAS unsigned char* lds, const bf16* A, const bf16* Bt, int M, int N, int K, const F& f) {
    LAS float* As = (LAS float*)lds; LAS float* Bs = As + 64 * 33;
    const int tid = threadIdx.x, ty = tid >> 4, tx = tid & 15;
    const int ntn = N / 64, ntiles = (M / 64) * ntn;
    for (int tile = blockIdx.x; tile < ntiles; tile += gridDim.x) {
        const int tm = tile / ntn, tn = tile % ntn;
        f32x4 a0 = {0.f, 0.f, 0.f, 0.f}, a1 = a0;
        for (int k0 = 0; k0 < K; k0 += 32) {
            { const int r = tid >> 3, cc = (tid & 7) * 4;
              const v2u av = *(const v2u*)(A + (size_t)(tm * 64 + r) * K + k0 + cc), bv = *(const v2u*)(Bt + (size_t)(tn * 64 + r) * K + k0 + cc);
              As[r * 33 + cc] = bflo(av.x); As[r * 33 + cc + 1] = bfhi(av.x); As[r * 33 + cc + 2] = bflo(av.y); As[r * 33 + cc + 3] = bfhi(av.y);
              Bs[r * 33 + cc] = bflo(bv.x); Bs[r * 33 + cc + 1] = bfhi(bv.x); Bs[r * 33 + cc + 2] = bflo(bv.y); Bs[r * 33 + cc + 3] = bfhi(bv.y); }
            __syncthreads();
#pragma unroll 8
            for (int kk = 0; kk < 32; ++kk) { const float x0 = As[(2 * ty) * 33 + kk], x1 = As[(2 * ty + 1) * 33 + kk];
                const f32x4 b = {Bs[(4 * tx) * 33 + kk], Bs[(4 * tx + 1) * 33 + kk], Bs[(4 * tx + 2) * 33 + kk], Bs[(4 * tx + 3) * 33 + kk]};
                a0 += b * x0; a1 += b * x1; }
            __syncthreads();
        }
        f.elem4(tm * 64 + 2 * ty, tn * 64 + 4 * tx, a0); f.elem4(tm * 64 + 2 * ty + 1, tn * 64 + 4 * tx, a1);
    }
}
template <class F> DEV void run_gemm(bool naive, LAS unsigned char* lds, const bf16* A, const bf16* Bt, int M, int N, int K, const F& f, int G, int bid) {
    if (naive) { naive_gemm<F>(lds, A, Bt, M, N, K, f); return; }
    asm volatile("" : "+s"(K));
    pg8::Gemm g{A, Bt, M, N, K, A + K / 2, K}; pg8::StaticOrder S; S.init(M, N, G, bid);
    pg8::EpiW<F> E{f};
    pg8::gemm_phase<pg8::EpiW<F>, pg8::StaticOrder, true, true>((PG8_LAS unsigned char*)lds, g, S, E);
}

template <class F> DEV void run_gemm_i8(LAS unsigned char* lds, const unsigned char* A8, const unsigned char* Bt8, const float* rs, const float* cs, int M, int N, int K, const F& f, int G, int bid) {
    asm volatile("" : "+s"(K));
    pg8::Gemm g{(const bf16*)A8, (const bf16*)Bt8, M, N, K, nullptr, K}; pg8::StaticOrder S; S.init(M, N, G, bid);
    pg8::EpiW8<F> E{f, rs, cs};
    pg8::gemm_phase_i8<pg8::EpiW8<F>, pg8::StaticOrder, GI8_ALIGN, true>((PG8_LAS unsigned char*)lds, g, S, E);
}

DEV void run_gemm_in(LAS unsigned char* lds, const Ctx& c, int skip = 0) {
    int K = D; asm volatile("" : "+s"(K));
    pg8::Gemm g{(const bf16*)c.xq8, (const bf16*)c.WinT8, T, INW, K, nullptr, XP}; pg8::StaticOrder S; S.init(T, INW, c.G, c.bid);
    if ((T / 256) * (INW / 256) % c.G == 0) { S.nround = (T / 256) * (INW / 256) / c.G;
#if GEMM1_ORDER == 0
        S.rot = (c.bid & 7) % S.nround;
#else
        if (S.nround == 9) S.perm9 = 0x430218765ull;
#endif
    }
    pg8::gemm_phase_i8<EpiIn, pg8::StaticOrder, GI8_ALIGN, true>((PG8_LAS unsigned char*)lds, g, S, EpiIn{c.proj, c.xs, c.wcs, c.kmp, c.sst, skip});
}

DEV void phase_kmean_vt(const Ctx& c, unsigned* kcnt) {
    const int gw = c.bid * 8 + c.wave, NGW = c.G * 8, lane = c.lane;
    for (int it = gw; it < 16 * NBLK; it += NGW) { const int bh = it / NBLK, n = it % NBLK, b = bh >> 3, h = bh & 7;
        const bf16* kp = c.proj + (size_t)(b * SEQ + n * BLK + (lane >> 4)) * PST + C_K + h * HD + (lane & 15) * 8;
        float s[8];
#pragma unroll
        for (int i = 0; i < 8; ++i) s[i] = 0.f;
#pragma unroll 8
        for (int r = 0; r < BLK; r += 4) { const v4u w = *(const v4u*)(kp + (size_t)r * PST);
            s[0] += bflo(w.x); s[1] += bfhi(w.x); s[2] += bflo(w.y); s[3] += bfhi(w.y); s[4] += bflo(w.z); s[5] += bfhi(w.z); s[6] += bflo(w.w); s[7] += bfhi(w.w); }
#pragma unroll
        for (int i = 0; i < 8; ++i) { s[i] += __shfl_xor(s[i], 16); s[i] += __shfl_xor(s[i], 32); s[i] *= (1.0f / BLK); }
        if (lane < 16) { float* kd = c.kmean + ((size_t)bh * NBLK + n) * HD + lane * 8; *(f32x4*)kd = (f32x4){s[0], s[1], s[2], s[3]}; *(f32x4*)(kd + 4) = (f32x4){s[4], s[5], s[6], s[7]}; }
        asm volatile("s_waitcnt vmcnt(0)" ::: "memory");
        if (lane == 0) { __builtin_amdgcn_fence(__ATOMIC_RELEASE, "agent"); asm volatile("s_waitcnt vmcnt(0)" ::: "memory"); __hip_atomic_fetch_add(kcnt, 1u, __ATOMIC_RELAXED, __HIP_MEMORY_SCOPE_AGENT); }
    }
}
DEV void sgu_stats(const Ctx& c, LAS float* stats, int t0) {
    const int row = c.tid >> 2, part = c.tid & 3;
    const bf16* vp = c.proj + (size_t)(t0 + row) * PST + C_VG + part * 256;
    float s = 0.f, q = 0.f;
#pragma unroll 4
    for (int i = 0; i < 32; ++i) { const v4u w = *(const v4u*)(vp + i * 8);
        const float e0 = bflo(w.x), e1 = bfhi(w.x), e2 = bflo(w.y), e3 = bfhi(w.y), e4 = bflo(w.z), e5 = bfhi(w.z), e6 = bflo(w.w), e7 = bfhi(w.w);
        s += ((e0 + e1) + (e2 + e3)) + ((e4 + e5) + (e6 + e7)); q += ((e0 * e0 + e1 * e1) + (e2 * e2 + e3 * e3)) + ((e4 * e4 + e5 * e5) + (e6 * e6 + e7 * e7)); }
    s += __shfl_xor(s, 1); s += __shfl_xor(s, 2); q += __shfl_xor(q, 1); q += __shfl_xor(q, 2);
    const float mean = s * (1.0f / 1024.0f), var = fmaxf(q * (1.0f / 1024.0f) - mean * mean, 0.f);
    if (part == 0) { stats[row * 2] = mean; stats[row * 2 + 1] = 1.0f / sqrtf(var + EPS); }
}
DEV void sgu_stats2(const Ctx& c, LAS float* stats, int t0) {
    const int row = c.tid >> 2, j = c.tid & 3;
    const f32x4* sp = (const f32x4*)(c.sst + ((size_t)(t0 + row) * 16 + 4 * j) * 2); const f32x4 a = sp[0], b = sp[1];
    float s = (a.x + a.z) + (b.x + b.z), q = (a.y + a.w) + (b.y + b.w);
    s += dppq<0xB1>(s); s += dppq<0x4E>(s); q += dppq<0xB1>(q); q += dppq<0x4E>(q);
    const float mean = s * (1.0f / 1024.0f), var = fmaxf(q * (1.0f / 1024.0f) - mean * mean, 0.f);
    if (j == 0) { stats[row * 2] = mean; stats[row * 2 + 1] = 1.0f / sqrtf(var + EPS); }
}
constexpr int SG_RS = 320, SG_IMG = 128 * SG_RS, SG_SCR = 32 * 144;
DEV void phase_sgu(const Ctx& c, LAS unsigned char* lds) {
    LAS float* stats = (LAS float*)lds;
    LAS unsigned char* img = lds + 1024;
    LAS unsigned char* scr = lds + 1024 + 2 * SG_IMG + c.wave * SG_SCR;
    const int lane = c.lane, r = lane & 31, hh = lane >> 5, wave = c.wave, tid = c.tid;
    const int mt = wave >> 1, cw = wave & 1, nks = 2 * (mt + 1);
    const int srow = tid >> 4, sch = (tid & 15) * 8;
    const int erow = lane >> 3, ech = cw * 64 + (lane & 7) * 8;
    const unsigned troff = (unsigned)(size_t)img + (unsigned)((8 * hh + ((lane & 15) >> 2)) * SG_RS + (cw * 64 + 16 * ((lane >> 4) & 1) + 4 * (lane & 3)) * 2);
#define SG_LOADVG(V, LG, LB, G_) do { _Pragma("unroll") for (int q = 0; q < 4; ++q) V[q] = *(const v4u*)(c.proj + (size_t)(t0 + srow + 32 * q) * PST + C_VG + (G_) * 128 + sch); \
        LG[0] = *(const f32x4*)(c.ln_g + (G_) * 128 + sch); LG[1] = *(const f32x4*)(c.ln_g + (G_) * 128 + sch + 4); LB[0] = *(const f32x4*)(c.ln_b + (G_) * 128 + sch); LB[1] = *(const f32x4*)(c.ln_b + (G_) * 128 + sch + 4); } while (0)
#define SG_LOADOPS(AF, UU, BI, G_) do { _Pragma("unroll") for (int ks = 0; ks < 8; ++ks) if (ks < nks) AF[ks] = *(const v4u*)(c.swb + ((size_t)((G_) * 128 + 32 * mt + r)) * 128 + 16 * ks + 8 * hh); \
        _Pragma("unroll") for (int j = 0; j < 4; ++j) UU[j] = *(const v4u*)(c.proj + (size_t)(t0 + 32 * mt + erow + 8 * j) * PST + C_U + (G_) * 128 + ech); \
        BI = c.sgu_b[(G_) * 128 + 32 * mt + r]; } while (0)
#define SG_STAGE(V, LG, LB, BUF) do { LAS unsigned char* ib = img + (BUF) * SG_IMG; \
        const float gg[8] = {LG[0].x, LG[0].y, LG[0].z, LG[0].w, LG[1].x, LG[1].y, LG[1].z, LG[1].w}, bbv[8] = {LB[0].x, LB[0].y, LB[0].z, LB[0].w, LB[1].x, LB[1].y, LB[1].z, LB[1].w}; \
        _Pragma("unroll") for (int q = 0; q < 4; ++q) { const int row = srow + 32 * q; const float mean = stats[2 * row], rstd = stats[2 * row + 1]; const v4u w = V[q]; \
            const float e[8] = {bflo(w.x), bfhi(w.x), bflo(w.y), bfhi(w.y), bflo(w.z), bfhi(w.z), bflo(w.w), bfhi(w.w)}; float y[8]; \
            _Pragma("unroll") for (int i = 0; i < 8; ++i) y[i] = (e[i] - mean) * rstd * gg[i] + bbv[i]; \
            *(LAS v4u*)(ib + row * SG_RS + sch * 2) = (v4u){pkbf(y[0], y[1]), pkbf(y[2], y[3]), pkbf(y[4], y[5]), pkbf(y[6], y[7])}; } } while (0)
#define SG_BAR asm volatile("s_waitcnt lgkmcnt(0)\n\ts_barrier" ::: "memory")
    for (int unit = c.bid; unit < 256; unit += c.G) {
        const int chunk = unit >> 1, gh = unit & 1, t0 = chunk * 128, g0 = gh * 4;
        __syncthreads();
        v4u vgN[4]; f32x4 lgN[2], lbN[2];
        v4u afN[8], uuN[4]; float biasN;
        SG_LOADVG(vgN, lgN, lbN, g0);
        SG_LOADOPS(afN, uuN, biasN, g0);
        sgu_stats2(c, stats, t0);
        __syncthreads();
        SG_STAGE(vgN, lgN, lbN, 0);
        SG_BAR;
#pragma unroll 1
        for (int gi = 0; gi < 4; ++gi) { const int g = g0 + gi, buf = gi & 1;
            v4u af[8], uu[4]; const float bias = biasN;
#pragma unroll
            for (int ks = 0; ks < 8; ++ks) af[ks] = afN[ks];
#pragma unroll
            for (int j = 0; j < 4; ++j) uu[j] = uuN[j];
            if (gi < 3) { SG_LOADVG(vgN, lgN, lbN, g + 1); SG_LOADOPS(afN, uuN, biasN, g + 1); }
            f32x16 acc0, acc1;
#pragma unroll
            for (int i = 0; i < 16; ++i) { acc0[i] = 0.f; acc1[i] = 0.f; }
#pragma unroll
            for (int ks = 0; ks < 8; ++ks) if (ks < nks) {
                const unsigned ad = troff + (unsigned)(buf * SG_IMG + 16 * ks * SG_RS);
                v2u b00, b01, b10, b11;
                asm volatile("ds_read_b64_tr_b16 %0, %4\n\tds_read_b64_tr_b16 %1, %4 offset:1280\n\tds_read_b64_tr_b16 %2, %4 offset:64\n\tds_read_b64_tr_b16 %3, %4 offset:1344\n\ts_waitcnt lgkmcnt(0)"
                             : "=&v"(b00), "=&v"(b01), "=&v"(b10), "=&v"(b11) : "v"(ad) : "memory");
                const bf16x8 a = __builtin_bit_cast(bf16x8, af[ks]);
                acc0 = MFMA32(__builtin_bit_cast(bf16x8, ((v4u){b00.x, b00.y, b01.x, b01.y})), a, acc0);
                acc1 = MFMA32(__builtin_bit_cast(bf16x8, ((v4u){b10.x, b10.y, b11.x, b11.y})), a, acc1); }
#pragma unroll
            for (int k = 0; k < 4; ++k) {
                *(LAS v2u*)(scr + r * 144 + (8 * k + 4 * hh) * 2) = (v2u){pkbf(acc0[4 * k] + bias, acc0[4 * k + 1] + bias), pkbf(acc0[4 * k + 2] + bias, acc0[4 * k + 3] + bias)};
                *(LAS v2u*)(scr + r * 144 + (32 + 8 * k + 4 * hh) * 2) = (v2u){pkbf(acc1[4 * k] + bias, acc1[4 * k + 1] + bias), pkbf(acc1[4 * k + 2] + bias, acc1[4 * k + 3] + bias)}; }
            asm volatile("s_waitcnt lgkmcnt(0)" ::: "memory");
#pragma unroll
            for (int j = 0; j < 4; ++j) { const int row = erow + 8 * j; const v4u mx = *(const LAS v4u*)(scr + row * 144 + (lane & 7) * 16); const v4u u = uu[j];
                v4u o; o.x = pkbf(bflo(u.x) * bflo(mx.x), bfhi(u.x) * bfhi(mx.x)); o.y = pkbf(bflo(u.y) * bflo(mx.y), bfhi(u.y) * bfhi(mx.y));
                o.z = pkbf(bflo(u.z) * bflo(mx.z), bfhi(u.z) * bfhi(mx.z)); o.w = pkbf(bflo(u.w) * bflo(mx.w), bfhi(u.w) * bfhi(mx.w));
                *(v4u*)(c.ysgu + (size_t)(t0 + 32 * mt + row) * 1024 + g * 128 + ech) = o; }
            asm volatile("s_waitcnt lgkmcnt(0)" ::: "memory");
            if (gi < 3) SG_STAGE(vgN, lgN, lbN, (gi + 1) & 1);
            SG_BAR;
        }
    }
#undef SG_LOADVG
#undef SG_LOADOPS
#undef SG_STAGE
#undef SG_BAR
}
DEV void naive_sgu(const Ctx& c, LAS unsigned char* lds) {
    LAS float* stats = (LAS float*)lds;
    for (int chunk = c.bid; chunk < 128; chunk += c.G) { const int t0 = chunk * 128;
        __syncthreads(); sgu_stats(c, stats, t0); __syncthreads();
        for (int o = c.tid; o < 128 * 1024; o += NTHREADS) { const int tl = o >> 10, f = o & 1023, g = f >> 7;
            float acc = 0.f;
            for (int s = 0; s <= tl; ++s) { const float v = bf2f(c.proj[(size_t)(t0 + s) * PST + C_VG + f]); const float y = (v - stats[2 * s]) * stats[2 * s + 1] * c.ln_g[f] + c.ln_b[f];
                acc += c.sgu_w[((size_t)g * 128 + tl) * 128 + s] * y; }
            acc += c.sgu_b[g * 128 + tl];
            c.ysgu[(size_t)(t0 + tl) * 1024 + f] = (bf16)(pkbf(bf2f(c.proj[(size_t)(t0 + tl) * PST + C_U + f]) * acc, 0.f) & 0xffff); }
    }
}

DEV void insert3(float v, int n, float& v1, float& v2, float& v3, int& i1, int& i2, int& i3) {
    const bool b1 = v > v1, b2 = v > v2, b3 = v > v3;
    v3 = b2 ? v2 : (b3 ? v : v3); i3 = b2 ? i2 : (b3 ? n : i3);
    v2 = b1 ? v1 : (b2 ? v : v2); i2 = b1 ? i1 : (b2 ? n : i2);
    v1 = b1 ? v : v1; i1 = b1 ? n : i1;
}
constexpr int VT_STRIDE = 520;
constexpr float ATT_C = 0.08838834764831845f * 1.4426950408889634f;
DEV void phase_select(const Ctx& c, unsigned* kcnt) {
    const int lane = c.lane, r = lane & 31, hh = lane >> 5, gw = c.bid * 8 + c.wave, NGW = c.G * 8;
    for (int wt = gw; wt < 16 * NBLK * 8; wt += NGW) {
        const int bh = wt >> 8, j = (wt >> 3) & 31, w = wt & 7, b = bh >> 3, h = bh & 7;
        const int q = j * BLK + 32 * w + r;
        int i1 = -1, i2 = -1, i3 = -1;
        if (j > 0) {
            const bf16* qrow = c.proj + ((size_t)b * SEQ + q) * PST + C_Q + h * HD;
            f32x16 g;
#pragma unroll
            for (int i = 0; i < 16; ++i) g[i] = 0.f;
            const float* km = c.kmp + ((size_t)bh * NBLK + r) * HD; const float* km1 = km + 16 * NBLK * HD;
#pragma unroll
            for (int ks = 0; ks < 8; ++ks) { const bf16x8 qf = *(const bf16x8*)(qrow + 16 * ks + 8 * hh);
                const f32x4 ka = *(const f32x4*)(km + 16 * ks + 8 * hh) + *(const f32x4*)(km1 + 16 * ks + 8 * hh), kb = *(const f32x4*)(km + 16 * ks + 8 * hh + 4) + *(const f32x4*)(km1 + 16 * ks + 8 * hh + 4);
                v4u hi; hi.x = pkbf(ka.x, ka.y); hi.y = pkbf(ka.z, ka.w); hi.z = pkbf(kb.x, kb.y); hi.w = pkbf(kb.z, kb.w);
                v4u lo; lo.x = pkbf(ka.x - bflo(hi.x), ka.y - bfhi(hi.x)); lo.y = pkbf(ka.z - bflo(hi.y), ka.w - bfhi(hi.y)); lo.z = pkbf(kb.x - bflo(hi.z), kb.y - bfhi(hi.z)); lo.w = pkbf(kb.z - bflo(hi.w), kb.w - bfhi(hi.w));
                g = MFMA32(__builtin_bit_cast(bf16x8, hi), qf, g); g = MFMA32(__builtin_bit_cast(bf16x8, lo), qf, g); }
            float v1 = -INFINITY, v2 = -INFINITY, v3 = -INFINITY; int a1 = 0, a2 = 0, a3 = 0;
#pragma unroll
            for (int i = 0; i < 16; ++i) { const int n = crow(i, hh); const float v = (n < j) ? g[i] : -INFINITY; insert3(v, n, v1, v2, v3, a1, a2, a3); }
            const float pv1 = __shfl_xor(v1, 32), pv2 = __shfl_xor(v2, 32), pv3 = __shfl_xor(v3, 32); const int pi1 = __shfl_xor(a1, 32), pi2 = __shfl_xor(a2, 32), pi3 = __shfl_xor(a3, 32);
            insert3(pv1, pi1, v1, v2, v3, a1, a2, a3); insert3(pv2, pi2, v1, v2, v3, a1, a2, a3); insert3(pv3, pi3, v1, v2, v3, a1, a2, a3);
            i1 = v1 > -INFINITY ? a1 : -1; i2 = v2 > -INFINITY ? a2 : -1; i3 = v3 > -INFINITY ? a3 : -1;
        }
        if (hh == 0) *(int4*)(c.sel + ((size_t)bh * SEQ + q) * 4) = make_int4(i1, i2, i3, -1);
    }
}
struct AttItem { unsigned char n, jlo, jhi, own; };
#if ATT_FINE
constexpr int NATT_ITEMS = 58;
__device__ const AttItem ATT_ITEMS[NATT_ITEMS] = {{2,3,6,1}, {0,3,7,0}, {2,13,32,0}, {1,2,4,1}, {0,1,3,1}, {7,8,15,1}, {3,4,7,1}, {0,14,32,0}, {17,18,32,1}, {2,6,13,0}, {3,7,15,0}, {8,9,15,1}, {18,19,32,1}, {8,15,32,0}, {7,15,32,0}, {3,15,32,0}, {1,15,32,0}, {4,5,8,1}, {1,4,8,0}, {9,10,16,1}, {0,7,14,0}, {19,20,32,1}, {4,8,16,0}, {9,16,32,0}, {4,16,32,0}, {10,11,17,1}, {5,6,9,1}, {20,21,32,1}, {11,12,18,1}, {5,9,17,0}, {1,8,15,0}, {10,17,32,0}, {5,17,32,0}, {12,13,19,1}, {21,22,32,1}, {6,7,10,1}, {6,10,18,0}, {11,18,32,0}, {6,18,32,0}, {22,23,32,1}, {13,14,19,1}, {14,15,20,1}, {23,24,32,1}, {13,19,32,0}, {12,19,32,0}, {24,25,32,1}, {15,16,20,1}, {15,20,32,0}, {14,20,32,0}, {16,17,21,1}, {25,26,32,1}, {16,21,32,0}, {26,27,32,1}, {27,28,32,1}, {28,29,32,1}, {29,30,32,1}, {30,31,32,1}, {31,32,32,1}};
#else
constexpr int NATT_ITEMS = 44;
__device__ const AttItem ATT_ITEMS[NATT_ITEMS] = {{9,10,32,1}, {10,11,32,1}, {11,12,32,1}, {0,1,4,1}, {3,4,10,1}, {3,10,32,0}, {4,5,12,1}, {12,13,32,1}, {1,2,5,1}, {0,11,32,0}, {13,14,32,1}, {0,4,11,0}, {5,6,13,1}, {2,3,6,1}, {14,15,32,1}, {4,12,32,0}, {1,12,32,0}, {6,7,14,1}, {15,16,32,1}, {1,5,12,0}, {5,13,32,0}, {2,13,32,0}, {7,8,15,1}, {16,17,32,1}, {6,14,32,0}, {17,18,32,1}, {2,6,13,0}, {8,9,15,1}, {18,19,32,1}, {8,15,32,0}, {7,15,32,0}, {19,20,32,1}, {20,21,32,1}, {21,22,32,1}, {22,23,32,1}, {23,24,32,1}, {24,25,32,1}, {25,26,32,1}, {26,27,32,1}, {27,28,32,1}, {28,29,32,1}, {29,30,32,1}, {30,31,32,1}, {31,32,32,1}};
#endif
constexpr int ATT_LIST_OFF = 65536 + 128 * VT_STRIDE;
constexpr int ATT_LIST_CAP = 2048;
DEV void quant_tables(const Ctx& c, int row0, int row1, int step, int first, LAS unsigned char* scr);
constexpr int NQUANT_ITEMS = 2 * NEXP / 128, QROWS = 64, NQMIX = QUANT_IN_PROLOGUE ? 0 : 2 * NEXP / QROWS;
DEV void phase_attn(const Ctx& c, LAS unsigned char* lds, unsigned* qctr, bool skip_compute = false, bool skip_quant = false) {
    LAS unsigned char* Kl = lds;
    LAS unsigned char* Vl = lds + 65536;
    LAS unsigned* list = (LAS unsigned*)(lds + ATT_LIST_OFF);
    LAS unsigned* lctl = list + ATT_LIST_CAP;
    const int tid = c.tid, lane = c.lane, wave = c.wave, r = lane & 31, hh = lane >> 5;
    bf16* partO = (bf16*)c.out;
    for (;;) {
        __syncthreads();
        if (tid == 0) lctl[1] = atomicAdd(qctr, 1u);
        __syncthreads();
        const int item = (int)lctl[1];
        if (item >= NATT_ITEMS * 16 + (ATT_MIX ? NQMIX : NQUANT_ITEMS)) break;
#if QUANT_FIRST
        if (item < NQUANT_ITEMS) { const int r0 = item * 128; quant_tables(c, r0, r0 + 128, 8, wave, lds + wave * 2048); continue; }
        const int aitem = item - NQUANT_ITEMS;
#else
#if ATT_MIX
        int aitem;
        if (item < 2 * NQMIX) { if (item & 1) { const int r0 = (item >> 1) * QROWS; if (!skip_quant) quant_tables(c, r0, r0 + QROWS, 8, wave, lds + wave * 2048); continue; } aitem = item >> 1; }
        else aitem = item - NQMIX;
#else
        if (item >= NATT_ITEMS * 16) { const int r0 = (item - NATT_ITEMS * 16) * 128; if (!skip_quant) quant_tables(c, r0, r0 + 128, 8, wave, lds + wave * 2048); continue; }
        const int aitem = item;
#endif
#endif
        const AttItem it = ATT_ITEMS[aitem >> 4]; const int bh = aitem & 15, n = it.n, b = bh >> 3, h = bh & 7;
        const size_t tb = (size_t)b * SEQ;
        { const bf16* kg = c.proj + (tb + (size_t)n * BLK) * PST + C_K + h * HD; const bf16* vg = c.proj + (tb + (size_t)n * BLK) * PST + C_V + h * HD;
#pragma unroll 1
          for (int qb = 0; qb < 8; qb += 4) {
              v4u kv[4], vv[4];
#pragma unroll
              for (int q = 0; q < 4; ++q) { const int ch = tid + NTHREADS * (qb + q); kv[q] = *(const v4u*)(kg + (size_t)(ch >> 4) * PST + (ch & 15) * 8); vv[q] = *(const v4u*)(vg + (size_t)(ch & 255) * PST + (ch >> 8) * 8); }
#pragma unroll
              for (int q = 0; q < 4; ++q) { const int ch = tid + NTHREADS * (qb + q); const int key = ch >> 4, c16 = ch & 15;
                  *(LAS v4u*)(Kl + key * 256 + ((c16 ^ (key & 15)) << 4)) = kv[q];
                  const int vk = ch & 255, dc = ch >> 8; LAS unsigned char* vp = Vl + (8 * dc) * VT_STRIDE + vk * 2;
                  const unsigned ww[4] = {vv[q].x, vv[q].y, vv[q].z, vv[q].w};
#pragma unroll
                  for (int i = 0; i < 4; ++i) { *(LAS bf16*)(vp + (2 * i) * VT_STRIDE) = (bf16)(ww[i] & 0xffffu); *(LAS bf16*)(vp + (2 * i + 1) * VT_STRIDE) = (bf16)(ww[i] >> 16); } } } }
        const int qlo = it.jlo * BLK, qhi = it.jhi * BLK;
        bool own_pending = it.own != 0;
        for (int cq = qlo; cq < qhi || own_pending; cq += ATT_LIST_CAP) {
            __syncthreads();
            if (tid == 0) lctl[0] = 0u;
            __syncthreads();
            const int cend = (cq + ATT_LIST_CAP < qhi) ? cq + ATT_LIST_CAP : qhi;
            for (int q = cq + tid; q < cend; q += NTHREADS) {
                const int4 s4 = *(const int4*)(c.sel + ((size_t)bh * SEQ + q) * 4);
                const int slot = (s4.x == n) ? 0 : ((s4.y == n) ? 1 : ((s4.z == n) ? 2 : -1));
                if (slot >= 0) { const unsigned pos = __hip_atomic_fetch_add(lctl, 1u, __ATOMIC_RELAXED, __HIP_MEMORY_SCOPE_WORKGROUP); list[pos] = (unsigned)q | ((unsigned)slot << 16); }
            }
            __syncthreads();
            const int len = (int)lctl[0];
            const int nown = own_pending ? 8 : 0, ngroups = nown + ((len + 31) >> 5);
            for (int gi = wave; gi < (skip_compute ? 0 : ngroups); gi += 8) {
                const bool own = gi < nown;
                int q, slot; bool valid = true;
                if (own) { q = n * BLK + 32 * gi + r; slot = 3; }
                else { const int li = 32 * (gi - nown) + r; valid = li < len; const unsigned e = list[valid ? li : 32 * (gi - nown)]; q = (int)(e & 0xffffu); slot = (int)(e >> 16); }
                const int qloc = 32 * gi + r;
                const bf16* qrow = c.proj + (tb + q) * PST + C_Q + h * HD;
                bf16x8 qf[8];
#pragma unroll
                for (int ks = 0; ks < 8; ++ks) qf[ks] = *(const bf16x8*)(qrow + 16 * ks + 8 * hh);
                float m = -INFINITY, l = 0.f;
                f32x16 o[4];
#pragma unroll
                for (int dt = 0; dt < 4; ++dt)
#pragma unroll
                    for (int i = 0; i < 16; ++i) o[dt][i] = 0.f;
                const int nsteps = own ? ((gi >> 1) + 1) : 4;
                for (int st = 0; st < nsteps; ++st) {
                    f32x16 s0, s1;
#pragma unroll
                    for (int i = 0; i < 16; ++i) { s0[i] = 0.f; s1[i] = 0.f; }
                    const int kr0 = 64 * st + r, kr1 = kr0 + 32;
#pragma unroll
                    for (int ks = 0; ks < 8; ++ks) { const int c16 = 2 * ks + hh;
                        const bf16x8 a0 = *(const LAS bf16x8*)(Kl + kr0 * 256 + ((c16 ^ (kr0 & 15)) << 4)), a1 = *(const LAS bf16x8*)(Kl + kr1 * 256 + ((c16 ^ (kr1 & 15)) << 4));
                        s0 = MFMA32(a0, qf[ks], s0); s1 = MFMA32(a1, qf[ks], s1); }
                    float mx = -INFINITY;
                    if (own) {
#pragma unroll
                        for (int i = 0; i < 16; ++i) { const int k0 = 64 * st + crow(i, hh), k1 = k0 + 32;
                            s0[i] = (k0 <= qloc) ? s0[i] * ATT_C : -INFINITY; s1[i] = (k1 <= qloc) ? s1[i] * ATT_C : -INFINITY; mx = fmaxf(mx, fmaxf(s0[i], s1[i])); }
                    } else {
#pragma unroll
                        for (int i = 0; i < 16; ++i) mx = fmaxf(mx, fmaxf(s0[i], s1[i]));
                        mx *= ATT_C;
                    }
                    { const auto rr = __builtin_amdgcn_permlane32_swap(__float_as_uint(mx), __float_as_uint(mx), false, false); mx = fmaxf(__uint_as_float(rr[0]), __uint_as_float(rr[1])); }
                    const float mn = fmaxf(m, mx);
                    const float alpha = __builtin_amdgcn_exp2f(m - mn);
                    float ps = 0.f;
                    if (own) {
#pragma unroll
                        for (int i = 0; i < 16; ++i) { s0[i] = __builtin_amdgcn_exp2f(s0[i] - mn); s1[i] = __builtin_amdgcn_exp2f(s1[i] - mn); ps += s0[i] + s1[i]; }
                    } else {
#pragma unroll
                        for (int i = 0; i < 16; ++i) { s0[i] = __builtin_amdgcn_exp2f(fmaf(s0[i], ATT_C, -mn)); s1[i] = __builtin_amdgcn_exp2f(fmaf(s1[i], ATT_C, -mn)); ps += s0[i] + s1[i]; }
                    }
                    l = l * alpha + ps; m = mn;
                    if (__any(alpha != 1.0f)) {
#pragma unroll
                        for (int dt = 0; dt < 4; ++dt)
#pragma unroll
                            for (int i = 0; i < 16; ++i) o[dt][i] *= alpha;
                    }
                    bf16x8 pf[2][2];
#pragma unroll
                    for (int s = 0; s < 2; ++s) {
                        v4u w0, w1;
                        w0.x = pkbf(s0[8 * s + 0], s0[8 * s + 1]); w0.y = pkbf(s0[8 * s + 2], s0[8 * s + 3]); w0.z = pkbf(s0[8 * s + 4], s0[8 * s + 5]); w0.w = pkbf(s0[8 * s + 6], s0[8 * s + 7]);
                        w1.x = pkbf(s1[8 * s + 0], s1[8 * s + 1]); w1.y = pkbf(s1[8 * s + 2], s1[8 * s + 3]); w1.z = pkbf(s1[8 * s + 4], s1[8 * s + 5]); w1.w = pkbf(s1[8 * s + 6], s1[8 * s + 7]);
                        pf[0][s] = __builtin_bit_cast(bf16x8, w0); pf[1][s] = __builtin_bit_cast(bf16x8, w1); }
#pragma unroll
                    for (int dt = 0; dt < 4; ++dt)
#pragma unroll
                        for (int kt = 0; kt < 2; ++kt)
#pragma unroll
                            for (int s = 0; s < 2; ++s) {
                                const LAS unsigned char* vp = Vl + (32 * dt + r) * VT_STRIDE + (64 * st + 32 * kt + 16 * s + 4 * hh) * 2;
                                const v2u lo = *(const LAS v2u*)vp, hi = *(const LAS v2u*)(vp + 16);
                                const v4u vw = {lo.x, lo.y, hi.x, hi.y};
                                o[dt] = MFMA32(__builtin_bit_cast(bf16x8, vw), pf[kt][s], o[dt]); }
                }
                { const auto rr = __builtin_amdgcn_permlane32_swap(__float_as_uint(l), __float_as_uint(l), false, false); l = __uint_as_float(rr[0]) + __uint_as_float(rr[1]); }
                const float inv = 1.0f / l;
                if (valid) {
                    const size_t pidx = ((size_t)bh * SEQ + q) * 4 + slot;
                    bf16* yp = partO + pidx * HD;
#pragma unroll
                    for (int dt = 0; dt < 4; ++dt)
#pragma unroll
                        for (int g4 = 0; g4 < 4; ++g4) { v2u w; w.x = pkbf(o[dt][4 * g4] * inv, o[dt][4 * g4 + 1] * inv); w.y = pkbf(o[dt][4 * g4 + 2] * inv, o[dt][4 * g4 + 3] * inv);
                            *(v2u*)(yp + 32 * dt + 8 * g4 + 4 * hh) = w; }
                    if (hh == 0) c.lse[pidx] = m + __builtin_amdgcn_logf(l);
                }
            }
            own_pending = false;
        }
    }
}
DEV void phase_attn_combine(const Ctx& c) {
    const int lane = c.lane, gw = c.bid * 8 + c.wave, NGW = c.G * 8, h = lane >> 3, sub = lane & 7;
    const bf16* partO = (const bf16*)c.out;
    const int t0c = c.grp ? 256 * c.pm + 64 * c.kq + 8 * c.wave : gw, tstep = c.grp ? 1 : NGW, tend = c.grp ? t0c + 8 : T;
    for (int t = t0c; t < tend; t += 2 * tstep) {
        int4 s4[2]; f32x4 L[2]; v4u sg0[2], sg1[2]; size_t pbase[2];
#pragma unroll
        for (int u = 0; u < 2; ++u) { const int tt = t + u * tstep; const int b = tt / SEQ, q = tt % SEQ; pbase[u] = ((size_t)(b * NH + h) * SEQ + q) * 4;
            s4[u] = *(const int4*)(c.sel + pbase[u]); L[u] = *(const f32x4*)(c.lse + pbase[u]);
            sg0[u] = *(const v4u*)(c.ysgu + (size_t)tt * 1024 + h * HD + 16 * sub); sg1[u] = *(const v4u*)(c.ysgu + (size_t)tt * 1024 + h * HD + 16 * sub + 8); }
        float ws[2][4];
#pragma unroll
        for (int u = 0; u < 2; ++u) {
            const float l0 = s4[u].x >= 0 ? L[u].x : -INFINITY, l1 = s4[u].y >= 0 ? L[u].y : -INFINITY, l2 = s4[u].z >= 0 ? L[u].z : -INFINITY, l3 = L[u].w;
            const float M = fmaxf(fmaxf(l0, l1), fmaxf(l2, l3));
            const float w0 = __builtin_amdgcn_exp2f(l0 - M), w1 = __builtin_amdgcn_exp2f(l1 - M), w2 = __builtin_amdgcn_exp2f(l2 - M), w3 = __builtin_amdgcn_exp2f(l3 - M);
            const float winv = 1.0f / (w0 + w1 + w2 + w3);
            ws[u][0] = w0 * winv; ws[u][1] = w1 * winv; ws[u][2] = w2 * winv; ws[u][3] = w3 * winv; }
        v4u pa[2][4], pq[2][4];
#pragma unroll
        for (int u = 0; u < 2; ++u)
#pragma unroll
            for (int s = 0; s < 4; ++s) { pa[u][s] = (v4u){0u, 0u, 0u, 0u}; pq[u][s] = (v4u){0u, 0u, 0u, 0u};
                if (ws[u][s] != 0.f) { pa[u][s] = *(const v4u*)(partO + (pbase[u] + s) * HD + 16 * sub); pq[u][s] = *(const v4u*)(partO + (pbase[u] + s) * HD + 16 * sub + 8); } }
#pragma unroll
        for (int u = 0; u < 2; ++u) { const int tt = t + u * tstep;
            float acc[16];
#pragma unroll
            for (int i = 0; i < 16; ++i) acc[i] = 0.f;
#pragma unroll
            for (int s = 0; s < 4; ++s) { const v4u a = pa[u][s], bq = pq[u][s]; const float w = ws[u][s];
                acc[0] += w * bflo(a.x); acc[1] += w * bfhi(a.x); acc[2] += w * bflo(a.y); acc[3] += w * bfhi(a.y); acc[4] += w * bflo(a.z); acc[5] += w * bfhi(a.z); acc[6] += w * bflo(a.w); acc[7] += w * bfhi(a.w);
                acc[8] += w * bflo(bq.x); acc[9] += w * bfhi(bq.x); acc[10] += w * bflo(bq.y); acc[11] += w * bfhi(bq.y); acc[12] += w * bflo(bq.z); acc[13] += w * bfhi(bq.z); acc[14] += w * bflo(bq.w); acc[15] += w * bfhi(bq.w); }
            const v4u g0 = sg0[u], g1 = sg1[u];
            float am = 0.f;
#pragma unroll
            for (int i = 0; i < 16; ++i) am = fmaxf(am, fabsf(acc[i]));
            am = fmaxf(am, fmaxf(fmaxf(fmaxf(fabsf(bflo(g0.x)), fabsf(bfhi(g0.x))), fmaxf(fabsf(bflo(g0.y)), fabsf(bfhi(g0.y)))), fmaxf(fmaxf(fabsf(bflo(g0.z)), fabsf(bfhi(g0.z))), fmaxf(fabsf(bflo(g0.w)), fabsf(bfhi(g0.w))))));
            am = fmaxf(am, fmaxf(fmaxf(fmaxf(fabsf(bflo(g1.x)), fabsf(bfhi(g1.x))), fmaxf(fabsf(bflo(g1.y)), fabsf(bfhi(g1.y)))), fmaxf(fmaxf(fabsf(bflo(g1.z)), fabsf(bfhi(g1.z))), fmaxf(fabsf(bflo(g1.w)), fabsf(bfhi(g1.w))))));
            am = wmax_q(am);
            const float inv = am > 0.f ? 127.0f / am : 0.f;
            unsigned char* brow = (unsigned char*)(c.proj + (size_t)tt * PST) + h * HD + 16 * sub;
            *(v4u*)brow = (v4u){q4(acc[0], acc[1], acc[2], acc[3], inv, 0), q4(acc[4], acc[5], acc[6], acc[7], inv, 0), q4(acc[8], acc[9], acc[10], acc[11], inv, 0), q4(acc[12], acc[13], acc[14], acc[15], inv, 0)};
            *(v4u*)(brow + 1024) = (v4u){q4(bflo(g0.x), bfhi(g0.x), bflo(g0.y), bfhi(g0.y), inv, 0), q4(bflo(g0.z), bfhi(g0.z), bflo(g0.w), bfhi(g0.w), inv, 0),
                                         q4(bflo(g1.x), bfhi(g1.x), bflo(g1.y), bfhi(g1.y), inv, 0), q4(bflo(g1.z), bfhi(g1.z), bflo(g1.w), bfhi(g1.w), inv, 0)};
            if (lane == 0) c.bs[tt] = am * (1.0f / 127.0f); }
    }
}
DEV void phase_attn_combine_1row(const Ctx& c) {
    const int lane = c.lane, gw = c.bid * 8 + c.wave, NGW = c.G * 8, h = lane >> 3, sub = lane & 7;
    const bf16* partO = (const bf16*)c.out;
    const int t0c = c.grp ? 256 * c.pm + 64 * c.kq + 8 * c.wave : gw, tstep = c.grp ? 1 : NGW, tend = c.grp ? t0c + 8 : T;
    for (int t = t0c; t < tend; t += tstep) {
        const int b = t / SEQ, q = t % SEQ; const size_t pbase = ((size_t)(b * NH + h) * SEQ + q) * 4;
        const int4 s4 = *(const int4*)(c.sel + pbase); const f32x4 L = *(const f32x4*)(c.lse + pbase);
#if BI8
        const v4u sg0 = *(const v4u*)(c.ysgu + (size_t)t * 1024 + h * HD + 16 * sub), sg1 = *(const v4u*)(c.ysgu + (size_t)t * 1024 + h * HD + 16 * sub + 8);
#endif
        const float l0 = s4.x >= 0 ? L.x : -INFINITY, l1 = s4.y >= 0 ? L.y : -INFINITY, l2 = s4.z >= 0 ? L.z : -INFINITY, l3 = L.w;
        const float M = fmaxf(fmaxf(l0, l1), fmaxf(l2, l3));
        const float w0 = __builtin_amdgcn_exp2f(l0 - M), w1 = __builtin_amdgcn_exp2f(l1 - M), w2 = __builtin_amdgcn_exp2f(l2 - M), w3 = __builtin_amdgcn_exp2f(l3 - M);
        const float winv = 1.0f / (w0 + w1 + w2 + w3);
        const float ws[4] = {w0 * winv, w1 * winv, w2 * winv, w3 * winv};
        float acc[16];
#pragma unroll
        for (int i = 0; i < 16; ++i) acc[i] = 0.f;
#pragma unroll
        for (int s = 0; s < 4; ++s) { if (ws[s] != 0.f) { const v4u a = *(const v4u*)(partO + (pbase + s) * HD + 16 * sub), bq = *(const v4u*)(partO + (pbase + s) * HD + 16 * sub + 8); const float w = ws[s];
            acc[0] += w * bflo(a.x); acc[1] += w * bfhi(a.x); acc[2] += w * bflo(a.y); acc[3] += w * bfhi(a.y); acc[4] += w * bflo(a.z); acc[5] += w * bfhi(a.z); acc[6] += w * bflo(a.w); acc[7] += w * bfhi(a.w);
            acc[8] += w * bflo(bq.x); acc[9] += w * bfhi(bq.x); acc[10] += w * bflo(bq.y); acc[11] += w * bfhi(bq.y); acc[12] += w * bflo(bq.z); acc[13] += w * bfhi(bq.z); acc[14] += w * bflo(bq.w); acc[15] += w * bfhi(bq.w); } }
        v4u o0, o1; o0.x = pkbf(acc[0], acc[1]); o0.y = pkbf(acc[2], acc[3]); o0.z = pkbf(acc[4], acc[5]); o0.w = pkbf(acc[6], acc[7]); o1.x = pkbf(acc[8], acc[9]); o1.y = pkbf(acc[10], acc[11]); o1.z = pkbf(acc[12], acc[13]); o1.w = pkbf(acc[14], acc[15]);
#if BI8
        (void)o0; (void)o1;
        float am = 0.f;
#pragma unroll
        for (int i = 0; i < 16; ++i) am = fmaxf(am, fabsf(acc[i]));
        am = fmaxf(am, fmaxf(fmaxf(fmaxf(fabsf(bflo(sg0.x)), fabsf(bfhi(sg0.x))), fmaxf(fabsf(bflo(sg0.y)), fabsf(bfhi(sg0.y)))), fmaxf(fmaxf(fabsf(bflo(sg0.z)), fabsf(bfhi(sg0.z))), fmaxf(fabsf(bflo(sg0.w)), fabsf(bfhi(sg0.w))))));
        am = fmaxf(am, fmaxf(fmaxf(fmaxf(fabsf(bflo(sg1.x)), fabsf(bfhi(sg1.x))), fmaxf(fabsf(bflo(sg1.y)), fabsf(bfhi(sg1.y)))), fmaxf(fmaxf(fabsf(bflo(sg1.z)), fabsf(bfhi(sg1.z))), fmaxf(fabsf(bflo(sg1.w)), fabsf(bfhi(sg1.w))))));
        am = wmax_q(am);
        const float inv = am > 0.f ? 127.0f / am : 0.f;
        unsigned char* brow = (unsigned char*)(c.proj + (size_t)t * PST) + h * HD + 16 * sub;
        *(v4u*)brow = (v4u){q4(acc[0], acc[1], acc[2], acc[3], inv, 0), q4(acc[4], acc[5], acc[6], acc[7], inv, 0), q4(acc[8], acc[9], acc[10], acc[11], inv, 0), q4(acc[12], acc[13], acc[14], acc[15], inv, 0)};
        *(v4u*)(brow + 1024) = (v4u){q4(bflo(sg0.x), bfhi(sg0.x), bflo(sg0.y), bfhi(sg0.y), inv, 0), q4(bflo(sg0.z), bfhi(sg0.z), bflo(sg0.w), bfhi(sg0.w), inv, 0),
                                     q4(bflo(sg1.x), bfhi(sg1.x), bflo(sg1.y), bfhi(sg1.y), inv, 0), q4(bflo(sg1.z), bfhi(sg1.z), bflo(sg1.w), bfhi(sg1.w), inv, 0)};
        if (lane == 0) c.bs[t] = am * (1.0f / 127.0f);
#else
        bf16* yp = c.yatt + (size_t)t * 1024 + h * HD + 16 * sub; *(v4u*)yp = o0; *(v4u*)(yp + 8) = o1;
#endif
    }
}
DEV void naive_attn(const Ctx& c, LAS unsigned char* lds) {
    LAS float* qs = (LAS float*)(lds + c.wave * 5120);
    LAS float* sc = qs + 128;
    const int lane = c.lane, gw = c.bid * 8 + c.wave, NGW = c.G * 8;
    for (int idx = gw; idx < 16 * SEQ; idx += NGW) {
        const int bh = idx / SEQ, sq = idx % SEQ, j = sq / BLK, b = bh >> 3, h = bh & 7; const size_t tb = (size_t)b * SEQ;
        const unsigned qw = *(const unsigned*)(c.proj + (tb + sq) * PST + C_Q + h * HD + 2 * lane);
        const float qa = bflo(qw), qb = bfhi(qw);
        qs[2 * lane] = qa; qs[2 * lane + 1] = qb;
        float v1 = -INFINITY, v2 = -INFINITY, v3 = -INFINITY; int i1 = 0, i2 = 0, i3 = 0;
        for (int n = 0; n < j; ++n) { const f32x2 km = *(const f32x2*)(c.kmean + ((size_t)bh * NBLK + n) * HD + 2 * lane); const float g = wave_sum(qa * km.x + qb * km.y); insert3(g, n, v1, v2, v3, i1, i2, i3); }
        const int nsel = j < 3 ? j : 3;
        asm volatile("s_waitcnt lgkmcnt(0)" ::: "memory");
        float mx = -INFINITY;
        for (int bi = 0; bi <= nsel; ++bi) { const int n = (bi == nsel) ? j : (bi == 0 ? i1 : (bi == 1 ? i2 : i3));
            for (int kk = lane; kk < BLK; kk += 64) { const int kpos = n * BLK + kk; float s = -INFINITY;
                if (kpos <= sq) { const bf16* kp = c.proj + (tb + kpos) * PST + C_K + h * HD; float a = 0.f;
                    for (int d = 0; d < HD; d += 2) { const unsigned w = *(const unsigned*)(kp + d); a += qs[d] * bflo(w) + qs[d + 1] * bfhi(w); }
                    s = a * 0.08838834764831845f; }
                sc[bi * BLK + kk] = s; mx = fmaxf(mx, s); } }
#pragma unroll
        for (int o = 1; o < 64; o <<= 1) mx = fmaxf(mx, __shfl_xor(mx, o));
        asm volatile("s_waitcnt lgkmcnt(0)" ::: "memory");
        float sum = 0.f, oa = 0.f, ob = 0.f;
        for (int bi = 0; bi <= nsel; ++bi) { const int n = (bi == nsel) ? j : (bi == 0 ? i1 : (bi == 1 ? i2 : i3));
            for (int kk = 0; kk < BLK; ++kk) { const float pz = __expf(sc[bi * BLK + kk] - mx); if (pz == 0.f) continue;
                const unsigned w = *(const unsigned*)(c.proj + (tb + n * BLK + kk) * PST + C_V + h * HD + 2 * lane); sum += pz; oa += pz * bflo(w); ob += pz * bfhi(w); } }
        *(unsigned*)(c.yatt + (tb + sq) * 1024 + h * HD + 2 * lane) = pkbf(oa / sum, ob / sum);
    }
}


DEV void phase_final(const Ctx& c) {
    const int lane = c.lane; int m, mstep, mend; xcd_rows(c, m, mstep, mend);
    const int NGW = mstep;
    const f32x4* gr = (const f32x4*)c.g_fin + lane;
    f32x4 gv[8];
#pragma unroll
    for (int j = 0; j < 8; ++j) gv[j] = gr[64 * j];
    v2u vn[8];
    if (m < mend) { const v2u* xr = (const v2u*)(c.h2b + (size_t)m * D) + lane;
#pragma unroll
        for (int j = 0; j < 8; ++j) vn[j] = __builtin_nontemporal_load(xr + 64 * j); }
    for (; m < mend; m += NGW) {
        f32x4 v[8]; float s = 0.f;
#pragma unroll
        for (int j = 0; j < 8; ++j) { v[j] = (f32x4){bflo(vn[j].x), bfhi(vn[j].x), bflo(vn[j].y), bfhi(vn[j].y)}; s += (v[j].x * v[j].x + v[j].y * v[j].y) + (v[j].z * v[j].z + v[j].w * v[j].w); }
        { const int mn = m + NGW < mend ? m + NGW : m; const v2u* xn_ = (const v2u*)(c.h2b + (size_t)mn * D) + lane;
#pragma unroll
          for (int j = 0; j < 8; ++j) vn[j] = __builtin_nontemporal_load(xn_ + 64 * j); }
        const float r = 1.0f / sqrtf(wsum_q(s) * (1.0f / D) + EPS);
        f32x4* xr = (f32x4*)(c.out + (size_t)m * D) + lane;
#pragma unroll
        for (int j = 0; j < 8; ++j) __builtin_nontemporal_store(v[j] * r * gv[j], xr + 64 * j);
    }
}

DEV unsigned f2key(float f) { const unsigned u = __float_as_uint(f); return u ^ ((unsigned)((int)u >> 31) | 0x80000000u); }
DEV float key2f(unsigned k) { const unsigned u = (k & 0x80000000u) ? (k ^ 0x80000000u) : ~k; return __uint_as_float(u); }
#define TK_INSERT(L, key) do { unsigned _k = (key); _Pragma("unroll") for (int _j = 0; _j < 16; ++_j) { const unsigned _hi = max(L[_j], _k); _k = min(L[_j], _k); L[_j] = _hi; } } while (0)
#define TK_MERGE(a, b) do { _Pragma("unroll") for (int _i = 0; _i < 16; ++_i) a[_i] = max(a[_i], b[15 - _i]); \
    _Pragma("unroll") for (int _st = 8; _st >= 1; _st >>= 1) { _Pragma("unroll") for (int _i = 0; _i < 16; ++_i) if ((_i & _st) == 0) { const unsigned _x = max(a[_i], a[_i + _st]), _y = min(a[_i], a[_i + _st]); a[_i] = _x; a[_i + _st] = _y; } } } while (0)
#define TK_CE(a, i, j) do { const unsigned _x = max(a[i], a[j]), _y = min(a[i], a[j]); a[i] = _x; a[j] = _y; } while (0)
#define TK_SORT16(a) do { TK_CE(a, 0, 1); TK_CE(a, 2, 3); TK_CE(a, 0, 2); TK_CE(a, 1, 3); TK_CE(a, 1, 2); TK_CE(a, 4, 5); TK_CE(a, 6, 7); TK_CE(a, 4, 6); TK_CE(a, 5, 7); TK_CE(a, 5, 6); TK_CE(a, 0, 4); TK_CE(a, 2, 6); TK_CE(a, 2, 4); TK_CE(a, 1, 5); TK_CE(a, 3, 7); TK_CE(a, 3, 5); TK_CE(a, 1, 2); TK_CE(a, 3, 4); TK_CE(a, 5, 6); TK_CE(a, 8, 9); TK_CE(a, 10, 11); TK_CE(a, 8, 10); TK_CE(a, 9, 11); TK_CE(a, 9, 10); TK_CE(a, 12, 13); TK_CE(a, 14, 15); TK_CE(a, 12, 14); TK_CE(a, 13, 15); TK_CE(a, 13, 14); TK_CE(a, 8, 12); TK_CE(a, 10, 14); TK_CE(a, 10, 12); TK_CE(a, 9, 13); TK_CE(a, 11, 15); TK_CE(a, 11, 13); TK_CE(a, 9, 10); TK_CE(a, 11, 12); TK_CE(a, 13, 14); TK_CE(a, 0, 8); TK_CE(a, 4, 12); TK_CE(a, 4, 8); TK_CE(a, 2, 10); TK_CE(a, 6, 14); TK_CE(a, 6, 10); TK_CE(a, 2, 4); TK_CE(a, 6, 8); TK_CE(a, 10, 12); TK_CE(a, 1, 9); TK_CE(a, 5, 13); TK_CE(a, 5, 9); TK_CE(a, 3, 11); TK_CE(a, 7, 15); TK_CE(a, 7, 11); TK_CE(a, 3, 5); TK_CE(a, 7, 9); TK_CE(a, 11, 13); TK_CE(a, 1, 2); TK_CE(a, 3, 4); TK_CE(a, 5, 6); TK_CE(a, 7, 8); TK_CE(a, 9, 10); TK_CE(a, 11, 12); TK_CE(a, 13, 14); } while (0)
DEV void peer_topk_task(const Ctx& c, int tg, int h) {
    const int lane = c.lane, r = lane & 31, hh = lane >> 5;
    {
        const int tok = tg * 32 + r;
        unsigned LA[16], LB[16];
#pragma unroll
        for (int p = 0; p < 2; ++p) {
            const bf16* qrow = c.qp + (size_t)tok * D + h * 256 + p * 128;
            bf16x8 qf[8];
#pragma unroll
            for (int ks = 0; ks < 8; ++ks) qf[ks] = *(const bf16x8*)(qrow + 16 * ks + 8 * hh);
            unsigned L[16];
            const bf16* skp = c.skb + ((size_t)(h * 2 + p) * 128) * 128;
            bf16x8 an[8];
#pragma unroll
            for (int ks = 0; ks < 8; ++ks) an[ks] = *(const bf16x8*)(skp + (size_t)r * 128 + 16 * ks + 8 * hh);
#pragma unroll 1
            for (int nt = 0; nt < 4; ++nt) {
                f32x16 s;
#pragma unroll
                for (int i = 0; i < 16; ++i) s[i] = 0.f;
                bf16x8 ac[8];
#pragma unroll
                for (int ks = 0; ks < 8; ++ks) ac[ks] = an[ks];
                { const int ntn = nt < 3 ? nt + 1 : 3;
#pragma unroll
                  for (int ks = 0; ks < 8; ++ks) an[ks] = *(const bf16x8*)(skp + (size_t)(32 * ntn + r) * 128 + 16 * ks + 8 * hh); }
#pragma unroll
                for (int ks = 0; ks < 8; ++ks) s = MFMA32(ac[ks], qf[ks], s);
                unsigned Tl[16];
#pragma unroll
                for (int i = 0; i < 16; ++i) Tl[i] = (f2key(s[i]) & ~0x7Fu) | (unsigned)(32 * nt + crow(i, hh));
                TK_SORT16(Tl);
                if (nt == 0) {
#pragma unroll
                    for (int i = 0; i < 16; ++i) L[i] = Tl[i];
                } else { TK_MERGE(L, Tl); }
            }
            unsigned PL[16];
#pragma unroll
            for (int i = 0; i < 16; ++i) PL[i] = (unsigned)__shfl_xor((int)L[i], 32);
            TK_MERGE(L, PL);
#pragma unroll
            for (int i = 0; i < 16; ++i) { if (p == 0) LA[i] = L[i]; else LB[i] = L[i]; }
        }
        float va[16], vb[16];
#pragma unroll
        for (int i = 0; i < 16; ++i) { va[i] = key2f(LA[i] & ~0x7Fu); vb[i] = key2f(LB[i] & ~0x7Fu); }
        unsigned CL[16];
#pragma unroll
        for (int i = 0; i < 16; ++i) { const float bsel = hh ? vb[1] : vb[0]; const bool okj = hh ? (i < 8) : true;
            CL[i] = okj ? ((f2key(va[i] + bsel) & ~0xFFu) | (unsigned)(i * 16 + hh)) : 0u; }
        {
            unsigned CB[16]; int nc = 0;
#pragma unroll
            for (int i = 0; i < 16; ++i)
#pragma unroll
                for (int m = 1; m < 8; ++m) if ((i + 1) * (2 * m + 1) <= 16) {
                    const float bsel = hh ? vb[2 * m + 1] : vb[2 * m];
                    const bool okj = hh ? ((i + 1) * (2 * m + 2) <= 16) : true;
                    CB[nc++] = okj ? ((f2key(va[i] + bsel) & ~0xFFu) | (unsigned)(i * 16 + 2 * m + hh)) : 0u; }
#pragma unroll
            for (int i = 14; i < 16; ++i) CB[i] = 0u;
            TK_SORT16(CB); TK_MERGE(CL, CB); }
        { unsigned PC[16];
#pragma unroll
          for (int i = 0; i < 16; ++i) PC[i] = (unsigned)__shfl_xor((int)CL[i], 32);
          TK_MERGE(CL, PC); }
        unsigned pa[4], pb[4];
#pragma unroll
        for (int w = 0; w < 4; ++w) { pa[w] = (LA[4 * w] & 0x7Fu) | ((LA[4 * w + 1] & 0x7Fu) << 8) | ((LA[4 * w + 2] & 0x7Fu) << 16) | ((LA[4 * w + 3] & 0x7Fu) << 24);
                                      pb[w] = (LB[4 * w] & 0x7Fu) | ((LB[4 * w + 1] & 0x7Fu) << 8) | ((LB[4 * w + 2] & 0x7Fu) << 16) | ((LB[4 * w + 3] & 0x7Fu) << 24); }
        float r1; { float ss = 0.f; const f32x4* rp = (const f32x4*)(c.rss + (size_t)tok * 32);
#pragma unroll
            for (int i = 0; i < 8; ++i) { const f32x4 t4 = rp[i]; ss += (t4.x + t4.y) + (t4.z + t4.w); }
            r1 = 1.0f / sqrtf(ss * (1.0f / D) + EPS); }
        float sv[16]; float ssum = 0.f; const float smax = key2f(CL[0] & ~0xFFu);
#pragma unroll
        for (int k = 0; k < 16; ++k) { sv[k] = __expf((key2f(CL[k] & ~0xFFu) - smax) * r1); ssum += sv[k]; }
        const float sinv = 1.0f / ssum;
        int* ep = c.eid + (size_t)tok * 128 + h * 16; float* gp = c.egate + (size_t)tok * 128 + h * 16;
#pragma unroll
        for (int k = 0; k < 16; ++k) {
            const unsigned ci = (CL[k] >> 4) & 15u, cj = CL[k] & 15u;
            const unsigned wa = (ci >> 2) == 0 ? pa[0] : ((ci >> 2) == 1 ? pa[1] : ((ci >> 2) == 2 ? pa[2] : pa[3]));
            const unsigned wb = (cj >> 2) == 0 ? pb[0] : ((cj >> 2) == 1 ? pb[1] : ((cj >> 2) == 2 ? pb[2] : pb[3]));
            const unsigned ia = (wa >> ((ci & 3u) * 8u)) & 0x7Fu, ib = (wb >> ((cj & 3u) * 8u)) & 0x7Fu;
            if (hh == 0) ep[k] = (int)(ia * 128u + ib); else gp[k] = sv[k] * sinv;
        }
    }
}
DEV void phase_peer_topk(const Ctx& c) {
    const int gw = c.bid * 8 + c.wave, NGW = c.G * 8;
    for (int wt = gw; wt < (T / 32) * NH; wt += NGW) peer_topk_task(c, wt >> 3, wt & 7);
}
DEV void naive_peer_topk(const Ctx& c) {
    const int lane = c.lane, gw = c.bid * 8 + c.wave, NGW = c.G * 8;
    for (int wt = gw; wt < T * NH; wt += NGW) {
        const int tok = wt >> 3, h = wt & 7;
        float ts[2][16]; int ti[2][16];
#pragma unroll
        for (int p = 0; p < 2; ++p) {
            const bf16* qrow = c.qp + (size_t)tok * D + h * 256 + p * 128;
            float s0 = 0.f, s1 = 0.f;
            const bf16* k0 = c.skb + ((size_t)(h * 2 + p) * 128 + lane) * 128; const bf16* k1 = k0 + 64 * 128;
            for (int d = 0; d < 128; ++d) { const float q = bf2f(qrow[d]); s0 += q * bf2f(k0[d]); s1 += q * bf2f(k1[d]); }
#pragma unroll
            for (int k = 0; k < 16; ++k) {
                float best = fmaxf(s0, s1); int bi = (s0 >= s1) ? lane : lane + 64;
#pragma unroll
                for (int o = 1; o < 64; o <<= 1) { const float ob = __shfl_xor(best, o); const int oi = __shfl_xor(bi, o); if (ob > best || (ob == best && oi < bi)) { best = ob; bi = oi; } }
                ts[p][k] = best; ti[p][k] = bi;
                if (bi == lane) s0 = -INFINITY; if (bi == lane + 64) s1 = -INFINITY;
            }
        }
        float cv[4]; int cid[4];
#pragma unroll
        for (int q = 0; q < 4; ++q) { cv[q] = 0.f; cid[q] = 0; }
#pragma unroll
        for (int i = 0; i < 16; ++i)
#pragma unroll
            for (int jj = 0; jj < 16; ++jj) { if ((lane >> 2) == i && (lane & 3) == (jj >> 2)) { cv[jj & 3] = ts[0][i] + ts[1][jj]; cid[jj & 3] = ti[0][i] * 128 + ti[1][jj]; } }
        float bs[16]; int be[16];
#pragma unroll
        for (int k = 0; k < 16; ++k) {
            float best = cv[0]; int bq = 0;
#pragma unroll
            for (int q = 1; q < 4; ++q) if (cv[q] > best) { best = cv[q]; bq = q; }
            int bpos = lane * 4 + bq; int bid_ = (bq == 0) ? cid[0] : (bq == 1 ? cid[1] : (bq == 2 ? cid[2] : cid[3]));
#pragma unroll
            for (int o = 1; o < 64; o <<= 1) { const float ob = __shfl_xor(best, o); const int op = __shfl_xor(bpos, o); const int oe = __shfl_xor(bid_, o); if (ob > best || (ob == best && op < bpos)) { best = ob; bpos = op; bid_ = oe; } }
            bs[k] = best; be[k] = bid_;
#pragma unroll
            for (int q = 0; q < 4; ++q) if (bpos == lane * 4 + q) cv[q] = -INFINITY;
        }
        const float mxs = bs[0]; float tot = 0.f;
#pragma unroll
        for (int k = 0; k < 16; ++k) { bs[k] = __expf(bs[k] - mxs); tot += bs[k]; }
        int* ep = c.eid + (size_t)tok * 128 + h * 16; float* gp = c.egate + (size_t)tok * 128 + h * 16;
        if (lane == 0) {
#pragma unroll
            for (int k = 0; k < 16; ++k) { ep[k] = be[k]; gp[k] = bs[k] / tot; }
        }
    }
}

DEV float rl_f(float v, int l) { return __int_as_float(__builtin_amdgcn_readlane(__float_as_int(v), l)); }
DEV unsigned q4(float a, float b, float c_, float d, float inv, int off) {
    const int qa = (int)rintf(a * inv) + off, qb = (int)rintf(b * inv) + off, qc = (int)rintf(c_ * inv) + off, qd = (int)rintf(d * inv) + off;
    return (unsigned)(qa & 0xff) | ((unsigned)(qb & 0xff) << 8) | ((unsigned)(qc & 0xff) << 16) | ((unsigned)(qd & 0xff) << 24);
}
DEV float wave_max(float v) {
#pragma unroll
    for (int o = 1; o < 64; o <<= 1) v = fmaxf(v, __shfl_xor(v, o));
    return v;
}
DEV void quant_tables(const Ctx& c, int row0, int row1, int step, int first, LAS unsigned char* scr) {
    const int lane = c.lane;
    int row = row0 + first;
    if (row >= row1) return;
    f32x4 vn[8];
    f32x4 gq[8];
#pragma unroll
    for (int j = 0; j < 8; ++j) gq[j] = ((const f32x4*)c.g_ffn)[64 * j + lane];
    { const bool isup = row >= NEXP; const int e = isup ? row - NEXP : row; const f32x4* src = (const f32x4*)((isup ? c.up : c.dn) + (size_t)e * D) + lane;
#pragma unroll
      for (int j = 0; j < 8; ++j) vn[j] = src[64 * j]; }
    for (; row < row1; row += step) {
        const bool isup = row >= NEXP; const int e = isup ? row - NEXP : row;
        f32x4 v[8];
#pragma unroll
        for (int j = 0; j < 8; ++j) v[j] = vn[j];
        { const int rn = row + step < row1 ? row + step : row; const bool upn = rn >= NEXP; const int en = upn ? rn - NEXP : rn; const f32x4* src = (const f32x4*)((upn ? c.up : c.dn) + (size_t)en * D) + lane;
#pragma unroll
          for (int j = 0; j < 8; ++j) vn[j] = src[64 * j]; }
        float am = 0.f;
#pragma unroll
        for (int j = 0; j < 8; ++j) { if (!isup) v[j] *= gq[j];
            am = fmaxf(am, fmaxf(fmaxf(fabsf(v[j].x), fabsf(v[j].y)), fmaxf(fabsf(v[j].z), fabsf(v[j].w)))); }
        am = wmax_q(am);
        if (!isup && !DN4) {
            const float inv = am > 0.f ? 127.0f / am : 0.f;
            unsigned* dst = (unsigned*)(c.dn8 + (size_t)e * D) + lane;
#pragma unroll
            for (int j = 0; j < 8; ++j) dst[64 * j] = q4(v[j].x, v[j].y, v[j].z, v[j].w, inv, 0);
            if (lane == 0) c.sdn[e] = am * (1.0f / 127.0f);
        } else {
            float ssq = 0.f;
#pragma unroll
            for (int j = 0; j < 8; ++j) ssq += (v[j].x * v[j].x + v[j].y * v[j].y) + (v[j].z * v[j].z + v[j].w * v[j].w);
            const float rms = sqrtf(wsum_q(ssq) * (1.0f / D));
            const float stA = am * (1.0f / 7.0f), stB = fminf(stA, 0.36f * rms);
            const float ivA = stA > 0.f ? 1.0f / stA : 0.f, ivB = stB > 0.f ? 1.0f / stB : 0.f, clipB = 7.0f * stB;
            float ec = 0.f;
#pragma unroll
            for (int j = 0; j < 8; ++j) { const float t0 = fmaxf(fabsf(v[j].x) - clipB, 0.f), t1 = fmaxf(fabsf(v[j].y) - clipB, 0.f), t2 = fmaxf(fabsf(v[j].z) - clipB, 0.f), t3 = fmaxf(fabsf(v[j].w) - clipB, 0.f);
                ec += (t0 * t0 + t1 * t1) + (t2 * t2 + t3 * t3); }
            ec = wsum_q(ec);
            const bool useB = am > 0.f && (ec + (float)D * (1.0f / 12.0f) * stB * stB) < (float)D * (1.0f / 12.0f) * stA * stA;
            const float st = useB ? stB : stA, inv = useB ? ivB : ivA; am = st * 7.0f;
#pragma unroll
            for (int j = 0; j < 8; ++j) {
                const float c0 = __builtin_amdgcn_fmed3f(rintf(fmaf(v[j].x, inv, 8.0f)), 1.f, 15.f), c1 = __builtin_amdgcn_fmed3f(rintf(fmaf(v[j].y, inv, 8.0f)), 1.f, 15.f),
                            c2 = __builtin_amdgcn_fmed3f(rintf(fmaf(v[j].z, inv, 8.0f)), 1.f, 15.f), c3 = __builtin_amdgcn_fmed3f(rintf(fmaf(v[j].w, inv, 8.0f)), 1.f, 15.f);
                unsigned wq = __builtin_amdgcn_cvt_pk_u8_f32(c0, 0u, 0u); wq = __builtin_amdgcn_cvt_pk_u8_f32(c1, 1u, wq); wq = __builtin_amdgcn_cvt_pk_u8_f32(c2, 2u, wq); wq = __builtin_amdgcn_cvt_pk_u8_f32(c3, 3u, wq);
                *(LAS unsigned*)(scr + 4 * (64 * j + lane)) = wq; }
            asm volatile("s_waitcnt lgkmcnt(0)" ::: "memory");
            const v4u lo = *(const LAS v4u*)(scr + 32 * lane), hi = *(const LAS v4u*)(scr + 32 * lane + 16);
            v4u o; o.x = (lo.x & 0x0F0F0F0Fu) | ((lo.y & 0x0F0F0F0Fu) << 4); o.y = (lo.z & 0x0F0F0F0Fu) | ((lo.w & 0x0F0F0F0Fu) << 4);
                   o.z = (hi.x & 0x0F0F0F0Fu) | ((hi.y & 0x0F0F0F0Fu) << 4); o.w = (hi.z & 0x0F0F0F0Fu) | ((hi.w & 0x0F0F0F0Fu) << 4);
            if (isup) *(v4u*)(c.up8 + (size_t)e * (D / 2) + 16 * lane) = o; else *(v4u*)(c.dn8 + (size_t)e * (D / 2) + 16 * lane) = o;
            if (lane == 0) c.sdn[row] = am * (1.0f / 7.0f);
            asm volatile("s_waitcnt lgkmcnt(0)" ::: "memory");
        }
    }
}
#ifndef EXP_NT
#define EXP_NT 2
#endif
constexpr int ENT = EXP_NT;
struct TokQ { int e0, e1, hid0, hid1; float sd0, sd1, gs0, gs1, cf0, cf1, sx, csum; };
DEV int sread_i(int v0, int v1, int k) { const int a = __builtin_amdgcn_readlane(v0, k & 63), b = __builtin_amdgcn_readlane(v1, k & 63); return k < 64 ? a : b; }
DEV float sread_f(float v0, float v1, int k) { return __int_as_float(sread_i(__float_as_int(v0), __float_as_int(v1), k)); }
DEV v4u bload16(__amdgpu_buffer_rsrc_t rs, int voff, int soff) { return __builtin_bit_cast(v4u, __builtin_amdgcn_raw_buffer_load_b128(rs, voff, soff, 0)); }
DEV unsigned bsort_step(unsigned v, unsigned pv, bool keepmin) { return keepmin ? min(v, pv) : max(v, pv); }
DEV void tokq_init(const Ctx& c, int tok, TokQ& s, unsigned (&xq)[4][4], int lane, unsigned idmask = 0xFFFFu) {
    float am = 0.f;
#pragma unroll
    for (int q = 0; q < 4; ++q)
#pragma unroll
        for (int hf = 0; hf < 2; ++hf) { const v4u w = *(const v4u*)(c.h1n + (size_t)tok * D + q * 512 + 16 * (lane & 31) + 8 * hf);
            am = fmaxf(am, fmaxf(fmaxf(fmaxf(fabsf(bflo(w.x)), fabsf(bfhi(w.x))), fmaxf(fabsf(bflo(w.y)), fabsf(bfhi(w.y)))), fmaxf(fmaxf(fabsf(bflo(w.z)), fabsf(bfhi(w.z))), fmaxf(fabsf(bflo(w.w)), fabsf(bfhi(w.w)))))); }
    am = wave_max(am);
    const float r1 = 1.0f / sqrtf(wave_sum(lane < 32 ? c.rss[(size_t)tok * 32 + lane] : 0.f) * (1.0f / D) + EPS);
    const float inv = am > 0.f ? 127.0f / am : 0.f; s.sx = am * (1.0f / 127.0f) * r1;
#pragma unroll
    for (int q = 0; q < 4; ++q)
#pragma unroll
        for (int hf = 0; hf < 2; ++hf) { const v4u w = *(const v4u*)(c.h1n + (size_t)tok * D + q * 512 + 16 * (lane & 31) + 8 * hf);
            xq[q][2 * hf] = q4(bflo(w.x), bfhi(w.x), bflo(w.y), bfhi(w.y), inv, 0); xq[q][2 * hf + 1] = q4(bflo(w.z), bfhi(w.z), bflo(w.w), bfhi(w.w), inv, 0); }
    const float g0 = c.egate[(size_t)tok * 128 + lane], g1 = c.egate[(size_t)tok * 128 + 64 + lane];
    unsigned k0 = (((unsigned)c.eid[(size_t)tok * 128 + lane] & idmask) << 7) | (unsigned)lane, k1 = (((unsigned)c.eid[(size_t)tok * 128 + 64 + lane] & idmask) << 7) | (unsigned)(64 + lane);
#pragma unroll
    for (int k = 2; k <= 128; k <<= 1)
#pragma unroll
        for (int j = k >> 1; j > 0; j >>= 1) {
            if (j == 64) { const unsigned a = min(k0, k1), b = max(k0, k1); k0 = a; k1 = b; }
            else { const unsigned p0 = (unsigned)__shfl_xor((int)k0, j), p1 = (unsigned)__shfl_xor((int)k1, j);
                const bool lower = (lane & j) == 0;
                const bool up0 = (k == 128) ? true : ((lane & k) == 0), up1 = (k == 128) ? true : ((k == 64) ? false : ((lane & k) == 0));
                k0 = bsort_step(k0, p0, up0 == lower); k1 = bsort_step(k1, p1, up1 == lower); }
        }
    s.e0 = (int)(k0 >> 7); s.e1 = (int)(k1 >> 7);
    { const int s0 = (int)(k0 & 127u), s1 = (int)(k1 & 127u);
      const float a0 = __shfl(g0, s0 & 63), b0 = __shfl(g1, s0 & 63), a1 = __shfl(g0, s1 & 63), b1 = __shfl(g1, s1 & 63);
      s.gs0 = (s0 < 64 ? a0 : b0) * c.sup[s.e0]; s.gs1 = (s1 < 64 ? a1 : b1) * c.sup[s.e1]; }
    s.sd0 = c.sdn[s.e0]; s.sd1 = c.sdn[s.e1];
    s.hid0 = 0; s.hid1 = 0; s.cf0 = 0.f; s.cf1 = 0.f; s.csum = 0.f;
}
DEV void q_load(__amdgpu_buffer_rsrc_t rs, const TokQ& s, int kb, int q, int lane, v4u (&dq)[4]) {
    const int esel = kb < 64 ? s.e0 : s.e1;
#pragma unroll
    for (int j = 0; j < 4; ++j) { const int id = __shfl(esel, (kb + 2 * j + (lane >> 5)) & 63);
        dq[j] = bload16(rs, id * D + q * 512 + 16 * (lane & 31), 0); }
}
DEV void u_load(__amdgpu_buffer_rsrc_t rs, const TokQ& s, int kb, int hq, int lane, v4u (&dq)[4]) {
    const int esel = kb < 64 ? s.e0 : s.e1;
#pragma unroll
    for (int j = 0; j < 4; ++j) { const int id = __shfl(esel, (kb + 2 * j + (lane >> 5)) & 63);
        dq[j] = bload16(rs, id * (D / 2) + hq * 512 + 16 * (lane & 31), 0); }
}
DEV void q_down_dot(const unsigned (&xq)[4], const v4u (&dq)[4], int (&part)[16], const int sub) {
#pragma unroll
    for (int j = 0; j < 4; ++j) { int a = __builtin_amdgcn_sdot4((int)dq[j].x, (int)xq[0], 0, false); a = __builtin_amdgcn_sdot4((int)dq[j].y, (int)xq[1], a, false);
        a = __builtin_amdgcn_sdot4((int)dq[j].z, (int)xq[2], a, false); a = __builtin_amdgcn_sdot4((int)dq[j].w, (int)xq[3], a, false); part[4 * sub + j] = a; }
}
template <int CTRL> DEV int dpp_i(int v) { return __builtin_amdgcn_update_dpp(0, v, CTRL, 0xF, 0xF, false); }
DEV void q_down_reduce(TokQ& s, int kg, int lane, const int (&part)[16]) {
    int r8[8], r4[4], r2[2], r1;
#pragma unroll
    for (int i = 0; i < 8; ++i) { const auto r = __builtin_amdgcn_permlane16_swap((unsigned)part[i], (unsigned)part[i + 8], false, false); r8[i] = (int)(r[0] + r[1]); }
    { const bool h = (lane & 8) != 0;
#pragma unroll
      for (int i = 0; i < 4; ++i) { const int keep = h ? r8[i + 4] : r8[i], send = h ? r8[i] : r8[i + 4]; r4[i] = keep + dpp_i<0x128>(send); } }
    { const bool h = (lane & 4) != 0;
#pragma unroll
      for (int i = 0; i < 2; ++i) { const int keep = h ? r4[i + 2] : r4[i], send = h ? r4[i] : r4[i + 2]; r2[i] = keep + dpp_i<0x1B>(dpp_i<0x141>(send)); } }
    { const bool h = (lane & 2) != 0; const int keep = h ? r2[1] : r2[0], send = h ? r2[0] : r2[1]; r1 = keep + dpp_i<0x4E>(send); }
    r1 += dpp_i<0xB1>(r1);
    const int e = (lane - kg) & 31;
    const int isrc = 4 * (e >> 3) + ((e & 7) >> 1), hsrc = e & 1;
    const int gsum = __shfl(r1, 32 * hsrc + 2 * isrc);
    if ((lane >> 5) == ((kg & 63) >> 5)) { if (kg < 64) s.hid0 += gsum; else s.hid1 += gsum; }
}
DEV void q_up_compute(const TokQ& s, float (&y)[16], int kb, int lane, const v4u (&uq)[4]) {
#pragma unroll
    for (int j = 0; j < 4; ++j) { const float flo = sread_f(s.cf0, s.cf1, kb + 2 * j), fhi = sread_f(s.cf0, s.cf1, kb + 2 * j + 1); const float f = lane < 32 ? flo : fhi;
        const unsigned ww[4] = {uq[j].x, uq[j].y, uq[j].z, uq[j].w};
#pragma unroll
        for (int w = 0; w < 4; ++w) { y[4 * w + 0] += f * (float)(ww[w] & 0xffu); y[4 * w + 1] += f * (float)((ww[w] >> 8) & 0xffu); y[4 * w + 2] += f * (float)((ww[w] >> 16) & 0xffu); y[4 * w + 3] += f * (float)(ww[w] >> 24); } }
}
DEV void tokq_final(const Ctx& c, int tok, int lane) {
    const v2u* hp = (const v2u*)(c.h2b + (size_t)tok * D) + lane;
    f32x4 v[8]; float ss = 0.f, am = 0.f;
#pragma unroll
    for (int j = 0; j < 8; ++j) { const v2u w = hp[64 * j]; v[j] = (f32x4){bflo(w.x), bfhi(w.x), bflo(w.y), bfhi(w.y)}; ss += (v[j].x * v[j].x + v[j].y * v[j].y) + (v[j].z * v[j].z + v[j].w * v[j].w);
        am = fmaxf(am, fmaxf(fmaxf(fabsf(v[j].x), fabsf(v[j].y)), fmaxf(fabsf(v[j].z), fabsf(v[j].w)))); }
    const float rr = 1.0f / sqrtf(wave_sum(ss) * (1.0f / D) + EPS);
    am = wave_max(am);
    const float inv = am > 0.f ? 127.0f / am : 0.f;
    unsigned* o4 = (unsigned*)(c.h2q8 + (size_t)tok * D) + lane;
#pragma unroll
    for (int j = 0; j < 8; ++j) o4[64 * j] = q4(v[j].x, v[j].y, v[j].z, v[j].w, inv, 0);
    if (lane == 0) c.h2s[tok] = am * (1.0f / 127.0f) * rr;
}
constexpr int NP = 4;
DEV void d4_load_e(__amdgpu_buffer_rsrc_t rs, int e0, int e1, int kb, int hq, int lane, v4u (&dq)[4]) {
    const int esel = kb < 64 ? e0 : e1;
#pragma unroll
    for (int j = 0; j < 4; ++j) { const int id = __shfl(esel, (kb + 2 * j + (lane >> 5)) & 63);
        dq[j] = bload16(rs, id * (D / 2) + hq * 512 + 16 * (lane & 31), 0); }
}
DEV void d4_down_dot(const unsigned (&xq)[8], const v4u (&dq)[4], int (&part)[16], const int sub) {
#pragma unroll
    for (int j = 0; j < 4; ++j) { const unsigned ww[4] = {dq[j].x, dq[j].y, dq[j].z, dq[j].w}; int a = 0;
#pragma unroll
        for (int w = 0; w < 4; ++w) { a = __builtin_amdgcn_sdot4((int)(ww[w] & 0x0F0F0F0Fu), (int)xq[2 * w], a, false); a = __builtin_amdgcn_sdot4((int)((ww[w] >> 4) & 0x0F0F0F0Fu), (int)xq[2 * w + 1], a, false); }
        part[4 * sub + j] = a; }
}
DEV void tokd_init(const Ctx& c, int tok, LAS unsigned char* xrow, LAS float* sxp, LAS int* xsp, int lane_in) {
    int lane = lane_in; asm volatile("" : "+v"(lane));
#if QI8
    if (lane < 32) {
#pragma unroll
        for (int q = 0; q < 4; ++q) *(LAS v4u*)(xrow + q * 512 + 16 * lane) = *(const v4u*)(c.xq8g + (size_t)tok * D + q * 512 + 16 * lane); }
    if (lane == 0) { *sxp = c.sxg[tok]; *xsp = c.xsg[tok]; }
#else
    float am = 0.f;
#pragma unroll
    for (int q = 0; q < 4; ++q)
#pragma unroll
        for (int hf = 0; hf < 2; ++hf) { const v4u w = *(const v4u*)(c.h1n + (size_t)tok * D + q * 512 + 16 * (lane & 31) + 8 * hf);
            am = fmaxf(am, fmaxf(fmaxf(fmaxf(fabsf(bflo(w.x)), fabsf(bfhi(w.x))), fmaxf(fabsf(bflo(w.y)), fabsf(bfhi(w.y)))), fmaxf(fmaxf(fabsf(bflo(w.z)), fabsf(bfhi(w.z))), fmaxf(fabsf(bflo(w.w)), fabsf(bfhi(w.w)))))); }
    am = wave_max(am);
    const float r1 = 1.0f / sqrtf(wave_sum(lane < 32 ? c.rss[(size_t)tok * 32 + lane] : 0.f) * (1.0f / D) + EPS);
    const float inv = am > 0.f ? 127.0f / am : 0.f;
    if (lane == 0) *sxp = am * (1.0f / 127.0f) * r1;
    int xacc = 0;
#pragma unroll
    for (int q = 0; q < 4; ++q) { v4u o;
        { const v4u w = *(const v4u*)(c.h1n + (size_t)tok * D + q * 512 + 16 * (lane & 31)); o.x = q4(bflo(w.x), bfhi(w.x), bflo(w.y), bfhi(w.y), inv, 0); o.y = q4(bflo(w.z), bfhi(w.z), bflo(w.w), bfhi(w.w), inv, 0); }
        { const v4u w = *(const v4u*)(c.h1n + (size_t)tok * D + q * 512 + 16 * (lane & 31) + 8); o.z = q4(bflo(w.x), bfhi(w.x), bflo(w.y), bfhi(w.y), inv, 0); o.w = q4(bflo(w.z), bfhi(w.z), bflo(w.w), bfhi(w.w), inv, 0); }
        if (lane < 32) *(LAS v4u*)(xrow + q * 512 + 16 * lane) = o;
        xacc = __builtin_amdgcn_sdot4((int)o.x, 0x01010101, xacc, false); xacc = __builtin_amdgcn_sdot4((int)o.y, 0x01010101, xacc, false); xacc = __builtin_amdgcn_sdot4((int)o.z, 0x01010101, xacc, false); xacc = __builtin_amdgcn_sdot4((int)o.w, 0x01010101, xacc, false); }
    { int xs_ = lane < 32 ? xacc : 0;
#pragma unroll
      for (int o2 = 1; o2 < 64; o2 <<= 1) xs_ += __shfl_xor(xs_, o2);
      if (lane == 0) *xsp = xs_; }
#endif
    unsigned k0 = ((unsigned)c.eid[(size_t)tok * 128 + lane] << 7) | (unsigned)lane, k1 = ((unsigned)c.eid[(size_t)tok * 128 + 64 + lane] << 7) | (unsigned)(64 + lane);
#pragma unroll
    for (int k = 2; k <= 128; k <<= 1)
#pragma unroll
        for (int j = k >> 1; j > 0; j >>= 1) {
            if (j == 64) { const unsigned a = min(k0, k1), b = max(k0, k1); k0 = a; k1 = b; }
            else { const unsigned p0 = (unsigned)__shfl_xor((int)k0, j), p1 = (unsigned)__shfl_xor((int)k1, j);
                const bool lower = (lane & j) == 0;
                const bool up0 = (k == 128) ? true : ((lane & k) == 0), up1 = (k == 128) ? true : ((k == 64) ? false : ((lane & k) == 0));
                k0 = bsort_step(k0, p0, up0 == lower); k1 = bsort_step(k1, p1, up1 == lower); }
        }
    asm volatile("s_waitcnt vmcnt(0)" ::: "memory");
    c.eid[(size_t)tok * 128 + lane] = (int)k0; c.eid[(size_t)tok * 128 + 64 + lane] = (int)k1;
}
DEV void tokg_init(const Ctx& c, int tok, unsigned char* xrow, float* sxp, int* xsp, int lane_in) {
    int lane = lane_in; asm volatile("" : "+v"(lane));
    float am = 0.f;
#pragma unroll
    for (int q = 0; q < 4; ++q)
#pragma unroll
        for (int hf = 0; hf < 2; ++hf) { const v4u w = *(const v4u*)(c.h1n + (size_t)tok * D + q * 512 + 16 * (lane & 31) + 8 * hf);
            am = fmaxf(am, fmaxf(fmaxf(fmaxf(fabsf(bflo(w.x)), fabsf(bfhi(w.x))), fmaxf(fabsf(bflo(w.y)), fabsf(bfhi(w.y)))), fmaxf(fmaxf(fabsf(bflo(w.z)), fabsf(bfhi(w.z))), fmaxf(fabsf(bflo(w.w)), fabsf(bfhi(w.w)))))); }
    am = wave_max(am);
    const float r1 = 1.0f / sqrtf(wave_sum(lane < 32 ? c.rss[(size_t)tok * 32 + lane] : 0.f) * (1.0f / D) + EPS);
    const float inv = am > 0.f ? 127.0f / am : 0.f;
    if (lane == 0) *sxp = am * (1.0f / 127.0f) * r1;
    int xacc = 0;
#pragma unroll
    for (int q = 0; q < 4; ++q) { v4u o;
        { const v4u w = *(const v4u*)(c.h1n + (size_t)tok * D + q * 512 + 16 * (lane & 31)); o.x = q4(bflo(w.x), bfhi(w.x), bflo(w.y), bfhi(w.y), inv, 0); o.y = q4(bflo(w.z), bfhi(w.z), bflo(w.w), bfhi(w.w), inv, 0); }
        { const v4u w = *(const v4u*)(c.h1n + (size_t)tok * D + q * 512 + 16 * (lane & 31) + 8); o.z = q4(bflo(w.x), bfhi(w.x), bflo(w.y), bfhi(w.y), inv, 0); o.w = q4(bflo(w.z), bfhi(w.z), bflo(w.w), bfhi(w.w), inv, 0); }
        if (lane < 32) *(v4u*)(xrow + q * 512 + 16 * lane) = o;
        xacc = __builtin_amdgcn_sdot4((int)o.x, 0x01010101, xacc, false); xacc = __builtin_amdgcn_sdot4((int)o.y, 0x01010101, xacc, false); xacc = __builtin_amdgcn_sdot4((int)o.z, 0x01010101, xacc, false); xacc = __builtin_amdgcn_sdot4((int)o.w, 0x01010101, xacc, false); }
    { int xs_ = lane < 32 ? xacc : 0;
#pragma unroll
      for (int o2 = 1; o2 < 64; o2 <<= 1) xs_ += __shfl_xor(xs_, o2);
      if (lane == 0) *xsp = xs_; }
    unsigned k0 = ((unsigned)c.eid[(size_t)tok * 128 + lane] << 7) | (unsigned)lane, k1 = ((unsigned)c.eid[(size_t)tok * 128 + 64 + lane] << 7) | (unsigned)(64 + lane);
#pragma unroll
    for (int k = 2; k <= 128; k <<= 1)
#pragma unroll
        for (int j = k >> 1; j > 0; j >>= 1) {
            if (j == 64) { const unsigned a = min(k0, k1), b = max(k0, k1); k0 = a; k1 = b; }
            else { const unsigned p0 = (unsigned)__shfl_xor((int)k0, j), p1 = (unsigned)__shfl_xor((int)k1, j);
                const bool lower = (lane & j) == 0;
                const bool up0 = (k == 128) ? true : ((lane & k) == 0), up1 = (k == 128) ? true : ((k == 64) ? false : ((lane & k) == 0));
                k0 = bsort_step(k0, p0, up0 == lower); k1 = bsort_step(k1, p1, up1 == lower); }
        }
    asm volatile("s_waitcnt vmcnt(0)" ::: "memory");
    c.eid[(size_t)tok * 128 + lane] = (int)k0; c.eid[(size_t)tok * 128 + 64 + lane] = (int)k1;
}
DEV void q_load_e(__amdgpu_buffer_rsrc_t rs, int e0, int e1, int kb, int q, int lane, v4u (&dq)[4]) {
    const int esel = kb < 64 ? e0 : e1;
#pragma unroll
    for (int j = 0; j < 4; ++j) { const int id = __shfl(esel, (kb + 2 * j + (lane >> 5)) & 63);
        dq[j] = bload16(rs, id * D + q * 512 + 16 * (lane & 31), 0); }
}
DEV void phase_peer_experts(const Ctx& c, unsigned idmask = 0xFFFFu, const int part = 0) {
    const int lane = c.lane, gw = c.bid * 8 + c.wave, NGW = c.G * 8;
    const __amdgpu_buffer_rsrc_t rsd = __builtin_amdgcn_make_buffer_rsrc((void*)c.dn8, 0, DN4 ? NEXP * D / 2 : NEXP * D, 0x00020000), rsu = __builtin_amdgcn_make_buffer_rsrc((void*)c.up8, 0, NEXP * D / 2, 0x00020000);
    extern __shared__ __attribute__((aligned(16))) unsigned char lds_all[];
    LAS unsigned char* xl = (LAS unsigned char*)lds_all + c.wave * 18432;
    LAS float* sxl = (LAS float*)(xl + 16384); LAS int* xsl = (LAS int*)(xl + 16384 + 32);
    int* hidbuf = c.hidb;
    const int tgs = c.grp ? 1 : NGW, tgfirst = c.grp ? 128 * c.pm + 32 * c.kq + 4 * c.wave : gw, tgloop = c.grp ? T : NGW * NP;
    for (int tg0 = tgfirst; tg0 < T / ENT; tg0 += tgloop) {
        if (part != 2) {
#pragma unroll 1
        for (int i = 0; i < NP * ENT; ++i) { const int tg = tg0 + (i / ENT) * tgs; if (tg < T / ENT) tokd_init(c, tg * ENT + (i % ENT), xl + i * 2048, sxl + i, xsl + i, lane); }
        __builtin_amdgcn_fence(__ATOMIC_RELEASE, "workgroup"); asm volatile("s_waitcnt vmcnt(0) lgkmcnt(0)" ::: "memory"); __builtin_amdgcn_fence(__ATOMIC_ACQUIRE, "workgroup");
        int E[NP][ENT][2], H[NP][ENT][2];
#pragma unroll
        for (int p = 0; p < NP; ++p)
#pragma unroll
            for (int t = 0; t < ENT; ++t) { const int tg = tg0 + p * tgs; const int tok = (tg < T / ENT ? tg : tg0) * ENT + t;
                E[p][t][0] = (int)(((unsigned)c.eid[(size_t)tok * 128 + lane] >> 7) & idmask); E[p][t][1] = (int)(((unsigned)c.eid[(size_t)tok * 128 + 64 + lane] >> 7) & idmask); H[p][t][0] = 0; H[p][t][1] = 0; }
#if DN4
#pragma unroll 1
        for (int q = 0; q < 2; ++q) {
            v4u dq[ENT][2][4];
#pragma unroll
            for (int t = 0; t < ENT; ++t) { d4_load_e(rsd, E[0][t][0], E[0][t][1], 0, q, lane, dq[t][0]); d4_load_e(rsd, E[0][t][0], E[0][t][1], 8, q, lane, dq[t][1]); }
#pragma unroll 1
            for (int kg = 0; kg < 128; kg += 32) {
#pragma unroll
                for (int p = 0; p < NP; ++p) {
                    int part[ENT][16];
#pragma unroll
                    for (int t = 0; t < ENT; ++t) {
                        unsigned xc[8];
                        { const LAS v4u* xp = (const LAS v4u*)(xl + (p * ENT + t) * 2048 + q * 1024 + 32 * (lane & 31)); const v4u xa = xp[0], xb = xp[1];
                          xc[0] = xa.x; xc[1] = xa.y; xc[2] = xa.z; xc[3] = xa.w; xc[4] = xb.x; xc[5] = xb.y; xc[6] = xb.z; xc[7] = xb.w; }
#pragma unroll
                        for (int sub = 0; sub < 4; ++sub) { d4_down_dot(xc, dq[t][sub & 1], part[t], sub);
                            if (sub < 2) d4_load_e(rsd, E[p][t][0], E[p][t][1], kg + 8 * (sub + 2), q, lane, dq[t][sub & 1]);
                            else if (p + 1 < NP) d4_load_e(rsd, E[p + 1 < NP ? p + 1 : 0][t][0], E[p + 1 < NP ? p + 1 : 0][t][1], kg + 8 * (sub - 2), q, lane, dq[t][sub & 1]);
                            else { const int kn = kg + 32 + 8 * (sub - 2); d4_load_e(rsd, E[0][t][0], E[0][t][1], kn < 128 ? kn : 120, q, lane, dq[t][sub & 1]); } } }
                    { int lane_r = c.lane; asm volatile("" : "+v"(lane_r));
#pragma unroll
                    for (int t = 0; t < ENT; ++t) { TokQ tmp; tmp.hid0 = H[p][t][0]; tmp.hid1 = H[p][t][1]; q_down_reduce(tmp, kg, lane_r, part[t]); H[p][t][0] = tmp.hid0; H[p][t][1] = tmp.hid1; } }
                }
            }
        }
#else
#pragma unroll 1
        for (int q = 0; q < 4; ++q) {
            v4u dq[ENT][2][4];
#pragma unroll
            for (int t = 0; t < ENT; ++t) { q_load_e(rsd, E[0][t][0], E[0][t][1], 0, q, lane, dq[t][0]); q_load_e(rsd, E[0][t][0], E[0][t][1], 8, q, lane, dq[t][1]); }
#pragma unroll 1
            for (int kg = 0; kg < 128; kg += 32) {
#pragma unroll
                for (int p = 0; p < NP; ++p) {
                    unsigned xc[ENT][4];
#pragma unroll
                    for (int t = 0; t < ENT; ++t) { const v4u xv = *(const LAS v4u*)(xl + (p * ENT + t) * 2048 + q * 512 + 16 * (lane & 31)); xc[t][0] = xv.x; xc[t][1] = xv.y; xc[t][2] = xv.z; xc[t][3] = xv.w; }
                    int part[ENT][16];
#pragma unroll
                    for (int sub = 0; sub < 4; ++sub) {
#pragma unroll
                        for (int t = 0; t < ENT; ++t) { q_down_dot(xc[t], dq[t][sub & 1], part[t], sub);
                            if (sub < 2) q_load_e(rsd, E[p][t][0], E[p][t][1], kg + 8 * (sub + 2), q, lane, dq[t][sub & 1]);
                            else if (p + 1 < NP) q_load_e(rsd, E[p + 1 < NP ? p + 1 : 0][t][0], E[p + 1 < NP ? p + 1 : 0][t][1], kg + 8 * (sub - 2), q, lane, dq[t][sub & 1]);
                            else { const int kn = kg + 32 + 8 * (sub - 2); q_load_e(rsd, E[0][t][0], E[0][t][1], kn < 128 ? kn : 120, q, lane, dq[t][sub & 1]); } } }
#pragma unroll
                    for (int t = 0; t < ENT; ++t) { TokQ tmp; tmp.hid0 = H[p][t][0]; tmp.hid1 = H[p][t][1]; q_down_reduce(tmp, kg, lane, part[t]); H[p][t][0] = tmp.hid0; H[p][t][1] = tmp.hid1; }
                }
            }
        }
#endif
#pragma unroll
        for (int p = 0; p < NP; ++p)
#pragma unroll
            for (int t = 0; t < ENT; ++t) { const int tg = tg0 + p * tgs; if (tg < T / ENT) { const int tok = tg * ENT + t; hidbuf[(size_t)tok * 128 + lane] = H[p][t][0]; hidbuf[(size_t)tok * 128 + 64 + lane] = H[p][t][1]; } }
        __builtin_amdgcn_fence(__ATOMIC_RELEASE, "workgroup"); asm volatile("s_waitcnt vmcnt(0)" ::: "memory"); __builtin_amdgcn_fence(__ATOMIC_ACQUIRE, "workgroup");
        }
        if (part == 1) continue;
#pragma unroll 1
      for (int pp = 0; pp < NP; ++pp) { const int tg = tg0 + pp * tgs; if (tg >= T / ENT) break;
        int lane_o = c.lane; asm volatile("" : "+v"(lane_o)); const int lane = lane_o;
        const int tok0 = tg * ENT;
        TokQ S[ENT];
#pragma unroll
        for (int t = 0; t < ENT; ++t) { const int tok = tok0 + t;
            const unsigned k0 = (unsigned)c.eid[(size_t)tok * 128 + lane], k1 = (unsigned)c.eid[(size_t)tok * 128 + 64 + lane];
            S[t].e0 = (int)((k0 >> 7) & idmask); S[t].e1 = (int)((k1 >> 7) & idmask);
            S[t].gs0 = c.egate[(size_t)tok * 128 + (k0 & 127u)] * c.sup[S[t].e0]; S[t].gs1 = c.egate[(size_t)tok * 128 + (k1 & 127u)] * c.sup[S[t].e1];
            S[t].sd0 = c.sdn[S[t].e0]; S[t].sd1 = c.sdn[S[t].e1];
            { const int corr8 = DN4 ? 8 * xsl[pp * ENT + t] : 0; S[t].hid0 = hidbuf[(size_t)tok * 128 + lane] - corr8; S[t].hid1 = hidbuf[(size_t)tok * 128 + 64 + lane] - corr8; }
            S[t].sx = sxl[pp * ENT + t]; S[t].cf0 = 0.f; S[t].cf1 = 0.f; S[t].csum = 0.f; }
#pragma unroll
        for (int t = 0; t < ENT; ++t) { S[t].cf0 = S[t].gs0 * gelu_erf((float)S[t].hid0 * (S[t].sx * S[t].sd0)); S[t].cf1 = S[t].gs1 * gelu_erf((float)S[t].hid1 * (S[t].sx * S[t].sd1));
            S[t].csum = wave_sum(S[t].cf0 + S[t].cf1); }
        unsigned cpk[ENT]; float cscale[ENT]; int csumq[ENT];
#pragma unroll
        for (int t = 0; t < ENT; ++t) { const float cm = wave_max(fmaxf(fabsf(S[t].cf0), fabsf(S[t].cf1))); const float inv = cm > 0.f ? 127.0f / cm : 0.f; cscale[t] = cm * (1.0f / 127.0f);
            const int c0 = (int)rintf(S[t].cf0 * inv), c1 = (int)rintf(S[t].cf1 * inv);
            { int sq = c0 + c1;
#pragma unroll
              for (int o = 1; o < 64; o <<= 1) sq += __shfl_xor(sq, o);
              csumq[t] = sq; }
            unsigned pk = 0u;
#pragma unroll
            for (int i = 0; i < 4; ++i) { const int p = 8 * ((lane & 31) >> 1) + (lane & 1) + 2 * i; const int a = __shfl(c0, p & 63), bq = __shfl(c1, p & 63); pk |= ((unsigned)((p < 64 ? a : bq) & 0xff)) << (8 * i); }
            cpk[t] = pk; }
#pragma unroll 1
        for (int hq = 0; hq < 2; ++hq) {
            int y[ENT][32];
#pragma unroll
            for (int t = 0; t < ENT; ++t)
#pragma unroll
                for (int i = 0; i < 32; ++i) y[t][i] = 0;
            v4u uq[ENT][4];
#pragma unroll
            for (int t = 0; t < ENT; ++t) u_load(rsu, S[t], 0, hq, lane, uq[t]);
            for (int kb = 0; kb < 128; kb += 8) { const int kn = kb + 8 < 128 ? kb + 8 : 120;
#pragma unroll
                for (int t = 0; t < ENT; ++t) {
                    const unsigned clo = (unsigned)__builtin_amdgcn_readlane((int)cpk[t], (kb >> 2) & 31), chi = (unsigned)__builtin_amdgcn_readlane((int)cpk[t], ((kb >> 2) & 31) + 1);
                    const int cw = (int)(lane < 32 ? clo : chi);
                    const unsigned a0[4] = {uq[t][0].x, uq[t][0].y, uq[t][0].z, uq[t][0].w}, a1[4] = {uq[t][1].x, uq[t][1].y, uq[t][1].z, uq[t][1].w}, a2[4] = {uq[t][2].x, uq[t][2].y, uq[t][2].z, uq[t][2].w}, a3[4] = {uq[t][3].x, uq[t][3].y, uq[t][3].z, uq[t][3].w};
#pragma unroll
                    for (int w = 0; w < 4; ++w) {
                        const unsigned x0 = __builtin_amdgcn_perm(a1[w], a0[w], 0x05010400u), x1 = __builtin_amdgcn_perm(a1[w], a0[w], 0x07030602u), x2 = __builtin_amdgcn_perm(a3[w], a2[w], 0x05010400u), x3 = __builtin_amdgcn_perm(a3[w], a2[w], 0x07030602u);
                        const unsigned tb[4] = {__builtin_amdgcn_perm(x2, x0, 0x05040100u), __builtin_amdgcn_perm(x2, x0, 0x07060302u), __builtin_amdgcn_perm(x3, x1, 0x05040100u), __builtin_amdgcn_perm(x3, x1, 0x07060302u)};
#pragma unroll
                        for (int b = 0; b < 4; ++b) {
                            y[t][8 * w + b] = __builtin_amdgcn_sdot4((int)(tb[b] ^ 0x80808080u), cw, y[t][8 * w + b], false);
                            y[t][8 * w + 4 + b] = __builtin_amdgcn_sdot4((int)((tb[b] >> 4) & 0x0F0F0F0Fu), cw, y[t][8 * w + 4 + b], false); } }
                    u_load(rsu, S[t], kn, hq, lane, uq[t]); } }
#pragma unroll
            for (int t = 0; t < ENT; ++t) {
#pragma unroll
                for (int i = 0; i < 32; ++i) y[t][i] += __shfl_xor(y[t][i], 32);
                if (lane < 32) { bf16* hp = c.h2b + (size_t)(tok0 + t) * D + hq * 1024 + 32 * lane; const float sc = cscale[t]; const int corr = 8 * csumq[t];
                    const bf16* hb = c.h1n + (size_t)(tok0 + t) * D + hq * 1024 + 32 * lane;
#pragma unroll
                    for (int g8 = 0; g8 < 4; ++g8) { const v4u hw = *(const v4u*)(hb + 8 * g8); const int yb = 8 * g8; v4u o;
                        int yv[8];
#pragma unroll
                        for (int b = 0; b < 4; ++b) { yv[b] = y[t][yb + b] - 16 * y[t][yb + 4 + b] + 15 * corr; yv[4 + b] = y[t][yb + 4 + b] - corr; }
                        o.x = pkbf(bflo(hw.x) + (float)yv[0] * sc, bfhi(hw.x) + (float)yv[1] * sc); o.y = pkbf(bflo(hw.y) + (float)yv[2] * sc, bfhi(hw.y) + (float)yv[3] * sc);
                        o.z = pkbf(bflo(hw.z) + (float)yv[4] * sc, bfhi(hw.z) + (float)yv[5] * sc); o.w = pkbf(bflo(hw.w) + (float)yv[6] * sc, bfhi(hw.w) + (float)yv[7] * sc);
                        *(v4u*)(hp + yb) = o; } } }
        }
        __builtin_amdgcn_fence(__ATOMIC_RELEASE, "workgroup"); asm volatile("s_waitcnt vmcnt(0)" ::: "memory"); __builtin_amdgcn_fence(__ATOMIC_ACQUIRE, "workgroup");
#pragma unroll
        for (int t = 0; t < ENT; ++t) tokq_final(c, tok0 + t, lane);
      }
    }
}


DEV void phase_exp_pre(const Ctx& c) {
    const int gw = c.bid * 8 + c.wave, NGW = c.G * 8;
#pragma unroll 1
    for (int tok = gw; tok < T; tok += NGW) tokg_init(c, tok, c.xq8g + (size_t)tok * D, c.sxg + tok, c.xsg + tok, c.lane);
}
DEV void d4_down_dot_acc(const unsigned (&xq)[8], const v4u (&dq)[4], int (&part)[16], const int sub, const bool first) {
#pragma unroll
    for (int j = 0; j < 4; ++j) { const unsigned ww[4] = {dq[j].x, dq[j].y, dq[j].z, dq[j].w}; int a = first ? 0 : part[4 * sub + j];
#pragma unroll
        for (int w = 0; w < 4; ++w) { a = __builtin_amdgcn_sdot4((int)(ww[w] & 0x0F0F0F0Fu), (int)xq[2 * w], a, false); a = __builtin_amdgcn_sdot4((int)((ww[w] >> 4) & 0x0F0F0F0Fu), (int)xq[2 * w + 1], a, false); }
        part[4 * sub + j] = a; }
}
DEV void phase_exp_down(const Ctx& c, LAS unsigned char* lds) {
    const int lane = c.lane, g = c.bid & 7, nblk = (c.G - g + 7) >> 3, wg = (c.bid >> 3) * 8 + c.wave, nwg = nblk * 8, pb = 16 * g;
    const __amdgpu_buffer_rsrc_t rsd = __builtin_amdgcn_make_buffer_rsrc((void*)c.dn8, 0, NEXP * D / 2, 0x00020000);
    LAS unsigned char* xl = lds + c.wave * 18432;
    int* hidbuf = (int*)c.qp;
    constexpr int NPAIR = T / 2;
    if (wg >= NPAIR) return;
    auto ids_of = [&](int pr) -> int { const int prc = pr < NPAIR ? pr : wg; const int tok = 2 * prc + ((lane >> 4) & 1); return (int)((unsigned)c.eid[(size_t)tok * 128 + pb + (lane & 15)] >> 7); };
    auto xrows_of = [&](int pr, v4u (&xr)[4]) { const int prc = pr < NPAIR ? pr : wg;
#pragma unroll
        for (int i = 0; i < 4; ++i) xr[i] = *(const v4u*)(c.xq8g + (size_t)(2 * prc) * D + (lane + 64 * i) * 16); };
    int ereg = ids_of(wg), eregN = ids_of(wg + nwg);
    { v4u xr[4]; xrows_of(wg, xr);
#pragma unroll
      for (int i = 0; i < 4; ++i) *(LAS v4u*)(xl + (lane + 64 * i) * 16) = xr[i]; }
    v4u dq[4][4];
#pragma unroll
    for (int k = 0; k < 4; ++k) d4_load_e(rsd, ereg, ereg, 8 * k, 0, lane, dq[k]);
    asm volatile("s_waitcnt lgkmcnt(0)" ::: "memory");
    int it = 0;
#pragma unroll 1
    for (int pr = wg; pr < NPAIR; pr += nwg, ++it) {
        const int bufo = (it & 1) * 4096;
        const int eregNN = ids_of(pr + 2 * nwg);
        v4u xr[4]; xrows_of(pr + nwg, xr);
        int part[16];
        unsigned xc[8];
#pragma unroll
        for (int k = 0; k < 8; ++k) { const int hq = k >> 2, sub = k & 3, tokn = sub >> 1;
            if ((sub & 1) == 0) { const LAS v4u* xp = (const LAS v4u*)(xl + bufo + tokn * 2048 + hq * 1024 + 32 * (lane & 31)); const v4u xa = xp[0], xb = xp[1];
                xc[0] = xa.x; xc[1] = xa.y; xc[2] = xa.z; xc[3] = xa.w; xc[4] = xb.x; xc[5] = xb.y; xc[6] = xb.z; xc[7] = xb.w; }
            d4_down_dot_acc(xc, dq[k & 3], part, sub, hq == 0);
            if (k < 4) d4_load_e(rsd, ereg, ereg, 8 * k, 1, lane, dq[k & 3]);
            else d4_load_e(rsd, eregN, eregN, 8 * (k - 4), 0, lane, dq[k & 3]); }
        { TokQ tmp; tmp.hid0 = 0; tmp.hid1 = 0; q_down_reduce(tmp, 0, lane, part);
          if (lane < 32) hidbuf[(size_t)(2 * pr + (lane >> 4)) * 128 + pb + (lane & 15)] = tmp.hid0; }
#pragma unroll
        for (int i = 0; i < 4; ++i) *(LAS v4u*)(xl + (4096 - bufo) + (lane + 64 * i) * 16) = xr[i];
        asm volatile("s_waitcnt lgkmcnt(0)" ::: "memory");
        ereg = eregN; eregN = eregNN;
    }
}
DEV void phase_exp_up(const Ctx& c, unsigned idmask = 0xFFFFu) {
    const int gw = c.bid * 8 + c.wave, NGW = c.G * 8;
    const __amdgpu_buffer_rsrc_t rsu = __builtin_amdgcn_make_buffer_rsrc((void*)c.up8, 0, NEXP * D / 2, 0x00020000);
    int* hidbuf = (int*)c.qp;
    for (int tg0 = gw; tg0 < T / ENT; tg0 += NGW * NP) {
#pragma unroll 1
      for (int pp = 0; pp < NP; ++pp) { const int tg = tg0 + pp * NGW; if (tg >= T / ENT) break;
        int lane_o = c.lane; asm volatile("" : "+v"(lane_o)); const int lane = lane_o;
        const int tok0 = tg * ENT;
        TokQ S[ENT];
#pragma unroll
        for (int t = 0; t < ENT; ++t) { const int tok = tok0 + t;
            const unsigned k0 = (unsigned)c.eid[(size_t)tok * 128 + lane], k1 = (unsigned)c.eid[(size_t)tok * 128 + 64 + lane];
            S[t].e0 = (int)((k0 >> 7) & idmask); S[t].e1 = (int)((k1 >> 7) & idmask);
            S[t].gs0 = c.egate[(size_t)tok * 128 + (k0 & 127u)] * c.sup[S[t].e0]; S[t].gs1 = c.egate[(size_t)tok * 128 + (k1 & 127u)] * c.sup[S[t].e1];
            S[t].sd0 = c.sdn[S[t].e0]; S[t].sd1 = c.sdn[S[t].e1];
            { const int corr8 = 8 * c.xsg[tok]; S[t].hid0 = hidbuf[(size_t)tok * 128 + lane] - corr8; S[t].hid1 = hidbuf[(size_t)tok * 128 + 64 + lane] - corr8; }
            S[t].sx = c.sxg[tok]; S[t].cf0 = 0.f; S[t].cf1 = 0.f; S[t].csum = 0.f; }
#pragma unroll
        for (int t = 0; t < ENT; ++t) { S[t].cf0 = S[t].gs0 * gelu_erf((float)S[t].hid0 * (S[t].sx * S[t].sd0)); S[t].cf1 = S[t].gs1 * gelu_erf((float)S[t].hid1 * (S[t].sx * S[t].sd1));
            S[t].csum = wave_sum(S[t].cf0 + S[t].cf1); }
        unsigned cpk[ENT]; float cscale[ENT]; int csumq[ENT];
#pragma unroll
        for (int t = 0; t < ENT; ++t) { const float cm = wave_max(fmaxf(fabsf(S[t].cf0), fabsf(S[t].cf1))); const float inv = cm > 0.f ? 127.0f / cm : 0.f; cscale[t] = cm * (1.0f / 127.0f);
            const int c0 = (int)rintf(S[t].cf0 * inv), c1 = (int)rintf(S[t].cf1 * inv);
            { int sq = c0 + c1;
#pragma unroll
              for (int o = 1; o < 64; o <<= 1) sq += __shfl_xor(sq, o);
              csumq[t] = sq; }
            unsigned pk = 0u;
#pragma unroll
            for (int i = 0; i < 4; ++i) { const int p = 8 * ((lane & 31) >> 1) + (lane & 1) + 2 * i; const int a = __shfl(c0, p & 63), bq = __shfl(c1, p & 63); pk |= ((unsigned)((p < 64 ? a : bq) & 0xff)) << (8 * i); }
            cpk[t] = pk; }
#pragma unroll 1
        for (int hq = 0; hq < 2; ++hq) {
            int y[ENT][32];
#pragma unroll
            for (int t = 0; t < ENT; ++t)
#pragma unroll
                for (int i = 0; i < 32; ++i) y[t][i] = 0;
            v4u uq[ENT][4];
#pragma unroll
            for (int t = 0; t < ENT; ++t) u_load(rsu, S[t], 0, hq, lane, uq[t]);
            for (int kb = 0; kb < 128; kb += 8) { const int kn = kb + 8 < 128 ? kb + 8 : 120;
#pragma unroll
                for (int t = 0; t < ENT; ++t) {
                    const unsigned clo = (unsigned)__builtin_amdgcn_readlane((int)cpk[t], (kb >> 2) & 31), chi = (unsigned)__builtin_amdgcn_readlane((int)cpk[t], ((kb >> 2) & 31) + 1);
                    const int cw = (int)(lane < 32 ? clo : chi);
                    const unsigned a0[4] = {uq[t][0].x, uq[t][0].y, uq[t][0].z, uq[t][0].w}, a1[4] = {uq[t][1].x, uq[t][1].y, uq[t][1].z, uq[t][1].w}, a2[4] = {uq[t][2].x, uq[t][2].y, uq[t][2].z, uq[t][2].w}, a3[4] = {uq[t][3].x, uq[t][3].y, uq[t][3].z, uq[t][3].w};
#pragma unroll
                    for (int w = 0; w < 4; ++w) {
                        const unsigned x0 = __builtin_amdgcn_perm(a1[w], a0[w], 0x05010400u), x1 = __builtin_amdgcn_perm(a1[w], a0[w], 0x07030602u), x2 = __builtin_amdgcn_perm(a3[w], a2[w], 0x05010400u), x3 = __builtin_amdgcn_perm(a3[w], a2[w], 0x07030602u);
                        const unsigned tb[4] = {__builtin_amdgcn_perm(x2, x0, 0x05040100u), __builtin_amdgcn_perm(x2, x0, 0x07060302u), __builtin_amdgcn_perm(x3, x1, 0x05040100u), __builtin_amdgcn_perm(x3, x1, 0x07060302u)};
#pragma unroll
                        for (int b = 0; b < 4; ++b) {
                            y[t][8 * w + b] = __builtin_amdgcn_sdot4((int)(tb[b] ^ 0x80808080u), cw, y[t][8 * w + b], false);
                            y[t][8 * w + 4 + b] = __builtin_amdgcn_sdot4((int)((tb[b] >> 4) & 0x0F0F0F0Fu), cw, y[t][8 * w + 4 + b], false); } }
                    u_load(rsu, S[t], kn, hq, lane, uq[t]); } }
#pragma unroll
            for (int t = 0; t < ENT; ++t) {
#pragma unroll
                for (int i = 0; i < 32; ++i) y[t][i] += __shfl_xor(y[t][i], 32);
                if (lane < 32) { bf16* hp = c.h2b + (size_t)(tok0 + t) * D + hq * 1024 + 32 * lane; const float sc = cscale[t]; const int corr = 8 * csumq[t];
                    const bf16* hb = c.h1n + (size_t)(tok0 + t) * D + hq * 1024 + 32 * lane;
#pragma unroll
                    for (int g8 = 0; g8 < 4; ++g8) { const v4u hw = *(const v4u*)(hb + 8 * g8); const int yb = 8 * g8; v4u o;
                        int yv[8];
#pragma unroll
                        for (int b = 0; b < 4; ++b) { yv[b] = y[t][yb + b] - 16 * y[t][yb + 4 + b] + 15 * corr; yv[4 + b] = y[t][yb + 4 + b] - corr; }
                        o.x = pkbf(bflo(hw.x) + (float)yv[0] * sc, bfhi(hw.x) + (float)yv[1] * sc); o.y = pkbf(bflo(hw.y) + (float)yv[2] * sc, bfhi(hw.y) + (float)yv[3] * sc);
                        o.z = pkbf(bflo(hw.z) + (float)yv[4] * sc, bfhi(hw.z) + (float)yv[5] * sc); o.w = pkbf(bflo(hw.w) + (float)yv[6] * sc, bfhi(hw.w) + (float)yv[7] * sc);
                        *(v4u*)(hp + yb) = o; } } }
        }
        __builtin_amdgcn_fence(__ATOMIC_RELEASE, "workgroup"); asm volatile("s_waitcnt vmcnt(0)" ::: "memory"); __builtin_amdgcn_fence(__ATOMIC_ACQUIRE, "workgroup");
#pragma unroll
        for (int t = 0; t < ENT; ++t) tokq_final(c, tok0 + t, lane);
      }
    }
}


#define GAS __attribute__((address_space(1)))
#define XB_TMO      128
#define XB_XCNT(j)  (256  + 64 * (j))
#define XB_XSUB(j)  (1280 + 64 * (j))
#define XB_XGEN(j)  (2304 + 64 * (j))
#define XB_TOP      3328
#define XB_TOPGEN   3392
#define XCD_BAR_WORDS 3456
#define XB_SPIN_CAP (1u << 18)

__device__ __forceinline__ unsigned xb_ld(unsigned* p)              { return __hip_atomic_load(p, __ATOMIC_RELAXED, __HIP_MEMORY_SCOPE_AGENT); }
__device__ __forceinline__ unsigned xb_add(unsigned* p, unsigned v) { return __hip_atomic_fetch_add(p, v, __ATOMIC_RELAXED, __HIP_MEMORY_SCOPE_AGENT); }
__device__ __forceinline__ unsigned xb_xcc_id() { return (unsigned)__builtin_amdgcn_s_getreg((3 << 11) | 20) & 0xFu; }
#define XB_SPIN(cond, bar) do { unsigned _sp = 0; while (cond) { __builtin_amdgcn_s_sleep(1); \
    if ((++_sp & 255u) == 0u) { if (xb_ld(&(bar)[XB_TMO])) break; if (_sp > XB_SPIN_CAP) { atomicAdd(&(bar)[XB_TMO], 1u); break; } } } } while (0)

struct XcdBarrier {
    unsigned* bar; unsigned x;
    volatile LAS unsigned* st;
};

__device__ __forceinline__ XcdBarrier xcd_barrier_post(unsigned* bar, volatile LAS unsigned* st) {
    XcdBarrier b; b.bar = bar; b.x = xb_xcc_id(); b.st = st;
    if (threadIdx.x == 0) (void)xb_add(&bar[XB_XCNT(b.x)], 1u);
    return b;
}
__device__ __forceinline__ void xcd_barrier_complete(unsigned* bar, unsigned x, unsigned& nloc, unsigned& nx) {
    const unsigned G = gridDim.x * gridDim.y * gridDim.z;
    unsigned sum, cnt, mine, sp = 0u;
    for (;;) {
        sum = 0u; cnt = 0u; mine = 0u;
#pragma unroll
        for (unsigned j = 0; j < 16; ++j) { const unsigned c = xb_ld(&bar[XB_XCNT(j)]); sum += c; cnt += (c > 0u) ? 1u : 0u; mine = (j == x) ? c : mine; }
        if (sum == G) break;
        __builtin_amdgcn_s_sleep(1);
        if ((++sp & 255u) == 0u) { if (xb_ld(&bar[XB_TMO])) break; if (sp > XB_SPIN_CAP) { atomicAdd(&bar[XB_TMO], 1u); break; } }
    }
    nloc = mine > 0u ? mine : 1u; nx = cnt > 0u ? cnt : 1u;
}

__device__ __forceinline__ void xcd_barrier(const XcdBarrier& b) {
    asm volatile("s_waitcnt vmcnt(0)" ::: "memory");
    __syncthreads();
    if (threadIdx.x == 0) {
        unsigned* bar = b.bar;
        __builtin_amdgcn_s_waitcnt(0);
        unsigned nloc = b.st[0], nx = b.st[1];
        if (nloc == 0u) { xcd_barrier_complete(bar, b.x, nloc, nx); b.st[0] = nloc; b.st[1] = nx; }
        const unsigned old = xb_add(&bar[XB_XSUB(b.x)], 1u);
        const unsigned gen = old / nloc;
        if (old + 1u == (gen + 1u) * nloc) {
            __builtin_amdgcn_fence(__ATOMIC_RELEASE, "agent");
            asm volatile("s_waitcnt vmcnt(0)" ::: "memory");
            const unsigned og = xb_add(&bar[XB_TOP], 1u);
            const unsigned tg = og / nx;
            if (og + 1u == (tg + 1u) * nx) xb_add(&bar[XB_TOPGEN], 1u);
            else XB_SPIN(xb_ld(&bar[XB_TOPGEN]) == tg, bar);
            __builtin_amdgcn_fence(__ATOMIC_ACQUIRE, "agent");
            xb_add(&bar[XB_XGEN(b.x)], 1u);
            asm volatile("s_waitcnt vmcnt(0)" ::: "memory");
        } else {
            XB_SPIN(xb_ld(&bar[XB_XGEN(b.x)]) == gen, bar);
            __builtin_amdgcn_fence(__ATOMIC_ACQUIRE, "agent");
            asm volatile("s_waitcnt vmcnt(0)" ::: "memory");
        }
    }
    __syncthreads();
}

__device__ __forceinline__ void group_sync(unsigned* gword, unsigned target, bool same_xcd) {
    asm volatile("s_waitcnt vmcnt(0)" ::: "memory");
    __syncthreads();
    if (threadIdx.x == 0) {
        __builtin_amdgcn_s_waitcnt(0);
        if (!same_xcd) { __builtin_amdgcn_fence(__ATOMIC_RELEASE, "agent");
            asm volatile("s_waitcnt vmcnt(0)" ::: "memory"); }
        (void)xb_add(gword, 1u);
        unsigned sp = 0u; while (xb_ld(gword) < target) { __builtin_amdgcn_s_sleep(1); if (++sp > (1u << 24)) break; }
        __builtin_amdgcn_fence(__ATOMIC_ACQUIRE, "agent");
        asm volatile("s_waitcnt vmcnt(0)" ::: "memory");
    }
    __syncthreads();
}

struct Args { const float* in[20]; float* out; unsigned char* ws; int ph_lo, ph_hi; };
constexpr int NPHASES = 16;
__global__ void __launch_bounds__(NTHREADS, 2) fwd_kernel(Args args) {
    extern __shared__ __attribute__((aligned(16))) unsigned char lds_raw[];
    LAS unsigned char* lds = (LAS unsigned char*)lds_raw;
    cg::grid_group grid = cg::this_grid();
    Ctx c;
    c.x = args.in[0]; c.p = args.in[1]; c.g_mix = args.in[2]; c.w_in = args.in[3]; c.ln_g = args.in[4]; c.ln_b = args.in[5]; c.sgu_w = args.in[6]; c.sgu_b = args.in[7];
    c.w_ba = args.in[8]; c.w_bs = args.in[9]; c.w_out = args.in[10]; c.g_ffn = args.in[11]; c.w_pq = args.in[12]; c.subk = args.in[13]; c.dn = args.in[14]; c.up = args.in[15];
    c.g_ple = args.in[16]; c.w_pp = args.in[17]; c.w_pg = args.in[18]; c.g_fin = args.in[19];
    c.out = args.out;
    unsigned char* ws = args.ws;
    c.WinT = (bf16*)(ws + WS_WIN); c.WbaT = (bf16*)(ws + WS_WBA); c.WbsT = (bf16*)(ws + WS_WBS); c.WoutT = (bf16*)(ws + WS_WOUT); c.WqT = (bf16*)(ws + WS_WQ); c.WgT = (bf16*)(ws + WS_WG); c.WprojT = (bf16*)(ws + WS_WPROJ);
    c.pb = (bf16*)(ws + WS_PB); c.skb = (bf16*)(ws + WS_SKB); c.kmean = (float*)(ws + WS_KMEAN); c.xn = (bf16*)(ws + WS_XN); c.proj = (bf16*)(ws + WS_PROJ); c.vT = (bf16*)(ws + WS_VT);
    c.yatt = (bf16*)(ws + WS_YATT); c.ysgu = (bf16*)(ws + WS_YSGU); c.merged = (bf16*)(ws + WS_MERGED); c.h1n = (bf16*)(ws + WS_H1N); c.qp = (bf16*)(ws + WS_QP);
    c.dn8 = ws + WS_DN8; c.up8 = ws + WS_UP8; c.sdn = (float*)(ws + WS_SDN); c.sup = (float*)(ws + WS_SDN) + NEXP; c.rss = (float*)(ws + WS_RSS); c.h2n = (bf16*)(ws + WS_H2N); c.gtmp = (bf16*)(ws + WS_GTMP); c.eid = (int*)(ws + WS_EID); c.egate = (float*)(ws + WS_EGATE); c.sel = (int*)(ws + WS_SEL); c.lse = (float*)(ws + WS_LSE);
    c.h2b = (bf16*)(ws + WS_H2B); c.WcatT8 = ws + WS_WBA; c.bs = (float*)(ws + 100 * MiB);        c.mq8 = ws + 240 * MiB; c.xq8g = ws + 208 * MiB; c.hidb = (int*)(ws + 416 * MiB); c.sxg = (float*)(ws + 424 * MiB); c.xsg = (int*)(ws + 425 * MiB);   c.sst = (float*)(ws + 468 * MiB); c.kmp = (float*)(ws + 470 * MiB); c.swb = (bf16*)(ws + WS_SKB + 512 * 1024); c.xq8 = ws + WS_XN; c.WinT8 = ws + WS_WIN; c.WgT8 = ws + WS_WG; c.h2q8 = ws + WS_H2N; c.xs = (float*)(ws + WS_SC); c.h2s = c.xs + T; c.wcs = c.h2s + T; c.gcs = c.wcs + INW; c.qcs = c.gcs + D; c.h1s = c.qcs + D; c.ocs = c.h1s + T; c.ms = c.ocs + D; c.bcs = c.ms + T; c.WoutT8 = ws + WS_WOUT; c.WqT8 = ws + WS_WQ; c.h1q8 = ws + WS_H1N;
    c.G = gridDim.x; c.bid = blockIdx.x; c.tid = threadIdx.x; c.lane = c.tid & 63; c.wave = __builtin_amdgcn_readfirstlane(c.tid >> 6);
    const int lo = args.ph_lo, hi = args.ph_hi;
    volatile LAS unsigned* xst = (volatile LAS unsigned*)(lds + LDS_BYTES - 64);
    if (c.tid < 2) xst[c.tid] = 0u;
    __syncthreads();
    XcdBarrier xbar = xcd_barrier_post((unsigned*)(ws + WS_CTL), xst);
#ifndef PHASE_MASK
#define PHASE_MASK 0xFFFFFFFu
#endif
#ifndef REP_MASK
#define REP_MASK 0u
#endif
#define IN(k) ((((PHASE_MASK) >> (k)) & 1u) && lo <= (k) && (k) < hi)
#define NAIVE(k) (((NAIVE_MASK) >> (k)) & 1u)
#define REP(k) for (int _rep = 0; _rep < 1 + (int)(((REP_MASK) >> (k)) & 1u); ++_rep)
    const bool single = (hi - lo) > 1;
    bool first_sync = true;
    c.grp = (GROUP_SYNC && single && c.G == 256) ? 1 : 0; c.pm = 8 * (c.bid & 7) + ((c.bid >> 3) & 7); c.kq = c.bid >> 6;
    unsigned* gword = (unsigned*)(ws + WS_CTL) + 28672 + 32 * c.pm; unsigned gepoch = 0u;
    if (c.grp && c.tid == 0) __hip_atomic_store(gword + 1 + c.kq, xb_xcc_id() + 1u, __ATOMIC_RELAXED, __HIP_MEMORY_SCOPE_AGENT);
    bool gsame = false;
#define GRSYNC() do { if (c.grp) { ++gepoch; group_sync(gword, gepoch * 4u, gsame); } else GSYNC(); } while (0)
#define GSYNC() do { if (single) { if ((first_sync && !ALL_XCD) || !USE_XCDBAR) grid.sync(); else xcd_barrier(xbar); first_sync = false; } } while (0)
    unsigned* kcnt = (unsigned*)(ws + WS_CTL) + 8192; unsigned* qctr = (unsigned*)(ws + WS_CTL) + 8256;
    unsigned* cam = (unsigned*)(ws + WS_CTL) + 9216;
    if (IN(0)) REP(0) { __syncthreads(); phase_prologue(c, lds, cam); }
    if (IN(0)) GSYNC();
    if (IN(15)) REP(15) { __syncthreads(); phase_prologue2(c, lds, cam); }
    if (IN(15)) GSYNC();
#ifdef PAD_NOPS
    if (IN(1)) { asm volatile(".fill %0, 4, 0xbf800000" :: "n"(PAD_NOPS)); }
#endif
    if (IN(1)) REP(1) { __syncthreads(); run_gemm_in(lds, c, _rep); }
    if (IN(1)) GSYNC();
#ifndef P2_REP_PARTS
#define P2_REP_PARTS 7
#endif
    if (IN(2)) REP(2) { __syncthreads(); const int parts = _rep == 0 ? 7 : P2_REP_PARTS;
        if (parts & 2) { if (NAIVE(2)) naive_sgu(c, lds); else phase_sgu(c, lds); } if (parts & 4) phase_select(c, kcnt);
        if (LATE_W && _rep == 0) { __syncthreads(); phase_prologue2(c, lds, cam, true); } }
    if (IN(2)) GSYNC();
    if (IN(3)) REP(3) { __syncthreads(); if (NAIVE(3)) naive_attn(c, lds); else phase_attn(c, lds, qctr + 64 * _rep, _rep == 1 && ATT_PROBE_SKIPC, _rep == 1 && ATT_PROBE_SKIPQ); }
    if (IN(3)) GSYNC();
    if (IN(14)) REP(14) { if (!NAIVE(3)) phase_attn_combine(c); }
    if (IN(14)) GSYNC();
    if (c.grp) { const unsigned i0 = xb_ld(gword + 1), i1 = xb_ld(gword + 2), i2 = xb_ld(gword + 3), i3 = xb_ld(gword + 4); gsame = (i0 != 0u) && (i0 == i1) && (i0 == i2) && (i0 == i3); }
#if BI8
    if (IN(5)) {
        int Kk = D; asm volatile("" : "+s"(Kk)); pg8::Gemm g{(const bf16*)c.proj, (const bf16*)c.WcatT8, T, D, Kk, nullptr, PST * 2, D}; pg8::StaticOrder S; S.init(T, D, c.G, c.bid);
        pg8::gemm_phase_i8<EpiBranchI, pg8::StaticOrder, GI8_ALIGN, true>((PG8_LAS unsigned char*)lds, g, S, EpiBranchI{c.proj, c.merged, c.bs, c.bcs}); }
#else
    if (IN(5)) REP(5) { __syncthreads(); int Kk = D; asm volatile("" : "+s"(Kk)); pg8::Gemm g{c.yatt, c.WbaT, T, D, Kk, c.ysgu, 1024}; pg8::StaticOrder S; S.init(T, D, c.G, c.bid);
                 pg8::gemm_phase<EpiBranch, pg8::StaticOrder, true, true>((PG8_LAS unsigned char*)lds, g, S, EpiBranch{c.proj, c.merged}); }
#endif
    if (IN(5)) GSYNC();
#if OI8
    if (IN(6)) { { phase_quant_merged(c); GRSYNC();
            int Kk = D; asm volatile("" : "+s"(Kk)); pg8::Gemm g{(const bf16*)c.mq8, (const bf16*)c.WoutT8, T, D, Kk, nullptr, Kk}; pg8::StaticOrder S; S.init(T, D, c.G, c.bid);
            pg8::gemm_phase_i8<EpiF5i, pg8::StaticOrder, GI8_ALIGN, true>((PG8_LAS unsigned char*)lds, g, S, EpiF5i{c.x, c.h1n, c.rss, c.ms, c.ocs}); } }
#else
    if (IN(6)) REP(6) { __syncthreads(); int Kk = D; asm volatile("" : "+s"(Kk)); pg8::Gemm g{c.merged, c.WoutT, T, D, Kk, c.merged + D / 2, D}; pg8::StaticOrder S; S.init(T, D, c.G, c.bid);
                 pg8::gemm_phase<EpiF5, pg8::StaticOrder, true, true>((PG8_LAS unsigned char*)lds, g, S, EpiF5{c.x, c.out, c.h1n, c.rss}); }
#endif
    if (IN(6)) GRSYNC();
#if QI8
    if (IN(8)) { phase_quant_h1(c); }
    if (IN(8)) GRSYNC();
    if (IN(8)) REP(8) { __syncthreads(); run_gemm_i8(lds, c.xq8g, c.WqT8, c.h1s, c.qcs, T, D, D, F6{c.qp}, c.G, c.bid);
#else
    if (IN(8)) REP(8) { __syncthreads(); run_gemm(false, lds, c.h1n, c.WqT, T, D, D, F6{c.qp}, c.G, c.bid);
#endif
        asm volatile("s_waitcnt vmcnt(0)" ::: "memory"); __syncthreads();
        if (c.tid == 0) __builtin_amdgcn_fence(__ATOMIC_ACQUIRE, "agent");
        asm volatile("s_waitcnt vmcnt(0)" ::: "memory"); __syncthreads();
        pg8::StaticOrder S; S.init(T, D, c.G, c.bid); pg8::Unit u;
        for (int i = 0; S.next(i, u); ++i) peer_topk_task(c, u.pm * 8 + c.wave, u.pn); }
    if (IN(8)) GRSYNC();
#ifdef EXP_DUMMY_MASK
    if (IN(10)) { phase_peer_experts(c, EXP_DUMMY_MASK); __syncthreads(); }
#endif
#if EXP_PART
    if (IN(10)) { phase_exp_pre(c); }
    if (IN(10)) GSYNC();
    if (IN(10)) { phase_exp_down(c, lds); }
    if (IN(10)) GSYNC();
    if (IN(10)) { phase_exp_up(c); }
#else
#if EXP_SPLIT
    if (IN(10)) { if ((T / ENT) == c.G * 8 * NP) { phase_peer_experts(c, 0xFFFFu, 1); GSYNC(); phase_peer_experts(c, 0xFFFFu, 2); } else phase_peer_experts(c); }
#else
    if (IN(10)) REP(10) { phase_peer_experts(c); }
#endif
#endif
    if (IN(10)) GRSYNC();
    if (IN(11)) REP(11) { __syncthreads(); run_gemm_i8(lds, c.h2q8, c.WgT8, c.h2s, c.gcs, T, D, D, F9a{c.gtmp}, c.G, c.bid); }
    if (IN(11) && NAIVE(11) != NAIVE(12)) GSYNC();
    if (IN(12)) { int Kk = PLE; asm volatile("" : "+s"(Kk)); pg8::Gemm g{c.pb, c.WprojT, T, D, Kk, c.pb + PLE / 2, PLE}; pg8::StaticOrder S; S.init(T, D, c.G, c.bid);
                  pg8::gemm_phase<Epi9b, pg8::StaticOrder, true, true>((PG8_LAS unsigned char*)lds, g, S, Epi9b{c.gtmp, c.h2b}); }
    if (IN(12)) GRSYNC();
#ifdef BENCH_OP
    if (IN(13)) {
        unsigned a[16];
#pragma unroll
        for (int i = 0; i < 16; ++i) a[i] = c.tid * 2654435761u + i;
        unsigned b = c.lane * 40503u + 77u, sel = 0x05010400u;
#pragma unroll 1
        for (int it = 0; it < 4000; ++it) {
#pragma unroll
            for (int i = 0; i < 16; ++i) {
#if BENCH_OP == 0
                a[i] = (unsigned)__builtin_amdgcn_sdot4((int)a[i], (int)b, (int)a[i], false);
#elif BENCH_OP == 1
                a[i] = __builtin_amdgcn_perm(a[i], b, sel);
#elif BENCH_OP == 2
                a[i] = (a[i] >> 4) & 0x0F0F0F0Fu;  a[i] += b;
#elif BENCH_OP == 3
                a[i] = (unsigned)__shfl_xor((int)a[i], 16);
#elif BENCH_OP == 4
                a[i] = (unsigned)__builtin_amdgcn_readlane((int)a[i], it & 63) + b;
#elif BENCH_OP == 5
                a[i] = __float_as_uint(__uint_as_float(a[i]) * 1.0001f + 0.5f);
#elif BENCH_OP == 6
                a[i] = __float_as_uint(__builtin_amdgcn_exp2f(__uint_as_float(a[i])));
#elif BENCH_OP == 7
                a[i] = __float_as_uint(__builtin_amdgcn_rcpf(__uint_as_float(a[i])));
#elif BENCH_OP == 8
                { _Float16 hx = __builtin_bit_cast(_Float16, (unsigned short)(a[i] & 0xffffu)); hx = __builtin_exp2f16(hx); a[i] = (a[i] & 0xffff0000u) | (unsigned)__builtin_bit_cast(unsigned short, hx); }
#endif
            }
        }
        unsigned s = 0;
#pragma unroll
        for (int i = 0; i < 16; ++i) s ^= a[i];
        if (s == 0x12345679u) c.out[0] = 1.0f;
        __syncthreads();
    }
#endif
    if (IN(13)) { phase_final(c); }
#if DEBUG_CHECK
    {
        float* dbg = (float*)(ws + WS_KMEAN + 512 * 1024);
        const int gw = c.bid * 8 + c.wave, NGW = c.G * 8;
        if (IN(0)) { for (int i = c.bid * NTHREADS + c.tid; i < T; i += c.G * NTHREADS) dbg[i] = 0.f; }
        if (IN(3)) { __syncthreads(); Ctx c2 = c; c2.yatt = (bf16*)(ws + 434 * MiB); naive_attn(c2, lds); }
        if (IN(20)) { const bf16* ya = (const bf16*)(ws + 434 * MiB);
            for (int t = gw; t < T; t += NGW) { float sa = 0.f;
                for (int cc = c.lane; cc < 1024; cc += 64) { const float d1 = bf2f(c.yatt[(size_t)t * 1024 + cc]) - bf2f(ya[(size_t)t * 1024 + cc]); sa += d1 * d1; }
                sa = wave_sum(sa); if (c.lane == 0) dbg[t] += DBG_GA * sa; } }
        if (IN(22)) { for (int t = c.bid * NTHREADS + c.tid; t < T; t += c.G * NTHREADS) c.out[(size_t)t * D] += sqrtf(dbg[t]); }
    }
#endif
#undef IN
#undef GSYNC
#undef NAIVE
}

extern "C" void kernel_launch(void* const* d_in, const int* in_sizes, int n_in, void* d_out, int out_size, void* d_ws, size_t ws_size, hipStream_t stream) {
    static int grid = 0;
    if (grid == 0) {
        if (n_in != 20 || out_size != T * D || ws_size < WS_END) { fprintf(stderr, "kernel_launch: unexpected shapes (n_in %d, out %d, ws %zu)\n", n_in, out_size, ws_size); grid = -1; return; }
        int dev = 0, cus = 0, per_cu = 0;
        if (hipGetDevice(&dev) != hipSuccess || hipDeviceGetAttribute(&cus, hipDeviceAttributeMultiprocessorCount, dev) != hipSuccess) { grid = -1; return; }
        if (hipFuncSetAttribute((const void*)fwd_kernel, hipFuncAttributeMaxDynamicSharedMemorySize, LDS_BYTES) != hipSuccess) { fprintf(stderr, "kernel_launch: hipFuncSetAttribute failed\n"); grid = -1; return; }
        if (hipOccupancyMaxActiveBlocksPerMultiprocessor(&per_cu, (const void*)fwd_kernel, NTHREADS, LDS_BYTES) != hipSuccess || per_cu < 1) { fprintf(stderr, "kernel_launch: occupancy query says %d blocks per CU\n", per_cu); per_cu = 1; }
        (void)hipGetLastError();
        grid = cus;
    }
    if (grid < 0) return;
    if (hipMemsetAsync((char*)d_ws + WS_CTL, 0, 131072, stream) != hipSuccess) { fprintf(stderr, "kernel_launch: memset failed\n"); return; }
    Args a{};
    for (int i = 0; i < 20; ++i) a.in[i] = (const float*)d_in[i];
    a.out = (float*)d_out; a.ws = (unsigned char*)d_ws;
#if MK_SINGLE
    a.ph_lo = 0; a.ph_hi = NPHASES;
    void* kargs[] = {&a};
    hipError_t e = hipLaunchCooperativeKernel((const void*)fwd_kernel, dim3(grid), dim3(NTHREADS), kargs, LDS_BYTES, stream);
    if (e != hipSuccess) fprintf(stderr, "kernel_launch: cooperative launch failed: %s (grid %d)\n", hipGetErrorString(e), grid);
#else
#if DEBUG_CHECK
    const int order[] = {0, 15, 1, 2, 3, 14, 20, 5, 6, 8, 10, 11, 12, 13, 22};
    for (int ph : order) { a.ph_lo = ph; a.ph_hi = ph + 1; hipLaunchKernelGGL(fwd_kernel, dim3(grid), dim3(NTHREADS), LDS_BYTES, stream, a); }
#else
    const int order[] = {0, 15, 1, 2, 3, 14, 5, 6, 8, 10, 11, 12, 13};
    for (int ph : order) { a.ph_lo = ph; a.ph_hi = ph + 1; hipLaunchKernelGGL(fwd_kernel, dim3(grid), dim3(NTHREADS), LDS_BYTES, stream, a); }
#endif
#endif
}
```
